# Optimizing an MI355X kernel written in HIP

```python
import math
import jax, jax.numpy as jnp
from jax import lax
import numpy as np

D_MODEL = 1024
BATCH = 4
SEQ = 8192
DEPTH = 2

HEAD_DIM = 64
A_GROUPS = 4
A_WIDTH = A_GROUPS * HEAD_DIM
A_CHUNK = 128
B_Q_HEADS = 8
B_KV_HEADS = 2
B_GROUP = B_Q_HEADS // B_KV_HEADS
B_WIDTH = B_Q_HEADS * HEAD_DIM
B_KV_WIDTH = B_KV_HEADS * HEAD_DIM
WINDOW = 128
REL_BUCKETS = 32
REL_MAX_DIST = 128
C_HEADS = 4
C_KEY_DIM = 64
C_VAL_DIM = 64
C_KEY_WIDTH = C_HEADS * C_KEY_DIM
C_WIDTH = C_HEADS * C_VAL_DIM
C_CHUNK = 16
MIX_WIDTH = A_WIDTH + B_WIDTH + C_WIDTH
IN_WIDTH = 2 * A_WIDTH + B_WIDTH + 2 * B_KV_WIDTH + 2 * C_KEY_WIDTH + 2 * C_WIDTH
D_FF = 2816
CONV_WIDTH = 3
EPS = 1e-6
MASK_VALUE = -1e30

kernel_name = "hybrid_gmlp_swa_hgrn2_block"


def rms_norm(x, g):
    xf = x.astype(jnp.float32)
    y = xf * lax.rsqrt(jnp.mean(xf * xf, axis=-1, keepdims=True) + EPS)
    return (y * g.astype(jnp.float32)).astype(x.dtype)


def spatial_gating_mixer(u, v, vnorm_g, w_s, b_s):
    B, S = u.shape[:2]
    n_chunks = S // A_CHUNK
    v = rms_norm(v, vnorm_g)
    causal = jnp.tril(jnp.ones((A_CHUNK, A_CHUNK), dtype=bool))
    w = jnp.where(causal, w_s, jnp.zeros_like(w_s))
    vc = v.reshape(B, n_chunks, A_CHUNK, A_GROUPS, HEAD_DIM)
    sv = jnp.einsum('gts,bcsgd->bctgd', w, vc) + b_s.T[:, :, None]
    return (u.reshape(vc.shape) * sv).reshape(B, S, A_WIDTH)


def t5_causal_bucket(dist):
    max_exact = REL_BUCKETS // 2
    n = jnp.maximum(dist, 0)
    is_small = n < max_exact
    nf = jnp.maximum(n, 1).astype(jnp.float32)
    large = max_exact + (jnp.log(nf / max_exact) / math.log(REL_MAX_DIST / max_exact)
                         * (REL_BUCKETS - max_exact)).astype(jnp.int32)
    large = jnp.minimum(large, REL_BUCKETS - 1)
    return jnp.where(is_small, n, large)


def sliding_window_attention(q, k, v, qn_g, kn_g, sinks, rel_bias):
    f32 = jnp.float32
    B, S = q.shape[:2]
    nb = S // WINDOW
    q = rms_norm(q, qn_g).astype(f32)
    k = rms_norm(k, kn_g).astype(f32)
    v = v.astype(f32)
    qb = q.reshape(B, nb, WINDOW, B_KV_HEADS, B_GROUP, HEAD_DIM)

    def banded(t):
        tb = t.reshape(B, nb, WINDOW, B_KV_HEADS, HEAD_DIM)
        prev = jnp.concatenate([jnp.zeros_like(tb[:, :1]), tb[:, :-1]], axis=1)
        return jnp.concatenate([prev, tb], axis=2)

    kw, vw = banded(k), banded(v)
    scores = jnp.einsum('bnihgd,bnjhd->bhgnij', qb, kw) * (HEAD_DIM ** -0.5)
    qi = jnp.arange(WINDOW)[:, None]
    kj = jnp.arange(2 * WINDOW)[None, :]
    dist = qi + WINDOW - kj
    bias = rel_bias.astype(f32)[t5_causal_bucket(dist)]
    bias = bias.reshape(WINDOW, 2 * WINDOW, B_KV_HEADS, B_GROUP).transpose(2, 3, 0, 1)[:, :, None]
    blk = jnp.arange(nb)[:, None, None]
    valid = (dist >= 0) & (dist < WINDOW) & (blk * WINDOW - WINDOW + kj >= 0)
    scores = jnp.where(valid, scores + bias, MASK_VALUE)
    sink = sinks.astype(f32).reshape(B_KV_HEADS, B_GROUP, 1, 1, 1)
    m = jnp.maximum(scores.max(axis=-1, keepdims=True), sink)
    p = jnp.exp(scores - m)
    denom = p.sum(axis=-1, keepdims=True) + jnp.exp(sink - m)
    o = jnp.einsum('bhgnij,bnjhd->bnihgd', p / denom, vw)
    return o.reshape(B, S, B_WIDTH)


def hgrn2_mixer(q, fz, i, g, lb, onorm_g):
    f32 = jnp.float32
    B, S = q.shape[:2]
    N = S // C_CHUNK
    lb = lb.astype(f32)
    z = fz.astype(f32)
    q = jax.nn.silu(q.astype(f32))
    log_f = jnp.logaddexp(jnp.log(lb), jnp.log1p(-lb) + jax.nn.log_sigmoid(z))
    k = (1.0 - lb) * jax.nn.sigmoid(-z)
    shp = (B, N, C_CHUNK, C_HEADS, C_KEY_DIM)
    q, k, log_f = q.reshape(shp), k.reshape(shp), log_f.reshape(shp)
    v = i.astype(f32).reshape(B, N, C_CHUNK, C_HEADS, C_VAL_DIM)
    cum = jnp.cumsum(log_f, axis=2)
    causal = jnp.tril(jnp.ones((C_CHUNK, C_CHUNK), dtype=bool))[:, :, None, None]
    rel = jnp.exp(jnp.where(causal, cum[:, :, :, None] - cum[:, :, None, :], -jnp.inf))
    attn = jnp.einsum('bnthk,bntshk,bnshk->bnhts', q, rel, k)
    o = jnp.einsum('bnhts,bnshv->bnthv', attn, v)
    last = cum[:, :, -1]
    w_k = k * jnp.exp(last[:, :, None] - cum)
    dstate = jnp.einsum('bnshk,bnshv->nbhkv', w_k, v)
    decay = jnp.exp(last).transpose(1, 0, 2, 3)

    def step(state, inp):
        dec, ds = inp
        return dec[..., None] * state + ds, state

    init = jnp.zeros((B, C_HEADS, C_KEY_DIM, C_VAL_DIM), f32)
    _, s_in = lax.scan(step, init, (decay, dstate))
    o = o + jnp.einsum('bnthk,nbhkv->bnthv', q * jnp.exp(cum), s_in)
    o = o.reshape(B, S, C_HEADS, C_VAL_DIM)
    o = rms_norm(o, onorm_g) * jax.nn.silu(g.astype(f32))
    return o.reshape(B, S, C_WIDTH)


def conv_ffn(h, w_gate, w_up, conv_w, conv_b, w_down):
    S = h.shape[1]
    gate = h @ w_gate
    gp = jnp.pad(gate, ((0, 0), (CONV_WIDTH - 1, 0), (0, 0)))
    conv = conv_b
    for tap in range(CONV_WIDTH):
        conv = conv + conv_w[tap] * gp[:, tap:tap + S]
    return (jax.nn.silu(conv) * (h @ w_up)) @ w_down


def setup_inputs(seed: int = 0) -> dict:
    key = jax.random.key(seed)
    ks = jax.random.split(key, 20)
    nrm = jax.random.normal
    f32 = jnp.float32
    return {
        "x": nrm(ks[0], (BATCH, SEQ, D_MODEL), f32),
        "norm1_g": 1.0 + 0.02 * nrm(ks[1], (DEPTH, D_MODEL), f32),
        "w_in": nrm(ks[2], (DEPTH, D_MODEL, IN_WIDTH), f32) * D_MODEL ** -0.5,
        "gmlp_vnorm_g": 1.0 + 0.02 * nrm(ks[3], (DEPTH, A_GROUPS, HEAD_DIM), f32),
        "gmlp_w_s": nrm(ks[4], (DEPTH, A_GROUPS, A_CHUNK, A_CHUNK), f32) * A_CHUNK ** -0.5,
        "gmlp_b_s": 1.0 + 0.02 * nrm(ks[5], (DEPTH, A_GROUPS, A_CHUNK), f32),
        "q_norm_g": 1.0 + 0.02 * nrm(ks[6], (DEPTH, HEAD_DIM), f32),
        "k_norm_g": 1.0 + 0.02 * nrm(ks[7], (DEPTH, HEAD_DIM), f32),
        "attn_sinks": 0.5 * nrm(ks[8], (DEPTH, B_Q_HEADS), f32),
        "rel_bias": 0.5 * nrm(ks[9], (REL_BUCKETS, B_Q_HEADS), f32),
        "hgrn_lb_logits": nrm(ks[10], (DEPTH, C_KEY_WIDTH), f32),
        "hgrn_onorm_g": 1.0 + 0.02 * nrm(ks[11], (DEPTH, C_VAL_DIM), f32),
        "w_out": nrm(ks[12], (DEPTH, MIX_WIDTH, D_MODEL), f32) * MIX_WIDTH ** -0.5,
        "norm2_g": 1.0 + 0.02 * nrm(ks[13], (DEPTH, D_MODEL), f32),
        "w_gate": nrm(ks[14], (DEPTH, D_MODEL, D_FF), f32) * D_MODEL ** -0.5,
        "w_up": nrm(ks[15], (DEPTH, D_MODEL, D_FF), f32) * D_MODEL ** -0.5,
        "conv_w": nrm(ks[16], (DEPTH, CONV_WIDTH, D_FF), f32) * CONV_WIDTH ** -0.5,
        "conv_b": 0.02 * nrm(ks[17], (DEPTH, D_FF), f32),
        "w_down": nrm(ks[18], (DEPTH, D_FF, D_MODEL), f32) * D_FF ** -0.5,
    }


def reference(x, norm1_g, w_in, gmlp_vnorm_g, gmlp_w_s, gmlp_b_s, q_norm_g, k_norm_g,
              attn_sinks, rel_bias, hgrn_lb_logits, hgrn_onorm_g, w_out, norm2_g,
              w_gate, w_up, conv_w, conv_b, w_down):
    B, S, _ = x.shape
    widths = [A_WIDTH, A_WIDTH, B_WIDTH, B_KV_WIDTH, B_KV_WIDTH,
              C_KEY_WIDTH, C_KEY_WIDTH, C_WIDTH, C_WIDTH]
    split_idx = np.cumsum(widths)[:-1].tolist()
    lb_cum = jnp.cumsum(jax.nn.softmax(hgrn_lb_logits.astype(jnp.float32), axis=0), axis=0)
    lower_bounds = lb_cum - lb_cum[0]
    for l in range(DEPTH):
        h = rms_norm(x, norm1_g[l])
        proj = h @ w_in[l]
        a_u, a_v, b_q, b_k, b_v, c_q, c_f, c_i, c_g = jnp.split(proj, split_idx, axis=-1)
        u = jax.nn.gelu(a_u, approximate=False).reshape(B, S, A_GROUPS, HEAD_DIM)
        v = jax.nn.gelu(a_v, approximate=False).reshape(B, S, A_GROUPS, HEAD_DIM)
        y_a = spatial_gating_mixer(u, v, gmlp_vnorm_g[l], gmlp_w_s[l], gmlp_b_s[l])
        y_b = sliding_window_attention(
            b_q.reshape(B, S, B_Q_HEADS, HEAD_DIM),
            b_k.reshape(B, S, B_KV_HEADS, HEAD_DIM),
            b_v.reshape(B, S, B_KV_HEADS, HEAD_DIM),
            q_norm_g[l], k_norm_g[l], attn_sinks[l], rel_bias)
        y_c = hgrn2_mixer(
            c_q.reshape(B, S, C_HEADS, C_KEY_DIM),
            c_f.reshape(B, S, C_HEADS, C_KEY_DIM),
            c_i.reshape(B, S, C_HEADS, C_VAL_DIM),
            c_g.reshape(B, S, C_HEADS, C_VAL_DIM),
            lower_bounds[l].reshape(C_HEADS, C_KEY_DIM), hgrn_onorm_g[l])
        mixed = jnp.concatenate([y_a.astype(x.dtype), y_b.astype(x.dtype), y_c.astype(x.dtype)], axis=-1)
        x = x + mixed @ w_out[l]
        h = rms_norm(x, norm2_g[l])
        x = x + conv_ffn(h, w_gate[l], w_up[l], conv_w[l], conv_b[l], w_down[l])
    return x
```

```cpp
#include <hip/hip_runtime.h>
#include <cstdio>
#include <cstdint>
#include <cmath>
namespace pg8 {
#define PG8_LAS __attribute__((address_space(3)))
typedef unsigned short bf16_t;
typedef short bf16x8 __attribute__((ext_vector_type(8)));
typedef float f32x4 __attribute__((ext_vector_type(4)));
typedef unsigned u32x4 __attribute__((ext_vector_type(4)));
constexpr int BM = 256, BK = 64, HALF = 128, HTB = HALF * BK * 2  , STAGE_BYTES = 8 * HTB, NXCD = 8, WGM = 8;

__host__ __device__ __forceinline__ int lds_byte(int r, int c) { const int st = (r >> 4) * 2 + (c >> 5), rr = r & 15, cc = c & 31, ob = rr * 64 + cc * 2; return st * 1024 + (ob ^ (((ob >> 9) & 1) << 5)); }
__host__ __device__ __forceinline__ void stage_rc(int b, int& R, int& C) { const int st = b / 1024, sb = b % 1024, swz = sb ^ (((sb >> 9) & 1) << 5); R = (st >> 1) * 16 + swz / 64; C = (st & 1) * 32 + (swz % 64) / 2; }
__host__ __device__ __forceinline__ int perm32(int rho) { const int n = rho >> 4, i = rho & 15; return 8 * (i >> 2) + 4 * n + (i & 3); }

struct Unit { int pm, pn; };
struct Gemm { const bf16_t* A; const bf16_t* Bt; int M, N, K; };

struct StaticOrder {
    int nM, nN, nwg, G, c;
    __host__ __device__ void init(int M, int N, int G_, int c_) { nM = M / BM; nN = N / BM; nwg = nM * nN; G = G_; c = c_; }
    __host__ __device__ bool next(int i, Unit& u) const {
        const long L = (long)i * G + c; if (L >= nwg) return false;
        int wgid = (int)L; { const int q = nwg / NXCD, r = nwg % NXCD, xcd = wgid % NXCD, off = wgid / NXCD; wgid = (xcd < r ? xcd * (q + 1) : r * (q + 1) + (xcd - r) * q) + off; }
        const int nig = WGM * nN, gid = wgid / nig, fm = gid * WGM, gsz = (nM - fm) < WGM ? (nM - fm) : WGM;
        u.pm = fm + ((wgid % nig) % gsz); u.pn = (wgid % nig) / gsz; return true;
    }
    __device__ __forceinline__ void a_ready(const Unit&) const {}
    __device__ __forceinline__ void done(const Unit&) const {}
};

__device__ __forceinline__ unsigned cvt_pk_bf16(float lo, float hi) { unsigned r; asm volatile("v_cvt_pk_bf16_f32 %0, %1, %2" : "=v"(r) : "v"(lo), "v"(hi)); return r; }
typedef float f32x2 __attribute__((ext_vector_type(2)));
__device__ __forceinline__ f32x2 gelu_pk(f32x2 v) {
    const f32x2 av = __builtin_elementwise_abs(v), d = av * 0.2316418882f + 1.0f;
    f32x2 t; t.x = __builtin_amdgcn_rcpf(d.x); t.y = __builtin_amdgcn_rcpf(d.y);
    f32x2 q = t * 0.5307027145f + (-0.7265760135f); q = q * t + 0.7107068705f; q = q * t + (-0.142248368f); q = q * t + 0.127414796f; q = q * t;
    const f32x2 s = (v * v) * (-0.72134752044f);
    f32x2 e; e.x = __builtin_amdgcn_exp2f(s.x); e.y = __builtin_amdgcn_exp2f(s.y);
    const f32x2 m = v * (q * e), r = v - m;
    f32x2 o; o.x = v.x < 0.f ? m.x : r.x; o.y = v.y < 0.f ? m.y : r.y; return o;
}

template <class Epi, class Sched, bool ALIGN_EPI = false, bool SP2 = false>
__device__ __forceinline__ void gemm_phase(PG8_LAS unsigned char* lds, const Gemm g, const Sched& S, const Epi& E) {
    int tid_l = threadIdx.x; asm volatile("" : "+v"(tid_l));
    const int tid = tid_l, wid = __builtin_amdgcn_readfirstlane(tid >> 6), lane = tid & 63, wr = wid >> 2, wc = wid & 3, fr = lane & 15, fq = lane >> 4;
    const int K = g.K, nt = K / BK;
    unsigned voffA[2], voffB[2];
#pragma unroll
    for (int i = 0; i < 2; ++i) { int R, C; stage_rc(tid * 16 + i * 8192, R, C); const int Rb = Epi::PERM ? ((R & ~31) + perm32(R & 31)) : R;
        voffA[i] = (unsigned)(R * K + C) * 2u; voffB[i] = (unsigned)(Rb * K + C) * 2u; }
    const size_t kstep = (size_t)(BK * 2);
    const size_t hstep = (size_t)HALF * K * 2;
    const size_t tstep = 2 * hstep;
    const unsigned ldsw = (unsigned)wid * 1024u;
    const int aoff = lds_byte(wr * 64 + fr, fq * 8), boff = lds_byte(wc * 32 + fr, fq * 8);
#define PG8_SA(b, h) (((b) * 2 + (h)) * HTB)
#define PG8_SB(b, h) ((4 + (b) * 2 + (h)) * HTB)
#define PG8_STAGE(bufoff, gbase, voff) do { _Pragma("unroll") for (int _i = 0; _i < 2; ++_i) \
        __builtin_amdgcn_global_load_lds((const unsigned*)((const char*)(gbase) + (voff)[_i]), (PG8_LAS unsigned*)(lds + (bufoff) + ldsw + _i * 8192), 16, 0, 0); } while (0)
#define PG8_LDA(dst, b, h) do { _Pragma("unroll") for (int m = 0; m < 4; ++m) _Pragma("unroll") for (int k = 0; k < 2; ++k) dst[m][k] = *(const PG8_LAS bf16x8*)(lds + PG8_SA(b, h) + aoff + m * 2048 + k * 1024); } while (0)
#define PG8_LDB(dst, b, h) do { _Pragma("unroll") for (int n = 0; n < 2; ++n) _Pragma("unroll") for (int k = 0; k < 2; ++k) dst[n][k] = *(const PG8_LAS bf16x8*)(lds + PG8_SB(b, h) + boff + n * 2048 + k * 1024); } while (0)
#define PG8_MMA(ai, bj, At, Bt) do { __builtin_amdgcn_s_setprio(1); _Pragma("unroll") for (int m = 0; m < 4; ++m) _Pragma("unroll") for (int n = 0; n < 2; ++n) _Pragma("unroll") for (int k = 0; k < 2; ++k) \
        acc[ai][bj][m][n] = __builtin_amdgcn_mfma_f32_16x16x32_bf16(Bt[n][k], At[m][k], acc[ai][bj][m][n], 0, 0, 0); __builtin_amdgcn_s_setprio(0); } while (0)
#define PG8_WAIT_V(n) asm volatile("s_waitcnt vmcnt(" #n ")" ::: "memory")
#define PG8_WAIT_L(n) asm volatile("s_waitcnt lgkmcnt(" #n ")" ::: "memory")
#define PG8_BAR __builtin_amdgcn_s_barrier()
#define PG8_SCHED __builtin_amdgcn_sched_barrier(0)
    Unit cur, nxt; int ui = 0;
    if (!S.next(0, cur)) return;
    f32x4 acc[2][2][4][2];
#pragma unroll
    for (int a = 0; a < 2; ++a)
#pragma unroll
        for (int b = 0; b < 2; ++b)
#pragma unroll
            for (int m = 0; m < 4; ++m)
#pragma unroll
                for (int n = 0; n < 2; ++n) acc[a][b][m][n] = (f32x4){0.f, 0.f, 0.f, 0.f};
    bf16x8 At[4][2], B0[2][2], B1[2][2];
    const char* cA = (const char*)g.A + (size_t)cur.pm * tstep; const char* cB = (const char*)g.Bt + (size_t)cur.pn * tstep;
    S.a_ready(cur);
    if constexpr (SP2) {
        PG8_STAGE(PG8_SB(0, 0), cB, voffB); PG8_STAGE(PG8_SB(0, 1), cB + hstep, voffB); PG8_STAGE(PG8_SA(0, 0), cA, voffA); PG8_STAGE(PG8_SA(0, 1), cA + hstep, voffA);
        if (wr == 1) PG8_BAR;
        PG8_WAIT_V(2); PG8_BAR;
        PG8_STAGE(PG8_SB(1, 0), cB + kstep, voffB); PG8_STAGE(PG8_SA(1, 0), cA + kstep, voffA); PG8_STAGE(PG8_SB(1, 1), cB + hstep + kstep, voffB);
        PG8_WAIT_V(6); PG8_BAR;
    } else {
        PG8_STAGE(PG8_SB(0, 0), cB, voffB); PG8_STAGE(PG8_SA(0, 0), cA, voffA); PG8_STAGE(PG8_SB(0, 1), cB + hstep, voffB); PG8_STAGE(PG8_SA(0, 1), cA + hstep, voffA);
        if (wr == 1) PG8_BAR;
        PG8_WAIT_V(4); PG8_BAR;
        PG8_STAGE(PG8_SB(1, 0), cB + kstep, voffB); PG8_STAGE(PG8_SA(1, 0), cA + kstep, voffA); PG8_STAGE(PG8_SB(1, 1), cB + hstep + kstep, voffB);
        PG8_WAIT_V(6); PG8_BAR;
    }
    for (;;) {
        const bool has_next = S.next(ui + 1, nxt);
        const char* nA = has_next ? (const char*)g.A + (size_t)nxt.pm * tstep : cA; const char* nB = has_next ? (const char*)g.Bt + (size_t)nxt.pn * tstep : cB;
        for (int t = 0; t < nt; t += 2) {
            const bool last = (t == nt - 2);
            const char* a1 = cA + (size_t)(t + 1) * kstep;
            const char* a2 = last ? nA : cA + (size_t)(t + 2) * kstep; const char* b2 = last ? nB : cB + (size_t)(t + 2) * kstep;
            const char* a3 = a2 + kstep; const char* b3 = b2 + kstep;
            if (last && has_next) S.a_ready(nxt);
            if constexpr (SP2) {
            PG8_LDB(B0, 0, 0); PG8_LDB(B1, 0, 1); PG8_SCHED; PG8_LDA(At, 0, 0); PG8_STAGE(PG8_SA(1, 1), a1 + hstep, voffA);
            PG8_WAIT_V(8); PG8_WAIT_L(0); PG8_BAR; PG8_MMA(0, 0, At, B0); PG8_MMA(0, 1, At, B1); PG8_BAR; PG8_SCHED;
            PG8_LDA(At, 0, 1); PG8_STAGE(PG8_SB(0, 0), b2, voffB); PG8_STAGE(PG8_SB(0, 1), b2 + hstep, voffB); PG8_STAGE(PG8_SA(0, 0), a2, voffA);
            PG8_WAIT_V(8); PG8_WAIT_L(0); PG8_BAR; PG8_MMA(1, 0, At, B0); PG8_MMA(1, 1, At, B1); PG8_BAR; PG8_SCHED;
            PG8_LDB(B0, 1, 0); PG8_LDB(B1, 1, 1); PG8_SCHED; PG8_LDA(At, 1, 0); PG8_STAGE(PG8_SA(0, 1), a2 + hstep, voffA);
            PG8_WAIT_V(8); PG8_WAIT_L(0); PG8_BAR; PG8_MMA(0, 0, At, B0); PG8_MMA(0, 1, At, B1); PG8_BAR; PG8_SCHED;
            PG8_LDA(At, 1, 1); PG8_STAGE(PG8_SB(1, 0), b3, voffB); PG8_STAGE(PG8_SB(1, 1), b3 + hstep, voffB); PG8_STAGE(PG8_SA(1, 0), a3, voffA);
            PG8_WAIT_V(8); PG8_WAIT_L(0); PG8_BAR; PG8_MMA(1, 0, At, B0); PG8_MMA(1, 1, At, B1); PG8_BAR; PG8_SCHED;
            } else {
            PG8_LDB(B0, 0, 0); PG8_SCHED; PG8_LDA(At, 0, 0); PG8_STAGE(PG8_SA(1, 1), a1 + hstep, voffA);
            PG8_WAIT_L(8); PG8_BAR; PG8_WAIT_L(0); PG8_MMA(0, 0, At, B0); PG8_BAR; PG8_SCHED;
            PG8_LDB(B1, 0, 1); PG8_STAGE(PG8_SB(0, 0), b2, voffB);
            PG8_BAR; PG8_WAIT_L(0); PG8_MMA(0, 1, At, B1); PG8_BAR;
            PG8_LDA(At, 0, 1); PG8_STAGE(PG8_SA(0, 0), a2, voffA);
            PG8_BAR; PG8_WAIT_L(0); PG8_MMA(1, 0, At, B0); PG8_BAR; PG8_SCHED;
            PG8_STAGE(PG8_SB(0, 1), b2 + hstep, voffB);
            PG8_WAIT_V(6); PG8_BAR; PG8_MMA(1, 1, At, B1); PG8_BAR;
            PG8_LDB(B0, 1, 0); PG8_SCHED; PG8_LDA(At, 1, 0); PG8_STAGE(PG8_SA(0, 1), a2 + hstep, voffA);
            PG8_WAIT_L(8); PG8_BAR; PG8_WAIT_L(0); PG8_MMA(0, 0, At, B0); PG8_BAR; PG8_SCHED;
            PG8_LDB(B1, 1, 1); PG8_STAGE(PG8_SB(1, 0), b3, voffB);
            PG8_BAR; PG8_WAIT_L(0); PG8_MMA(0, 1, At, B1); PG8_BAR;
            PG8_LDA(At, 1, 1); PG8_STAGE(PG8_SA(1, 0), a3, voffA);
            PG8_BAR; PG8_WAIT_L(0); PG8_MMA(1, 0, At, B0); PG8_BAR; PG8_SCHED;
            PG8_STAGE(PG8_SB(1, 1), b3 + hstep, voffB);
            PG8_WAIT_V(6); PG8_BAR; PG8_MMA(1, 1, At, B1); PG8_BAR;
            }
        }
        if constexpr (ALIGN_EPI) { if (wr == 0) PG8_BAR; }
        if constexpr (!Epi::AFTER_DRAIN) { E(acc, cur, wr, wc, fr, fq); S.done(cur); }
        if (!has_next) break;
#pragma unroll
        for (int a = 0; a < 2; ++a)
#pragma unroll
            for (int b = 0; b < 2; ++b)
#pragma unroll
                for (int m = 0; m < 4; ++m)
#pragma unroll
                    for (int n = 0; n < 2; ++n) acc[a][b][m][n] = (f32x4){0.f, 0.f, 0.f, 0.f};
        cur = nxt; cA = nA; cB = nB; ++ui;
        if constexpr (ALIGN_EPI) { if (wr == 1) PG8_BAR; }
    }
    PG8_WAIT_V(0);
    if constexpr (!ALIGN_EPI) { if (wr == 0) PG8_BAR; }
    PG8_BAR;
    if constexpr (Epi::AFTER_DRAIN) { E.fused(acc, cur, wr, wc, fr, fq, lds, wid, lane); S.done(cur); }
#undef PG8_SA
#undef PG8_SB
#undef PG8_STAGE
#undef PG8_LDA
#undef PG8_LDB
#undef PG8_MMA
#undef PG8_WAIT_V
#undef PG8_WAIT_L
#undef PG8_BAR
#undef PG8_SCHED
}
}

constexpr int NWAVES = 8;
constexpr int BATCH = 4, SEQ = 8192, DM = 1024, DEPTH = 2;
constexpr int M = BATCH * SEQ;
constexpr int INW = 2304, DFF = 2816, NGU = 2 * DFF;
constexpr float EPS = 1e-6f;
constexpr int C_AU = 0, C_AV = 256, C_BQ = 512, C_BK = 1024, C_BV = 1152, C_CQ = 1280, C_CF = 1536, C_CI = 1792, C_CG = 2048;
constexpr int MX_A = 0, MX_B = 256, MX_C = 768;

constexpr size_t MiB = 1u << 20;
constexpr size_t WS_CTL = 0, CTL_ZERO_BYTES = 1 * MiB;
constexpr size_t WS_TAB = 1 * MiB;
constexpr size_t WS_SS = 2 * MiB;
constexpr size_t WS_SEGS = 4 * MiB;
constexpr size_t WS_SEGP = 8 * MiB;
constexpr size_t WS_HG = 10 * MiB;
constexpr size_t WS_HU = 32 * MiB;
constexpr size_t WS_W = 44 * MiB, W_LAYER = 24 * MiB;
constexpr size_t W_IN = 0, W_OUT = 5 * MiB, W_GU = 7 * MiB, W_DN = 18 * MiB;
constexpr size_t WS_XB = 92 * MiB;
constexpr size_t WS_X1 = 156 * MiB;
constexpr size_t WS_PROJ = 284 * MiB;
constexpr size_t WS_MIXED = 428 * MiB;
constexpr size_t WS_ACT = 284 * MiB;
constexpr size_t WS_END = 492 * MiB;
static_assert((size_t)INW * DM * 2 <= W_OUT - W_IN && (size_t)DM * DM * 2 <= W_GU - W_OUT && (size_t)NGU * DM * 2 <= W_DN - W_GU && W_DN + (size_t)DM * DFF * 2 <= W_LAYER, "weight map");
static_assert(WS_ACT + (size_t)M * DFF * 2 <= WS_END && WS_MIXED + (size_t)M * DM * 2 <= WS_END && WS_PROJ + (size_t)M * INW * 2 <= WS_MIXED, "activation map");
static_assert(WS_HG + (size_t)512 * 4 * DFF * 4 <= WS_HU && WS_HU + (size_t)512 * 2 * DFF * 4 <= WS_W, "halo map");
constexpr int CW_BAR = 4096;

constexpr int LDS_BYTES = 147456;
constexpr int MISC_OFF = LDS_BYTES - 256;

#define GAS __attribute__((address_space(1)))
#define LAS __attribute__((address_space(3)))
typedef unsigned short bf16;
typedef unsigned v4u __attribute__((ext_vector_type(4)));
typedef unsigned v2u __attribute__((ext_vector_type(2)));
typedef float f32x4 __attribute__((ext_vector_type(4)));
typedef float f32x2 __attribute__((ext_vector_type(2)));
#define RLX_AGENT __ATOMIC_RELAXED, __HIP_MEMORY_SCOPE_AGENT
#define LDS_WAIT() asm volatile("s_waitcnt lgkmcnt(0)" ::: "memory")
__device__ __forceinline__ unsigned f2bf(float f) { unsigned u = __builtin_bit_cast(unsigned, f); return (u + 0x7fffu + ((u >> 16) & 1u)) >> 16; }
__device__ __forceinline__ unsigned pk2(float lo, float hi) { return f2bf(lo) | (f2bf(hi) << 16); }
__device__ __forceinline__ float bf2f(unsigned short h) { return __builtin_bit_cast(float, (unsigned)h << 16); }
__device__ __forceinline__ float bflo(unsigned w) { return __builtin_bit_cast(float, w << 16); }
__device__ __forceinline__ float bfhi(unsigned w) { return __builtin_bit_cast(float, w & 0xffff0000u); }
__device__ __forceinline__ float silu_f(float v) { return v * __builtin_amdgcn_rcpf(1.0f + __expf(-v)); }
__device__ __forceinline__ float wave_sum(float v) {
#pragma unroll
    for (int o = 1; o < 64; o <<= 1) v += __shfl_xor(v, o);
    return v;
}
#define XB_TMO      128
#define XB_XCNT(j)  (256  + 64 * (j))
#define XB_XSUB(j)  (1280 + 64 * (j))
#define XB_XGEN(j)  (2304 + 64 * (j))
#define XB_TOP      3328
#define XB_TOPGEN   3392
#define XCD_BAR_WORDS 3456
#define XB_SPIN_CAP (1u << 18)

__device__ __forceinline__ unsigned xb_ld(unsigned* p)              { return __hip_atomic_load(p, __ATOMIC_RELAXED, __HIP_MEMORY_SCOPE_AGENT); }
__device__ __forceinline__ unsigned xb_add(unsigned* p, unsigned v) { return __hip_atomic_fetch_add(p, v, __ATOMIC_RELAXED, __HIP_MEMORY_SCOPE_AGENT); }
__device__ __forceinline__ unsigned xb_xcc_id() { return (unsigned)__builtin_amdgcn_s_getreg((3 << 11) | 20) & 0xFu; }
#define XB_SPIN(cond, bar) do { unsigned _sp = 0; while (cond) { __builtin_amdgcn_s_sleep(1); \
    if ((++_sp & 255u) == 0u) { if (xb_ld(&(bar)[XB_TMO])) break; if (_sp > XB_SPIN_CAP) { atomicAdd(&(bar)[XB_TMO], 1u); break; } } } } while (0)

struct XcdBarrier {
    unsigned* bar; unsigned x;
    volatile LAS unsigned* st;
};

__device__ __forceinline__ XcdBarrier xcd_barrier_post(unsigned* bar, volatile LAS unsigned* st) {
    XcdBarrier b; b.bar = bar; b.x = xb_xcc_id(); b.st = st;
    if (threadIdx.x == 0) (void)xb_add(&bar[XB_XCNT(b.x)], 1u);
    return b;
}
__device__ __forceinline__ void xcd_barrier_complete(unsigned* bar, unsigned x, unsigned& nloc, unsigned& nx) {
    const unsigned G = gridDim.x * gridDim.y * gridDim.z;
    unsigned sum, cnt, mine, sp = 0u;
    for (;;) {
        sum = 0u; cnt = 0u; mine = 0u;
#pragma nounroll
        for (unsigned j = 0; j < 16; ++j) { const unsigned c = xb_ld(&bar[XB_XCNT(j)]); sum += c; cnt += (c > 0u) ? 1u : 0u; mine = (j == x) ? c : mine; }
        if (sum == G) break;
        __builtin_amdgcn_s_sleep(1);
        if ((++sp & 255u) == 0u) { if (xb_ld(&bar[XB_TMO])) break; if (sp > XB_SPIN_CAP) { atomicAdd(&bar[XB_TMO], 1u); break; } }
    }
    nloc = mine > 0u ? mine : 1u; nx = cnt > 0u ? cnt : 1u;
}

__device__ __forceinline__ void xcd_barrier(const XcdBarrier& b) {
    asm volatile("s_waitcnt vmcnt(0)" ::: "memory");
    __syncthreads();
    if (threadIdx.x == 0) {
        unsigned* bar = b.bar;
        __builtin_amdgcn_s_waitcnt(0);
        unsigned nloc = b.st[0], nx = b.st[1];
        if (nloc == 0u) { xcd_barrier_complete(bar, b.x, nloc, nx); b.st[0] = nloc; b.st[1] = nx; }
        const unsigned old = xb_add(&bar[XB_XSUB(b.x)], 1u);
        const unsigned gen = old / nloc;
        if (old + 1u == (gen + 1u) * nloc) {
            __builtin_amdgcn_fence(__ATOMIC_RELEASE, "agent");
            asm volatile("s_waitcnt vmcnt(0)" ::: "memory");
            const unsigned og = xb_add(&bar[XB_TOP], 1u);
            const unsigned tg = og / nx;
            if (og + 1u == (tg + 1u) * nx) xb_add(&bar[XB_TOPGEN], 1u);
            else XB_SPIN(xb_ld(&bar[XB_TOPGEN]) == tg, bar);
            __builtin_amdgcn_fence(__ATOMIC_ACQUIRE, "agent");
            xb_add(&bar[XB_XGEN(b.x)], 1u);
            asm volatile("s_waitcnt vmcnt(0)" ::: "memory");
        } else {
            XB_SPIN(xb_ld(&bar[XB_XGEN(b.x)]) == gen, bar);
            __builtin_amdgcn_fence(__ATOMIC_ACQUIRE, "agent");
            asm volatile("s_waitcnt vmcnt(0)" ::: "memory");
        }
    }
    __syncthreads();
}


#ifndef DBG_MIX
#define DBG_MIX 7
#endif
#define DBG_A ((DBG_MIX & 1) ? 1.0f : 0.0f)
#define DBG_B ((DBG_MIX & 2) ? 1.0f : 0.0f)
#define DBG_C ((DBG_MIX & 4) ? 1.0f : 0.0f)
struct Params { const float* in[19]; float* out; unsigned char* ws; int ph_lo, ph_hi; unsigned char bucket[128]; };

struct Ctx { volatile LAS unsigned long long* tab; unsigned char* ws; const unsigned char* bucket; };
constexpr int TAB_OFF = LDS_BYTES - 1024;
__device__ __forceinline__ const float* tab_ptr(const Ctx& c, int i) {
    const unsigned long long v = c.tab[i];
    const unsigned lo = (unsigned)__builtin_amdgcn_readfirstlane((int)(unsigned)v), hi = (unsigned)__builtin_amdgcn_readfirstlane((int)(unsigned)(v >> 32));
    return (const float*)(const GAS float*)(((unsigned long long)hi << 32) | lo);
}
#define PIN(c, i) tab_ptr(c, (i))
#define POUT(c) ((float*)tab_ptr(c, 19))
enum { I_X = 0, I_N1G, I_WIN, I_VNG, I_WS, I_BS, I_QNG, I_KNG, I_SINK, I_RELB, I_LBL, I_ONG, I_WOUT, I_N2G, I_WGATE, I_WUP, I_CONVW, I_CONVB, I_WDOWN };

__device__ __forceinline__ float row_rstd(const unsigned long long* SS, int r) {
    return rsqrtf((float)SS[r] * (1.0f / 16777216.0f / DM) + EPS);
}

struct EpiInProj {
    static constexpr bool PERM = true, AFTER_DRAIN = false;
    bf16* O; const unsigned long long* SS;
    __device__ __forceinline__ void operator()(pg8::f32x4 (&acc)[2][2][4][2], const pg8::Unit& u, int wr, int wc, int fr_in, int fq_in) const {
        int fr = fr_in, fq = fq_in; asm volatile("" : "+v"(fr), "+v"(fq));
        const int row0 = u.pm * 256 + wr * 64 + fr, col0 = u.pn * 256 + wc * 32 + 8 * fq;
        const int act = (u.pn <= 1) ? 1 : ((u.pn == 5 || u.pn == 8) ? 2 : 0);
#pragma unroll
        for (int ai = 0; ai < 2; ++ai)
#pragma unroll
            for (int m = 0; m < 4; ++m) {
                const int r = row0 + ai * 128 + m * 16; const float rs = row_rstd(SS, r);
                bf16* rowp = O + (size_t)r * INW + col0;
#pragma unroll
                for (int bj = 0; bj < 2; ++bj) {
                    f32x4 v0 = acc[ai][bj][m][0] * rs, v1 = acc[ai][bj][m][1] * rs;
                    if (act == 1) { pg8::f32x2 a = pg8::gelu_pk((pg8::f32x2){v0[0], v0[1]}), b = pg8::gelu_pk((pg8::f32x2){v0[2], v0[3]}), c = pg8::gelu_pk((pg8::f32x2){v1[0], v1[1]}), d = pg8::gelu_pk((pg8::f32x2){v1[2], v1[3]});
                        v0 = (f32x4){a.x, a.y, b.x, b.y}; v1 = (f32x4){c.x, c.y, d.x, d.y}; }
                    else if (act == 2) {
#pragma unroll
                        for (int j = 0; j < 4; ++j) { v0[j] = silu_f(v0[j]); v1[j] = silu_f(v1[j]); } }
                    v4u w; w.x = pg8::cvt_pk_bf16(v0[0], v0[1]); w.y = pg8::cvt_pk_bf16(v0[2], v0[3]); w.z = pg8::cvt_pk_bf16(v1[0], v1[1]); w.w = pg8::cvt_pk_bf16(v1[2], v1[3]);
                    *(v4u*)(rowp + bj * 128) = w; }
            }
    }
};
struct EpiResid {
    static constexpr bool PERM = false, AFTER_DRAIN = false;
    const float* base; float* out; bf16* xb; unsigned long long* SS; int write_xb;
    __device__ __forceinline__ void operator()(pg8::f32x4 (&acc)[2][2][4][2], const pg8::Unit& u, int wr, int wc, int fr_in, int fq_in) const {
        int fr = fr_in, fq = fq_in; asm volatile("" : "+v"(fr), "+v"(fq));
        const int row0 = u.pm * 256 + wr * 64 + fr, col0 = u.pn * 256 + wc * 32 + 4 * fq;
#pragma unroll
        for (int ai = 0; ai < 2; ++ai)
#pragma unroll
            for (int m = 0; m < 4; ++m) {
                const int r = row0 + ai * 128 + m * 16; const size_t off = (size_t)r * DM + col0; float ss = 0.f;
#pragma unroll
                for (int bj = 0; bj < 2; ++bj)
#pragma unroll
                    for (int n = 0; n < 2; ++n) {
                        const f32x4 bs = *(const f32x4*)(base + off + bj * 128 + n * 16); const f32x4 o = bs + acc[ai][bj][m][n];
                        *(f32x4*)(out + off + bj * 128 + n * 16) = o;
                        if (write_xb) { ss += (o[0] * o[0] + o[1] * o[1]) + (o[2] * o[2] + o[3] * o[3]);
                            v2u w; w.x = pg8::cvt_pk_bf16(o[0], o[1]); w.y = pg8::cvt_pk_bf16(o[2], o[3]); *(v2u*)(xb + off + bj * 128 + n * 16) = w; }
                    }
                if (write_xb) { ss += __shfl_xor(ss, 16); ss += __shfl_xor(ss, 32); if (fq == 0) __hip_atomic_fetch_add(SS + r, (unsigned long long)(ss * 16777216.0f), __ATOMIC_RELAXED, __HIP_MEMORY_SCOPE_AGENT); }
                asm volatile("" ::: "memory");
            }
    }
};
struct EpiFFN {
    static constexpr bool PERM = true, AFTER_DRAIN = false;
    bf16* ACT; const unsigned long long* SS; const float* cw; const float* cb; float* HG; float* HU;
    template <class T> static __device__ __forceinline__ T ldg(const void* base, unsigned boff) { return *(const T*)((const char*)base + boff); }
    template <class T> static __device__ __forceinline__ void stg(void* base, unsigned boff, T v) { *(T*)((char*)base + boff) = v; }
    __device__ __forceinline__ void operator()(pg8::f32x4 (&acc)[2][2][4][2], const pg8::Unit& u, int wr, int wc, int fr_in, int fq_in) const {
        int fr = fr_in, fq = fq_in; asm volatile("" : "+v"(fr), "+v"(fq));
        const unsigned rowb = (unsigned)(u.pm * 256 + wr * 64 + fr), ch0 = (unsigned)(u.pn * 128 + wc * 32 + 8 * fq);
        if (fr < 2 || fr >= 14) {
#pragma unroll
            for (int ai = 0; ai < 2; ++ai) {
                const unsigned blk = (unsigned)(u.pm * 4 + ai * 2 + wr);
                const float rs0 = rsqrtf((float)ldg<unsigned long long>(SS, (rowb + ai * 128) * 8u) * (1.0f / 16777216.0f / DM) + EPS);
                const float rs3 = rsqrtf((float)ldg<unsigned long long>(SS, (rowb + ai * 128 + 48) * 8u) * (1.0f / 16777216.0f / DM) + EPS);
#pragma unroll
                for (int n = 0; n < 2; ++n) { const unsigned ch = ch0 + 4u * n;
                    if (fr < 2) { stg<f32x4>(HG, ((blk * 4u + (unsigned)fr) * (unsigned)DFF + ch) * 4u, acc[ai][0][0][n] * rs0); stg<f32x4>(HU, ((blk * 2u + (unsigned)fr) * (unsigned)DFF + ch) * 4u, acc[ai][1][0][n] * rs0); }
                    else { stg<f32x4>(HG, ((blk * 4u + 2u + (unsigned)(fr - 14)) * (unsigned)DFF + ch) * 4u, acc[ai][0][3][n] * rs3); } }
            }
        }
        asm volatile("" ::: "memory");
#pragma unroll
        for (int ai = 0; ai < 2; ++ai) {
#pragma unroll
            for (int n = 0; n < 2; ++n) {
                unsigned ch = ch0 + 4u * n; asm volatile("" : "+v"(ch));
                const f32x4 w0 = ldg<f32x4>(cw, ch * 4u), w1 = ldg<f32x4>(cw, (DFF + ch) * 4u), w2 = ldg<f32x4>(cw, (2 * DFF + ch) * 4u), bb = ldg<f32x4>(cb, ch * 4u);
                f32x4 r1p = (f32x4){0.f, 0.f, 0.f, 0.f}, r2p = r1p;
#pragma unroll
                for (int m = 0; m < 4; ++m) {
                    unsigned r = rowb + ai * 128 + m * 16; asm volatile("" : "+v"(r));
                    const float rs = rsqrtf((float)ldg<unsigned long long>(SS, r * 8u) * (1.0f / 16777216.0f / DM) + EPS);
                    const f32x4 g = acc[ai][0][m][n] * rs, up = acc[ai][1][m][n] * rs;
                    f32x4 r1, r2;
#pragma unroll
                    for (int j = 0; j < 4; ++j) { const float gj = g[j]; const int gi = __float_as_int(gj);
                        r1[j] = __int_as_float(__builtin_amdgcn_update_dpp(0, gi, 0x121, 0xf, 0xf, false));
                        r2[j] = __int_as_float(__builtin_amdgcn_update_dpp(0, gi, 0x122, 0xf, 0xf, false)); }
                    const f32x4 p1 = (fr >= 1) ? r1 : r1p, p2 = (fr >= 2) ? r2 : r2p;
#if defined(DBG_TAPS) && DBG_TAPS == 0
                    f32x4 c = bb + w2 * g;
#elif defined(DBG_TAPS) && DBG_TAPS == 1
                    f32x4 c = bb + w1 * p1 + w2 * g;
#else
                    f32x4 c = bb + w0 * p2 + w1 * p1 + w2 * g;
#endif
#pragma unroll
                    for (int j = 0; j < 4; ++j) c[j] = silu_f(c[j]) * up[j];
                    acc[ai][0][m][n] = c;
                    r1p = r1; r2p = r2;
                }
                asm volatile("" ::: "memory");
            }
#pragma unroll
            for (int m = 0; m < 4; ++m) {
                const unsigned r = rowb + ai * 128 + m * 16;
                const f32x4 v0 = acc[ai][0][m][0], v1 = acc[ai][0][m][1];
                v4u w; w.x = pg8::cvt_pk_bf16(v0[0], v0[1]); w.y = pg8::cvt_pk_bf16(v0[2], v0[3]); w.z = pg8::cvt_pk_bf16(v1[0], v1[1]); w.w = pg8::cvt_pk_bf16(v1[2], v1[3]);
                unsigned bo = (r * (unsigned)DFF + ch0) * 2u;
                if (m == 0) bo = (fr < 2) ? (unsigned)((size_t)M * DFF * 2) + (threadIdx.x * 16u) : bo;
                stg<v4u>(ACT, bo, w);
            }
            asm volatile("" ::: "memory");
        }
    }
};

__device__ __forceinline__ void p0_transpose_item(const float* W, int K, int N, const float* gk, bf16* WT, int dest_row0, int k0, int n0, LAS float* scr, int lane) {
#pragma unroll 8
    for (int i = 0; i < 32; ++i) { const int kk = 2 * i + (lane >> 5); float v = W[(size_t)(k0 + kk) * N + n0 + (lane & 31)]; if (gk) v *= gk[k0 + kk]; scr[kk * 33 + (lane & 31)] = v; }
    LDS_WAIT(); asm volatile("" ::: "memory");
    const int c = lane & 7;
#pragma unroll
    for (int j = 0; j < 4; ++j) { const int n = (lane >> 3) + 8 * j; const LAS float* s = scr + (8 * c) * 33 + n;
        v4u o; o.x = pk2(s[0 * 33], s[1 * 33]); o.y = pk2(s[2 * 33], s[3 * 33]); o.z = pk2(s[4 * 33], s[5 * 33]); o.w = pk2(s[6 * 33], s[7 * 33]);
        *(GAS v4u*)(WT + (size_t)(dest_row0 + n) * K + k0 + 8 * c) = o; }
    LDS_WAIT(); asm volatile("" ::: "memory");
}

__device__ __forceinline__ void prologue(const Ctx& p, LAS unsigned char* lds, int wave, int lane) {
    LAS float* scr = (LAS float*)(lds + wave * 16384);
    const int gw = blockIdx.x * NWAVES + wave, NGW = gridDim.x * NWAVES;
    constexpr int I_IN = (DM / 64) * (INW / 32), I_OUT = (DM / 64) * (DM / 32), I_G = (DM / 64) * (DFF / 32), I_D = (DFF / 64) * (DM / 32);
    constexpr int PER_L = I_IN + I_OUT + 2 * I_G + I_D;
    for (int it = gw; it < DEPTH * PER_L; it += NGW) {
        const int l = it / PER_L; int r = it % PER_L;
        unsigned char* wl = p.ws + WS_W + (size_t)l * W_LAYER;
        if (r < I_IN) { const int nblk = INW / 32, kb = r / nblk, nb = r % nblk;
            p0_transpose_item(PIN(p, I_WIN) + (size_t)l * DM * INW, DM, INW, PIN(p, I_N1G) + l * DM, (bf16*)(wl + W_IN), 32 * nb, 64 * kb, 32 * nb, scr, lane); continue; } r -= I_IN;
        if (r < I_OUT) { const int nblk = DM / 32, kb = r / nblk, nb = r % nblk;
            p0_transpose_item(PIN(p, I_WOUT) + (size_t)l * DM * DM, DM, DM, nullptr, (bf16*)(wl + W_OUT), 32 * nb, 64 * kb, 32 * nb, scr, lane); continue; } r -= I_OUT;
        if (r < 2 * I_G) { const int up = r >= I_G; if (up) r -= I_G; const int nblk = DFF / 32, kb = r / nblk, nb = r % nblk, n0 = 32 * nb;
            const int dest = 256 * (n0 / 128) + (n0 % 128) + (up ? 128 : 0);
            p0_transpose_item(PIN(p, up ? I_WUP : I_WGATE) + (size_t)l * DM * DFF, DM, DFF, PIN(p, I_N2G) + l * DM, (bf16*)(wl + W_GU), dest, 64 * kb, n0, scr, lane); continue; } r -= 2 * I_G;
        { const int nblk = DM / 32, kb = r / nblk, nb = r % nblk;
            p0_transpose_item(PIN(p, I_WDOWN) + (size_t)l * DFF * DM, DFF, DM, nullptr, (bf16*)(wl + W_DN), 32 * nb, 64 * kb, 32 * nb, scr, lane); }
    }
    const float* x = PIN(p, I_X); bf16* XB = (bf16*)(p.ws + WS_XB); unsigned long long* SS = (unsigned long long*)(p.ws + WS_SS);
    for (int m = gw; m < M; m += NGW) {
        const f32x4* xr = (const f32x4*)(x + (size_t)m * DM) + lane; f32x4 v[4]; float s = 0.f;
#pragma unroll
        for (int j = 0; j < 4; ++j) { v[j] = xr[64 * j]; s += (v[j].x * v[j].x + v[j].y * v[j].y) + (v[j].z * v[j].z + v[j].w * v[j].w); }
        s = wave_sum(s);
        unsigned long long* o8 = (unsigned long long*)(XB + (size_t)m * DM) + lane;
#pragma unroll
        for (int j = 0; j < 4; ++j) o8[64 * j] = (unsigned long long)pk2(v[j].x, v[j].y) | ((unsigned long long)pk2(v[j].z, v[j].w) << 32);
        if (lane == 0) __hip_atomic_fetch_add(SS + m, (unsigned long long)(s * 16777216.0f), __ATOMIC_RELAXED, __HIP_MEMORY_SCOPE_AGENT);
    }
    if (blockIdx.x == 0) { float* bt = (float*)(p.ws + WS_TAB);
        for (int i = wave * 64 + lane; i < 1024; i += NWAVES * 64) { const int h = i >> 7, d = i & 127; bt[i] = PIN(p, I_RELB)[(int)((LAS unsigned char*)(lds + TAB_OFF + 256))[d] * 8 + h]; } }
}

__device__ __forceinline__ void mixer_a_unit(const Ctx& p, int l, int unit, LAS unsigned char* lds, int wave, int lane) {
    LAS float* vn = (LAS float*)lds;
    const int g = unit & 3, ck = unit >> 2; const size_t row0 = (size_t)ck * 128;
    const bf16* PROJ = (const bf16*)(p.ws + WS_PROJ); bf16* MIXED = (bf16*)(p.ws + WS_MIXED);
    const float vg = PIN(p, I_VNG)[(l * 4 + g) * 64 + lane];
#pragma unroll 4
    for (int i = 0; i < 16; ++i) { const int s = wave * 16 + i;
        const float v = bf2f(PROJ[(row0 + s) * INW + C_AV + g * 64 + lane]);
        const float ss = wave_sum(v * v);
        vn[s * 64 + lane] = v * rsqrtf(ss * (1.0f / 64.0f) + EPS) * vg; }
    __syncthreads();
    const float* Wg = PIN(p, I_WS) + (size_t)(l * 4 + g) * 128 * 128; const float* bs = PIN(p, I_BS) + (l * 4 + g) * 128;
    for (int i = 0; i < 16; ++i) { const int t = __builtin_amdgcn_readfirstlane(wave + 8 * i);
        const float* wrow = Wg + t * 128; float a = 0.f;
        for (int s0 = 0; s0 <= t; s0 += 4) { const f32x4 w = *(const f32x4*)(wrow + s0);
#pragma unroll
            for (int j = 0; j < 4; ++j) { const float wj = (s0 + j <= t) ? w[j] : 0.f; a += wj * vn[(s0 + j) * 64 + lane]; } }
        a += bs[t];
        const float uval = bf2f(PROJ[(row0 + t) * INW + C_AU + g * 64 + lane]);
        MIXED[(row0 + t) * DM + MX_A + g * 64 + lane] = (bf16)f2bf(uval * a * DBG_A); }
    __syncthreads();
}

constexpr int KVS = 68;
__device__ __forceinline__ void mixer_b_unit(const Ctx& p, int l, int unit, LAS unsigned char* lds, int wave, int lane) {
    LAS float* Kt = (LAS float*)lds; LAS float* Vt = Kt + 256 * KVS;
    const int hk = unit & 1, nb = unit >> 1, n = nb & 63; const long row0 = (long)nb * 128, win0 = row0 - 128;
    const bf16* PROJ = (const bf16*)(p.ws + WS_PROJ); bf16* MIXED = (bf16*)(p.ws + WS_MIXED);
    const int tid = wave * 64 + lane;
    {
        const int row = tid >> 1, half = tid & 1; const bool valid = (n > 0) || (row >= 128);
        float kf[32], vf[32];
        if (valid) { const v4u* kp = (const v4u*)(PROJ + (win0 + row) * INW + C_BK + hk * 64 + half * 32); const v4u* vp = (const v4u*)(PROJ + (win0 + row) * INW + C_BV + hk * 64 + half * 32);
#pragma unroll
            for (int c = 0; c < 4; ++c) { const v4u a = kp[c], b = vp[c];
                kf[8 * c + 0] = bflo(a.x); kf[8 * c + 1] = bfhi(a.x); kf[8 * c + 2] = bflo(a.y); kf[8 * c + 3] = bfhi(a.y); kf[8 * c + 4] = bflo(a.z); kf[8 * c + 5] = bfhi(a.z); kf[8 * c + 6] = bflo(a.w); kf[8 * c + 7] = bfhi(a.w);
                vf[8 * c + 0] = bflo(b.x); vf[8 * c + 1] = bfhi(b.x); vf[8 * c + 2] = bflo(b.y); vf[8 * c + 3] = bfhi(b.y); vf[8 * c + 4] = bflo(b.z); vf[8 * c + 5] = bfhi(b.z); vf[8 * c + 6] = bflo(b.w); vf[8 * c + 7] = bfhi(b.w); } }
        else {
#pragma unroll
            for (int c = 0; c < 32; ++c) { kf[c] = 0.f; vf[c] = 0.f; } }
        float ss = 0.f;
#pragma unroll
        for (int c = 0; c < 32; ++c) ss += kf[c] * kf[c];
        ss += __shfl_xor(ss, 1);
        const float rs = rsqrtf(ss * (1.0f / 64.0f) + EPS); const float* kng = PIN(p, I_KNG) + l * 64 + half * 32;
#pragma unroll
        for (int c = 0; c < 8; ++c) {
            *(LAS f32x4*)(Kt + row * KVS + half * 32 + 4 * c) = (f32x4){kf[4 * c] * rs * kng[4 * c], kf[4 * c + 1] * rs * kng[4 * c + 1], kf[4 * c + 2] * rs * kng[4 * c + 2], kf[4 * c + 3] * rs * kng[4 * c + 3]};
            *(LAS f32x4*)(Vt + row * KVS + half * 32 + 4 * c) = (f32x4){vf[4 * c], vf[4 * c + 1], vf[4 * c + 2], vf[4 * c + 3]}; }
    }
    __syncthreads();
    const int g = wave >> 1, i = (wave & 1) * 64 + lane, h = hk * 4 + g;
    float q[64];
    { const v4u* qp = (const v4u*)(PROJ + (row0 + i) * INW + C_BQ + h * 64); float ss = 0.f;
#pragma unroll
        for (int c = 0; c < 8; ++c) { const v4u a = qp[c];
            q[8 * c + 0] = bflo(a.x); q[8 * c + 1] = bfhi(a.x); q[8 * c + 2] = bflo(a.y); q[8 * c + 3] = bfhi(a.y); q[8 * c + 4] = bflo(a.z); q[8 * c + 5] = bfhi(a.z); q[8 * c + 6] = bflo(a.w); q[8 * c + 7] = bfhi(a.w); }
#pragma unroll
        for (int c = 0; c < 64; ++c) ss += q[c] * q[c];
        const float rs = rsqrtf(ss * (1.0f / 64.0f) + EPS) * 0.125f; const float* qng = PIN(p, I_QNG) + l * 64;
#pragma unroll
        for (int c = 0; c < 64; ++c) q[c] *= rs * qng[c]; }
    float mx = PIN(p, I_SINK)[l * 8 + h], lsum = 1.0f; float o[64];
#pragma unroll
    for (int c = 0; c < 64; ++c) o[c] = 0.f;
    const float* bt = (const float*)(p.ws + WS_TAB) + h * 128;
    for (int dist = 0; dist < 128; ++dist) {
        const int j = i + 128 - dist; const LAS float* kr = Kt + j * KVS; const LAS float* vr = Vt + j * KVS;
        float s0 = 0.f, s1 = 0.f, s2 = 0.f, s3 = 0.f;
#pragma unroll
        for (int c = 0; c < 16; ++c) { const f32x4 kk = *(const LAS f32x4*)(kr + 4 * c); s0 += q[4 * c] * kk.x; s1 += q[4 * c + 1] * kk.y; s2 += q[4 * c + 2] * kk.z; s3 += q[4 * c + 3] * kk.w; }
        float s = (s0 + s1) + (s2 + s3) + bt[dist];
        if (n == 0 && j < 128) s = -1e30f;
        if (s > mx) { const float f = __expf(mx - s); lsum *= f;
#pragma unroll
            for (int c = 0; c < 64; ++c) o[c] *= f;
            mx = s; }
        const float pr = __expf(s - mx); lsum += pr;
#pragma unroll
        for (int c = 0; c < 16; ++c) { const f32x4 vv = *(const LAS f32x4*)(vr + 4 * c); o[4 * c] += pr * vv.x; o[4 * c + 1] += pr * vv.y; o[4 * c + 2] += pr * vv.z; o[4 * c + 3] += pr * vv.w; }
    }
    const float inv = DBG_B / lsum; v4u* op = (v4u*)(MIXED + (row0 + i) * DM + MX_B + h * 64);
#pragma unroll
    for (int c = 0; c < 8; ++c) { v4u w; w.x = pk2(o[8 * c] * inv, o[8 * c + 1] * inv); w.y = pk2(o[8 * c + 2] * inv, o[8 * c + 3] * inv); w.z = pk2(o[8 * c + 4] * inv, o[8 * c + 5] * inv); w.w = pk2(o[8 * c + 6] * inv, o[8 * c + 7] * inv); op[c] = w; }
    __syncthreads();
}

__device__ __forceinline__ float hgrn_lb(const Ctx& p, int l, int kidx) { if (l == 0) return 0.f; const float* lg = PIN(p, I_LBL); return 1.0f / (1.0f + __expf(lg[kidx] - lg[256 + kidx])); }
__device__ __forceinline__ void hgrn_stage(const bf16* PROJ, size_t rowbase, int hc, const float (&lb8)[8], LAS float* F, LAS float* V, LAS float* Q, int tid) {
    const int tt = tid >> 3, k0 = (tid & 7) * 8; const bf16* rp = PROJ + (rowbase + tt) * INW + hc * 64 + k0;
    const v4u z = *(const v4u*)(rp + C_CF), vi = *(const v4u*)(rp + C_CI);
    float zf[8] = {bflo(z.x), bfhi(z.x), bflo(z.y), bfhi(z.y), bflo(z.z), bfhi(z.z), bflo(z.w), bfhi(z.w)}; float ff[8];
#pragma unroll
    for (int j = 0; j < 8; ++j) ff[j] = lb8[j] + (1.0f - lb8[j]) * __builtin_amdgcn_rcpf(1.0f + __expf(-zf[j]));
    *(LAS f32x4*)(F + tt * 64 + k0) = (f32x4){ff[0], ff[1], ff[2], ff[3]}; *(LAS f32x4*)(F + tt * 64 + k0 + 4) = (f32x4){ff[4], ff[5], ff[6], ff[7]};
    *(LAS f32x4*)(V + tt * 64 + k0) = (f32x4){bflo(vi.x), bfhi(vi.x), bflo(vi.y), bfhi(vi.y)}; *(LAS f32x4*)(V + tt * 64 + k0 + 4) = (f32x4){bflo(vi.z), bfhi(vi.z), bflo(vi.w), bfhi(vi.w)};
    if (Q) { const v4u qq = *(const v4u*)(rp + C_CQ);
        *(LAS f32x4*)(Q + tt * 64 + k0) = (f32x4){bflo(qq.x), bfhi(qq.x), bflo(qq.y), bfhi(qq.y)}; *(LAS f32x4*)(Q + tt * 64 + k0 + 4) = (f32x4){bflo(qq.z), bfhi(qq.z), bflo(qq.w), bfhi(qq.w)}; }
}
__device__ __forceinline__ void mixer_c_pass1(const Ctx& p, int l, int unit, LAS unsigned char* lds, int wave, int lane) {
    LAS float* F = (LAS float*)lds; LAS float* V = F + 4096;
    const int bh = unit >> 4, seg = unit & 15, b = bh >> 2, hc = bh & 3; const size_t row0 = (size_t)b * SEQ + (size_t)seg * 512;
    const bf16* PROJ = (const bf16*)(p.ws + WS_PROJ); const int tid = wave * 64 + lane;
    float lb8[8];
#pragma unroll
    for (int j = 0; j < 8; ++j) lb8[j] = hgrn_lb(p, l, hc * 64 + (tid & 7) * 8 + j);
    float S[8], P[8];
#pragma unroll
    for (int j = 0; j < 8; ++j) { S[j] = 0.f; P[j] = 1.f; }
    for (int cks = 0; cks < 8; ++cks) {
        __syncthreads();
        hgrn_stage(PROJ, row0 + cks * 64, hc, lb8, F, V, nullptr, tid);
        __syncthreads();
        for (int tt = 0; tt < 64; ++tt) {
            const f32x4 fa = *(const LAS f32x4*)(F + tt * 64 + wave * 8), fb = *(const LAS f32x4*)(F + tt * 64 + wave * 8 + 4); const float vv = V[tt * 64 + lane];
            const float f8[8] = {fa.x, fa.y, fa.z, fa.w, fb.x, fb.y, fb.z, fb.w};
#pragma unroll
            for (int j = 0; j < 8; ++j) { S[j] = fmaf(f8[j], S[j] - vv, vv); P[j] *= f8[j]; }
        }
    }
    float* SEGS = (float*)(p.ws + WS_SEGS); float* SEGP = (float*)(p.ws + WS_SEGP);
#pragma unroll
    for (int j = 0; j < 8; ++j) { SEGS[(size_t)unit * 4096 + (wave * 8 + j) * 64 + lane] = S[j]; if (lane == 0) SEGP[unit * 64 + wave * 8 + j] = P[j]; }
    __syncthreads();
}
__device__ __forceinline__ void mixer_c_pass2(const Ctx& p, int l, int unit, LAS unsigned char* lds, int wave, int lane) {
    LAS float* F = (LAS float*)lds; LAS float* V = F + 4096; LAS float* Q = V + 4096; LAS float* PO = Q + 4096;
    const int bh = unit >> 4, seg = unit & 15, b = bh >> 2, hc = bh & 3; const size_t row0 = (size_t)b * SEQ + (size_t)seg * 512;
    const bf16* PROJ = (const bf16*)(p.ws + WS_PROJ); bf16* MIXED = (bf16*)(p.ws + WS_MIXED); const int tid = wave * 64 + lane;
    const float* SEGS = (const float*)(p.ws + WS_SEGS); const float* SEGP = (const float*)(p.ws + WS_SEGP);
    float lb8[8];
#pragma unroll
    for (int j = 0; j < 8; ++j) lb8[j] = hgrn_lb(p, l, hc * 64 + (tid & 7) * 8 + j);
    float S[8];
#pragma unroll
    for (int j = 0; j < 8; ++j) S[j] = 0.f;
    for (int s = 0; s < seg; ++s) { const int u2 = bh * 16 + s;
#pragma unroll
        for (int j = 0; j < 8; ++j) S[j] = SEGP[u2 * 64 + wave * 8 + j] * S[j] + SEGS[(size_t)u2 * 4096 + (wave * 8 + j) * 64 + lane]; }
    const float ong = PIN(p, I_ONG)[l * 64 + lane];
    for (int cks = 0; cks < 8; ++cks) {
        __syncthreads();
        hgrn_stage(PROJ, row0 + cks * 64, hc, lb8, F, V, Q, tid);
        __syncthreads();
        for (int tg = 0; tg < 4; ++tg) {
            for (int t16 = 0; t16 < 16; ++t16) { const int tt = tg * 16 + t16;
                const f32x4 fa = *(const LAS f32x4*)(F + tt * 64 + wave * 8), fb = *(const LAS f32x4*)(F + tt * 64 + wave * 8 + 4);
                const f32x4 qa = *(const LAS f32x4*)(Q + tt * 64 + wave * 8), qb = *(const LAS f32x4*)(Q + tt * 64 + wave * 8 + 4); const float vv = V[tt * 64 + lane];
                const float f8[8] = {fa.x, fa.y, fa.z, fa.w, fb.x, fb.y, fb.z, fb.w}; const float q8[8] = {qa.x, qa.y, qa.z, qa.w, qb.x, qb.y, qb.z, qb.w};
                float po = 0.f;
#pragma unroll
                for (int j = 0; j < 8; ++j) { S[j] = fmaf(f8[j], S[j] - vv, vv); po = fmaf(q8[j], S[j], po); }
                PO[(t16 * 8 + wave) * 64 + lane] = po; }
            __syncthreads();
#pragma unroll
            for (int e = 0; e < 2; ++e) { const int t16 = wave * 2 + e; float o = 0.f;
#pragma unroll
                for (int w = 0; w < 8; ++w) o += PO[(t16 * 8 + w) * 64 + lane];
                const float ss = wave_sum(o * o); const size_t row = row0 + cks * 64 + tg * 16 + t16;
                const float gg = bf2f(PROJ[row * INW + C_CG + hc * 64 + lane]);
                MIXED[row * DM + MX_C + hc * 64 + lane] = (bf16)f2bf(o * rsqrtf(ss * (1.0f / 64.0f) + EPS) * ong * gg * DBG_C); }
            __syncthreads();
        }
    }
}

__device__ __forceinline__ void ffn_fixup(const Ctx& p, int l, int tid) {
    const float* HG = (const float*)(p.ws + WS_HG); const float* HU = (const float*)(p.ws + WS_HU); bf16* ACT = (bf16*)(p.ws + WS_ACT);
    const float* cw = PIN(p, I_CONVW) + (size_t)l * 3 * DFF; const float* cb = PIN(p, I_CONVB) + (size_t)l * DFF;
    const int total = 512 * 2 * (DFF / 4);
    for (int idx = blockIdx.x * (NWAVES * 64) + tid; idx < total; idx += gridDim.x * (NWAVES * 64)) {
        const int c4 = idx % (DFF / 4), rr = idx / (DFF / 4), rho = rr & 1, blk = rr >> 1, ch = 4 * c4;
        const bool first = (blk % 128) == 0;
        const f32x4 z = (f32x4){0.f, 0.f, 0.f, 0.f};
        const f32x4 g0 = *(const f32x4*)(HG + ((size_t)blk * 4 + rho) * DFF + ch);
        f32x4 g1, g2;
        if (rho == 1) { g1 = *(const f32x4*)(HG + ((size_t)blk * 4 + 0) * DFF + ch); g2 = first ? z : *(const f32x4*)(HG + ((size_t)(blk - 1) * 4 + 3) * DFF + ch); }
        else { g1 = first ? z : *(const f32x4*)(HG + ((size_t)(blk - 1) * 4 + 3) * DFF + ch); g2 = first ? z : *(const f32x4*)(HG + ((size_t)(blk - 1) * 4 + 2) * DFF + ch); }
        const f32x4 up = *(const f32x4*)(HU + ((size_t)blk * 2 + rho) * DFF + ch);
        const f32x4 w0 = *(const f32x4*)(cw + ch), w1 = *(const f32x4*)(cw + DFF + ch), w2 = *(const f32x4*)(cw + 2 * DFF + ch), bb = *(const f32x4*)(cb + ch);
        f32x4 c = bb + w0 * g2 + w1 * g1 + w2 * g0;
#pragma unroll
        for (int j = 0; j < 4; ++j) c[j] = silu_f(c[j]) * up[j];
        v2u w; w.x = pk2(c[0], c[1]); w.y = pk2(c[2], c[3]);
        *(v2u*)(ACT + ((size_t)blk * 64 + rho) * DFF + ch) = w;
    }
}

constexpr int PH_PER_LAYER = 7, N_PHASES = 1 + DEPTH * PH_PER_LAYER;
__global__ void __launch_bounds__(NWAVES * 64, 2) fwd_kernel(Params args) {
    extern __shared__ __attribute__((aligned(16))) unsigned char lds_raw[];
    LAS unsigned char* lds = (LAS unsigned char*)lds_raw;
    volatile LAS unsigned* MISC = (volatile LAS unsigned*)(lds + MISC_OFF);
    volatile LAS unsigned long long* TAB = (volatile LAS unsigned long long*)(lds + TAB_OFF);
    LAS unsigned char* BKT = lds + TAB_OFF + 256;
    if (threadIdx.x < 64) MISC[threadIdx.x] = 0u;
    if (threadIdx.x == 0) {
#pragma unroll
        for (int i = 0; i < 19; ++i) TAB[i] = (unsigned long long)args.in[i];
        TAB[19] = (unsigned long long)args.out;
    }
    if (threadIdx.x >= 64 && threadIdx.x < 192) BKT[threadIdx.x - 64] = args.bucket[threadIdx.x - 64];
    __syncthreads();
    unsigned* barw = (unsigned*)(args.ws + WS_CTL) + CW_BAR;
    const int lo = args.ph_lo, hi = args.ph_hi;
    XcdBarrier bar; bar.bar = barw; bar.x = 0; bar.st = nullptr;
    if (hi - lo > 1) bar = xcd_barrier_post(barw, MISC + 8);
    const int G = gridDim.x;
#pragma nounroll
    for (int ph = lo; ph < hi; ++ph) {
        int tid = threadIdx.x; asm volatile("" : "+v"(tid));
        Ctx p; p.tab = TAB; p.bucket = nullptr; { GAS unsigned char* wsg = (GAS unsigned char*)args.ws; asm volatile("" : "+s"(wsg)); p.ws = (unsigned char*)wsg; }
        const int lane = tid & 63, wave = __builtin_amdgcn_readfirstlane(tid >> 6);
        const int l = (ph - 1) / PH_PER_LAYER, k = (ph == 0) ? -1 : (ph - 1) % PH_PER_LAYER;
        const unsigned char* wl = p.ws + WS_W + (size_t)l * W_LAYER;
        if (ph == 0) {
#ifndef NO_P0
            prologue(p, lds, wave, lane);
#endif
        } else if (k == 0) {
#ifndef NO_P1
            pg8::Gemm g{(const bf16*)(p.ws + WS_XB), (const bf16*)(wl + W_IN), M, INW, DM}; pg8::StaticOrder S; S.init(M, INW, G, (int)blockIdx.x);
            EpiInProj E{(bf16*)(p.ws + WS_PROJ), (const unsigned long long*)(p.ws + WS_SS) + (size_t)(2 * l) * M};
            pg8::gemm_phase<EpiInProj, pg8::StaticOrder, true, true>(lds, g, S, E);
#endif
        } else if (k == 1) {
#ifndef NO_P2A
            for (int u = blockIdx.x; u < 256; u += G) mixer_c_pass1(p, l, u, lds, wave, lane);
            for (int u = blockIdx.x; u < 1024; u += G) mixer_a_unit(p, l, u, lds, wave, lane);
#endif
        } else if (k == 2) {
#ifndef NO_P2B
            for (int u = blockIdx.x; u < 256; u += G) mixer_c_pass2(p, l, u, lds, wave, lane);
            for (int u = blockIdx.x; u < 512; u += G) mixer_b_unit(p, l, u, lds, wave, lane);
#endif
        } else if (k == 3) {
#ifndef NO_P3
            const float* xin = (l == 0) ? PIN(p, I_X) : POUT(p);
            pg8::Gemm g{(const bf16*)(p.ws + WS_MIXED), (const bf16*)(wl + W_OUT), M, DM, DM}; pg8::StaticOrder S; S.init(M, DM, G, (int)blockIdx.x);
            EpiResid E{xin, (float*)(p.ws + WS_X1), (bf16*)(p.ws + WS_XB), (unsigned long long*)(p.ws + WS_SS) + (size_t)(2 * l + 1) * M, 1};
            pg8::gemm_phase<EpiResid, pg8::StaticOrder, true, true>(lds, g, S, E);
#endif
        } else if (k == 4) {
#ifndef NO_P4
            pg8::Gemm g{(const bf16*)(p.ws + WS_XB), (const bf16*)(wl + W_GU), M, NGU, DM}; pg8::StaticOrder S; S.init(M, NGU, G, (int)blockIdx.x);
            EpiFFN E{(bf16*)(p.ws + WS_ACT), (const unsigned long long*)(p.ws + WS_SS) + (size_t)(2 * l + 1) * M, PIN(p, I_CONVW) + (size_t)l * 3 * DFF, PIN(p, I_CONVB) + (size_t)l * DFF, (float*)(p.ws + WS_HG), (float*)(p.ws + WS_HU)};
            pg8::gemm_phase<EpiFFN, pg8::StaticOrder, true, true>(lds, g, S, E);
#endif
        } else if (k == 5) {
            ffn_fixup(p, l, tid);
        } else {
#ifndef NO_P5
            pg8::Gemm g{(const bf16*)(p.ws + WS_ACT), (const bf16*)(wl + W_DN), M, DM, DFF}; pg8::StaticOrder S; S.init(M, DM, G, (int)blockIdx.x);
            EpiResid E{(const float*)(p.ws + WS_X1), POUT(p), (bf16*)(p.ws + WS_XB), (unsigned long long*)(p.ws + WS_SS) + (size_t)(2 * l + 2) * M, (l + 1 < DEPTH) ? 1 : 0};
            pg8::gemm_phase<EpiResid, pg8::StaticOrder, true, true>(lds, g, S, E);
#endif
        }
        if (ph + 1 < hi) xcd_barrier(bar);
    }
}


#if defined(DBG_NAIVE_DOWN)
__global__ void __launch_bounds__(256) dbg_down(const bf16* ACT, const float* Wd, const float* X1, float* out) {
    __shared__ float a[4][DFF];
    const int r0 = blockIdx.x * 4, c = threadIdx.x * 4;
    for (int i = threadIdx.x; i < 4 * DFF; i += 256) a[i / DFF][i % DFF] = bf2f(ACT[(size_t)(r0 + i / DFF) * DFF + i % DFF]);
    __syncthreads();
    f32x4 acc[4]; for (int r = 0; r < 4; ++r) acc[r] = (f32x4){0.f, 0.f, 0.f, 0.f};
    for (int k = 0; k < DFF; ++k) { const f32x4 w = *(const f32x4*)(Wd + (size_t)k * DM + c);
        for (int r = 0; r < 4; ++r) acc[r] += w * a[r][k]; }
    for (int r = 0; r < 4; ++r) { const size_t off = (size_t)(r0 + r) * DM + c; *(f32x4*)(out + off) = *(const f32x4*)(X1 + off) + acc[r]; }
}
#endif

#if defined(DBG_FFNCMP)
constexpr int DBG_R = 512;
__global__ void __launch_bounds__(256) dbg_gu(const float* X1, const float* g2, const float* Wg, const float* Wu, float* GU) {
    __shared__ float h[DM];
    const int r = blockIdx.x, c = blockIdx.y * 256 + threadIdx.x;
    float ss = 0.f; for (int k = threadIdx.x; k < DM; k += 256) { const float v = X1[(size_t)r * DM + k]; ss += v * v; }
    __shared__ float red[256]; red[threadIdx.x] = ss; __syncthreads();
    for (int o = 128; o > 0; o >>= 1) { if (threadIdx.x < o) red[threadIdx.x] += red[threadIdx.x + o]; __syncthreads(); }
    const float rstd = rsqrtf(red[0] / DM + EPS);
    for (int k = threadIdx.x; k < DM; k += 256) h[k] = X1[(size_t)r * DM + k] * rstd * g2[k];
    __syncthreads();
    if (c < DFF) { float a = 0.f, b = 0.f; for (int k = 0; k < DM; ++k) { a += h[k] * Wg[(size_t)k * DFF + c]; b += h[k] * Wu[(size_t)k * DFF + c]; }
        GU[((size_t)r * 2 + 0) * DFF + c] = a; GU[((size_t)r * 2 + 1) * DFF + c] = b; }
}
__global__ void __launch_bounds__(256) dbg_cmp(const float* GU, const float* cw, const float* cb, const bf16* ACT, float* acc2) {
    const int r = blockIdx.x, c = blockIdx.y * 256 + threadIdx.x; float num = 0.f, den = 0.f;
    if (c < DFF) { const float g0 = GU[((size_t)r * 2) * DFF + c], g1 = r >= 1 ? GU[((size_t)(r - 1) * 2) * DFF + c] : 0.f, g2 = r >= 2 ? GU[((size_t)(r - 2) * 2) * DFF + c] : 0.f;
#if defined(DBG_TAPS) && DBG_TAPS == 0
        const float cv = cb[c] + cw[2 * DFF + c] * g0;
#elif defined(DBG_TAPS) && DBG_TAPS == 1
        const float cv = cb[c] + cw[DFF + c] * g1 + cw[2 * DFF + c] * g0;
#else
        const float cv = cb[c] + cw[c] * g2 + cw[DFF + c] * g1 + cw[2 * DFF + c] * g0;
#endif
        const float ref = cv / (1.0f + expf(-cv)) * GU[((size_t)r * 2 + 1) * DFF + c];
        const float mine = bf2f(ACT[(size_t)r * DFF + c]);
#if DBG_FFNCMP == 2
        if ((r & 63) < 2) { num = (mine - ref) * (mine - ref); den = ref * ref; }
#elif DBG_FFNCMP == 3
        if ((r & 63) >= 2) { num = (mine - ref) * (mine - ref); den = ref * ref; }
#else
        num = (mine - ref) * (mine - ref); den = ref * ref;
#endif
    }
    __shared__ float rn[256], rd[256]; rn[threadIdx.x] = num; rd[threadIdx.x] = den; __syncthreads();
    for (int o = 128; o > 0; o >>= 1) { if (threadIdx.x < o) { rn[threadIdx.x] += rn[threadIdx.x + o]; rd[threadIdx.x] += rd[threadIdx.x + o]; } __syncthreads(); }
    if (threadIdx.x == 0) { atomicAdd(acc2, rn[0]); atomicAdd(acc2 + 1, rd[0]); }
}
__global__ void dbg_emit(const float* acc2, float* out) { out[0] = 1000.0f * sqrtf(acc2[0] / acc2[1]); }
#endif
#ifndef MK_PER_PHASE
#define MK_PER_PHASE 0
#endif
extern "C" void kernel_launch(void* const* d_in, const int* in_sizes, int n_in, void* d_out, int out_size, void* d_ws, size_t ws_size, hipStream_t stream) {
    static int grid = 0;
    if (grid == 0) {
        if (n_in != 19 || in_sizes[0] != M * DM || out_size != M * DM || ws_size < WS_END) { fprintf(stderr, "kernel_launch: unexpected shapes (n_in %d, in0 %d, out %d, ws %zu)\n", n_in, n_in > 0 ? in_sizes[0] : -1, out_size, ws_size); grid = -1; return; }
        int dev = 0, cus = 0;
        if (hipGetDevice(&dev) != hipSuccess || hipDeviceGetAttribute(&cus, hipDeviceAttributeMultiprocessorCount, dev) != hipSuccess) { grid = -1; return; }
        if (hipFuncSetAttribute((const void*)fwd_kernel, hipFuncAttributeMaxDynamicSharedMemorySize, LDS_BYTES) != hipSuccess) { fprintf(stderr, "kernel_launch: hipFuncSetAttribute failed\n"); grid = -1; return; }
        int per_cu = 0;
        if (hipOccupancyMaxActiveBlocksPerMultiprocessor(&per_cu, (const void*)fwd_kernel, NWAVES * 64, LDS_BYTES) != hipSuccess || per_cu < 1) { fprintf(stderr, "kernel_launch: occupancy query reports %d blocks per CU\n", per_cu); }
        (void)hipGetLastError();
        grid = cus < 256 ? cus : 256;
    }
    if (grid < 0) return;
    (void)hipMemsetAsync((char*)d_ws + WS_CTL, 0, CTL_ZERO_BYTES, stream);
    (void)hipMemsetAsync((char*)d_ws + WS_SS, 0, (size_t)4 * M * 8, stream);
    Params a{};
    for (int i = 0; i < 19; ++i) a.in[i] = (const float*)d_in[i];
    a.out = (float*)d_out; a.ws = (unsigned char*)d_ws;
    for (int n = 0; n < 128; ++n) {
        int bkt;
        if (n < 16) bkt = n; else { const float v = logf((float)n / 16.0f) / (float)log(128.0 / 16.0) * 16.0f; bkt = 16 + (int)v; if (bkt > 31) bkt = 31; }
        a.bucket[n] = (unsigned char)bkt;
    }
#if MK_PER_PHASE
    for (int ph = 0; ph < N_PHASES; ++ph) { a.ph_lo = ph; a.ph_hi = ph + 1; hipLaunchKernelGGL(fwd_kernel, dim3(grid), dim3(NWAVES * 64), LDS_BYTES, stream, a); }
#elif defined(DBG_NAIVE_DOWN)
    a.ph_lo = 0; a.ph_hi = 7;
    hipLaunchKernelGGL(fwd_kernel, dim3(grid), dim3(NWAVES * 64), LDS_BYTES, stream, a);
    hipLaunchKernelGGL(dbg_down, dim3(M / 4), dim3(256), 0, stream, (const bf16*)((char*)d_ws + WS_ACT), (const float*)d_in[I_WDOWN], (const float*)((char*)d_ws + WS_X1), (float*)d_out);
#elif defined(DBG_FFNCMP)
    a.ph_lo = 0; a.ph_hi = 7;
    hipLaunchKernelGGL(fwd_kernel, dim3(grid), dim3(NWAVES * 64), LDS_BYTES, stream, a);
    { float* GU = (float*)d_out + (size_t)16 * 1024 * 1024; float* acc2 = (float*)((char*)d_ws + WS_TAB + 65536);
      (void)hipMemsetAsync(acc2, 0, 8, stream);
      hipLaunchKernelGGL(dbg_gu, dim3(DBG_R, 11), dim3(256), 0, stream, (const float*)((char*)d_ws + WS_X1), (const float*)d_in[I_N2G], (const float*)d_in[I_WGATE], (const float*)d_in[I_WUP], GU);
      hipLaunchKernelGGL(dbg_cmp, dim3(DBG_R, 11), dim3(256), 0, stream, (const float*)GU, (const float*)d_in[I_CONVW], (const float*)d_in[I_CONVB], (const bf16*)((char*)d_ws + WS_ACT), acc2);
      (void)hipMemcpyAsync(d_out, d_in[0], (size_t)M * DM * 4, hipMemcpyDeviceToDevice, stream);
      hipLaunchKernelGGL(dbg_emit, dim3(1), dim3(1), 0, stream, (const float*)acc2, (float*)d_out); }
#elif defined(DBG_STOP)
    a.ph_lo = 0; a.ph_hi = DBG_STOP + 1;
    hipLaunchKernelGGL(fwd_kernel, dim3(grid), dim3(NWAVES * 64), LDS_BYTES, stream, a);
    { const int k = (DBG_STOP == 0) ? -1 : (DBG_STOP - 1) % PH_PER_LAYER;
      const float* src = (DBG_STOP == 0) ? (const float*)d_in[0] : ((k >= 3 && k <= 5) ? (const float*)((char*)d_ws + WS_X1) : nullptr);
      if (src) (void)hipMemcpyAsync(d_out, src, (size_t)M * DM * 4, hipMemcpyDeviceToDevice, stream); }
#else
    a.ph_lo = 0; a.ph_hi = N_PHASES;
    hipLaunchKernelGGL(fwd_kernel, dim3(grid), dim3(NWAVES * 64), LDS_BYTES, stream, a);
#endif
    const hipError_t le = hipPeekAtLastError();
    if (le != hipSuccess) fprintf(stderr, "kernel_launch: launch failed: %s\n", hipGetErrorName(le));
}
```

```cpp
#include <hip/hip_runtime.h>
#include <cstdio>
#include <cstdint>
#include <cmath>
namespace pg8 {
#define PG8_LAS __attribute__((address_space(3)))
typedef unsigned short bf16_t;
typedef short bf16x8 __attribute__((ext_vector_type(8)));
typedef float f32x4 __attribute__((ext_vector_type(4)));
typedef unsigned u32x4 __attribute__((ext_vector_type(4)));
constexpr int BM = 256, BK = 64, HALF = 128, HTB = HALF * BK * 2  , STAGE_BYTES = 8 * HTB, NXCD = 8, WGM = 8;

__host__ __device__ __forceinline__ int lds_byte(int r, int c) { const int st = (r >> 4) * 2 + (c >> 5), rr = r & 15, cc = c & 31, ob = rr * 64 + cc * 2; return st * 1024 + (ob ^ (((ob >> 9) & 1) << 5)); }
__host__ __device__ __forceinline__ void stage_rc(int b, int& R, int& C) { const int st = b / 1024, sb = b % 1024, swz = sb ^ (((sb >> 9) & 1) << 5); R = (st >> 1) * 16 + swz / 64; C = (st & 1) * 32 + (swz % 64) / 2; }
__host__ __device__ __forceinline__ int perm32(int rho) { const int n = rho >> 4, i = rho & 15; return 8 * (i >> 2) + 4 * n + (i & 3); }

struct Unit { int pm, pn; };
struct Gemm { const bf16_t* A; const bf16_t* Bt; int M, N, K; };

struct StaticOrder {
    int nM, nN, nwg, G, c;
    __host__ __device__ void init(int M, int N, int G_, int c_) { nM = M / BM; nN = N / BM; nwg = nM * nN; G = G_; c = c_; }
    __host__ __device__ bool next(int i, Unit& u) const {
        const long L = (long)i * G + c; if (L >= nwg) return false;
        int wgid = (int)L; { const int q = nwg / NXCD, r = nwg % NXCD, xcd = wgid % NXCD, off = wgid / NXCD; wgid = (xcd < r ? xcd * (q + 1) : r * (q + 1) + (xcd - r) * q) + off; }
        const int nig = WGM * nN, gid = wgid / nig, fm = gid * WGM, gsz = (nM - fm) < WGM ? (nM - fm) : WGM;
        u.pm = fm + ((wgid % nig) % gsz); u.pn = (wgid % nig) / gsz; return true;
    }
    __device__ __forceinline__ void a_ready(const Unit&) const {}
    __device__ __forceinline__ void done(const Unit&) const {}
};

__device__ __forceinline__ unsigned cvt_pk_bf16(float lo, float hi) { unsigned r; asm volatile("v_cvt_pk_bf16_f32 %0, %1, %2" : "=v"(r) : "v"(lo), "v"(hi)); return r; }
typedef float f32x2 __attribute__((ext_vector_type(2)));
__device__ __forceinline__ f32x2 gelu_pk(f32x2 v) {
    const f32x2 av = __builtin_elementwise_abs(v), d = av * 0.2316418882f + 1.0f;
    f32x2 t; t.x = __builtin_amdgcn_rcpf(d.x); t.y = __builtin_amdgcn_rcpf(d.y);
    f32x2 q = t * 0.5307027145f + (-0.7265760135f); q = q * t + 0.7107068705f; q = q * t + (-0.142248368f); q = q * t + 0.127414796f; q = q * t;
    const f32x2 s = (v * v) * (-0.72134752044f);
    f32x2 e; e.x = __builtin_amdgcn_exp2f(s.x); e.y = __builtin_amdgcn_exp2f(s.y);
    const f32x2 m = v * (q * e), r = v - m;
    f32x2 o; o.x = v.x < 0.f ? m.x : r.x; o.y = v.y < 0.f ? m.y : r.y; return o;
}

template <class Epi, class Sched, bool ALIGN_EPI = false, bool SP2 = false>
__device__ __forceinline__ void gemm_phase(PG8_LAS unsigned char* lds, const Gemm g, const Sched& S, const Epi& E) {
    int tid_l = threadIdx.x; asm volatile("" : "+v"(tid_l));
    const int tid = tid_l, wid = __builtin_amdgcn_readfirstlane(tid >> 6), lane = tid & 63, wr = wid >> 2, wc = wid & 3, fr = lane & 15, fq = lane >> 4;
    const int K = g.K, nt = K / BK;
    unsigned voffA[2], voffB[2];
#pragma unroll
    for (int i = 0; i < 2; ++i) { int R, C; stage_rc(tid * 16 + i * 8192, R, C); const int Rb = Epi::PERM ? ((R & ~31) + perm32(R & 31)) : R;
        voffA[i] = (unsigned)(R * K + C) * 2u; voffB[i] = (unsigned)(Rb * K + C) * 2u; }
    const size_t kstep = (size_t)(BK * 2);
    const size_t hstep = (size_t)HALF * K * 2;
    const size_t tstep = 2 * hstep;
    const unsigned ldsw = (unsigned)wid * 1024u;
    const int aoff = lds_byte(wr * 64 + fr, fq * 8), boff = lds_byte(wc * 32 + fr, fq * 8);
#define PG8_SA(b, h) (((b) * 2 + (h)) * HTB)
#define PG8_SB(b, h) ((4 + (b) * 2 + (h)) * HTB)
#define PG8_STAGE(bufoff, gbase, voff) do { _Pragma("unroll") for (int _i = 0; _i < 2; ++_i) \
        __builtin_amdgcn_global_load_lds((const unsigned*)((const char*)(gbase) + (voff)[_i]), (PG8_LAS unsigned*)(lds + (bufoff) + ldsw + _i * 8192), 16, 0, 0); } while (0)
#define PG8_LDA(dst, b, h) do { _Pragma("unroll") for (int m = 0; m < 4; ++m) _Pragma("unroll") for (int k = 0; k < 2; ++k) dst[m][k] = *(const PG8_LAS bf16x8*)(lds + PG8_SA(b, h) + aoff + m * 2048 + k * 1024); } while (0)
#define PG8_LDB(dst, b, h) do { _Pragma("unroll") for (int n = 0; n < 2; ++n) _Pragma("unroll") for (int k = 0; k < 2; ++k) dst[n][k] = *(const PG8_LAS bf16x8*)(lds + PG8_SB(b, h) + boff + n * 2048 + k * 1024); } while (0)
#define PG8_MMA(ai, bj, At, Bt) do { __builtin_amdgcn_s_setprio(1); _Pragma("unroll") for (int m = 0; m < 4; ++m) _Pragma("unroll") for (int n = 0; n < 2; ++n) _Pragma("unroll") for (int k = 0; k < 2; ++k) \
        acc[ai][bj][m][n] = __builtin_amdgcn_mfma_f32_16x16x32_bf16(Bt[n][k], At[m][k], acc[ai][bj][m][n], 0, 0, 0); __builtin_amdgcn_s_setprio(0); } while (0)
#define PG8_WAIT_V(n) asm volatile("s_waitcnt vmcnt(" #n ")" ::: "memory")
#define PG8_WAIT_L(n) asm volatile("s_waitcnt lgkmcnt(" #n ")" ::: "memory")
#define PG8_BAR __builtin_amdgcn_s_barrier()
#define PG8_SCHED __builtin_amdgcn_sched_barrier(0)
    Unit cur, nxt; int ui = 0;
    if (!S.next(0, cur)) return;
    f32x4 acc[2][2][4][2];
#pragma unroll
    for (int a = 0; a < 2; ++a)
#pragma unroll
        for (int b = 0; b < 2; ++b)
#pragma unroll
            for (int m = 0; m < 4; ++m)
#pragma unroll
                for (int n = 0; n < 2; ++n) acc[a][b][m][n] = (f32x4){0.f, 0.f, 0.f, 0.f};
    bf16x8 At[4][2], B0[2][2], B1[2][2];
    const char* cA = (const char*)g.A + (size_t)cur.pm * tstep; const char* cB = (const char*)g.Bt + (size_t)cur.pn * tstep;
    S.a_ready(cur);
    if constexpr (SP2) {
        PG8_STAGE(PG8_SB(0, 0), cB, voffB); PG8_STAGE(PG8_SB(0, 1), cB + hstep, voffB); PG8_STAGE(PG8_SA(0, 0), cA, voffA); PG8_STAGE(PG8_SA(0, 1), cA + hstep, voffA);
        if (wr == 1) PG8_BAR;
        PG8_WAIT_V(2); PG8_BAR;
        PG8_STAGE(PG8_SB(1, 0), cB + kstep, voffB); PG8_STAGE(PG8_SA(1, 0), cA + kstep, voffA); PG8_STAGE(PG8_SB(1, 1), cB + hstep + kstep, voffB);
        PG8_WAIT_V(6); PG8_BAR;
    } else {
        PG8_STAGE(PG8_SB(0, 0), cB, voffB); PG8_STAGE(PG8_SA(0, 0), cA, voffA); PG8_STAGE(PG8_SB(0, 1), cB + hstep, voffB); PG8_STAGE(PG8_SA(0, 1), cA + hstep, voffA);
        if (wr == 1) PG8_BAR;
        PG8_WAIT_V(4); PG8_BAR;
        PG8_STAGE(PG8_SB(1, 0), cB + kstep, voffB); PG8_STAGE(PG8_SA(1, 0), cA + kstep, voffA); PG8_STAGE(PG8_SB(1, 1), cB + hstep + kstep, voffB);
        PG8_WAIT_V(6); PG8_BAR;
    }
    for (;;) {
        const bool has_next = S.next(ui + 1, nxt);
        const char* nA = has_next ? (const char*)g.A + (size_t)nxt.pm * tstep : cA; const char* nB = has_next ? (const char*)g.Bt + (size_t)nxt.pn * tstep : cB;
        for (int t = 0; t < nt; t += 2) {
            const bool last = (t == nt - 2);
            const char* a1 = cA + (size_t)(t + 1) * kstep;
            const char* a2 = last ? nA : cA + (size_t)(t + 2) * kstep; const char* b2 = last ? nB : cB + (size_t)(t + 2) * kstep;
            const char* a3 = a2 + kstep; const char* b3 = b2 + kstep;
            if (last && has_next) S.a_ready(nxt);
            if constexpr (SP2) {
            PG8_LDB(B0, 0, 0); PG8_LDB(B1, 0, 1); PG8_SCHED; PG8_LDA(At, 0, 0); PG8_STAGE(PG8_SA(1, 1), a1 + hstep, voffA);
            PG8_WAIT_V(8); PG8_WAIT_L(0); PG8_BAR; PG8_MMA(0, 0, At, B0); PG8_MMA(0, 1, At, B1); PG8_BAR; PG8_SCHED;
            PG8_LDA(At, 0, 1); PG8_STAGE(PG8_SB(0, 0), b2, voffB); PG8_STAGE(PG8_SB(0, 1), b2 + hstep, voffB); PG8_STAGE(PG8_SA(0, 0), a2, voffA);
            PG8_WAIT_V(8); PG8_WAIT_L(0); PG8_BAR; PG8_MMA(1, 0, At, B0); PG8_MMA(1, 1, At, B1); PG8_BAR; PG8_SCHED;
            PG8_LDB(B0, 1, 0); PG8_LDB(B1, 1, 1); PG8_SCHED; PG8_LDA(At, 1, 0); PG8_STAGE(PG8_SA(0, 1), a2 + hstep, voffA);
            PG8_WAIT_V(8); PG8_WAIT_L(0); PG8_BAR; PG8_MMA(0, 0, At, B0); PG8_MMA(0, 1, At, B1); PG8_BAR; PG8_SCHED;
            PG8_LDA(At, 1, 1); PG8_STAGE(PG8_SB(1, 0), b3, voffB); PG8_STAGE(PG8_SB(1, 1), b3 + hstep, voffB); PG8_STAGE(PG8_SA(1, 0), a3, voffA);
            PG8_WAIT_V(8); PG8_WAIT_L(0); PG8_BAR; PG8_MMA(1, 0, At, B0); PG8_MMA(1, 1, At, B1); PG8_BAR; PG8_SCHED;
            } else {
            PG8_LDB(B0, 0, 0); PG8_SCHED; PG8_LDA(At, 0, 0); PG8_STAGE(PG8_SA(1, 1), a1 + hstep, voffA);
            PG8_WAIT_L(8); PG8_BAR; PG8_WAIT_L(0); PG8_MMA(0, 0, At, B0); PG8_BAR; PG8_SCHED;
            PG8_LDB(B1, 0, 1); PG8_STAGE(PG8_SB(0, 0), b2, voffB);
            PG8_BAR; PG8_WAIT_L(0); PG8_MMA(0, 1, At, B1); PG8_BAR;
            PG8_LDA(At, 0, 1); PG8_STAGE(PG8_SA(0, 0), a2, voffA);
            PG8_BAR; PG8_WAIT_L(0); PG8_MMA(1, 0, At, B0); PG8_BAR; PG8_SCHED;
            PG8_STAGE(PG8_SB(0, 1), b2 + hstep, voffB);
            PG8_WAIT_V(6); PG8_BAR; PG8_MMA(1, 1, At, B1); PG8_BAR;
            PG8_LDB(B0, 1, 0); PG8_SCHED; PG8_LDA(At, 1, 0); PG8_STAGE(PG8_SA(0, 1), a2 + hstep, voffA);
            PG8_WAIT_L(8); PG8_BAR; PG8_WAIT_L(0); PG8_MMA(0, 0, At, B0); PG8_BAR; PG8_SCHED;
            PG8_LDB(B1, 1, 1); PG8_STAGE(PG8_SB(1, 0), b3, voffB);
            PG8_BAR; PG8_WAIT_L(0); PG8_MMA(0, 1, At, B1); PG8_BAR;
            PG8_LDA(At, 1, 1); PG8_STAGE(PG8_SA(1, 0), a3, voffA);
            PG8_BAR; PG8_WAIT_L(0); PG8_MMA(1, 0, At, B0); PG8_BAR; PG8_SCHED;
            PG8_STAGE(PG8_SB(1, 1), b3 + hstep, voffB);
            PG8_WAIT_V(6); PG8_BAR; PG8_MMA(1, 1, At, B1); PG8_BAR;
            }
        }
        if constexpr (ALIGN_EPI) { if (wr == 0) PG8_BAR; }
        if constexpr (!Epi::AFTER_DRAIN) { E(acc, cur, wr, wc, fr, fq); S.done(cur); }
        if (!has_next) break;
#pragma unroll
        for (int a = 0; a < 2; ++a)
#pragma unroll
            for (int b = 0; b < 2; ++b)
#pragma unroll
                for (int m = 0; m < 4; ++m)
#pragma unroll
                    for (int n = 0; n < 2; ++n) acc[a][b][m][n] = (f32x4){0.f, 0.f, 0.f, 0.f};
        cur = nxt; cA = nA; cB = nB; ++ui;
        if constexpr (ALIGN_EPI) { if (wr == 1) PG8_BAR; }
    }
    PG8_WAIT_V(0);
    if constexpr (!ALIGN_EPI) { if (wr == 0) PG8_BAR; }
    PG8_BAR;
    if constexpr (Epi::AFTER_DRAIN) { E.fused(acc, cur, wr, wc, fr, fq, lds, wid, lane); S.done(cur); }
#undef PG8_SA
#undef PG8_SB
#undef PG8_STAGE
#undef PG8_LDA
#undef PG8_LDB
#undef PG8_MMA
#undef PG8_WAIT_V
#undef PG8_WAIT_L
#undef PG8_BAR
#undef PG8_SCHED
}
}

constexpr int NWAVES = 8;
constexpr int BATCH = 4, SEQ = 8192, DM = 1024, DEPTH = 2;
constexpr int M = BATCH * SEQ;
constexpr int INW = 2304, DFF = 2816, NGU = 2 * DFF;
constexpr float EPS = 1e-6f;
constexpr int C_AU = 0, C_AV = 256, C_BQ = 512, C_BK = 1024, C_BV = 1152, C_CQ = 1280, C_CF = 1536, C_CI = 1792, C_CG = 2048;
constexpr int MX_A = 0, MX_B = 256, MX_C = 768;

constexpr size_t MiB = 1u << 20;
constexpr size_t WS_CTL = 0, CTL_ZERO_BYTES = 1 * MiB;
constexpr size_t WS_TAB = 1 * MiB;
constexpr size_t WS_SS = 2 * MiB;
constexpr size_t WS_SEGS = 4 * MiB;
constexpr size_t WS_SEGP = 8 * MiB;
constexpr size_t WS_HG = 10 * MiB;
constexpr size_t WS_HU = 32 * MiB;
constexpr size_t WS_W = 44 * MiB, W_LAYER = 24 * MiB;
constexpr size_t W_IN = 0, W_OUT = 5 * MiB, W_GU = 7 * MiB, W_DN = 18 * MiB;
constexpr size_t WS_XB = 92 * MiB;
constexpr size_t WS_X1 = 156 * MiB;
constexpr size_t WS_PROJ = 284 * MiB;
constexpr size_t WS_MIXED = 428 * MiB;
constexpr size_t WS_ACT = 284 * MiB;
constexpr size_t WS_END = 492 * MiB;
static_assert((size_t)INW * DM * 2 <= W_OUT - W_IN && (size_t)DM * DM * 2 <= W_GU - W_OUT && (size_t)NGU * DM * 2 <= W_DN - W_GU && W_DN + (size_t)DM * DFF * 2 <= W_LAYER, "weight map");
static_assert(WS_ACT + (size_t)M * DFF * 2 <= WS_END && WS_MIXED + (size_t)M * DM * 2 <= WS_END && WS_PROJ + (size_t)M * INW * 2 <= WS_MIXED, "activation map");
static_assert(WS_HG + (size_t)512 * 4 * DFF * 4 <= WS_HU && WS_HU + (size_t)512 * 2 * DFF * 4 <= WS_W, "halo map");
constexpr int CW_BAR = 4096;

constexpr int LDS_BYTES = 147456;
constexpr int MISC_OFF = LDS_BYTES - 256;

#define GAS __attribute__((address_space(1)))
#define LAS __attribute__((address_space(3)))
typedef unsigned short bf16;
typedef unsigned v4u __attribute__((ext_vector_type(4)));
typedef unsigned v2u __attribute__((ext_vector_type(2)));
typedef float f32x4 __attribute__((ext_vector_type(4)));
typedef float f32x2 __attribute__((ext_vector_type(2)));
#define RLX_AGENT __ATOMIC_RELAXED, __HIP_MEMORY_SCOPE_AGENT
#define LDS_WAIT() asm volatile("s_waitcnt lgkmcnt(0)" ::: "memory")
__device__ __forceinline__ unsigned f2bf(float f) { unsigned u = __builtin_bit_cast(unsigned, f); return (u + 0x7fffu + ((u >> 16) & 1u)) >> 16; }
__device__ __forceinline__ unsigned pk2(float lo, float hi) { return f2bf(lo) | (f2bf(hi) << 16); }
__device__ __forceinline__ float bf2f(unsigned short h) { return __builtin_bit_cast(float, (unsigned)h << 16); }
__device__ __forceinline__ float bflo(unsigned w) { return __builtin_bit_cast(float, w << 16); }
__device__ __forceinline__ float bfhi(unsigned w) { return __builtin_bit_cast(float, w & 0xffff0000u); }
__device__ __forceinline__ float silu_f(float v) { return v * __builtin_amdgcn_rcpf(1.0f + __expf(-v)); }
__device__ __forceinline__ float wave_sum(float v) {
#pragma unroll
    for (int o = 1; o < 64; o <<= 1) v += __shfl_xor(v, o);
    return v;
}
#define XB_TMO      128
#define XB_XCNT(j)  (256  + 64 * (j))
#define XB_XSUB(j)  (1280 + 64 * (j))
#define XB_XGEN(j)  (2304 + 64 * (j))
#define XB_TOP      3328
#define XB_TOPGEN   3392
#define XCD_BAR_WORDS 3456
#define XB_SPIN_CAP (1u << 18)

__device__ __forceinline__ unsigned xb_ld(unsigned* p)              { return __hip_atomic_load(p, __ATOMIC_RELAXED, __HIP_MEMORY_SCOPE_AGENT); }
__device__ __forceinline__ unsigned xb_add(unsigned* p, unsigned v) { return __hip_atomic_fetch_add(p, v, __ATOMIC_RELAXED, __HIP_MEMORY_SCOPE_AGENT); }
__device__ __forceinline__ unsigned xb_xcc_id() { return (unsigned)__builtin_amdgcn_s_getreg((3 << 11) | 20) & 0xFu; }
#define XB_SPIN(cond, bar) do { unsigned _sp = 0; while (cond) { __builtin_amdgcn_s_sleep(1); \
    if ((++_sp & 255u) == 0u) { if (xb_ld(&(bar)[XB_TMO])) break; if (_sp > XB_SPIN_CAP) { atomicAdd(&(bar)[XB_TMO], 1u); break; } } } } while (0)

struct XcdBarrier {
    unsigned* bar; unsigned x;
    volatile LAS unsigned* st;
};

__device__ __forceinline__ XcdBarrier xcd_barrier_post(unsigned* bar, volatile LAS unsigned* st) {
    XcdBarrier b; b.bar = bar; b.x = xb_xcc_id(); b.st = st;
    if (threadIdx.x == 0) (void)xb_add(&bar[XB_XCNT(b.x)], 1u);
    return b;
}
__device__ __forceinline__ void xcd_barrier_complete(unsigned* bar, unsigned x, unsigned& nloc, unsigned& nx) {
    const unsigned G = gridDim.x * gridDim.y * gridDim.z;
    unsigned sum, cnt, mine, sp = 0u;
    for (;;) {
        sum = 0u; cnt = 0u; mine = 0u;
#pragma nounroll
        for (unsigned j = 0; j < 16; ++j) { const unsigned c = xb_ld(&bar[XB_XCNT(j)]); sum += c; cnt += (c > 0u) ? 1u : 0u; mine = (j == x) ? c : mine; }
        if (sum == G) break;
        __builtin_amdgcn_s_sleep(1);
        if ((++sp & 255u) == 0u) { if (xb_ld(&bar[XB_TMO])) break; if (sp > XB_SPIN_CAP) { atomicAdd(&bar[XB_TMO], 1u); break; } }
    }
    nloc = mine > 0u ? mine : 1u; nx = cnt > 0u ? cnt : 1u;
}

__device__ __forceinline__ void xcd_barrier(const XcdBarrier& b) {
    asm volatile("s_waitcnt vmcnt(0)" ::: "memory");
    __syncthreads();
    if (threadIdx.x == 0) {
        unsigned* bar = b.bar;
        __builtin_amdgcn_s_waitcnt(0);
        unsigned nloc = b.st[0], nx = b.st[1];
        if (nloc == 0u) { xcd_barrier_complete(bar, b.x, nloc, nx); b.st[0] = nloc; b.st[1] = nx; }
        const unsigned old = xb_add(&bar[XB_XSUB(b.x)], 1u);
        const unsigned gen = old / nloc;
        if (old + 1u == (gen + 1u) * nloc) {
            __builtin_amdgcn_fence(__ATOMIC_RELEASE, "agent");
            asm volatile("s_waitcnt vmcnt(0)" ::: "memory");
            const unsigned og = xb_add(&bar[XB_TOP], 1u);
            const unsigned tg = og / nx;
            if (og + 1u == (tg + 1u) * nx) xb_add(&bar[XB_TOPGEN], 1u);
            else XB_SPIN(xb_ld(&bar[XB_TOPGEN]) == tg, bar);
            __builtin_amdgcn_fence(__ATOMIC_ACQUIRE, "agent");
            xb_add(&bar[XB_XGEN(b.x)], 1u);
            asm volatile("s_waitcnt vmcnt(0)" ::: "memory");
        } else {
            XB_SPIN(xb_ld(&bar[XB_XGEN(b.x)]) == gen, bar);
            __builtin_amdgcn_fence(__ATOMIC_ACQUIRE, "agent");
            asm volatile("s_waitcnt vmcnt(0)" ::: "memory");
        }
    }
    __syncthreads();
}


#ifndef DBG_MIX
#define DBG_MIX 7
#endif
#define DBG_A ((DBG_MIX & 1) ? 1.0f : 0.0f)
#define DBG_B ((DBG_MIX & 2) ? 1.0f : 0.0f)
#define DBG_C ((DBG_MIX & 4) ? 1.0f : 0.0f)
struct Params { const float* in[19]; float* out; unsigned char* ws; int ph_lo, ph_hi; int flags, bar_region; unsigned char bucket[128]; };

struct Ctx { volatile LAS unsigned long long* tab; unsigned char* ws; const unsigned char* bucket; };
constexpr int TAB_OFF = LDS_BYTES - 1024;
__device__ __forceinline__ const float* tab_ptr(const Ctx& c, int i) {
    const unsigned long long v = c.tab[i];
    const unsigned lo = (unsigned)__builtin_amdgcn_readfirstlane((int)(unsigned)v), hi = (unsigned)__builtin_amdgcn_readfirstlane((int)(unsigned)(v >> 32));
    return (const float*)(const GAS float*)(((unsigned long long)hi << 32) | lo);
}
#define PIN(c, i) tab_ptr(c, (i))
#define POUT(c) ((float*)tab_ptr(c, 19))
enum { I_X = 0, I_N1G, I_WIN, I_VNG, I_WS, I_BS, I_QNG, I_KNG, I_SINK, I_RELB, I_LBL, I_ONG, I_WOUT, I_N2G, I_WGATE, I_WUP, I_CONVW, I_CONVB, I_WDOWN };

__device__ __forceinline__ float row_rstd(const unsigned long long* SS, int r) {
    return rsqrtf((float)SS[r] * (1.0f / 16777216.0f / DM) + EPS);
}

struct EpiInProj {
    static constexpr bool PERM = true, AFTER_DRAIN = false;
    bf16* O; const unsigned long long* SS;
    __device__ __forceinline__ void operator()(pg8::f32x4 (&acc)[2][2][4][2], const pg8::Unit& u, int wr, int wc, int fr_in, int fq_in) const {
        int fr = fr_in, fq = fq_in; asm volatile("" : "+v"(fr), "+v"(fq));
        const int row0 = u.pm * 256 + wr * 64 + fr, col0 = u.pn * 256 + wc * 32 + 8 * fq;
        const int act = (u.pn <= 1) ? 1 : ((u.pn == 5 || u.pn == 8) ? 2 : 0);
#pragma unroll
        for (int ai = 0; ai < 2; ++ai)
#pragma unroll
            for (int m = 0; m < 4; ++m) {
                const int r = row0 + ai * 128 + m * 16; const float rs = row_rstd(SS, r);
                bf16* rowp = O + (size_t)r * INW + col0;
#pragma unroll
                for (int bj = 0; bj < 2; ++bj) {
                    f32x4 v0 = acc[ai][bj][m][0] * rs, v1 = acc[ai][bj][m][1] * rs;
                    if (act == 1) { pg8::f32x2 a = pg8::gelu_pk((pg8::f32x2){v0[0], v0[1]}), b = pg8::gelu_pk((pg8::f32x2){v0[2], v0[3]}), c = pg8::gelu_pk((pg8::f32x2){v1[0], v1[1]}), d = pg8::gelu_pk((pg8::f32x2){v1[2], v1[3]});
                        v0 = (f32x4){a.x, a.y, b.x, b.y}; v1 = (f32x4){c.x, c.y, d.x, d.y}; }
                    else if (act == 2) {
#pragma unroll
                        for (int j = 0; j < 4; ++j) { v0[j] = silu_f(v0[j]); v1[j] = silu_f(v1[j]); } }
                    v4u w; w.x = pg8::cvt_pk_bf16(v0[0], v0[1]); w.y = pg8::cvt_pk_bf16(v0[2], v0[3]); w.z = pg8::cvt_pk_bf16(v1[0], v1[1]); w.w = pg8::cvt_pk_bf16(v1[2], v1[3]);
                    *(v4u*)(rowp + bj * 128) = w; }
            }
    }
};
struct EpiResid {
    static constexpr bool PERM = false, AFTER_DRAIN = false;
    const float* base; float* out; bf16* xb; unsigned long long* SS; int write_xb;
    __device__ __forceinline__ void operator()(pg8::f32x4 (&acc)[2][2][4][2], const pg8::Unit& u, int wr, int wc, int fr_in, int fq_in) const {
        int fr = fr_in, fq = fq_in; asm volatile("" : "+v"(fr), "+v"(fq));
        const int row0 = u.pm * 256 + wr * 64 + fr, col0 = u.pn * 256 + wc * 32 + 4 * fq;
#pragma unroll
        for (int ai = 0; ai < 2; ++ai)
#pragma unroll
            for (int m = 0; m < 4; ++m) {
                const int r = row0 + ai * 128 + m * 16; const size_t off = (size_t)r * DM + col0; float ss = 0.f;
#pragma unroll
                for (int bj = 0; bj < 2; ++bj)
#pragma unroll
                    for (int n = 0; n < 2; ++n) {
                        const f32x4 bs = *(const f32x4*)(base + off + bj * 128 + n * 16); const f32x4 o = bs + acc[ai][bj][m][n];
                        *(f32x4*)(out + off + bj * 128 + n * 16) = o;
                        if (write_xb) { ss += (o[0] * o[0] + o[1] * o[1]) + (o[2] * o[2] + o[3] * o[3]);
                            v2u w; w.x = pg8::cvt_pk_bf16(o[0], o[1]); w.y = pg8::cvt_pk_bf16(o[2], o[3]); *(v2u*)(xb + off + bj * 128 + n * 16) = w; }
                    }
                if (write_xb) { ss += __shfl_xor(ss, 16); ss += __shfl_xor(ss, 32); if (fq == 0) __hip_atomic_fetch_add(SS + r, (unsigned long long)(ss * 16777216.0f), __ATOMIC_RELAXED, __HIP_MEMORY_SCOPE_AGENT); }
                asm volatile("" ::: "memory");
            }
    }
};
struct EpiFFN {
    static constexpr bool PERM = true, AFTER_DRAIN = false;
    bf16* ACT; const unsigned long long* SS; const float* cw; const float* cb; float* HG; float* HU;
    template <class T> static __device__ __forceinline__ T ldg(const void* base, unsigned boff) { return *(const T*)((const char*)base + boff); }
    template <class T> static __device__ __forceinline__ void stg(void* base, unsigned boff, T v) { *(T*)((char*)base + boff) = v; }
    __device__ __forceinline__ void operator()(pg8::f32x4 (&acc)[2][2][4][2], const pg8::Unit& u, int wr, int wc, int fr_in, int fq_in) const {
        int fr = fr_in, fq = fq_in; asm volatile("" : "+v"(fr), "+v"(fq));
        const unsigned rowb = (unsigned)(u.pm * 256 + wr * 64 + fr), ch0 = (unsigned)(u.pn * 128 + wc * 32 + 8 * fq);
        if (fr < 2 || fr >= 14) {
#pragma unroll
            for (int ai = 0; ai < 2; ++ai) {
                const unsigned blk = (unsigned)(u.pm * 4 + ai * 2 + wr);
                const float rs0 = rsqrtf((float)ldg<unsigned long long>(SS, (rowb + ai * 128) * 8u) * (1.0f / 16777216.0f / DM) + EPS);
                const float rs3 = rsqrtf((float)ldg<unsigned long long>(SS, (rowb + ai * 128 + 48) * 8u) * (1.0f / 16777216.0f / DM) + EPS);
#pragma unroll
                for (int n = 0; n < 2; ++n) { const unsigned ch = ch0 + 4u * n;
                    if (fr < 2) { stg<f32x4>(HG, ((blk * 4u + (unsigned)fr) * (unsigned)DFF + ch) * 4u, acc[ai][0][0][n] * rs0); stg<f32x4>(HU, ((blk * 2u + (unsigned)fr) * (unsigned)DFF + ch) * 4u, acc[ai][1][0][n] * rs0); }
                    else { stg<f32x4>(HG, ((blk * 4u + 2u + (unsigned)(fr - 14)) * (unsigned)DFF + ch) * 4u, acc[ai][0][3][n] * rs3); } }
            }
        }
        asm volatile("" ::: "memory");
#pragma unroll
        for (int ai = 0; ai < 2; ++ai) {
#pragma unroll
            for (int n = 0; n < 2; ++n) {
                unsigned ch = ch0 + 4u * n; asm volatile("" : "+v"(ch));
                const f32x4 w0 = ldg<f32x4>(cw, ch * 4u), w1 = ldg<f32x4>(cw, (DFF + ch) * 4u), w2 = ldg<f32x4>(cw, (2 * DFF + ch) * 4u), bb = ldg<f32x4>(cb, ch * 4u);
                f32x4 r1p = (f32x4){0.f, 0.f, 0.f, 0.f}, r2p = r1p;
#pragma unroll
                for (int m = 0; m < 4; ++m) {
                    unsigned r = rowb + ai * 128 + m * 16; asm volatile("" : "+v"(r));
                    const float rs = rsqrtf((float)ldg<unsigned long long>(SS, r * 8u) * (1.0f / 16777216.0f / DM) + EPS);
                    const f32x4 g = acc[ai][0][m][n] * rs, up = acc[ai][1][m][n] * rs;
                    f32x4 r1, r2;
#pragma unroll
                    for (int j = 0; j < 4; ++j) { const float gj = g[j]; const int gi = __float_as_int(gj);
                        r1[j] = __int_as_float(__builtin_amdgcn_update_dpp(0, gi, 0x121, 0xf, 0xf, false));
                        r2[j] = __int_as_float(__builtin_amdgcn_update_dpp(0, gi, 0x122, 0xf, 0xf, false)); }
                    const f32x4 p1 = (fr >= 1) ? r1 : r1p, p2 = (fr >= 2) ? r2 : r2p;
#if defined(DBG_TAPS) && DBG_TAPS == 0
                    f32x4 c = bb + w2 * g;
#elif defined(DBG_TAPS) && DBG_TAPS == 1
                    f32x4 c = bb + w1 * p1 + w2 * g;
#else
                    f32x4 c = bb + w0 * p2 + w1 * p1 + w2 * g;
#endif
#pragma unroll
                    for (int j = 0; j < 4; ++j) c[j] = silu_f(c[j]) * up[j];
                    acc[ai][0][m][n] = c;
                    r1p = r1; r2p = r2;
                }
                asm volatile("" ::: "memory");
            }
#pragma unroll
            for (int m = 0; m < 4; ++m) {
                const unsigned r = rowb + ai * 128 + m * 16;
                const f32x4 v0 = acc[ai][0][m][0], v1 = acc[ai][0][m][1];
                v4u w; w.x = pg8::cvt_pk_bf16(v0[0], v0[1]); w.y = pg8::cvt_pk_bf16(v0[2], v0[3]); w.z = pg8::cvt_pk_bf16(v1[0], v1[1]); w.w = pg8::cvt_pk_bf16(v1[2], v1[3]);
                unsigned bo = (r * (unsigned)DFF + ch0) * 2u;
                if (m == 0) bo = (fr < 2) ? (unsigned)((size_t)M * DFF * 2) + (threadIdx.x * 16u) : bo;
                stg<v4u>(ACT, bo, w);
            }
            asm volatile("" ::: "memory");
        }
    }
};

__device__ __forceinline__ void p0_transpose_item(const float* W, int K, int N, const float* gk, bf16* WT, int dest_row0, int k0, int n0, LAS float* scr, int lane) {
#pragma unroll 8
    for (int i = 0; i < 32; ++i) { const int kk = 2 * i + (lane >> 5); float v = W[(size_t)(k0 + kk) * N + n0 + (lane & 31)]; if (gk) v *= gk[k0 + kk]; scr[kk * 33 + (lane & 31)] = v; }
    LDS_WAIT(); asm volatile("" ::: "memory");
    const int c = lane & 7;
#pragma unroll
    for (int j = 0; j < 4; ++j) { const int n = (lane >> 3) + 8 * j; const LAS float* s = scr + (8 * c) * 33 + n;
        v4u o; o.x = pk2(s[0 * 33], s[1 * 33]); o.y = pk2(s[2 * 33], s[3 * 33]); o.z = pk2(s[4 * 33], s[5 * 33]); o.w = pk2(s[6 * 33], s[7 * 33]);
        *(GAS v4u*)(WT + (size_t)(dest_row0 + n) * K + k0 + 8 * c) = o; }
    LDS_WAIT(); asm volatile("" ::: "memory");
}

__device__ __forceinline__ void prologue(const Ctx& p, LAS unsigned char* lds, int wave, int lane, bool first) {
    LAS float* scr = (LAS float*)(lds + wave * 16384);
    const int gw = blockIdx.x * NWAVES + wave, NGW = gridDim.x * NWAVES;
    constexpr int I_IN = (DM / 64) * (INW / 32), I_OUT = (DM / 64) * (DM / 32), I_G = (DM / 64) * (DFF / 32), I_D = (DFF / 64) * (DM / 32);
    constexpr int PER_L = I_IN + I_OUT + 2 * I_G + I_D;
    for (int it = gw; it < DEPTH * PER_L; it += NGW) {
        const int l = it / PER_L; int r = it % PER_L;
        unsigned char* wl = p.ws + WS_W + (size_t)l * W_LAYER;
        if (r < I_IN) { const int nblk = INW / 32, kb = r / nblk, nb = r % nblk;
            p0_transpose_item(PIN(p, I_WIN) + (size_t)l * DM * INW, DM, INW, PIN(p, I_N1G) + l * DM, (bf16*)(wl + W_IN), 32 * nb, 64 * kb, 32 * nb, scr, lane); continue; } r -= I_IN;
        if (r < I_OUT) { const int nblk = DM / 32, kb = r / nblk, nb = r % nblk;
            p0_transpose_item(PIN(p, I_WOUT) + (size_t)l * DM * DM, DM, DM, nullptr, (bf16*)(wl + W_OUT), 32 * nb, 64 * kb, 32 * nb, scr, lane); continue; } r -= I_OUT;
        if (r < 2 * I_G) { const int up = r >= I_G; if (up) r -= I_G; const int nblk = DFF / 32, kb = r / nblk, nb = r % nblk, n0 = 32 * nb;
            const int dest = 256 * (n0 / 128) + (n0 % 128) + (up ? 128 : 0);
            p0_transpose_item(PIN(p, up ? I_WUP : I_WGATE) + (size_t)l * DM * DFF, DM, DFF, PIN(p, I_N2G) + l * DM, (bf16*)(wl + W_GU), dest, 64 * kb, n0, scr, lane); continue; } r -= 2 * I_G;
        { const int nblk = DM / 32, kb = r / nblk, nb = r % nblk;
            p0_transpose_item(PIN(p, I_WDOWN) + (size_t)l * DFF * DM, DFF, DM, nullptr, (bf16*)(wl + W_DN), 32 * nb, 64 * kb, 32 * nb, scr, lane); }
    }
    const float* x = PIN(p, I_X); bf16* XB = (bf16*)(p.ws + WS_XB); unsigned long long* SS = (unsigned long long*)(p.ws + WS_SS);
    for (int m = gw; m < M; m += NGW) {
        const f32x4* xr = (const f32x4*)(x + (size_t)m * DM) + lane; f32x4 v[4]; float s = 0.f;
#pragma unroll
        for (int j = 0; j < 4; ++j) { v[j] = xr[64 * j]; s += (v[j].x * v[j].x + v[j].y * v[j].y) + (v[j].z * v[j].z + v[j].w * v[j].w); }
        s = wave_sum(s);
        unsigned long long* o8 = (unsigned long long*)(XB + (size_t)m * DM) + lane;
#pragma unroll
        for (int j = 0; j < 4; ++j) o8[64 * j] = (unsigned long long)pk2(v[j].x, v[j].y) | ((unsigned long long)pk2(v[j].z, v[j].w) << 32);
        if (lane == 0 && first) __hip_atomic_fetch_add(SS + m, (unsigned long long)(s * 16777216.0f), __ATOMIC_RELAXED, __HIP_MEMORY_SCOPE_AGENT);
    }
    { bf16* wtb = (bf16*)(p.ws + WS_TAB + 131072); const float* wsrc = PIN(p, I_WS);
        for (int i = gw * 64 + lane; i < DEPTH * 4 * 128 * 128; i += NGW * 64) { const int s_ = i & 127, t_ = (i >> 7) & 127; wtb[i] = (bf16)f2bf(s_ <= t_ ? wsrc[i] : 0.f); } }
    if (blockIdx.x == 0) { float* bt = (float*)(p.ws + WS_TAB);
        for (int i = wave * 64 + lane; i < 1024; i += NWAVES * 64) { const int h = i >> 7, d = i & 127; bt[i] = PIN(p, I_RELB)[(int)((LAS unsigned char*)(lds + TAB_OFF + 256))[d] * 8 + h]; } }
}

#ifdef DBG_MIXCMP
__device__ __forceinline__ void mixer_a_simple(const Ctx& p, int l, int unit, LAS unsigned char* lds, int wave, int lane) {
    LAS float* vn = (LAS float*)lds;
    const int g = unit & 3, ck = unit >> 2; const size_t row0 = (size_t)ck * 128;
    const bf16* PROJ = (const bf16*)(p.ws + WS_PROJ); bf16* MIXED = (bf16*)(p.ws + WS_MIXED);
    const float vg = PIN(p, I_VNG)[(l * 4 + g) * 64 + lane];
#pragma unroll 4
    for (int i = 0; i < 16; ++i) { const int s = wave * 16 + i;
        const float v = bf2f(PROJ[(row0 + s) * INW + C_AV + g * 64 + lane]);
        const float ss = wave_sum(v * v);
        vn[s * 64 + lane] = v * rsqrtf(ss * (1.0f / 64.0f) + EPS) * vg; }
    __syncthreads();
    const float* Wg = PIN(p, I_WS) + (size_t)(l * 4 + g) * 128 * 128; const float* bs = PIN(p, I_BS) + (l * 4 + g) * 128;
    for (int i = 0; i < 16; ++i) { const int t = __builtin_amdgcn_readfirstlane(wave + 8 * i);
        const float* wrow = Wg + t * 128; float a = 0.f;
        for (int s0 = 0; s0 <= t; s0 += 4) { const f32x4 w = *(const f32x4*)(wrow + s0);
#pragma unroll
            for (int j = 0; j < 4; ++j) { const float wj = (s0 + j <= t) ? w[j] : 0.f; a += wj * vn[(s0 + j) * 64 + lane]; } }
        a += bs[t];
        const float uval = bf2f(PROJ[(row0 + t) * INW + C_AU + g * 64 + lane]);
        MIXED[(row0 + t) * DM + MX_A + g * 64 + lane] = (bf16)f2bf(uval * a * DBG_A); }
    __syncthreads();
}

#endif
#ifdef DBG_MIXCMP
constexpr int KVS = 68;
__device__ __forceinline__ void mixer_b_simple(const Ctx& p, int l, int unit, LAS unsigned char* lds, int wave, int lane) {
    LAS float* Kt = (LAS float*)lds; LAS float* Vt = Kt + 256 * KVS;
    const int hk = unit & 1, nb = unit >> 1, n = nb & 63; const long row0 = (long)nb * 128, win0 = row0 - 128;
    const bf16* PROJ = (const bf16*)(p.ws + WS_PROJ); bf16* MIXED = (bf16*)(p.ws + WS_MIXED);
    const int tid = wave * 64 + lane;
    {
        const int row = tid >> 1, half = tid & 1; const bool valid = (n > 0) || (row >= 128);
        float kf[32], vf[32];
        if (valid) { const v4u* kp = (const v4u*)(PROJ + (win0 + row) * INW + C_BK + hk * 64 + half * 32); const v4u* vp = (const v4u*)(PROJ + (win0 + row) * INW + C_BV + hk * 64 + half * 32);
#pragma unroll
            for (int c = 0; c < 4; ++c) { const v4u a = kp[c], b = vp[c];
                kf[8 * c + 0] = bflo(a.x); kf[8 * c + 1] = bfhi(a.x); kf[8 * c + 2] = bflo(a.y); kf[8 * c + 3] = bfhi(a.y); kf[8 * c + 4] = bflo(a.z); kf[8 * c + 5] = bfhi(a.z); kf[8 * c + 6] = bflo(a.w); kf[8 * c + 7] = bfhi(a.w);
                vf[8 * c + 0] = bflo(b.x); vf[8 * c + 1] = bfhi(b.x); vf[8 * c + 2] = bflo(b.y); vf[8 * c + 3] = bfhi(b.y); vf[8 * c + 4] = bflo(b.z); vf[8 * c + 5] = bfhi(b.z); vf[8 * c + 6] = bflo(b.w); vf[8 * c + 7] = bfhi(b.w); } }
        else {
#pragma unroll
            for (int c = 0; c < 32; ++c) { kf[c] = 0.f; vf[c] = 0.f; } }
        float ss = 0.f;
#pragma unroll
        for (int c = 0; c < 32; ++c) ss += kf[c] * kf[c];
        ss += __shfl_xor(ss, 1);
        const float rs = rsqrtf(ss * (1.0f / 64.0f) + EPS); const float* kng = PIN(p, I_KNG) + l * 64 + half * 32;
#pragma unroll
        for (int c = 0; c < 8; ++c) {
            *(LAS f32x4*)(Kt + row * KVS + half * 32 + 4 * c) = (f32x4){kf[4 * c] * rs * kng[4 * c], kf[4 * c + 1] * rs * kng[4 * c + 1], kf[4 * c + 2] * rs * kng[4 * c + 2], kf[4 * c + 3] * rs * kng[4 * c + 3]};
            *(LAS f32x4*)(Vt + row * KVS + half * 32 + 4 * c) = (f32x4){vf[4 * c], vf[4 * c + 1], vf[4 * c + 2], vf[4 * c + 3]}; }
    }
    __syncthreads();
    const int g = wave >> 1, i = (wave & 1) * 64 + lane, h = hk * 4 + g;
    float q[64];
    { const v4u* qp = (const v4u*)(PROJ + (row0 + i) * INW + C_BQ + h * 64); float ss = 0.f;
#pragma unroll
        for (int c = 0; c < 8; ++c) { const v4u a = qp[c];
            q[8 * c + 0] = bflo(a.x); q[8 * c + 1] = bfhi(a.x); q[8 * c + 2] = bflo(a.y); q[8 * c + 3] = bfhi(a.y); q[8 * c + 4] = bflo(a.z); q[8 * c + 5] = bfhi(a.z); q[8 * c + 6] = bflo(a.w); q[8 * c + 7] = bfhi(a.w); }
#pragma unroll
        for (int c = 0; c < 64; ++c) ss += q[c] * q[c];
        const float rs = rsqrtf(ss * (1.0f / 64.0f) + EPS) * 0.125f; const float* qng = PIN(p, I_QNG) + l * 64;
#pragma unroll
        for (int c = 0; c < 64; ++c) q[c] *= rs * qng[c]; }
    float mx = PIN(p, I_SINK)[l * 8 + h], lsum = 1.0f; float o[64];
#pragma unroll
    for (int c = 0; c < 64; ++c) o[c] = 0.f;
    const float* bt = (const float*)(p.ws + WS_TAB) + h * 128;
    for (int dist = 0; dist < 128; ++dist) {
        const int j = i + 128 - dist; const LAS float* kr = Kt + j * KVS; const LAS float* vr = Vt + j * KVS;
        float s0 = 0.f, s1 = 0.f, s2 = 0.f, s3 = 0.f;
#pragma unroll
        for (int c = 0; c < 16; ++c) { const f32x4 kk = *(const LAS f32x4*)(kr + 4 * c); s0 += q[4 * c] * kk.x; s1 += q[4 * c + 1] * kk.y; s2 += q[4 * c + 2] * kk.z; s3 += q[4 * c + 3] * kk.w; }
        float s = (s0 + s1) + (s2 + s3) + bt[dist];
        if (n == 0 && j < 128) s = -1e30f;
        if (s > mx) { const float f = __expf(mx - s); lsum *= f;
#pragma unroll
            for (int c = 0; c < 64; ++c) o[c] *= f;
            mx = s; }
        const float pr = __expf(s - mx); lsum += pr;
#pragma unroll
        for (int c = 0; c < 16; ++c) { const f32x4 vv = *(const LAS f32x4*)(vr + 4 * c); o[4 * c] += pr * vv.x; o[4 * c + 1] += pr * vv.y; o[4 * c + 2] += pr * vv.z; o[4 * c + 3] += pr * vv.w; }
    }
    const float inv = DBG_B / lsum; v4u* op = (v4u*)(MIXED + (row0 + i) * DM + MX_B + h * 64);
#pragma unroll
    for (int c = 0; c < 8; ++c) { v4u w; w.x = pk2(o[8 * c] * inv, o[8 * c + 1] * inv); w.y = pk2(o[8 * c + 2] * inv, o[8 * c + 3] * inv); w.z = pk2(o[8 * c + 4] * inv, o[8 * c + 5] * inv); w.w = pk2(o[8 * c + 6] * inv, o[8 * c + 7] * inv); op[c] = w; }
    __syncthreads();
}

#endif

namespace mb {
typedef short bf16x8 __attribute__((ext_vector_type(8)));
typedef short s16x4 __attribute__((ext_vector_type(4)));
typedef float f32x16 __attribute__((ext_vector_type(16)));
typedef float f32x2_t __attribute__((ext_vector_type(2)));
typedef __bf16 bf16x2_t __attribute__((ext_vector_type(2)));
constexpr int KB_OFF = 0, VB_OFF = 32768, BIAS_OFF = 65536, WS_OFF = 73728, WS_STRIDE = 4608;
__device__ __forceinline__ int crow(int r, int hi) { return (r & 3) + 8 * (r >> 2) + 4 * hi; }
__device__ __forceinline__ unsigned cvtpk(float lo, float hi) { f32x2_t v = {lo, hi}; bf16x2_t b = __builtin_convertvector(v, bf16x2_t); return __builtin_bit_cast(unsigned, b); }
__device__ __forceinline__ s16x4 vtr(LAS const unsigned char* p) { return __builtin_bit_cast(s16x4, __builtin_amdgcn_ds_read_tr16_b64_v4i16((LAS s16x4*)p)); }
}
__device__ __forceinline__ void mixer_b_mfma(const Ctx& p, int l, int unit, LAS unsigned char* lds, int wave, int lane) {
    using namespace mb;
    const int hk = unit & 1, nb = unit >> 1, n = nb & 63; const long row0 = (long)nb * 128, win0 = row0 - 128;
    const bf16* PROJ = (const bf16*)(p.ws + WS_PROJ); bf16* MIXED = (bf16*)(p.ws + WS_MIXED);
    const int tid = wave * 64 + lane, r32 = lane & 31, hi = lane >> 5;
    {
        const int row = tid >> 1, half = tid & 1; const bool valid = (n > 0) || (row >= 128);
        v4u kr[4], vr[4];
        if (valid) { const v4u* kp = (const v4u*)(PROJ + (win0 + row) * INW + C_BK + hk * 64 + half * 32); const v4u* vp = (const v4u*)(PROJ + (win0 + row) * INW + C_BV + hk * 64 + half * 32);
#pragma unroll
            for (int c = 0; c < 4; ++c) { kr[c] = kp[c]; vr[c] = vp[c]; } }
        else {
#pragma unroll
            for (int c = 0; c < 4; ++c) { kr[c] = (v4u){0u, 0u, 0u, 0u}; vr[c] = kr[c]; } }
        float ss = 0.f;
#pragma unroll
        for (int c = 0; c < 4; ++c) { const unsigned w4[4] = {kr[c].x, kr[c].y, kr[c].z, kr[c].w};
#pragma unroll
            for (int e = 0; e < 4; ++e) { const float a = bflo(w4[e]), b = bfhi(w4[e]); ss += a * a + b * b; } }
        ss += __shfl_xor(ss, 1);
        const float rs = rsqrtf(ss * (1.0f / 64.0f) + EPS); const float* kng = PIN(p, I_KNG) + l * 64 + half * 32;
        LAS unsigned char* kdst = lds + KB_OFF + (row >> 6) * 8192 + (half * 4) * 1024 + (row & 63) * 16;
        LAS unsigned char* vdst = lds + VB_OFF + (row >> 6) * 8192 + half * 4096 + ((row & 63) >> 4) * 1024 + (row & 15) * 64;
#pragma unroll
        for (int c = 0; c < 4; ++c) { const unsigned w4[4] = {kr[c].x, kr[c].y, kr[c].z, kr[c].w}; v4u o;
            unsigned ow[4];
#pragma unroll
            for (int e = 0; e < 4; ++e) ow[e] = cvtpk(bflo(w4[e]) * rs * kng[8 * c + 2 * e], bfhi(w4[e]) * rs * kng[8 * c + 2 * e + 1]);
            o.x = ow[0]; o.y = ow[1]; o.z = ow[2]; o.w = ow[3];
            *(LAS v4u*)(kdst + c * 1024) = o;
            *(LAS v4u*)(vdst + c * 16) = vr[c]; }
        const float* bt = (const float*)(p.ws + WS_TAB) + (hk * 4) * 128;
        for (int i = tid; i < 4 * 384; i += NWAVES * 64) { const int g = i / 384, x = i % 384 - 128; ((LAS float*)(lds + BIAS_OFF))[i] = (x >= 0 && x < 128) ? bt[g * 128 + 127 - x] : 0.f; }
    }
    __syncthreads();
    const int g = wave >> 1, h = hk * 4 + g;
    LAS float* wsf = (LAS float*)(lds + WS_OFF + wave * WS_STRIDE);
    LAS bf16* stg = (LAS bf16*)(lds + WS_OFF + wave * WS_STRIDE + 256);
    const float sink = PIN(p, I_SINK)[l * 8 + h];
    const float* qng = PIN(p, I_QNG) + l * 64;
    const LAS unsigned char* vp0 = lds + VB_OFF + ((lane >> 4) & 1) * 32 + (lane & 3) * 8 + (4 * hi + ((lane & 15) >> 2)) * 64;
#pragma unroll 1
    for (int qt = 0; qt < 2; ++qt) {
        const int i0 = (wave & 1) * 64 + qt * 32, qi = i0 + r32, jt0 = (i0 >= 64) ? 1 : 0;
        bf16x8 qr[4];
        { const bf16* qp = PROJ + (row0 + qi) * INW + C_BQ + h * 64 + hi * 8; v4u raw[4]; float ss = 0.f;
#pragma unroll
            for (int d0 = 0; d0 < 4; ++d0) { raw[d0] = *(const v4u*)(qp + d0 * 16); const unsigned w4[4] = {raw[d0].x, raw[d0].y, raw[d0].z, raw[d0].w};
#pragma unroll
                for (int e = 0; e < 4; ++e) { const float a = bflo(w4[e]), b = bfhi(w4[e]); ss += a * a + b * b; } }
            ss += __shfl_xor(ss, 32);
            const float rs = rsqrtf(ss * (1.0f / 64.0f) + EPS) * 0.125f;
#pragma unroll
            for (int d0 = 0; d0 < 4; ++d0) { const unsigned w4[4] = {raw[d0].x, raw[d0].y, raw[d0].z, raw[d0].w}; const float* gq = qng + d0 * 16 + hi * 8; unsigned ow[4];
#pragma unroll
                for (int e = 0; e < 4; ++e) ow[e] = cvtpk(bflo(w4[e]) * rs * gq[2 * e], bfhi(w4[e]) * rs * gq[2 * e + 1]);
                v4u o; o.x = ow[0]; o.y = ow[1]; o.z = ow[2]; o.w = ow[3]; qr[d0] = __builtin_bit_cast(bf16x8, o); } }
        f32x16 sc[3][2];
#pragma unroll
        for (int jt = 0; jt < 3; ++jt) { const LAS unsigned char* kb = lds + KB_OFF + (jt0 + jt) * 8192 + hi * 1024 + r32 * 16;
            f32x16 a0 = {}, a1 = {};
#pragma unroll
            for (int d0 = 0; d0 < 4; ++d0) { const bf16x8 b0 = *(const LAS bf16x8*)(kb + d0 * 2048), b1 = *(const LAS bf16x8*)(kb + d0 * 2048 + 512);
                a0 = __builtin_amdgcn_mfma_f32_32x32x16_bf16(b0, qr[d0], a0, 0, 0, 0); a1 = __builtin_amdgcn_mfma_f32_32x32x16_bf16(b1, qr[d0], a1, 0, 0, 0); }
            sc[jt][0] = a0; sc[jt][1] = a1; }
        const LAS float* tb = (const LAS float*)(lds + BIAS_OFF) + g * 384 + 128;
        float mx = sink;
#pragma unroll
        for (int jt = 0; jt < 3; ++jt)
#pragma unroll
            for (int hh = 0; hh < 2; ++hh) { const int kj0 = 64 * (jt0 + jt) + 32 * hh + 4 * hi;
                const int x0 = 127 - (qi + 128 - kj0);
#pragma unroll
                for (int r = 0; r < 16; ++r) { const int kc = (r & 3) + 8 * (r >> 2); const int kj = kj0 + kc, dist = qi + 128 - kj;
                    const bool ok = (dist >= 0) && (dist < 128) && ((n > 0) || (kj >= 128));
                    const float s = ok ? sc[jt][hh][r] + tb[x0 + kc] : -1e30f;
                    sc[jt][hh][r] = s; mx = fmaxf(mx, s); } }
        mx = fmaxf(mx, __shfl_xor(mx, 32));
        float lsum = 0.f;
#pragma unroll
        for (int jt = 0; jt < 3; ++jt)
#pragma unroll
            for (int hh = 0; hh < 2; ++hh)
#pragma unroll
                for (int r = 0; r < 16; ++r) { const float e = __expf(sc[jt][hh][r] - mx); sc[jt][hh][r] = e; lsum += e; }
        lsum += __shfl_xor(lsum, 32);
        lsum += __expf(sink - mx);
        f32x16 o0 = {}, o1 = {};
#pragma unroll
        for (int jt = 0; jt < 3; ++jt) { const LAS unsigned char* vb = vp0 + (jt0 + jt) * 8192;
#pragma unroll
            for (int ks = 0; ks < 4; ++ks) { const int hh = ks >> 1, rb = (ks & 1) * 8;
                v4u pw; pw.x = cvtpk(sc[jt][hh][rb + 0], sc[jt][hh][rb + 1]); pw.y = cvtpk(sc[jt][hh][rb + 2], sc[jt][hh][rb + 3]); pw.z = cvtpk(sc[jt][hh][rb + 4], sc[jt][hh][rb + 5]); pw.w = cvtpk(sc[jt][hh][rb + 6], sc[jt][hh][rb + 7]);
                const bf16x8 pa = __builtin_bit_cast(bf16x8, pw);
                const s16x4 l0 = vtr(vb + ks * 1024), h0 = vtr(vb + ks * 1024 + 512), l1 = vtr(vb + 4096 + ks * 1024), h1 = vtr(vb + 4096 + ks * 1024 + 512);
                const bf16x8 v0 = (bf16x8){l0[0], l0[1], l0[2], l0[3], h0[0], h0[1], h0[2], h0[3]}, v1 = (bf16x8){l1[0], l1[1], l1[2], l1[3], h1[0], h1[1], h1[2], h1[3]};
                o0 = __builtin_amdgcn_mfma_f32_32x32x16_bf16(pa, v0, o0, 0, 0, 0); o1 = __builtin_amdgcn_mfma_f32_32x32x16_bf16(pa, v1, o1, 0, 0, 0); } }
        if (hi == 0) wsf[r32] = lsum;
        LDS_WAIT(); asm volatile("" ::: "memory");
#pragma unroll
        for (int r = 0; r < 16; ++r) { const int orow = crow(r, hi); const float inv = DBG_B / wsf[orow];
            stg[orow * 64 + r32] = (bf16)f2bf(o0[r] * inv); stg[orow * 64 + 32 + r32] = (bf16)f2bf(o1[r] * inv); }
        LDS_WAIT(); asm volatile("" ::: "memory");
        bf16* ow = MIXED + (row0 + i0) * DM + MX_B + h * 64;
#pragma unroll
        for (int i = 0; i < 4; ++i) { const int row = i * 8 + (lane >> 3), ch = lane & 7; const v4u v = *(const LAS v4u*)(stg + row * 64 + ch * 8); *(v4u*)(ow + (long)row * DM + ch * 8) = v; }
        LDS_WAIT(); asm volatile("" ::: "memory");
    }
    __syncthreads();
}

constexpr size_t WS_WTB = WS_TAB + 131072;
constexpr int VNT_STRIDE = 136;
__device__ __forceinline__ void mixer_a_mfma(const Ctx& p, int l, int unit, LAS unsigned char* lds, int wave, int lane) {
    using namespace mb;
    LAS bf16* vnT = (LAS bf16*)lds;
    const int g = unit & 3, ck = unit >> 2; const size_t row0 = (size_t)ck * 128;
    const bf16* PROJ = (const bf16*)(p.ws + WS_PROJ); bf16* MIXED = (bf16*)(p.ws + WS_MIXED);
    const int r32 = lane & 31, hi = lane >> 5;
    {
        const int sub = lane >> 4, d4 = (lane & 15) * 4; const f32x4 vg = *(const f32x4*)(PIN(p, I_VNG) + (l * 4 + g) * 64 + d4);
#pragma unroll
        for (int i = 0; i < 4; ++i) { const int s = wave * 16 + i * 4 + sub;
            const v2u raw = *(const v2u*)(PROJ + (row0 + s) * INW + C_AV + g * 64 + d4);
            const float v0 = bflo(raw.x), v1 = bfhi(raw.x), v2 = bflo(raw.y), v3 = bfhi(raw.y);
            float ss = (v0 * v0 + v1 * v1) + (v2 * v2 + v3 * v3);
            ss += __shfl_xor(ss, 1); ss += __shfl_xor(ss, 2); ss += __shfl_xor(ss, 4); ss += __shfl_xor(ss, 8);
            const float rs = rsqrtf(ss * (1.0f / 64.0f) + EPS);
            vnT[(d4 + 0) * VNT_STRIDE + s] = (bf16)f2bf(v0 * rs * vg.x); vnT[(d4 + 1) * VNT_STRIDE + s] = (bf16)f2bf(v1 * rs * vg.y);
            vnT[(d4 + 2) * VNT_STRIDE + s] = (bf16)f2bf(v2 * rs * vg.z); vnT[(d4 + 3) * VNT_STRIDE + s] = (bf16)f2bf(v3 * rs * vg.w); }
    }
    __syncthreads();
    const int ti = wave >> 1, dt = wave & 1;
    const bf16* Wt = (const bf16*)(p.ws + WS_WTB) + ((size_t)(l * 4 + g) * 128 + 32 * ti + r32) * 128 + 8 * hi;
    const LAS bf16* vb = vnT + (32 * dt + r32) * VNT_STRIDE + 8 * hi;
    f32x16 acc = {};
    for (int ks = 0; ks < 2 * ti + 2; ++ks) {
        const bf16x8 a = __builtin_bit_cast(bf16x8, *(const v4u*)(Wt + 16 * ks)); const bf16x8 b = *(const LAS bf16x8*)(vb + 16 * ks);
        acc = __builtin_amdgcn_mfma_f32_32x32x16_bf16(a, b, acc, 0, 0, 0); }
    const float* bs = PIN(p, I_BS) + (l * 4 + g) * 128 + 32 * ti;
#pragma unroll
    for (int r = 0; r < 16; ++r) { const int t = crow(r, hi); const size_t row = row0 + 32 * ti + t;
        const float uval = bf2f(PROJ[row * INW + C_AU + g * 64 + 32 * dt + r32]);
        MIXED[row * DM + MX_A + g * 64 + 32 * dt + r32] = (bf16)f2bf(uval * (acc[r] + bs[t]) * DBG_A); }
    __syncthreads();
}
__device__ __forceinline__ float hgrn_lb(const Ctx& p, int l, int kidx) { if (l == 0) return 0.f; const float* lg = PIN(p, I_LBL); return 1.0f / (1.0f + __expf(lg[kidx] - lg[256 + kidx])); }
__device__ __forceinline__ void hgrn_stage(const bf16* PROJ, size_t rowbase, int hc, const float (&lb8)[8], LAS float* F, LAS float* V, LAS float* Q, int tid) {
    const int tt = tid >> 3, k0 = (tid & 7) * 8; const bf16* rp = PROJ + (rowbase + tt) * INW + hc * 64 + k0;
    const v4u z = *(const v4u*)(rp + C_CF), vi = *(const v4u*)(rp + C_CI);
    float zf[8] = {bflo(z.x), bfhi(z.x), bflo(z.y), bfhi(z.y), bflo(z.z), bfhi(z.z), bflo(z.w), bfhi(z.w)}; float ff[8];
#pragma unroll
    for (int j = 0; j < 8; ++j) ff[j] = lb8[j] + (1.0f - lb8[j]) * __builtin_amdgcn_rcpf(1.0f + __expf(-zf[j]));
    *(LAS f32x4*)(F + tt * 64 + k0) = (f32x4){ff[0], ff[1], ff[2], ff[3]}; *(LAS f32x4*)(F + tt * 64 + k0 + 4) = (f32x4){ff[4], ff[5], ff[6], ff[7]};
    *(LAS f32x4*)(V + tt * 64 + k0) = (f32x4){bflo(vi.x), bfhi(vi.x), bflo(vi.y), bfhi(vi.y)}; *(LAS f32x4*)(V + tt * 64 + k0 + 4) = (f32x4){bflo(vi.z), bfhi(vi.z), bflo(vi.w), bfhi(vi.w)};
    if (Q) { const v4u qq = *(const v4u*)(rp + C_CQ);
        *(LAS f32x4*)(Q + tt * 64 + k0) = (f32x4){bflo(qq.x), bfhi(qq.x), bflo(qq.y), bfhi(qq.y)}; *(LAS f32x4*)(Q + tt * 64 + k0 + 4) = (f32x4){bflo(qq.z), bfhi(qq.z), bflo(qq.w), bfhi(qq.w)}; }
}
__device__ __forceinline__ void mixer_c_pass1(const Ctx& p, int l, int unit, LAS unsigned char* lds, int wave, int lane) {
    LAS float* F = (LAS float*)lds; LAS float* V = F + 4096;
    const int bh = unit >> 4, seg = unit & 15, b = bh >> 2, hc = bh & 3; const size_t row0 = (size_t)b * SEQ + (size_t)seg * 512;
    const bf16* PROJ = (const bf16*)(p.ws + WS_PROJ); const int tid = wave * 64 + lane;
    float lb8[8];
#pragma unroll
    for (int j = 0; j < 8; ++j) lb8[j] = hgrn_lb(p, l, hc * 64 + (tid & 7) * 8 + j);
    float S[8], P[8];
#pragma unroll
    for (int j = 0; j < 8; ++j) { S[j] = 0.f; P[j] = 1.f; }
    for (int cks = 0; cks < 8; ++cks) {
        __syncthreads();
        hgrn_stage(PROJ, row0 + cks * 64, hc, lb8, F, V, nullptr, tid);
        __syncthreads();
        for (int tt = 0; tt < 64; ++tt) {
            const f32x4 fa = *(const LAS f32x4*)(F + tt * 64 + wave * 8), fb = *(const LAS f32x4*)(F + tt * 64 + wave * 8 + 4); const float vv = V[tt * 64 + lane];
            const float f8[8] = {fa.x, fa.y, fa.z, fa.w, fb.x, fb.y, fb.z, fb.w};
#pragma unroll
            for (int j = 0; j < 8; ++j) { S[j] = fmaf(f8[j], S[j] - vv, vv); P[j] *= f8[j]; }
        }
    }
    float* SEGS = (float*)(p.ws + WS_SEGS); float* SEGP = (float*)(p.ws + WS_SEGP);
#pragma unroll
    for (int j = 0; j < 8; ++j) { SEGS[(size_t)unit * 4096 + (wave * 8 + j) * 64 + lane] = S[j]; if (lane == 0) SEGP[unit * 64 + wave * 8 + j] = P[j]; }
    __syncthreads();
}
__device__ __forceinline__ void mixer_c_pass2(const Ctx& p, int l, int unit, LAS unsigned char* lds, int wave, int lane) {
    LAS float* F = (LAS float*)lds; LAS float* V = F + 4096; LAS float* Q = V + 4096; LAS float* PO = Q + 4096;
    const int bh = unit >> 4, seg = unit & 15, b = bh >> 2, hc = bh & 3; const size_t row0 = (size_t)b * SEQ + (size_t)seg * 512;
    const bf16* PROJ = (const bf16*)(p.ws + WS_PROJ); bf16* MIXED = (bf16*)(p.ws + WS_MIXED); const int tid = wave * 64 + lane;
    const float* SEGS = (const float*)(p.ws + WS_SEGS); const float* SEGP = (const float*)(p.ws + WS_SEGP);
    float lb8[8];
#pragma unroll
    for (int j = 0; j < 8; ++j) lb8[j] = hgrn_lb(p, l, hc * 64 + (tid & 7) * 8 + j);
    float S[8];
#pragma unroll
    for (int j = 0; j < 8; ++j) S[j] = 0.f;
    for (int s = 0; s < seg; ++s) { const int u2 = bh * 16 + s;
#pragma unroll
        for (int j = 0; j < 8; ++j) S[j] = SEGP[u2 * 64 + wave * 8 + j] * S[j] + SEGS[(size_t)u2 * 4096 + (wave * 8 + j) * 64 + lane]; }
    const float ong = PIN(p, I_ONG)[l * 64 + lane];
    for (int cks = 0; cks < 8; ++cks) {
        __syncthreads();
        hgrn_stage(PROJ, row0 + cks * 64, hc, lb8, F, V, Q, tid);
        __syncthreads();
        for (int tg = 0; tg < 4; ++tg) {
            for (int t16 = 0; t16 < 16; ++t16) { const int tt = tg * 16 + t16;
                const f32x4 fa = *(const LAS f32x4*)(F + tt * 64 + wave * 8), fb = *(const LAS f32x4*)(F + tt * 64 + wave * 8 + 4);
                const f32x4 qa = *(const LAS f32x4*)(Q + tt * 64 + wave * 8), qb = *(const LAS f32x4*)(Q + tt * 64 + wave * 8 + 4); const float vv = V[tt * 64 + lane];
                const float f8[8] = {fa.x, fa.y, fa.z, fa.w, fb.x, fb.y, fb.z, fb.w}; const float q8[8] = {qa.x, qa.y, qa.z, qa.w, qb.x, qb.y, qb.z, qb.w};
                float po = 0.f;
#pragma unroll
                for (int j = 0; j < 8; ++j) { S[j] = fmaf(f8[j], S[j] - vv, vv); po = fmaf(q8[j], S[j], po); }
                PO[(t16 * 8 + wave) * 64 + lane] = po; }
            __syncthreads();
#pragma unroll
            for (int e = 0; e < 2; ++e) { const int t16 = wave * 2 + e; float o = 0.f;
#pragma unroll
                for (int w = 0; w < 8; ++w) o += PO[(t16 * 8 + w) * 64 + lane];
                const float ss = wave_sum(o * o); const size_t row = row0 + cks * 64 + tg * 16 + t16;
                const float gg = bf2f(PROJ[row * INW + C_CG + hc * 64 + lane]);
                MIXED[row * DM + MX_C + hc * 64 + lane] = (bf16)f2bf(o * rsqrtf(ss * (1.0f / 64.0f) + EPS) * ong * gg * DBG_C); }
            __syncthreads();
        }
    }
}

__device__ __forceinline__ void ffn_fixup(const Ctx& p, int l, int tid) {
    const float* HG = (const float*)(p.ws + WS_HG); const float* HU = (const float*)(p.ws + WS_HU); bf16* ACT = (bf16*)(p.ws + WS_ACT);
    const float* cw = PIN(p, I_CONVW) + (size_t)l * 3 * DFF; const float* cb = PIN(p, I_CONVB) + (size_t)l * DFF;
    const int total = 512 * 2 * (DFF / 4);
    for (int idx = blockIdx.x * (NWAVES * 64) + tid; idx < total; idx += gridDim.x * (NWAVES * 64)) {
        const int c4 = idx % (DFF / 4), rr = idx / (DFF / 4), rho = rr & 1, blk = rr >> 1, ch = 4 * c4;
        const bool first = (blk % 128) == 0;
        const f32x4 z = (f32x4){0.f, 0.f, 0.f, 0.f};
        const f32x4 g0 = *(const f32x4*)(HG + ((size_t)blk * 4 + rho) * DFF + ch);
        f32x4 g1, g2;
        if (rho == 1) { g1 = *(const f32x4*)(HG + ((size_t)blk * 4 + 0) * DFF + ch); g2 = first ? z : *(const f32x4*)(HG + ((size_t)(blk - 1) * 4 + 3) * DFF + ch); }
        else { g1 = first ? z : *(const f32x4*)(HG + ((size_t)(blk - 1) * 4 + 3) * DFF + ch); g2 = first ? z : *(const f32x4*)(HG + ((size_t)(blk - 1) * 4 + 2) * DFF + ch); }
        const f32x4 up = *(const f32x4*)(HU + ((size_t)blk * 2 + rho) * DFF + ch);
        const f32x4 w0 = *(const f32x4*)(cw + ch), w1 = *(const f32x4*)(cw + DFF + ch), w2 = *(const f32x4*)(cw + 2 * DFF + ch), bb = *(const f32x4*)(cb + ch);
        f32x4 c = bb + w0 * g2 + w1 * g1 + w2 * g0;
#pragma unroll
        for (int j = 0; j < 4; ++j) c[j] = silu_f(c[j]) * up[j];
        v2u w; w.x = pk2(c[0], c[1]); w.y = pk2(c[2], c[3]);
        *(v2u*)(ACT + ((size_t)blk * 64 + rho) * DFF + ch) = w;
    }
}

constexpr int PH_PER_LAYER = 7, N_PHASES = 1 + DEPTH * PH_PER_LAYER;
__global__ void __launch_bounds__(NWAVES * 64, 2) fwd_kernel(Params args) {
    extern __shared__ __attribute__((aligned(16))) unsigned char lds_raw[];
    LAS unsigned char* lds = (LAS unsigned char*)lds_raw;
    volatile LAS unsigned* MISC = (volatile LAS unsigned*)(lds + MISC_OFF);
    volatile LAS unsigned long long* TAB = (volatile LAS unsigned long long*)(lds + TAB_OFF);
    LAS unsigned char* BKT = lds + TAB_OFF + 256;
    if (threadIdx.x < 64) MISC[threadIdx.x] = 0u;
    if (threadIdx.x == 0) {
#pragma unroll
        for (int i = 0; i < 19; ++i) TAB[i] = (unsigned long long)args.in[i];
        TAB[19] = (unsigned long long)args.out;
    }
    if (threadIdx.x >= 64 && threadIdx.x < 192) BKT[threadIdx.x - 64] = args.bucket[threadIdx.x - 64];
    __syncthreads();
    unsigned* barw = (unsigned*)(args.ws + WS_CTL) + CW_BAR + args.bar_region * XCD_BAR_WORDS;
    const int lo = args.ph_lo, hi = args.ph_hi;
    XcdBarrier bar; bar.bar = barw; bar.x = 0; bar.st = nullptr;
    if (hi - lo > 1) bar = xcd_barrier_post(barw, MISC + 8);
    const int G = gridDim.x;
#pragma nounroll
    for (int ph = lo; ph < hi; ++ph) {
        const int l = (ph - 1) / PH_PER_LAYER, k = (ph == 0) ? -1 : (ph - 1) % PH_PER_LAYER;
#ifdef DBG_DOUBLE
        const int nrep = ((ph == 0 ? 7 : k) == DBG_DOUBLE) ? 2 : 1;
#else
        const int nrep = 1;
#endif
#pragma nounroll
        for (int rep = 0; rep < nrep; ++rep) {
        int tid = threadIdx.x; asm volatile("" : "+v"(tid));
        Ctx p; p.tab = TAB; p.bucket = nullptr; { GAS unsigned char* wsg = (GAS unsigned char*)args.ws; asm volatile("" : "+s"(wsg)); p.ws = (unsigned char*)wsg; }
        const int lane = tid & 63, wave = __builtin_amdgcn_readfirstlane(tid >> 6);
        const unsigned char* wl = p.ws + WS_W + (size_t)l * W_LAYER;
        if (ph == 0) {
#ifndef NO_P0
            prologue(p, lds, wave, lane, rep == 0);
#endif
        } else if (k == 0) {
#ifndef NO_P1
            pg8::Gemm g{(const bf16*)(p.ws + WS_XB), (const bf16*)(wl + W_IN), M, INW, DM}; pg8::StaticOrder S; S.init(M, INW, G, (int)blockIdx.x);
            EpiInProj E{(bf16*)(p.ws + WS_PROJ), (const unsigned long long*)(p.ws + WS_SS) + (size_t)(2 * l) * M};
            pg8::gemm_phase<EpiInProj, pg8::StaticOrder, true, true>(lds, g, S, E);
#endif
        } else if (k == 1) {
#ifndef NO_P2A
            for (int u = blockIdx.x; u < 256; u += G) mixer_c_pass1(p, l, u, lds, wave, lane);
#ifdef DBG_MIXCMP
            if (args.flags & 1) { for (int u = blockIdx.x; u < 1024; u += G) mixer_a_simple(p, l, u, lds, wave, lane); } else
#endif
            for (int u = blockIdx.x; u < 1024; u += G) mixer_a_mfma(p, l, u, lds, wave, lane);
#endif
        } else if (k == 2) {
#ifndef NO_P2B
            for (int u = blockIdx.x; u < 256; u += G) mixer_c_pass2(p, l, u, lds, wave, lane);
#ifdef DBG_MIXCMP
            if (args.flags & 1) { for (int u = blockIdx.x; u < 512; u += G) mixer_b_simple(p, l, u, lds, wave, lane); } else
#endif
            for (int u = blockIdx.x; u < 512; u += G) mixer_b_mfma(p, l, u, lds, wave, lane);
#endif
        } else if (k == 3) {
#ifndef NO_P3
            const float* xin = (l == 0) ? PIN(p, I_X) : POUT(p);
            pg8::Gemm g{(const bf16*)(p.ws + WS_MIXED), (const bf16*)(wl + W_OUT), M, DM, DM}; pg8::StaticOrder S; S.init(M, DM, G, (int)blockIdx.x);
            EpiResid E{xin, (float*)(p.ws + WS_X1), (bf16*)(p.ws + WS_XB), (unsigned long long*)(p.ws + WS_SS) + (size_t)(2 * l + 1) * M, rep == 0 ? 1 : 0};
            pg8::gemm_phase<EpiResid, pg8::StaticOrder, true, true>(lds, g, S, E);
#endif
        } else if (k == 4) {
#ifndef NO_P4
            pg8::Gemm g{(const bf16*)(p.ws + WS_XB), (const bf16*)(wl + W_GU), M, NGU, DM}; pg8::StaticOrder S; S.init(M, NGU, G, (int)blockIdx.x);
            EpiFFN E{(bf16*)(p.ws + WS_ACT), (const unsigned long long*)(p.ws + WS_SS) + (size_t)(2 * l + 1) * M, PIN(p, I_CONVW) + (size_t)l * 3 * DFF, PIN(p, I_CONVB) + (size_t)l * DFF, (float*)(p.ws + WS_HG), (float*)(p.ws + WS_HU)};
            pg8::gemm_phase<EpiFFN, pg8::StaticOrder, true, true>(lds, g, S, E);
#endif
        } else if (k == 5) {
            ffn_fixup(p, l, tid);
        } else {
#ifndef NO_P5
            pg8::Gemm g{(const bf16*)(p.ws + WS_ACT), (const bf16*)(wl + W_DN), M, DM, DFF}; pg8::StaticOrder S; S.init(M, DM, G, (int)blockIdx.x);
            EpiResid E{(const float*)(p.ws + WS_X1), POUT(p), (bf16*)(p.ws + WS_XB), (unsigned long long*)(p.ws + WS_SS) + (size_t)(2 * l + 2) * M, (l + 1 < DEPTH && rep == 0) ? 1 : 0};
            pg8::gemm_phase<EpiResid, pg8::StaticOrder, true, true>(lds, g, S, E);
#endif
        }
        }
        if (ph + 1 < hi) xcd_barrier(bar);
    }
}


#if defined(DBG_NAIVE_DOWN)
__global__ void __launch_bounds__(256) dbg_down(const bf16* ACT, const float* Wd, const float* X1, float* out) {
    __shared__ float a[4][DFF];
    const int r0 = blockIdx.x * 4, c = threadIdx.x * 4;
    for (int i = threadIdx.x; i < 4 * DFF; i += 256) a[i / DFF][i % DFF] = bf2f(ACT[(size_t)(r0 + i / DFF) * DFF + i % DFF]);
    __syncthreads();
    f32x4 acc[4]; for (int r = 0; r < 4; ++r) acc[r] = (f32x4){0.f, 0.f, 0.f, 0.f};
    for (int k = 0; k < DFF; ++k) { const f32x4 w = *(const f32x4*)(Wd + (size_t)k * DM + c);
        for (int r = 0; r < 4; ++r) acc[r] += w * a[r][k]; }
    for (int r = 0; r < 4; ++r) { const size_t off = (size_t)(r0 + r) * DM + c; *(f32x4*)(out + off) = *(const f32x4*)(X1 + off) + acc[r]; }
}
#endif

#if defined(DBG_FFNCMP)
constexpr int DBG_R = 512;
__global__ void __launch_bounds__(256) dbg_gu(const float* X1, const float* g2, const float* Wg, const float* Wu, float* GU) {
    __shared__ float h[DM];
    const int r = blockIdx.x, c = blockIdx.y * 256 + threadIdx.x;
    float ss = 0.f; for (int k = threadIdx.x; k < DM; k += 256) { const float v = X1[(size_t)r * DM + k]; ss += v * v; }
    __shared__ float red[256]; red[threadIdx.x] = ss; __syncthreads();
    for (int o = 128; o > 0; o >>= 1) { if (threadIdx.x < o) red[threadIdx.x] += red[threadIdx.x + o]; __syncthreads(); }
    const float rstd = rsqrtf(red[0] / DM + EPS);
    for (int k = threadIdx.x; k < DM; k += 256) h[k] = X1[(size_t)r * DM + k] * rstd * g2[k];
    __syncthreads();
    if (c < DFF) { float a = 0.f, b = 0.f; for (int k = 0; k < DM; ++k) { a += h[k] * Wg[(size_t)k * DFF + c]; b += h[k] * Wu[(size_t)k * DFF + c]; }
        GU[((size_t)r * 2 + 0) * DFF + c] = a; GU[((size_t)r * 2 + 1) * DFF + c] = b; }
}
__global__ void __launch_bounds__(256) dbg_cmp(const float* GU, const float* cw, const float* cb, const bf16* ACT, float* acc2) {
    const int r = blockIdx.x, c = blockIdx.y * 256 + threadIdx.x; float num = 0.f, den = 0.f;
    if (c < DFF) { const float g0 = GU[((size_t)r * 2) * DFF + c], g1 = r >= 1 ? GU[((size_t)(r - 1) * 2) * DFF + c] : 0.f, g2 = r >= 2 ? GU[((size_t)(r - 2) * 2) * DFF + c] : 0.f;
#if defined(DBG_TAPS) && DBG_TAPS == 0
        const float cv = cb[c] + cw[2 * DFF + c] * g0;
#elif defined(DBG_TAPS) && DBG_TAPS == 1
        const float cv = cb[c] + cw[DFF + c] * g1 + cw[2 * DFF + c] * g0;
#else
        const float cv = cb[c] + cw[c] * g2 + cw[DFF + c] * g1 + cw[2 * DFF + c] * g0;
#endif
        const float ref = cv / (1.0f + expf(-cv)) * GU[((size_t)r * 2 + 1) * DFF + c];
        const float mine = bf2f(ACT[(size_t)r * DFF + c]);
#if DBG_FFNCMP == 2
        if ((r & 63) < 2) { num = (mine - ref) * (mine - ref); den = ref * ref; }
#elif DBG_FFNCMP == 3
        if ((r & 63) >= 2) { num = (mine - ref) * (mine - ref); den = ref * ref; }
#else
        num = (mine - ref) * (mine - ref); den = ref * ref;
#endif
    }
    __shared__ float rn[256], rd[256]; rn[threadIdx.x] = num; rd[threadIdx.x] = den; __syncthreads();
    for (int o = 128; o > 0; o >>= 1) { if (threadIdx.x < o) { rn[threadIdx.x] += rn[threadIdx.x + o]; rd[threadIdx.x] += rd[threadIdx.x + o]; } __syncthreads(); }
    if (threadIdx.x == 0) { atomicAdd(acc2, rn[0]); atomicAdd(acc2 + 1, rd[0]); }
}
__global__ void dbg_emit(const float* acc2, float* out) { out[0] = 1000.0f * sqrtf(acc2[0] / acc2[1]); }
#endif

#if defined(DBG_MIXCMP)
__global__ void __launch_bounds__(256) dbg_mixcmp(const bf16* A, const bf16* R, int c0, int c1, float* acc2) {
    float num = 0.f, den = 0.f;
    for (size_t r = blockIdx.x; r < (size_t)M; r += gridDim.x)
        for (int c = c0 + threadIdx.x; c < c1; c += 256) { const float a = bf2f(A[r * DM + c]), b = bf2f(R[r * DM + c]); num += (a - b) * (a - b); den += b * b; }
    __shared__ float rn[256], rd[256]; rn[threadIdx.x] = num; rd[threadIdx.x] = den; __syncthreads();
    for (int o = 128; o > 0; o >>= 1) { if (threadIdx.x < o) { rn[threadIdx.x] += rn[threadIdx.x + o]; rd[threadIdx.x] += rd[threadIdx.x + o]; } __syncthreads(); }
    if (threadIdx.x == 0) { atomicAdd(acc2, rn[0]); atomicAdd(acc2 + 1, rd[0]); }
}
__global__ void dbg_emit2(const float* acc2, float* out) { out[0] = 1000.0f * sqrtf(acc2[0] / acc2[1]); }
#endif
#ifndef MK_PER_PHASE
#define MK_PER_PHASE 0
#endif
extern "C" void kernel_launch(void* const* d_in, const int* in_sizes, int n_in, void* d_out, int out_size, void* d_ws, size_t ws_size, hipStream_t stream) {
    static int grid = 0;
    if (grid == 0) {
        if (n_in != 19 || in_sizes[0] != M * DM || out_size != M * DM || ws_size < WS_END) { fprintf(stderr, "kernel_launch: unexpected shapes (n_in %d, in0 %d, out %d, ws %zu)\n", n_in, n_in > 0 ? in_sizes[0] : -1, out_size, ws_size); grid = -1; return; }
        int dev = 0, cus = 0;
        if (hipGetDevice(&dev) != hipSuccess || hipDeviceGetAttribute(&cus, hipDeviceAttributeMultiprocessorCount, dev) != hipSuccess) { grid = -1; return; }
        if (hipFuncSetAttribute((const void*)fwd_kernel, hipFuncAttributeMaxDynamicSharedMemorySize, LDS_BYTES) != hipSuccess) { fprintf(stderr, "kernel_launch: hipFuncSetAttribute failed\n"); grid = -1; return; }
        int per_cu = 0;
        if (hipOccupancyMaxActiveBlocksPerMultiprocessor(&per_cu, (const void*)fwd_kernel, NWAVES * 64, LDS_BYTES) != hipSuccess || per_cu < 1) { fprintf(stderr, "kernel_launch: occupancy query reports %d blocks per CU\n", per_cu); }
        (void)hipGetLastError();
        grid = cus < 256 ? cus : 256;
    }
    if (grid < 0) return;
    (void)hipMemsetAsync((char*)d_ws + WS_CTL, 0, CTL_ZERO_BYTES, stream);
    (void)hipMemsetAsync((char*)d_ws + WS_SS, 0, (size_t)4 * M * 8, stream);
    Params a{};
    for (int i = 0; i < 19; ++i) a.in[i] = (const float*)d_in[i];
    a.out = (float*)d_out; a.ws = (unsigned char*)d_ws;
    for (int n = 0; n < 128; ++n) {
        int bkt;
        if (n < 16) bkt = n; else { const float v = logf((float)n / 16.0f) / (float)log(128.0 / 16.0) * 16.0f; bkt = 16 + (int)v; if (bkt > 31) bkt = 31; }
        a.bucket[n] = (unsigned char)bkt;
    }
#if MK_PER_PHASE
    for (int ph = 0; ph < N_PHASES; ++ph) { a.ph_lo = ph; a.ph_hi = ph + 1; hipLaunchKernelGGL(fwd_kernel, dim3(grid), dim3(NWAVES * 64), LDS_BYTES, stream, a); }
#elif defined(DBG_MIXCMP)
    { float* acc2 = (float*)((char*)d_ws + WS_TAB + 65536); (void)hipMemsetAsync(acc2, 0, 8, stream);
      a.ph_lo = 0; a.ph_hi = 4; a.flags = 1; a.bar_region = 0;
      hipLaunchKernelGGL(fwd_kernel, dim3(grid), dim3(NWAVES * 64), LDS_BYTES, stream, a);
      (void)hipMemcpyAsync((char*)d_ws + WS_X1, (char*)d_ws + WS_MIXED, (size_t)M * DM * 2, hipMemcpyDeviceToDevice, stream);
      (void)hipMemsetAsync((char*)d_ws + WS_MIXED, 0, (size_t)M * DM * 2, stream);
      a.ph_lo = 2; a.ph_hi = 4; a.flags = 0; a.bar_region = 1;
      hipLaunchKernelGGL(fwd_kernel, dim3(grid), dim3(NWAVES * 64), LDS_BYTES, stream, a);
      const int c0 = (DBG_MIXCMP == 1) ? 0 : (DBG_MIXCMP == 2) ? 256 : 768, c1 = (DBG_MIXCMP == 1) ? 256 : (DBG_MIXCMP == 2) ? 768 : 1024;
      hipLaunchKernelGGL(dbg_mixcmp, dim3(1024), dim3(256), 0, stream, (const bf16*)((char*)d_ws + WS_MIXED), (const bf16*)((char*)d_ws + WS_X1), c0, c1, acc2);
      (void)hipMemcpyAsync(d_out, d_in[0], (size_t)M * DM * 4, hipMemcpyDeviceToDevice, stream);
      hipLaunchKernelGGL(dbg_emit2, dim3(1), dim3(1), 0, stream, (const float*)acc2, (float*)d_out); }
#elif defined(DBG_NAIVE_DOWN)
    a.ph_lo = 0; a.ph_hi = 7;
    hipLaunchKernelGGL(fwd_kernel, dim3(grid), dim3(NWAVES * 64), LDS_BYTES, stream, a);
    hipLaunchKernelGGL(dbg_down, dim3(M / 4), dim3(256), 0, stream, (const bf16*)((char*)d_ws + WS_ACT), (const float*)d_in[I_WDOWN], (const float*)((char*)d_ws + WS_X1), (float*)d_out);
#elif defined(DBG_FFNCMP)
    a.ph_lo = 0; a.ph_hi = 7;
    hipLaunchKernelGGL(fwd_kernel, dim3(grid), dim3(NWAVES * 64), LDS_BYTES, stream, a);
    { float* GU = (float*)d_out + (size_t)16 * 1024 * 1024; float* acc2 = (float*)((char*)d_ws + WS_TAB + 65536);
      (void)hipMemsetAsync(acc2, 0, 8, stream);
      hipLaunchKernelGGL(dbg_gu, dim3(DBG_R, 11), dim3(256), 0, stream, (const float*)((char*)d_ws + WS_X1), (const float*)d_in[I_N2G], (const float*)d_in[I_WGATE], (const float*)d_in[I_WUP], GU);
      hipLaunchKernelGGL(dbg_cmp, dim3(DBG_R, 11), dim3(256), 0, stream, (const float*)GU, (const float*)d_in[I_CONVW], (const float*)d_in[I_CONVB], (const bf16*)((char*)d_ws + WS_ACT), acc2);
      (void)hipMemcpyAsync(d_out, d_in[0], (size_t)M * DM * 4, hipMemcpyDeviceToDevice, stream);
      hipLaunchKernelGGL(dbg_emit, dim3(1), dim3(1), 0, stream, (const float*)acc2, (float*)d_out); }
#elif defined(DBG_STOP)
    a.ph_lo = 0; a.ph_hi = DBG_STOP + 1;
    hipLaunchKernelGGL(fwd_kernel, dim3(grid), dim3(NWAVES * 64), LDS_BYTES, stream, a);
    { const int k = (DBG_STOP == 0) ? -1 : (DBG_STOP - 1) % PH_PER_LAYER;
      const float* src = (DBG_STOP == 0) ? (const float*)d_in[0] : ((k >= 3 && k <= 5) ? (const float*)((char*)d_ws + WS_X1) : nullptr);
      if (src) (void)hipMemcpyAsync(d_out, src, (size_t)M * DM * 4, hipMemcpyDeviceToDevice, stream); }
#else
    a.ph_lo = 0; a.ph_hi = N_PHASES;
    hipLaunchKernelGGL(fwd_kernel, dim3(grid), dim3(NWAVES * 64), LDS_BYTES, stream, a);
#endif
    const hipError_t le = hipPeekAtLastError();
    if (le != hipSuccess) fprintf(stderr, "kernel_launch: launch failed: %s\n", hipGetErrorName(le));
}
```

```cpp
#include <hip/hip_runtime.h>
#include <cstdio>
#include <cstdint>
#include <cmath>
namespace pg8 {
#define PG8_LAS __attribute__((address_space(3)))
typedef unsigned short bf16_t;
typedef short bf16x8 __attribute__((ext_vector_type(8)));
typedef float f32x4 __attribute__((ext_vector_type(4)));
typedef unsigned u32x4 __attribute__((ext_vector_type(4)));
constexpr int BM = 256, BK = 64, HALF = 128, HTB = HALF * BK * 2  , STAGE_BYTES = 8 * HTB, NXCD = 8, WGM = 8;

__host__ __device__ __forceinline__ int lds_byte(int r, int c) { const int st = (r >> 4) * 2 + (c >> 5), rr = r & 15, cc = c & 31, ob = rr * 64 + cc * 2; return st * 1024 + (ob ^ (((ob >> 9) & 1) << 5)); }
__host__ __device__ __forceinline__ void stage_rc(int b, int& R, int& C) { const int st = b / 1024, sb = b % 1024, swz = sb ^ (((sb >> 9) & 1) << 5); R = (st >> 1) * 16 + swz / 64; C = (st & 1) * 32 + (swz % 64) / 2; }
__host__ __device__ __forceinline__ int perm32(int rho) { const int n = rho >> 4, i = rho & 15; return 8 * (i >> 2) + 4 * n + (i & 3); }

struct Unit { int pm, pn; };
struct Gemm { const bf16_t* A; const bf16_t* Bt; int M, N, K; };

struct StaticOrder {
    int nM, nN, nwg, G, c;
    __host__ __device__ void init(int M, int N, int G_, int c_) { nM = M / BM; nN = N / BM; nwg = nM * nN; G = G_; c = c_; }
    __host__ __device__ bool next(int i, Unit& u) const {
        const long L = (long)i * G + c; if (L >= nwg) return false;
        int wgid = (int)L; { const int q = nwg / NXCD, r = nwg % NXCD, xcd = wgid % NXCD, off = wgid / NXCD; wgid = (xcd < r ? xcd * (q + 1) : r * (q + 1) + (xcd - r) * q) + off; }
        const int nig = WGM * nN, gid = wgid / nig, fm = gid * WGM, gsz = (nM - fm) < WGM ? (nM - fm) : WGM;
        u.pm = fm + ((wgid % nig) % gsz); u.pn = (wgid % nig) / gsz; return true;
    }
    __device__ __forceinline__ void a_ready(const Unit&) const {}
    __device__ __forceinline__ void done(const Unit&) const {}
};

__device__ __forceinline__ unsigned cvt_pk_bf16(float lo, float hi) { unsigned r; asm volatile("v_cvt_pk_bf16_f32 %0, %1, %2" : "=v"(r) : "v"(lo), "v"(hi)); return r; }
typedef float f32x2 __attribute__((ext_vector_type(2)));
__device__ __forceinline__ f32x2 gelu_pk(f32x2 v) {
    const f32x2 av = __builtin_elementwise_abs(v), d = av * 0.2316418882f + 1.0f;
    f32x2 t; t.x = __builtin_amdgcn_rcpf(d.x); t.y = __builtin_amdgcn_rcpf(d.y);
    f32x2 q = t * 0.5307027145f + (-0.7265760135f); q = q * t + 0.7107068705f; q = q * t + (-0.142248368f); q = q * t + 0.127414796f; q = q * t;
    const f32x2 s = (v * v) * (-0.72134752044f);
    f32x2 e; e.x = __builtin_amdgcn_exp2f(s.x); e.y = __builtin_amdgcn_exp2f(s.y);
    const f32x2 m = v * (q * e), r = v - m;
    f32x2 o; o.x = v.x < 0.f ? m.x : r.x; o.y = v.y < 0.f ? m.y : r.y; return o;
}

template <class Epi, class Sched, bool ALIGN_EPI = false, bool SP2 = false>
__device__ __forceinline__ void gemm_phase(PG8_LAS unsigned char* lds, const Gemm g, const Sched& S, const Epi& E) {
    int tid_l = threadIdx.x; asm volatile("" : "+v"(tid_l));
    const int tid = tid_l, wid = __builtin_amdgcn_readfirstlane(tid >> 6), lane = tid & 63, wr = wid >> 2, wc = wid & 3, fr = lane & 15, fq = lane >> 4;
    const int K = g.K, nt = K / BK;
    unsigned voffA[2], voffB[2];
#pragma unroll
    for (int i = 0; i < 2; ++i) { int R, C; stage_rc(tid * 16 + i * 8192, R, C); const int Rb = Epi::PERM ? ((R & ~31) + perm32(R & 31)) : R;
        voffA[i] = (unsigned)(R * K + C) * 2u; voffB[i] = (unsigned)(Rb * K + C) * 2u; }
    const size_t kstep = (size_t)(BK * 2);
    const size_t hstep = (size_t)HALF * K * 2;
    const size_t tstep = 2 * hstep;
    const unsigned ldsw = (unsigned)wid * 1024u;
    const int aoff = lds_byte(wr * 64 + fr, fq * 8), boff = lds_byte(wc * 32 + fr, fq * 8);
#define PG8_SA(b, h) (((b) * 2 + (h)) * HTB)
#define PG8_SB(b, h) ((4 + (b) * 2 + (h)) * HTB)
#define PG8_STAGE(bufoff, gbase, voff) do { _Pragma("unroll") for (int _i = 0; _i < 2; ++_i) \
        __builtin_amdgcn_global_load_lds((const unsigned*)((const char*)(gbase) + (voff)[_i]), (PG8_LAS unsigned*)(lds + (bufoff) + ldsw + _i * 8192), 16, 0, 0); } while (0)
#define PG8_LDA(dst, b, h) do { _Pragma("unroll") for (int m = 0; m < 4; ++m) _Pragma("unroll") for (int k = 0; k < 2; ++k) dst[m][k] = *(const PG8_LAS bf16x8*)(lds + PG8_SA(b, h) + aoff + m * 2048 + k * 1024); } while (0)
#define PG8_LDB(dst, b, h) do { _Pragma("unroll") for (int n = 0; n < 2; ++n) _Pragma("unroll") for (int k = 0; k < 2; ++k) dst[n][k] = *(const PG8_LAS bf16x8*)(lds + PG8_SB(b, h) + boff + n * 2048 + k * 1024); } while (0)
#define PG8_MMA(ai, bj, At, Bt) do { __builtin_amdgcn_s_setprio(1); _Pragma("unroll") for (int m = 0; m < 4; ++m) _Pragma("unroll") for (int n = 0; n < 2; ++n) _Pragma("unroll") for (int k = 0; k < 2; ++k) \
        acc[ai][bj][m][n] = __builtin_amdgcn_mfma_f32_16x16x32_bf16(Bt[n][k], At[m][k], acc[ai][bj][m][n], 0, 0, 0); __builtin_amdgcn_s_setprio(0); } while (0)
#define PG8_WAIT_V(n) asm volatile("s_waitcnt vmcnt(" #n ")" ::: "memory")
#define PG8_WAIT_L(n) asm volatile("s_waitcnt lgkmcnt(" #n ")" ::: "memory")
#define PG8_BAR __builtin_amdgcn_s_barrier()
#define PG8_SCHED __builtin_amdgcn_sched_barrier(0)
    Unit cur, nxt; int ui = 0;
    if (!S.next(0, cur)) return;
    f32x4 acc[2][2][4][2];
#pragma unroll
    for (int a = 0; a < 2; ++a)
#pragma unroll
        for (int b = 0; b < 2; ++b)
#pragma unroll
            for (int m = 0; m < 4; ++m)
#pragma unroll
                for (int n = 0; n < 2; ++n) acc[a][b][m][n] = (f32x4){0.f, 0.f, 0.f, 0.f};
    bf16x8 At[4][2], B0[2][2], B1[2][2];
    const char* cA = (const char*)g.A + (size_t)cur.pm * tstep; const char* cB = (const char*)g.Bt + (size_t)cur.pn * tstep;
    S.a_ready(cur);
    if constexpr (SP2) {
        PG8_STAGE(PG8_SB(0, 0), cB, voffB); PG8_STAGE(PG8_SB(0, 1), cB + hstep, voffB); PG8_STAGE(PG8_SA(0, 0), cA, voffA); PG8_STAGE(PG8_SA(0, 1), cA + hstep, voffA);
        if (wr == 1) PG8_BAR;
        PG8_WAIT_V(2); PG8_BAR;
        PG8_STAGE(PG8_SB(1, 0), cB + kstep, voffB); PG8_STAGE(PG8_SA(1, 0), cA + kstep, voffA); PG8_STAGE(PG8_SB(1, 1), cB + hstep + kstep, voffB);
        PG8_WAIT_V(6); PG8_BAR;
    } else {
        PG8_STAGE(PG8_SB(0, 0), cB, voffB); PG8_STAGE(PG8_SA(0, 0), cA, voffA); PG8_STAGE(PG8_SB(0, 1), cB + hstep, voffB); PG8_STAGE(PG8_SA(0, 1), cA + hstep, voffA);
        if (wr == 1) PG8_BAR;
        PG8_WAIT_V(4); PG8_BAR;
        PG8_STAGE(PG8_SB(1, 0), cB + kstep, voffB); PG8_STAGE(PG8_SA(1, 0), cA + kstep, voffA); PG8_STAGE(PG8_SB(1, 1), cB + hstep + kstep, voffB);
        PG8_WAIT_V(6); PG8_BAR;
    }
    for (;;) {
        const bool has_next = S.next(ui + 1, nxt);
        const char* nA = has_next ? (const char*)g.A + (size_t)nxt.pm * tstep : cA; const char* nB = has_next ? (const char*)g.Bt + (size_t)nxt.pn * tstep : cB;
        for (int t = 0; t < nt; t += 2) {
            const bool last = (t == nt - 2);
            const char* a1 = cA + (size_t)(t + 1) * kstep;
            const char* a2 = last ? nA : cA + (size_t)(t + 2) * kstep; const char* b2 = last ? nB : cB + (size_t)(t + 2) * kstep;
            const char* a3 = a2 + kstep; const char* b3 = b2 + kstep;
            if (last && has_next) S.a_ready(nxt);
            if constexpr (SP2) {
            PG8_LDB(B0, 0, 0); PG8_LDB(B1, 0, 1); PG8_SCHED; PG8_LDA(At, 0, 0); PG8_STAGE(PG8_SA(1, 1), a1 + hstep, voffA);
            PG8_WAIT_V(8); PG8_WAIT_L(0); PG8_BAR; PG8_MMA(0, 0, At, B0); PG8_MMA(0, 1, At, B1); PG8_BAR; PG8_SCHED;
            PG8_LDA(At, 0, 1); PG8_STAGE(PG8_SB(0, 0), b2, voffB); PG8_STAGE(PG8_SB(0, 1), b2 + hstep, voffB); PG8_STAGE(PG8_SA(0, 0), a2, voffA);
            PG8_WAIT_V(8); PG8_WAIT_L(0); PG8_BAR; PG8_MMA(1, 0, At, B0); PG8_MMA(1, 1, At, B1); PG8_BAR; PG8_SCHED;
            PG8_LDB(B0, 1, 0); PG8_LDB(B1, 1, 1); PG8_SCHED; PG8_LDA(At, 1, 0); PG8_STAGE(PG8_SA(0, 1), a2 + hstep, voffA);
            PG8_WAIT_V(8); PG8_WAIT_L(0); PG8_BAR; PG8_MMA(0, 0, At, B0); PG8_MMA(0, 1, At, B1); PG8_BAR; PG8_SCHED;
            PG8_LDA(At, 1, 1); PG8_STAGE(PG8_SB(1, 0), b3, voffB); PG8_STAGE(PG8_SB(1, 1), b3 + hstep, voffB); PG8_STAGE(PG8_SA(1, 0), a3, voffA);
            PG8_WAIT_V(8); PG8_WAIT_L(0); PG8_BAR; PG8_MMA(1, 0, At, B0); PG8_MMA(1, 1, At, B1); PG8_BAR; PG8_SCHED;
            } else {
            PG8_LDB(B0, 0, 0); PG8_SCHED; PG8_LDA(At, 0, 0); PG8_STAGE(PG8_SA(1, 1), a1 + hstep, voffA);
            PG8_WAIT_L(8); PG8_BAR; PG8_WAIT_L(0); PG8_MMA(0, 0, At, B0); PG8_BAR; PG8_SCHED;
            PG8_LDB(B1, 0, 1); PG8_STAGE(PG8_SB(0, 0), b2, voffB);
            PG8_BAR; PG8_WAIT_L(0); PG8_MMA(0, 1, At, B1); PG8_BAR;
            PG8_LDA(At, 0, 1); PG8_STAGE(PG8_SA(0, 0), a2, voffA);
            PG8_BAR; PG8_WAIT_L(0); PG8_MMA(1, 0, At, B0); PG8_BAR; PG8_SCHED;
            PG8_STAGE(PG8_SB(0, 1), b2 + hstep, voffB);
            PG8_WAIT_V(6); PG8_BAR; PG8_MMA(1, 1, At, B1); PG8_BAR;
            PG8_LDB(B0, 1, 0); PG8_SCHED; PG8_LDA(At, 1, 0); PG8_STAGE(PG8_SA(0, 1), a2 + hstep, voffA);
            PG8_WAIT_L(8); PG8_BAR; PG8_WAIT_L(0); PG8_MMA(0, 0, At, B0); PG8_BAR; PG8_SCHED;
            PG8_LDB(B1, 1, 1); PG8_STAGE(PG8_SB(1, 0), b3, voffB);
            PG8_BAR; PG8_WAIT_L(0); PG8_MMA(0, 1, At, B1); PG8_BAR;
            PG8_LDA(At, 1, 1); PG8_STAGE(PG8_SA(1, 0), a3, voffA);
            PG8_BAR; PG8_WAIT_L(0); PG8_MMA(1, 0, At, B0); PG8_BAR; PG8_SCHED;
            PG8_STAGE(PG8_SB(1, 1), b3 + hstep, voffB);
            PG8_WAIT_V(6); PG8_BAR; PG8_MMA(1, 1, At, B1); PG8_BAR;
            }
        }
        if constexpr (ALIGN_EPI) { if (wr == 0) PG8_BAR; }
        if constexpr (!Epi::AFTER_DRAIN) { E(acc, cur, wr, wc, fr, fq); S.done(cur); }
        if (!has_next) break;
#pragma unroll
        for (int a = 0; a < 2; ++a)
#pragma unroll
            for (int b = 0; b < 2; ++b)
#pragma unroll
                for (int m = 0; m < 4; ++m)
#pragma unroll
                    for (int n = 0; n < 2; ++n) acc[a][b][m][n] = (f32x4){0.f, 0.f, 0.f, 0.f};
        cur = nxt; cA = nA; cB = nB; ++ui;
        if constexpr (ALIGN_EPI) { if (wr == 1) PG8_BAR; }
    }
    PG8_WAIT_V(0);
    if constexpr (!ALIGN_EPI) { if (wr == 0) PG8_BAR; }
    PG8_BAR;
    if constexpr (Epi::AFTER_DRAIN) { E.fused(acc, cur, wr, wc, fr, fq, lds, wid, lane); S.done(cur); }
#undef PG8_SA
#undef PG8_SB
#undef PG8_STAGE
#undef PG8_LDA
#undef PG8_LDB
#undef PG8_MMA
#undef PG8_WAIT_V
#undef PG8_WAIT_L
#undef PG8_BAR
#undef PG8_SCHED
}
}

constexpr int NWAVES = 8;
constexpr int BATCH = 4, SEQ = 8192, DM = 1024, DEPTH = 2;
constexpr int M = BATCH * SEQ;
constexpr int INW = 2304, DFF = 2816, NGU = 2 * DFF;
constexpr float EPS = 1e-6f;
constexpr int C_AU = 0, C_AV = 256, C_BQ = 512, C_BK = 1024, C_BV = 1152, C_CQ = 1280, C_CF = 1536, C_CI = 1792, C_CG = 2048;
constexpr int MX_A = 0, MX_B = 256, MX_C = 768;

constexpr size_t MiB = 1u << 20;
constexpr size_t WS_CTL = 0, CTL_ZERO_BYTES = 1 * MiB;
constexpr size_t WS_TAB = 1 * MiB;
constexpr size_t WS_SS = 2 * MiB;
constexpr size_t WS_SEGS = 4 * MiB;
constexpr size_t WS_SEGP = 8 * MiB;
constexpr size_t WS_HG = 10 * MiB;
constexpr size_t WS_HU = 32 * MiB;
constexpr size_t WS_W = 44 * MiB, W_LAYER = 24 * MiB;
constexpr size_t W_IN = 0, W_OUT = 5 * MiB, W_GU = 7 * MiB, W_DN = 18 * MiB;
constexpr size_t WS_XB = 92 * MiB;
constexpr size_t WS_X1 = 156 * MiB;
constexpr size_t WS_PROJ = 284 * MiB;
constexpr size_t WS_MIXED = 428 * MiB;
constexpr size_t WS_ACT = 284 * MiB;
constexpr size_t WS_END = 492 * MiB;
static_assert((size_t)INW * DM * 2 <= W_OUT - W_IN && (size_t)DM * DM * 2 <= W_GU - W_OUT && (size_t)NGU * DM * 2 <= W_DN - W_GU && W_DN + (size_t)DM * DFF * 2 <= W_LAYER, "weight map");
static_assert(WS_ACT + (size_t)M * DFF * 2 <= WS_END && WS_MIXED + (size_t)M * DM * 2 <= WS_END && WS_PROJ + (size_t)M * INW * 2 <= WS_MIXED, "activation map");
static_assert(WS_HG + (size_t)512 * 4 * DFF * 4 <= WS_HU && WS_HU + (size_t)512 * 2 * DFF * 4 <= WS_W, "halo map");
constexpr int CW_BAR = 4096;

constexpr int LDS_BYTES = 147456;
constexpr int MISC_OFF = LDS_BYTES - 256;

#define GAS __attribute__((address_space(1)))
#define LAS __attribute__((address_space(3)))
typedef unsigned short bf16;
typedef unsigned v4u __attribute__((ext_vector_type(4)));
typedef unsigned v2u __attribute__((ext_vector_type(2)));
typedef float f32x4 __attribute__((ext_vector_type(4)));
typedef float f32x2 __attribute__((ext_vector_type(2)));
#define RLX_AGENT __ATOMIC_RELAXED, __HIP_MEMORY_SCOPE_AGENT
#define LDS_WAIT() asm volatile("s_waitcnt lgkmcnt(0)" ::: "memory")
__device__ __forceinline__ unsigned f2bf(float f) { unsigned u = __builtin_bit_cast(unsigned, f); return (u + 0x7fffu + ((u >> 16) & 1u)) >> 16; }
__device__ __forceinline__ unsigned pk2(float lo, float hi) { return f2bf(lo) | (f2bf(hi) << 16); }
__device__ __forceinline__ float bf2f(unsigned short h) { return __builtin_bit_cast(float, (unsigned)h << 16); }
__device__ __forceinline__ float bflo(unsigned w) { return __builtin_bit_cast(float, w << 16); }
__device__ __forceinline__ float bfhi(unsigned w) { return __builtin_bit_cast(float, w & 0xffff0000u); }
__device__ __forceinline__ float silu_f(float v) { return v * __builtin_amdgcn_rcpf(1.0f + __expf(-v)); }
__device__ __forceinline__ float wave_sum(float v) {
#pragma unroll
    for (int o = 1; o < 64; o <<= 1) v += __shfl_xor(v, o);
    return v;
}
#define XB_TMO      128
#define XB_XCNT(j)  (256  + 64 * (j))
#define XB_XSUB(j)  (1280 + 64 * (j))
#define XB_XGEN(j)  (2304 + 64 * (j))
#define XB_TOP      3328
#define XB_TOPGEN   3392
#define XCD_BAR_WORDS 3456
#define XB_SPIN_CAP (1u << 18)

__device__ __forceinline__ unsigned xb_ld(unsigned* p)              { return __hip_atomic_load(p, __ATOMIC_RELAXED, __HIP_MEMORY_SCOPE_AGENT); }
__device__ __forceinline__ unsigned xb_add(unsigned* p, unsigned v) { return __hip_atomic_fetch_add(p, v, __ATOMIC_RELAXED, __HIP_MEMORY_SCOPE_AGENT); }
__device__ __forceinline__ unsigned xb_xcc_id() { return (unsigned)__builtin_amdgcn_s_getreg((3 << 11) | 20) & 0xFu; }
#define XB_SPIN(cond, bar) do { unsigned _sp = 0; while (cond) { __builtin_amdgcn_s_sleep(1); \
    if ((++_sp & 255u) == 0u) { if (xb_ld(&(bar)[XB_TMO])) break; if (_sp > XB_SPIN_CAP) { atomicAdd(&(bar)[XB_TMO], 1u); break; } } } } while (0)

struct XcdBarrier {
    unsigned* bar; unsigned x;
    volatile LAS unsigned* st;
};

__device__ __forceinline__ XcdBarrier xcd_barrier_post(unsigned* bar, volatile LAS unsigned* st) {
    XcdBarrier b; b.bar = bar; b.x = xb_xcc_id(); b.st = st;
    if (threadIdx.x == 0) (void)xb_add(&bar[XB_XCNT(b.x)], 1u);
    return b;
}
__device__ __forceinline__ void xcd_barrier_complete(unsigned* bar, unsigned x, unsigned& nloc, unsigned& nx) {
    const unsigned G = gridDim.x * gridDim.y * gridDim.z;
    unsigned sum, cnt, mine, sp = 0u;
    for (;;) {
        sum = 0u; cnt = 0u; mine = 0u;
#pragma nounroll
        for (unsigned j = 0; j < 16; ++j) { const unsigned c = xb_ld(&bar[XB_XCNT(j)]); sum += c; cnt += (c > 0u) ? 1u : 0u; mine = (j == x) ? c : mine; }
        if (sum == G) break;
        __builtin_amdgcn_s_sleep(1);
        if ((++sp & 255u) == 0u) { if (xb_ld(&bar[XB_TMO])) break; if (sp > XB_SPIN_CAP) { atomicAdd(&bar[XB_TMO], 1u); break; } }
    }
    nloc = mine > 0u ? mine : 1u; nx = cnt > 0u ? cnt : 1u;
}

__device__ __forceinline__ void xcd_barrier(const XcdBarrier& b) {
    asm volatile("s_waitcnt vmcnt(0)" ::: "memory");
    __syncthreads();
    if (threadIdx.x == 0) {
        unsigned* bar = b.bar;
        __builtin_amdgcn_s_waitcnt(0);
        unsigned nloc = b.st[0], nx = b.st[1];
        if (nloc == 0u) { xcd_barrier_complete(bar, b.x, nloc, nx); b.st[0] = nloc; b.st[1] = nx; }
        const unsigned old = xb_add(&bar[XB_XSUB(b.x)], 1u);
        const unsigned gen = old / nloc;
        if (old + 1u == (gen + 1u) * nloc) {
            __builtin_amdgcn_fence(__ATOMIC_RELEASE, "agent");
            asm volatile("s_waitcnt vmcnt(0)" ::: "memory");
            const unsigned og = xb_add(&bar[XB_TOP], 1u);
            const unsigned tg = og / nx;
            if (og + 1u == (tg + 1u) * nx) xb_add(&bar[XB_TOPGEN], 1u);
            else XB_SPIN(xb_ld(&bar[XB_TOPGEN]) == tg, bar);
            __builtin_amdgcn_fence(__ATOMIC_ACQUIRE, "agent");
            xb_add(&bar[XB_XGEN(b.x)], 1u);
            asm volatile("s_waitcnt vmcnt(0)" ::: "memory");
        } else {
            XB_SPIN(xb_ld(&bar[XB_XGEN(b.x)]) == gen, bar);
            __builtin_amdgcn_fence(__ATOMIC_ACQUIRE, "agent");
            asm volatile("s_waitcnt vmcnt(0)" ::: "memory");
        }
    }
    __syncthreads();
}


#ifndef DBG_MIX
#define DBG_MIX 7
#endif
#ifndef DBG_REP_C1
#define DBG_REP_C1 1
#endif
#ifndef DBG_REP_C2
#define DBG_REP_C2 1
#endif
#ifndef DBG_REP_B
#define DBG_REP_B 1
#endif
#define DBG_A ((DBG_MIX & 1) ? 1.0f : 0.0f)
#define DBG_B ((DBG_MIX & 2) ? 1.0f : 0.0f)
#define DBG_C ((DBG_MIX & 4) ? 1.0f : 0.0f)
struct Params { const float* in[19]; float* out; unsigned char* ws; int ph_lo, ph_hi; int flags, bar_region; unsigned char bucket[128]; };

struct Ctx { volatile LAS unsigned long long* tab; unsigned char* ws; const unsigned char* bucket; };
constexpr int TAB_OFF = LDS_BYTES - 1024;
__device__ __forceinline__ const float* tab_ptr(const Ctx& c, int i) {
    const unsigned long long v = c.tab[i];
    const unsigned lo = (unsigned)__builtin_amdgcn_readfirstlane((int)(unsigned)v), hi = (unsigned)__builtin_amdgcn_readfirstlane((int)(unsigned)(v >> 32));
    return (const float*)(const GAS float*)(((unsigned long long)hi << 32) | lo);
}
#define PIN(c, i) tab_ptr(c, (i))
#define POUT(c) ((float*)tab_ptr(c, 19))
enum { I_X = 0, I_N1G, I_WIN, I_VNG, I_WS, I_BS, I_QNG, I_KNG, I_SINK, I_RELB, I_LBL, I_ONG, I_WOUT, I_N2G, I_WGATE, I_WUP, I_CONVW, I_CONVB, I_WDOWN };

__device__ __forceinline__ float row_rstd(const unsigned long long* SS, int r) {
    return rsqrtf((float)SS[r] * (1.0f / 16777216.0f / DM) + EPS);
}

struct EpiInProj {
    static constexpr bool PERM = true, AFTER_DRAIN = false;
    bf16* O; const unsigned long long* SS;
    __device__ __forceinline__ void operator()(pg8::f32x4 (&acc)[2][2][4][2], const pg8::Unit& u, int wr, int wc, int fr_in, int fq_in) const {
        int fr = fr_in, fq = fq_in; asm volatile("" : "+v"(fr), "+v"(fq));
        const int row0 = u.pm * 256 + wr * 64 + fr, col0 = u.pn * 256 + wc * 32 + 8 * fq;
        const int act = (u.pn <= 1) ? 1 : ((u.pn == 5 || u.pn == 8) ? 2 : 0);
#pragma unroll
        for (int ai = 0; ai < 2; ++ai)
#pragma unroll
            for (int m = 0; m < 4; ++m) {
                const int r = row0 + ai * 128 + m * 16; const float rs = row_rstd(SS, r);
                bf16* rowp = O + (size_t)r * INW + col0;
#pragma unroll
                for (int bj = 0; bj < 2; ++bj) {
                    f32x4 v0 = acc[ai][bj][m][0] * rs, v1 = acc[ai][bj][m][1] * rs;
                    if (act == 1) { pg8::f32x2 a = pg8::gelu_pk((pg8::f32x2){v0[0], v0[1]}), b = pg8::gelu_pk((pg8::f32x2){v0[2], v0[3]}), c = pg8::gelu_pk((pg8::f32x2){v1[0], v1[1]}), d = pg8::gelu_pk((pg8::f32x2){v1[2], v1[3]});
                        v0 = (f32x4){a.x, a.y, b.x, b.y}; v1 = (f32x4){c.x, c.y, d.x, d.y}; }
                    else if (act == 2) {
#pragma unroll
                        for (int j = 0; j < 4; ++j) { v0[j] = silu_f(v0[j]); v1[j] = silu_f(v1[j]); } }
                    v4u w; w.x = pg8::cvt_pk_bf16(v0[0], v0[1]); w.y = pg8::cvt_pk_bf16(v0[2], v0[3]); w.z = pg8::cvt_pk_bf16(v1[0], v1[1]); w.w = pg8::cvt_pk_bf16(v1[2], v1[3]);
                    *(v4u*)(rowp + bj * 128) = w; }
            }
    }
};
struct EpiResid {
    static constexpr bool PERM = true, AFTER_DRAIN = false;
    bf16* xb; float* out; unsigned long long* SS; int mode;
    __device__ __forceinline__ void operator()(pg8::f32x4 (&acc)[2][2][4][2], const pg8::Unit& u, int wr, int wc, int fr_in, int fq_in) const {
        int fr = fr_in, fq = fq_in; asm volatile("" : "+v"(fr), "+v"(fq));
        if (mode == 0) return;
        const unsigned row0 = (unsigned)(u.pm * 256 + wr * 64 + fr), col0 = (unsigned)(u.pn * 256 + wc * 32 + 8 * fq);
#pragma unroll
        for (int ai = 0; ai < 2; ++ai)
#pragma unroll
            for (int m = 0; m < 4; ++m) {
                const unsigned r = row0 + ai * 128 + m * 16, off = r * (unsigned)DM + col0; float ss = 0.f;
#pragma unroll
                for (int bj = 0; bj < 2; ++bj) {
                    const v4u raw = *(const v4u*)((const char*)xb + (off + bj * 128) * 2u);
                    const f32x4 o0 = (f32x4){bflo(raw.x), bfhi(raw.x), bflo(raw.y), bfhi(raw.y)} + acc[ai][bj][m][0], o1 = (f32x4){bflo(raw.z), bfhi(raw.z), bflo(raw.w), bfhi(raw.w)} + acc[ai][bj][m][1];
                    if (mode == 1) { ss += ((o0[0] * o0[0] + o0[1] * o0[1]) + (o0[2] * o0[2] + o0[3] * o0[3])) + ((o1[0] * o1[0] + o1[1] * o1[1]) + (o1[2] * o1[2] + o1[3] * o1[3]));
                        v4u w; w.x = pg8::cvt_pk_bf16(o0[0], o0[1]); w.y = pg8::cvt_pk_bf16(o0[2], o0[3]); w.z = pg8::cvt_pk_bf16(o1[0], o1[1]); w.w = pg8::cvt_pk_bf16(o1[2], o1[3]);
                        *(v4u*)((char*)xb + (off + bj * 128) * 2u) = w; }
                    else { *(f32x4*)((char*)out + (size_t)(off + bj * 128) * 4u) = o0; *(f32x4*)((char*)out + (size_t)(off + bj * 128 + 4) * 4u) = o1; }
                }
                if (mode == 1) { ss += __shfl_xor(ss, 16); ss += __shfl_xor(ss, 32); if (fq == 0) __hip_atomic_fetch_add(SS + r, (unsigned long long)(ss * 16777216.0f), __ATOMIC_RELAXED, __HIP_MEMORY_SCOPE_AGENT); }
                asm volatile("" ::: "memory");
            }
    }
};
struct EpiFFN {
    static constexpr bool PERM = true, AFTER_DRAIN = false;
    bf16* ACT; const unsigned long long* SS; const float* cw; const float* cb; float* HG; float* HU;
    template <class T> static __device__ __forceinline__ T ldg(const void* base, unsigned boff) { return *(const T*)((const char*)base + boff); }
    template <class T> static __device__ __forceinline__ void stg(void* base, unsigned boff, T v) { *(T*)((char*)base + boff) = v; }
    __device__ __forceinline__ void operator()(pg8::f32x4 (&acc)[2][2][4][2], const pg8::Unit& u, int wr, int wc, int fr_in, int fq_in) const {
        int fr = fr_in, fq = fq_in; asm volatile("" : "+v"(fr), "+v"(fq));
        const unsigned rowb = (unsigned)(u.pm * 256 + wr * 64 + fr), ch0 = (unsigned)(u.pn * 128 + wc * 32 + 8 * fq);
        if (fr < 2 || fr >= 14) {
#pragma unroll
            for (int ai = 0; ai < 2; ++ai) {
                const unsigned blk = (unsigned)(u.pm * 4 + ai * 2 + wr);
                const float rs0 = rsqrtf((float)ldg<unsigned long long>(SS, (rowb + ai * 128) * 8u) * (1.0f / 16777216.0f / DM) + EPS);
                const float rs3 = rsqrtf((float)ldg<unsigned long long>(SS, (rowb + ai * 128 + 48) * 8u) * (1.0f / 16777216.0f / DM) + EPS);
#pragma unroll
                for (int n = 0; n < 2; ++n) { const unsigned ch = ch0 + 4u * n;
                    if (fr < 2) { stg<f32x4>(HG, ((blk * 4u + (unsigned)fr) * (unsigned)DFF + ch) * 4u, acc[ai][0][0][n] * rs0); stg<f32x4>(HU, ((blk * 2u + (unsigned)fr) * (unsigned)DFF + ch) * 4u, acc[ai][1][0][n] * rs0); }
                    else { stg<f32x4>(HG, ((blk * 4u + 2u + (unsigned)(fr - 14)) * (unsigned)DFF + ch) * 4u, acc[ai][0][3][n] * rs3); } }
            }
        }
        asm volatile("" ::: "memory");
#pragma unroll
        for (int ai = 0; ai < 2; ++ai) {
#pragma unroll
            for (int n = 0; n < 2; ++n) {
                unsigned ch = ch0 + 4u * n; asm volatile("" : "+v"(ch));
                const f32x4 w0 = ldg<f32x4>(cw, ch * 4u), w1 = ldg<f32x4>(cw, (DFF + ch) * 4u), w2 = ldg<f32x4>(cw, (2 * DFF + ch) * 4u), bb = ldg<f32x4>(cb, ch * 4u);
                f32x4 r1p = (f32x4){0.f, 0.f, 0.f, 0.f}, r2p = r1p;
#pragma unroll
                for (int m = 0; m < 4; ++m) {
                    unsigned r = rowb + ai * 128 + m * 16; asm volatile("" : "+v"(r));
                    const float rs = rsqrtf((float)ldg<unsigned long long>(SS, r * 8u) * (1.0f / 16777216.0f / DM) + EPS);
                    const f32x4 g = acc[ai][0][m][n] * rs, up = acc[ai][1][m][n] * rs;
                    f32x4 r1, r2;
#pragma unroll
                    for (int j = 0; j < 4; ++j) { const float gj = g[j]; const int gi = __float_as_int(gj);
                        r1[j] = __int_as_float(__builtin_amdgcn_update_dpp(0, gi, 0x121, 0xf, 0xf, false));
                        r2[j] = __int_as_float(__builtin_amdgcn_update_dpp(0, gi, 0x122, 0xf, 0xf, false)); }
                    const f32x4 p1 = (fr >= 1) ? r1 : r1p, p2 = (fr >= 2) ? r2 : r2p;
#if defined(DBG_TAPS) && DBG_TAPS == 0
                    f32x4 c = bb + w2 * g;
#elif defined(DBG_TAPS) && DBG_TAPS == 1
                    f32x4 c = bb + w1 * p1 + w2 * g;
#else
                    f32x4 c = bb + w0 * p2 + w1 * p1 + w2 * g;
#endif
#pragma unroll
                    for (int j = 0; j < 4; ++j) c[j] = silu_f(c[j]) * up[j];
                    acc[ai][0][m][n] = c;
                    r1p = r1; r2p = r2;
                }
                asm volatile("" ::: "memory");
            }
#pragma unroll
            for (int m = 0; m < 4; ++m) {
                const unsigned r = rowb + ai * 128 + m * 16;
                const f32x4 v0 = acc[ai][0][m][0], v1 = acc[ai][0][m][1];
                v4u w; w.x = pg8::cvt_pk_bf16(v0[0], v0[1]); w.y = pg8::cvt_pk_bf16(v0[2], v0[3]); w.z = pg8::cvt_pk_bf16(v1[0], v1[1]); w.w = pg8::cvt_pk_bf16(v1[2], v1[3]);
                unsigned bo = (r * (unsigned)DFF + ch0) * 2u;
                if (m == 0) bo = (fr < 2) ? (unsigned)((size_t)M * DFF * 2) + (threadIdx.x * 16u) : bo;
                stg<v4u>(ACT, bo, w);
            }
            asm volatile("" ::: "memory");
        }
    }
};

__device__ __forceinline__ void p0_transpose_item(const float* W, int K, int N, const float* gk, bf16* WT, int dest_row0, int k0, int n0, LAS float* scr, int lane) {
#pragma unroll 8
    for (int i = 0; i < 32; ++i) { const int kk = 2 * i + (lane >> 5); float v = W[(size_t)(k0 + kk) * N + n0 + (lane & 31)]; if (gk) v *= gk[k0 + kk]; scr[kk * 33 + (lane & 31)] = v; }
    LDS_WAIT(); asm volatile("" ::: "memory");
    const int c = lane & 7;
#pragma unroll
    for (int j = 0; j < 4; ++j) { const int n = (lane >> 3) + 8 * j; const LAS float* s = scr + (8 * c) * 33 + n;
        v4u o; o.x = pk2(s[0 * 33], s[1 * 33]); o.y = pk2(s[2 * 33], s[3 * 33]); o.z = pk2(s[4 * 33], s[5 * 33]); o.w = pk2(s[6 * 33], s[7 * 33]);
        *(GAS v4u*)(WT + (size_t)(dest_row0 + n) * K + k0 + 8 * c) = o; }
    LDS_WAIT(); asm volatile("" ::: "memory");
}

__device__ __forceinline__ void prologue(const Ctx& p, LAS unsigned char* lds, int wave, int lane, bool first) {
    LAS float* scr = (LAS float*)(lds + wave * 16384);
    const int gw = blockIdx.x * NWAVES + wave, NGW = gridDim.x * NWAVES;
    constexpr int I_IN = (DM / 64) * (INW / 32), I_OUT = (DM / 64) * (DM / 32), I_G = (DM / 64) * (DFF / 32), I_D = (DFF / 64) * (DM / 32);
    constexpr int PER_L = I_IN + I_OUT + 2 * I_G + I_D;
    for (int it = gw; it < DEPTH * PER_L; it += NGW) {
        const int l = it / PER_L; int r = it % PER_L;
        unsigned char* wl = p.ws + WS_W + (size_t)l * W_LAYER;
        if (r < I_IN) { const int nblk = INW / 32, kb = r / nblk, nb = r % nblk;
            p0_transpose_item(PIN(p, I_WIN) + (size_t)l * DM * INW, DM, INW, PIN(p, I_N1G) + l * DM, (bf16*)(wl + W_IN), 32 * nb, 64 * kb, 32 * nb, scr, lane); continue; } r -= I_IN;
        if (r < I_OUT) { const int nblk = DM / 32, kb = r / nblk, nb = r % nblk;
            p0_transpose_item(PIN(p, I_WOUT) + (size_t)l * DM * DM, DM, DM, nullptr, (bf16*)(wl + W_OUT), 32 * nb, 64 * kb, 32 * nb, scr, lane); continue; } r -= I_OUT;
        if (r < 2 * I_G) { const int up = r >= I_G; if (up) r -= I_G; const int nblk = DFF / 32, kb = r / nblk, nb = r % nblk, n0 = 32 * nb;
            const int dest = 256 * (n0 / 128) + (n0 % 128) + (up ? 128 : 0);
            p0_transpose_item(PIN(p, up ? I_WUP : I_WGATE) + (size_t)l * DM * DFF, DM, DFF, PIN(p, I_N2G) + l * DM, (bf16*)(wl + W_GU), dest, 64 * kb, n0, scr, lane); continue; } r -= 2 * I_G;
        { const int nblk = DM / 32, kb = r / nblk, nb = r % nblk;
            p0_transpose_item(PIN(p, I_WDOWN) + (size_t)l * DFF * DM, DFF, DM, nullptr, (bf16*)(wl + W_DN), 32 * nb, 64 * kb, 32 * nb, scr, lane); }
    }
    const float* x = PIN(p, I_X); bf16* XB = (bf16*)(p.ws + WS_XB); unsigned long long* SS = (unsigned long long*)(p.ws + WS_SS);
    for (int m = gw; m < M; m += NGW) {
        const f32x4* xr = (const f32x4*)(x + (size_t)m * DM) + lane; f32x4 v[4]; float s = 0.f;
#pragma unroll
        for (int j = 0; j < 4; ++j) { v[j] = xr[64 * j]; s += (v[j].x * v[j].x + v[j].y * v[j].y) + (v[j].z * v[j].z + v[j].w * v[j].w); }
        s = wave_sum(s);
        unsigned long long* o8 = (unsigned long long*)(XB + (size_t)m * DM) + lane;
#pragma unroll
        for (int j = 0; j < 4; ++j) o8[64 * j] = (unsigned long long)pk2(v[j].x, v[j].y) | ((unsigned long long)pk2(v[j].z, v[j].w) << 32);
        if (lane == 0 && first) __hip_atomic_fetch_add(SS + m, (unsigned long long)(s * 16777216.0f), __ATOMIC_RELAXED, __HIP_MEMORY_SCOPE_AGENT);
    }
    { bf16* wtb = (bf16*)(p.ws + WS_TAB + 131072); const float* wsrc = PIN(p, I_WS);
        for (int i = gw * 64 + lane; i < DEPTH * 4 * 128 * 128; i += NGW * 64) { const int s_ = i & 127, t_ = (i >> 7) & 127; wtb[i] = (bf16)f2bf(s_ <= t_ ? wsrc[i] : 0.f); } }
    if (blockIdx.x == 0) { float* bt = (float*)(p.ws + WS_TAB);
        for (int i = wave * 64 + lane; i < 1024; i += NWAVES * 64) { const int h = i >> 7, d = i & 127; bt[i] = PIN(p, I_RELB)[(int)((LAS unsigned char*)(lds + TAB_OFF + 256))[d] * 8 + h]; } }
}

#ifdef DBG_MIXCMP
__device__ __forceinline__ void mixer_a_simple(const Ctx& p, int l, int unit, LAS unsigned char* lds, int wave, int lane) {
    LAS float* vn = (LAS float*)lds;
    const int g = unit & 3, ck = unit >> 2; const size_t row0 = (size_t)ck * 128;
    const bf16* PROJ = (const bf16*)(p.ws + WS_PROJ); bf16* MIXED = (bf16*)(p.ws + WS_MIXED);
    const float vg = PIN(p, I_VNG)[(l * 4 + g) * 64 + lane];
#pragma unroll 4
    for (int i = 0; i < 16; ++i) { const int s = wave * 16 + i;
        const float v = bf2f(PROJ[(row0 + s) * INW + C_AV + g * 64 + lane]);
        const float ss = wave_sum(v * v);
        vn[s * 64 + lane] = v * rsqrtf(ss * (1.0f / 64.0f) + EPS) * vg; }
    __syncthreads();
    const float* Wg = PIN(p, I_WS) + (size_t)(l * 4 + g) * 128 * 128; const float* bs = PIN(p, I_BS) + (l * 4 + g) * 128;
    for (int i = 0; i < 16; ++i) { const int t = __builtin_amdgcn_readfirstlane(wave + 8 * i);
        const float* wrow = Wg + t * 128; float a = 0.f;
        for (int s0 = 0; s0 <= t; s0 += 4) { const f32x4 w = *(const f32x4*)(wrow + s0);
#pragma unroll
            for (int j = 0; j < 4; ++j) { const float wj = (s0 + j <= t) ? w[j] : 0.f; a += wj * vn[(s0 + j) * 64 + lane]; } }
        a += bs[t];
        const float uval = bf2f(PROJ[(row0 + t) * INW + C_AU + g * 64 + lane]);
        MIXED[(row0 + t) * DM + MX_A + g * 64 + lane] = (bf16)f2bf(uval * a * DBG_A); }
    __syncthreads();
}

#endif
#ifdef DBG_MIXCMP
constexpr int KVS = 68;
__device__ __forceinline__ void mixer_b_simple(const Ctx& p, int l, int unit, LAS unsigned char* lds, int wave, int lane) {
    LAS float* Kt = (LAS float*)lds; LAS float* Vt = Kt + 256 * KVS;
    const int hk = unit & 1, nb = unit >> 1, n = nb & 63; const long row0 = (long)nb * 128, win0 = row0 - 128;
    const bf16* PROJ = (const bf16*)(p.ws + WS_PROJ); bf16* MIXED = (bf16*)(p.ws + WS_MIXED);
    const int tid = wave * 64 + lane;
    {
        const int row = tid >> 1, half = tid & 1; const bool valid = (n > 0) || (row >= 128);
        float kf[32], vf[32];
        if (valid) { const v4u* kp = (const v4u*)(PROJ + (win0 + row) * INW + C_BK + hk * 64 + half * 32); const v4u* vp = (const v4u*)(PROJ + (win0 + row) * INW + C_BV + hk * 64 + half * 32);
#pragma unroll
            for (int c = 0; c < 4; ++c) { const v4u a = kp[c], b = vp[c];
                kf[8 * c + 0] = bflo(a.x); kf[8 * c + 1] = bfhi(a.x); kf[8 * c + 2] = bflo(a.y); kf[8 * c + 3] = bfhi(a.y); kf[8 * c + 4] = bflo(a.z); kf[8 * c + 5] = bfhi(a.z); kf[8 * c + 6] = bflo(a.w); kf[8 * c + 7] = bfhi(a.w);
                vf[8 * c + 0] = bflo(b.x); vf[8 * c + 1] = bfhi(b.x); vf[8 * c + 2] = bflo(b.y); vf[8 * c + 3] = bfhi(b.y); vf[8 * c + 4] = bflo(b.z); vf[8 * c + 5] = bfhi(b.z); vf[8 * c + 6] = bflo(b.w); vf[8 * c + 7] = bfhi(b.w); } }
        else {
#pragma unroll
            for (int c = 0; c < 32; ++c) { kf[c] = 0.f; vf[c] = 0.f; } }
        float ss = 0.f;
#pragma unroll
        for (int c = 0; c < 32; ++c) ss += kf[c] * kf[c];
        ss += __shfl_xor(ss, 1);
        const float rs = rsqrtf(ss * (1.0f / 64.0f) + EPS); const float* kng = PIN(p, I_KNG) + l * 64 + half * 32;
#pragma unroll
        for (int c = 0; c < 8; ++c) {
            *(LAS f32x4*)(Kt + row * KVS + half * 32 + 4 * c) = (f32x4){kf[4 * c] * rs * kng[4 * c], kf[4 * c + 1] * rs * kng[4 * c + 1], kf[4 * c + 2] * rs * kng[4 * c + 2], kf[4 * c + 3] * rs * kng[4 * c + 3]};
            *(LAS f32x4*)(Vt + row * KVS + half * 32 + 4 * c) = (f32x4){vf[4 * c], vf[4 * c + 1], vf[4 * c + 2], vf[4 * c + 3]}; }
    }
    __syncthreads();
    const int g = wave >> 1, i = (wave & 1) * 64 + lane, h = hk * 4 + g;
    float q[64];
    { const v4u* qp = (const v4u*)(PROJ + (row0 + i) * INW + C_BQ + h * 64); float ss = 0.f;
#pragma unroll
        for (int c = 0; c < 8; ++c) { const v4u a = qp[c];
            q[8 * c + 0] = bflo(a.x); q[8 * c + 1] = bfhi(a.x); q[8 * c + 2] = bflo(a.y); q[8 * c + 3] = bfhi(a.y); q[8 * c + 4] = bflo(a.z); q[8 * c + 5] = bfhi(a.z); q[8 * c + 6] = bflo(a.w); q[8 * c + 7] = bfhi(a.w); }
#pragma unroll
        for (int c = 0; c < 64; ++c) ss += q[c] * q[c];
        const float rs = rsqrtf(ss * (1.0f / 64.0f) + EPS) * 0.125f; const float* qng = PIN(p, I_QNG) + l * 64;
#pragma unroll
        for (int c = 0; c < 64; ++c) q[c] *= rs * qng[c]; }
    float mx = PIN(p, I_SINK)[l * 8 + h], lsum = 1.0f; float o[64];
#pragma unroll
    for (int c = 0; c < 64; ++c) o[c] = 0.f;
    const float* bt = (const float*)(p.ws + WS_TAB) + h * 128;
    for (int dist = 0; dist < 128; ++dist) {
        const int j = i + 128 - dist; const LAS float* kr = Kt + j * KVS; const LAS float* vr = Vt + j * KVS;
        float s0 = 0.f, s1 = 0.f, s2 = 0.f, s3 = 0.f;
#pragma unroll
        for (int c = 0; c < 16; ++c) { const f32x4 kk = *(const LAS f32x4*)(kr + 4 * c); s0 += q[4 * c] * kk.x; s1 += q[4 * c + 1] * kk.y; s2 += q[4 * c + 2] * kk.z; s3 += q[4 * c + 3] * kk.w; }
        float s = (s0 + s1) + (s2 + s3) + bt[dist];
        if (n == 0 && j < 128) s = -1e30f;
        if (s > mx) { const float f = __expf(mx - s); lsum *= f;
#pragma unroll
            for (int c = 0; c < 64; ++c) o[c] *= f;
            mx = s; }
        const float pr = __expf(s - mx); lsum += pr;
#pragma unroll
        for (int c = 0; c < 16; ++c) { const f32x4 vv = *(const LAS f32x4*)(vr + 4 * c); o[4 * c] += pr * vv.x; o[4 * c + 1] += pr * vv.y; o[4 * c + 2] += pr * vv.z; o[4 * c + 3] += pr * vv.w; }
    }
    const float inv = DBG_B / lsum; v4u* op = (v4u*)(MIXED + (row0 + i) * DM + MX_B + h * 64);
#pragma unroll
    for (int c = 0; c < 8; ++c) { v4u w; w.x = pk2(o[8 * c] * inv, o[8 * c + 1] * inv); w.y = pk2(o[8 * c + 2] * inv, o[8 * c + 3] * inv); w.z = pk2(o[8 * c + 4] * inv, o[8 * c + 5] * inv); w.w = pk2(o[8 * c + 6] * inv, o[8 * c + 7] * inv); op[c] = w; }
    __syncthreads();
}

#endif

namespace mb {
typedef short bf16x8 __attribute__((ext_vector_type(8)));
typedef short s16x4 __attribute__((ext_vector_type(4)));
typedef float f32x16 __attribute__((ext_vector_type(16)));
typedef float f32x2_t __attribute__((ext_vector_type(2)));
typedef __bf16 bf16x2_t __attribute__((ext_vector_type(2)));
constexpr int KB_OFF = 0, VB_OFF = 32768, BIAS_OFF = 65536, WS_OFF = 73728, WS_STRIDE = 4608;
__device__ __forceinline__ int crow(int r, int hi) { return (r & 3) + 8 * (r >> 2) + 4 * hi; }
__device__ __forceinline__ unsigned cvtpk(float lo, float hi) { f32x2_t v = {lo, hi}; bf16x2_t b = __builtin_convertvector(v, bf16x2_t); return __builtin_bit_cast(unsigned, b); }
__device__ __forceinline__ s16x4 vtr(LAS const unsigned char* p) { return __builtin_bit_cast(s16x4, __builtin_amdgcn_ds_read_tr16_b64_v4i16((LAS s16x4*)p)); }
}
__device__ __forceinline__ void mixer_b_mfma(const Ctx& p, int l, int unit, LAS unsigned char* lds, int wave, int lane) {
    using namespace mb;
    const int hk = unit & 1, nb = unit >> 1, n = nb & 63; const long row0 = (long)nb * 128, win0 = row0 - 128;
    const bf16* PROJ = (const bf16*)(p.ws + WS_PROJ); bf16* MIXED = (bf16*)(p.ws + WS_MIXED);
    const int tid = wave * 64 + lane, r32 = lane & 31, hi = lane >> 5;
    {
        const int row = tid >> 1, half = tid & 1; const bool valid = (n > 0) || (row >= 128);
        v4u kr[4], vr[4];
        if (valid) { const v4u* kp = (const v4u*)(PROJ + (win0 + row) * INW + C_BK + hk * 64 + half * 32); const v4u* vp = (const v4u*)(PROJ + (win0 + row) * INW + C_BV + hk * 64 + half * 32);
#pragma unroll
            for (int c = 0; c < 4; ++c) { kr[c] = kp[c]; vr[c] = vp[c]; } }
        else {
#pragma unroll
            for (int c = 0; c < 4; ++c) { kr[c] = (v4u){0u, 0u, 0u, 0u}; vr[c] = kr[c]; } }
        float ss = 0.f;
#pragma unroll
        for (int c = 0; c < 4; ++c) { const unsigned w4[4] = {kr[c].x, kr[c].y, kr[c].z, kr[c].w};
#pragma unroll
            for (int e = 0; e < 4; ++e) { const float a = bflo(w4[e]), b = bfhi(w4[e]); ss += a * a + b * b; } }
        ss += __shfl_xor(ss, 1);
        const float rs = rsqrtf(ss * (1.0f / 64.0f) + EPS); const float* kng = PIN(p, I_KNG) + l * 64 + half * 32;
        LAS unsigned char* kdst = lds + KB_OFF + (row >> 6) * 8192 + (half * 4) * 1024 + (row & 63) * 16;
        LAS unsigned char* vdst = lds + VB_OFF + (row >> 6) * 8192 + half * 4096 + ((row & 63) >> 4) * 1024 + (row & 15) * 64;
#pragma unroll
        for (int c = 0; c < 4; ++c) { const unsigned w4[4] = {kr[c].x, kr[c].y, kr[c].z, kr[c].w}; v4u o;
            unsigned ow[4];
#pragma unroll
            for (int e = 0; e < 4; ++e) ow[e] = cvtpk(bflo(w4[e]) * rs * kng[8 * c + 2 * e], bfhi(w4[e]) * rs * kng[8 * c + 2 * e + 1]);
            o.x = ow[0]; o.y = ow[1]; o.z = ow[2]; o.w = ow[3];
            *(LAS v4u*)(kdst + c * 1024) = o;
            *(LAS v4u*)(vdst + c * 16) = vr[c]; }
        const float* bt = (const float*)(p.ws + WS_TAB) + (hk * 4) * 128;
        for (int i = tid; i < 4 * 384; i += NWAVES * 64) { const int g = i / 384, x = i % 384 - 128; ((LAS float*)(lds + BIAS_OFF))[i] = (x >= 0 && x < 128) ? bt[g * 128 + 127 - x] : 0.f; }
    }
    __syncthreads();
    const int g = wave >> 1, h = hk * 4 + g;
    LAS float* wsf = (LAS float*)(lds + WS_OFF + wave * WS_STRIDE);
    LAS bf16* stg = (LAS bf16*)(lds + WS_OFF + wave * WS_STRIDE + 256);
    const float sink = PIN(p, I_SINK)[l * 8 + h];
    const float* qng = PIN(p, I_QNG) + l * 64;
    const LAS unsigned char* vp0 = lds + VB_OFF + ((lane >> 4) & 1) * 32 + (lane & 3) * 8 + (4 * hi + ((lane & 15) >> 2)) * 64;
#pragma unroll 1
    for (int qt = 0; qt < 2; ++qt) {
        const int i0 = (wave & 1) * 64 + qt * 32, qi = i0 + r32, jt0 = (i0 >= 64) ? 1 : 0;
        bf16x8 qr[4];
        { const bf16* qp = PROJ + (row0 + qi) * INW + C_BQ + h * 64 + hi * 8; v4u raw[4]; float ss = 0.f;
#pragma unroll
            for (int d0 = 0; d0 < 4; ++d0) { raw[d0] = *(const v4u*)(qp + d0 * 16); const unsigned w4[4] = {raw[d0].x, raw[d0].y, raw[d0].z, raw[d0].w};
#pragma unroll
                for (int e = 0; e < 4; ++e) { const float a = bflo(w4[e]), b = bfhi(w4[e]); ss += a * a + b * b; } }
            ss += __shfl_xor(ss, 32);
            const float rs = rsqrtf(ss * (1.0f / 64.0f) + EPS) * 0.125f;
#pragma unroll
            for (int d0 = 0; d0 < 4; ++d0) { const unsigned w4[4] = {raw[d0].x, raw[d0].y, raw[d0].z, raw[d0].w}; const float* gq = qng + d0 * 16 + hi * 8; unsigned ow[4];
#pragma unroll
                for (int e = 0; e < 4; ++e) ow[e] = cvtpk(bflo(w4[e]) * rs * gq[2 * e], bfhi(w4[e]) * rs * gq[2 * e + 1]);
                v4u o; o.x = ow[0]; o.y = ow[1]; o.z = ow[2]; o.w = ow[3]; qr[d0] = __builtin_bit_cast(bf16x8, o); } }
        f32x16 sc[3][2];
#pragma unroll
        for (int jt = 0; jt < 3; ++jt) { const LAS unsigned char* kb = lds + KB_OFF + (jt0 + jt) * 8192 + hi * 1024 + r32 * 16;
            f32x16 a0 = {}, a1 = {};
#pragma unroll
            for (int d0 = 0; d0 < 4; ++d0) { const bf16x8 b0 = *(const LAS bf16x8*)(kb + d0 * 2048), b1 = *(const LAS bf16x8*)(kb + d0 * 2048 + 512);
                a0 = __builtin_amdgcn_mfma_f32_32x32x16_bf16(b0, qr[d0], a0, 0, 0, 0); a1 = __builtin_amdgcn_mfma_f32_32x32x16_bf16(b1, qr[d0], a1, 0, 0, 0); }
            sc[jt][0] = a0; sc[jt][1] = a1; }
        const LAS float* tb = (const LAS float*)(lds + BIAS_OFF) + g * 384 + 128;
        float mx = sink;
#pragma unroll
        for (int jt = 0; jt < 3; ++jt)
#pragma unroll
            for (int hh = 0; hh < 2; ++hh) { const int kj0 = 64 * (jt0 + jt) + 32 * hh + 4 * hi;
                const int x0 = 127 - (qi + 128 - kj0);
#pragma unroll
                for (int r = 0; r < 16; ++r) { const int kc = (r & 3) + 8 * (r >> 2); const int kj = kj0 + kc, dist = qi + 128 - kj;
                    const bool ok = (dist >= 0) && (dist < 128) && ((n > 0) || (kj >= 128));
                    const float s = ok ? sc[jt][hh][r] + tb[x0 + kc] : -1e30f;
                    sc[jt][hh][r] = s; mx = fmaxf(mx, s); } }
        mx = fmaxf(mx, __shfl_xor(mx, 32));
        float lsum = 0.f;
#pragma unroll
        for (int jt = 0; jt < 3; ++jt)
#pragma unroll
            for (int hh = 0; hh < 2; ++hh)
#pragma unroll
                for (int r = 0; r < 16; ++r) { const float e = __expf(sc[jt][hh][r] - mx); sc[jt][hh][r] = e; lsum += e; }
        lsum += __shfl_xor(lsum, 32);
        lsum += __expf(sink - mx);
        f32x16 o0 = {}, o1 = {};
#pragma unroll
        for (int jt = 0; jt < 3; ++jt) { const LAS unsigned char* vb = vp0 + (jt0 + jt) * 8192;
#pragma unroll
            for (int ks = 0; ks < 4; ++ks) { const int hh = ks >> 1, rb = (ks & 1) * 8;
                v4u pw; pw.x = cvtpk(sc[jt][hh][rb + 0], sc[jt][hh][rb + 1]); pw.y = cvtpk(sc[jt][hh][rb + 2], sc[jt][hh][rb + 3]); pw.z = cvtpk(sc[jt][hh][rb + 4], sc[jt][hh][rb + 5]); pw.w = cvtpk(sc[jt][hh][rb + 6], sc[jt][hh][rb + 7]);
                const bf16x8 pa = __builtin_bit_cast(bf16x8, pw);
                const s16x4 l0 = vtr(vb + ks * 1024), h0 = vtr(vb + ks * 1024 + 512), l1 = vtr(vb + 4096 + ks * 1024), h1 = vtr(vb + 4096 + ks * 1024 + 512);
                const bf16x8 v0 = (bf16x8){l0[0], l0[1], l0[2], l0[3], h0[0], h0[1], h0[2], h0[3]}, v1 = (bf16x8){l1[0], l1[1], l1[2], l1[3], h1[0], h1[1], h1[2], h1[3]};
                o0 = __builtin_amdgcn_mfma_f32_32x32x16_bf16(pa, v0, o0, 0, 0, 0); o1 = __builtin_amdgcn_mfma_f32_32x32x16_bf16(pa, v1, o1, 0, 0, 0); } }
        if (hi == 0) wsf[r32] = lsum;
        LDS_WAIT(); asm volatile("" ::: "memory");
#pragma unroll
        for (int r = 0; r < 16; ++r) { const int orow = crow(r, hi); const float inv = DBG_B / wsf[orow];
            stg[orow * 64 + r32] = (bf16)f2bf(o0[r] * inv); stg[orow * 64 + 32 + r32] = (bf16)f2bf(o1[r] * inv); }
        LDS_WAIT(); asm volatile("" ::: "memory");
        bf16* ow = MIXED + (row0 + i0) * DM + MX_B + h * 64;
#pragma unroll
        for (int i = 0; i < 4; ++i) { const int row = i * 8 + (lane >> 3), ch = lane & 7; const v4u v = *(const LAS v4u*)(stg + row * 64 + ch * 8); *(v4u*)(ow + (long)row * DM + ch * 8) = v; }
        LDS_WAIT(); asm volatile("" ::: "memory");
    }
    __syncthreads();
}

constexpr size_t WS_WTB = WS_TAB + 131072;
constexpr int VNT_STRIDE = 136;
__device__ __forceinline__ void mixer_a_mfma(const Ctx& p, int l, int unit, LAS unsigned char* lds, int wave, int lane) {
    using namespace mb;
    LAS bf16* vnT = (LAS bf16*)lds;
    const int g = unit & 3, ck = unit >> 2; const size_t row0 = (size_t)ck * 128;
    const bf16* PROJ = (const bf16*)(p.ws + WS_PROJ); bf16* MIXED = (bf16*)(p.ws + WS_MIXED);
    const int r32 = lane & 31, hi = lane >> 5;
    {
        const int sub = lane >> 4, d4 = (lane & 15) * 4; const f32x4 vg = *(const f32x4*)(PIN(p, I_VNG) + (l * 4 + g) * 64 + d4);
#pragma unroll
        for (int i = 0; i < 4; ++i) { const int s = wave * 16 + i * 4 + sub;
            const v2u raw = *(const v2u*)(PROJ + (row0 + s) * INW + C_AV + g * 64 + d4);
            const float v0 = bflo(raw.x), v1 = bfhi(raw.x), v2 = bflo(raw.y), v3 = bfhi(raw.y);
            float ss = (v0 * v0 + v1 * v1) + (v2 * v2 + v3 * v3);
            ss += __shfl_xor(ss, 1); ss += __shfl_xor(ss, 2); ss += __shfl_xor(ss, 4); ss += __shfl_xor(ss, 8);
            const float rs = rsqrtf(ss * (1.0f / 64.0f) + EPS);
            vnT[(d4 + 0) * VNT_STRIDE + s] = (bf16)f2bf(v0 * rs * vg.x); vnT[(d4 + 1) * VNT_STRIDE + s] = (bf16)f2bf(v1 * rs * vg.y);
            vnT[(d4 + 2) * VNT_STRIDE + s] = (bf16)f2bf(v2 * rs * vg.z); vnT[(d4 + 3) * VNT_STRIDE + s] = (bf16)f2bf(v3 * rs * vg.w); }
    }
    __syncthreads();
    const int ti = wave >> 1, dt = wave & 1;
    const bf16* Wt = (const bf16*)(p.ws + WS_WTB) + ((size_t)(l * 4 + g) * 128 + 32 * ti + r32) * 128 + 8 * hi;
    const LAS bf16* vb = vnT + (32 * dt + r32) * VNT_STRIDE + 8 * hi;
    f32x16 acc = {};
    for (int ks = 0; ks < 2 * ti + 2; ++ks) {
        const bf16x8 a = __builtin_bit_cast(bf16x8, *(const v4u*)(Wt + 16 * ks)); const bf16x8 b = *(const LAS bf16x8*)(vb + 16 * ks);
        acc = __builtin_amdgcn_mfma_f32_32x32x16_bf16(a, b, acc, 0, 0, 0); }
    const float* bs = PIN(p, I_BS) + (l * 4 + g) * 128 + 32 * ti;
#pragma unroll
    for (int r = 0; r < 16; ++r) { const int t = crow(r, hi); const size_t row = row0 + 32 * ti + t;
        const float uval = bf2f(PROJ[row * INW + C_AU + g * 64 + 32 * dt + r32]);
        MIXED[row * DM + MX_A + g * 64 + 32 * dt + r32] = (bf16)f2bf(uval * (acc[r] + bs[t]) * DBG_A); }
    __syncthreads();
}
__device__ __forceinline__ float hgrn_lb(const Ctx& p, int l, int kidx) { if (l == 0) return 0.f; const float* lg = PIN(p, I_LBL); return 1.0f / (1.0f + __expf(lg[kidx] - lg[256 + kidx])); }
#ifdef DBG_MIXCMP
__device__ __forceinline__ void hgrn_stage(const bf16* PROJ, size_t rowbase, int hc, const float (&lb8)[8], LAS float* F, LAS float* V, LAS float* Q, int tid) {
    const int tt = tid >> 3, k0 = (tid & 7) * 8; const bf16* rp = PROJ + (rowbase + tt) * INW + hc * 64 + k0;
    const v4u z = *(const v4u*)(rp + C_CF), vi = *(const v4u*)(rp + C_CI);
    float zf[8] = {bflo(z.x), bfhi(z.x), bflo(z.y), bfhi(z.y), bflo(z.z), bfhi(z.z), bflo(z.w), bfhi(z.w)}; float ff[8];
#pragma unroll
    for (int j = 0; j < 8; ++j) ff[j] = lb8[j] + (1.0f - lb8[j]) * __builtin_amdgcn_rcpf(1.0f + __expf(-zf[j]));
    *(LAS f32x4*)(F + tt * 64 + k0) = (f32x4){ff[0], ff[1], ff[2], ff[3]}; *(LAS f32x4*)(F + tt * 64 + k0 + 4) = (f32x4){ff[4], ff[5], ff[6], ff[7]};
    *(LAS f32x4*)(V + tt * 64 + k0) = (f32x4){bflo(vi.x), bfhi(vi.x), bflo(vi.y), bfhi(vi.y)}; *(LAS f32x4*)(V + tt * 64 + k0 + 4) = (f32x4){bflo(vi.z), bfhi(vi.z), bflo(vi.w), bfhi(vi.w)};
    if (Q) { const v4u qq = *(const v4u*)(rp + C_CQ);
        *(LAS f32x4*)(Q + tt * 64 + k0) = (f32x4){bflo(qq.x), bfhi(qq.x), bflo(qq.y), bfhi(qq.y)}; *(LAS f32x4*)(Q + tt * 64 + k0 + 4) = (f32x4){bflo(qq.z), bfhi(qq.z), bflo(qq.w), bfhi(qq.w)}; }
}
__device__ __forceinline__ void mixer_c_pass1_simple(const Ctx& p, int l, int unit, LAS unsigned char* lds, int wave, int lane) {
    LAS float* F = (LAS float*)lds; LAS float* V = F + 4096;
    const int bh = unit >> 4, seg = unit & 15, b = bh >> 2, hc = bh & 3; const size_t row0 = (size_t)b * SEQ + (size_t)seg * 512;
    const bf16* PROJ = (const bf16*)(p.ws + WS_PROJ); const int tid = wave * 64 + lane;
    float lb8[8];
#pragma unroll
    for (int j = 0; j < 8; ++j) lb8[j] = hgrn_lb(p, l, hc * 64 + (tid & 7) * 8 + j);
    float S[8], P[8];
#pragma unroll
    for (int j = 0; j < 8; ++j) { S[j] = 0.f; P[j] = 1.f; }
    for (int cks = 0; cks < 8; ++cks) {
        __syncthreads();
        hgrn_stage(PROJ, row0 + cks * 64, hc, lb8, F, V, nullptr, tid);
        __syncthreads();
        for (int tt = 0; tt < 64; ++tt) {
            const f32x4 fa = *(const LAS f32x4*)(F + tt * 64 + wave * 8), fb = *(const LAS f32x4*)(F + tt * 64 + wave * 8 + 4); const float vv = V[tt * 64 + lane];
            const float f8[8] = {fa.x, fa.y, fa.z, fa.w, fb.x, fb.y, fb.z, fb.w};
#pragma unroll
            for (int j = 0; j < 8; ++j) { S[j] = fmaf(f8[j], S[j] - vv, vv); P[j] *= f8[j]; }
        }
    }
    float* SEGS = (float*)(p.ws + WS_SEGS); float* SEGP = (float*)(p.ws + WS_SEGP);
#pragma unroll
    for (int j = 0; j < 8; ++j) { SEGS[(size_t)unit * 4096 + (wave * 8 + j) * 64 + lane] = S[j]; if (lane == 0) SEGP[unit * 64 + wave * 8 + j] = P[j]; }
    __syncthreads();
}
__device__ __forceinline__ void mixer_c_pass2_simple(const Ctx& p, int l, int unit, LAS unsigned char* lds, int wave, int lane) {
    LAS float* F = (LAS float*)lds; LAS float* V = F + 4096; LAS float* Q = V + 4096; LAS float* PO = Q + 4096;
    const int bh = unit >> 4, seg = unit & 15, b = bh >> 2, hc = bh & 3; const size_t row0 = (size_t)b * SEQ + (size_t)seg * 512;
    const bf16* PROJ = (const bf16*)(p.ws + WS_PROJ); bf16* MIXED = (bf16*)(p.ws + WS_MIXED); const int tid = wave * 64 + lane;
    const float* SEGS = (const float*)(p.ws + WS_SEGS); const float* SEGP = (const float*)(p.ws + WS_SEGP);
    float lb8[8];
#pragma unroll
    for (int j = 0; j < 8; ++j) lb8[j] = hgrn_lb(p, l, hc * 64 + (tid & 7) * 8 + j);
    float S[8];
#pragma unroll
    for (int j = 0; j < 8; ++j) S[j] = 0.f;
    for (int s = 0; s < seg; ++s) { const int u2 = bh * 16 + s;
#pragma unroll
        for (int j = 0; j < 8; ++j) S[j] = SEGP[u2 * 64 + wave * 8 + j] * S[j] + SEGS[(size_t)u2 * 4096 + (wave * 8 + j) * 64 + lane]; }
    const float ong = PIN(p, I_ONG)[l * 64 + lane];
    for (int cks = 0; cks < 8; ++cks) {
        __syncthreads();
        hgrn_stage(PROJ, row0 + cks * 64, hc, lb8, F, V, Q, tid);
        __syncthreads();
        for (int tg = 0; tg < 4; ++tg) {
            for (int t16 = 0; t16 < 16; ++t16) { const int tt = tg * 16 + t16;
                const f32x4 fa = *(const LAS f32x4*)(F + tt * 64 + wave * 8), fb = *(const LAS f32x4*)(F + tt * 64 + wave * 8 + 4);
                const f32x4 qa = *(const LAS f32x4*)(Q + tt * 64 + wave * 8), qb = *(const LAS f32x4*)(Q + tt * 64 + wave * 8 + 4); const float vv = V[tt * 64 + lane];
                const float f8[8] = {fa.x, fa.y, fa.z, fa.w, fb.x, fb.y, fb.z, fb.w}; const float q8[8] = {qa.x, qa.y, qa.z, qa.w, qb.x, qb.y, qb.z, qb.w};
                float po = 0.f;
#pragma unroll
                for (int j = 0; j < 8; ++j) { S[j] = fmaf(f8[j], S[j] - vv, vv); po = fmaf(q8[j], S[j], po); }
                PO[(t16 * 8 + wave) * 64 + lane] = po; }
            __syncthreads();
#pragma unroll
            for (int e = 0; e < 2; ++e) { const int t16 = wave * 2 + e; float o = 0.f;
#pragma unroll
                for (int w = 0; w < 8; ++w) o += PO[(t16 * 8 + w) * 64 + lane];
                const float ss = wave_sum(o * o); const size_t row = row0 + cks * 64 + tg * 16 + t16;
                const float gg = bf2f(PROJ[row * INW + C_CG + hc * 64 + lane]);
                MIXED[row * DM + MX_C + hc * 64 + lane] = (bf16)f2bf(o * rsqrtf(ss * (1.0f / 64.0f) + EPS) * ong * gg * DBG_C); }
            __syncthreads();
        }
    }
}

#endif

namespace mc {
constexpr int QT = 0, KT = 4096, QH = 8192, KH = 12288, VV = 16384, DD = 20480, WTO = 20736, OE = 22784, OI = 30976, RB = 39168, LDS_END = 55552;
}
#define MC_BAR() do { asm volatile("s_waitcnt lgkmcnt(0)" ::: "memory"); __builtin_amdgcn_s_barrier(); asm volatile("" ::: "memory"); } while (0)
template <bool PASS2>
__device__ __forceinline__ void mixer_c_mfma(const Ctx& p, int l, int unit, LAS unsigned char* lds, int wave, int lane) {
    using namespace mb;
    const int bh = unit >> 4, seg = unit & 15, b = bh >> 2, hc = bh & 3; const size_t row0 = (size_t)b * SEQ + (size_t)seg * 512;
    const bf16* PROJ = (const bf16*)(p.ws + WS_PROJ); bf16* MIXED = (bf16*)(p.ws + WS_MIXED);
    float* SEGS = (float*)(p.ws + WS_SEGS); float* SEGP = (float*)(p.ws + WS_SEGP);
    const int r32 = lane & 31, hi = lane >> 5, kt_lane_off = ((lane >> 4) & 1) * 32 + (lane & 3) * 8 + (4 * hi + ((lane & 15) >> 2)) * 64;
    const float lb = hgrn_lb(p, l, hc * 64 + lane), omlb = 1.0f - lb;
    const float ong = PASS2 ? PIN(p, I_ONG)[l * 64 + lane] : 0.f;
    f32x16 S0 = {}, S1 = {};
    if (PASS2 && wave < 2) {
        for (int s = 0; s < seg; ++s) { const int u2 = bh * 16 + s; const float* sp = SEGS + ((size_t)(u2 * 2 + wave) * 2) * 16 * 64 + lane; const float* pp = SEGP + u2 * 64 + 4 * hi;
#pragma unroll
            for (int gq = 0; gq < 4; ++gq) { const f32x4 d0 = *(const f32x4*)(pp + 8 * gq), d1 = *(const f32x4*)(pp + 32 + 8 * gq);
#pragma unroll
                for (int e = 0; e < 4; ++e) { const int r = 4 * gq + e; S0[r] = d0[e] * S0[r] + sp[(size_t)r * 64]; S1[r] = d1[e] * S1[r] + sp[(size_t)(16 + r) * 64]; } } }
    }
    float sumtot = 0.f;
    const int tid = wave * 64 + lane, ptok = (tid & 255) >> 3, pch = tid & 7, parr = tid >> 8;
    const bf16* gsrc = PROJ + (row0 + ptok) * INW + hc * 64 + pch * 8;
    const int rboff = ptok * 128 + pch * 16;
    v4u pf0, pf1 = (v4u){0u, 0u, 0u, 0u};
    pf0 = *(const v4u*)(gsrc + (parr ? C_CI : C_CF)); if (PASS2) pf1 = *(const v4u*)(gsrc + (parr ? C_CG : C_CQ));
    *(LAS v4u*)(lds + mc::RB + parr * 4096 + rboff) = pf0; if (PASS2) *(LAS v4u*)(lds + mc::RB + (2 + parr) * 4096 + rboff) = pf1;
    MC_BAR();
#pragma unroll 1
    for (int n = 0; n < 16; ++n) {
        float f[4], c[4], qv[4], vv[4], gv[4];
        if (n + 1 < 16) { const bf16* gn = gsrc + (size_t)(32 * (n + 1)) * INW;
            pf0 = *(const v4u*)(gn + (parr ? C_CI : C_CF)); if (PASS2) pf1 = *(const v4u*)(gn + (parr ? C_CG : C_CQ)); }
#pragma unroll
        for (int i = 0; i < 4; ++i) { const LAS bf16* rp = (const LAS bf16*)(lds + mc::RB) + (4 * wave + i) * 64 + lane;
            const float z = fmaxf(bf2f(rp[0]), -30.f); f[i] = lb + omlb * __builtin_amdgcn_rcpf(1.0f + __expf(-z)); vv[i] = bf2f(rp[2048]); if (PASS2) { qv[i] = bf2f(rp[4096]); gv[i] = bf2f(rp[6144]); } }
        c[0] = __logf(f[0]); c[1] = c[0] + __logf(f[1]); c[2] = c[1] + __logf(f[2]); c[3] = c[2] + __logf(f[3]);
        ((LAS float*)(lds + mc::WTO))[wave * 64 + lane] = c[3];
        MC_BAR();
        float off = 0.f, tot = 0.f, mid = 0.f;
#pragma unroll
        for (int w = 0; w < 8; ++w) { const float tw = ((LAS float*)(lds + mc::WTO))[w * 64 + lane]; if (w < wave) off += tw; if (w < 4) mid += tw; tot += tw; }
        sumtot += tot;
#pragma unroll
        for (int i = 0; i < 4; ++i) { const int t = 4 * wave + i; const float Bt = off + c[i], kk = 1.0f - f[i];
            const int chb = (lane >> 3) * 512 + t * 16 + (lane & 7) * 2, vlb = (lane >> 5) * 2048 + (t >> 4) * 1024 + (t & 15) * 64 + (lane & 31) * 2;
            *(LAS bf16*)(lds + mc::KH + vlb) = (bf16)f2bf(kk * __expf(tot - Bt));
            *(LAS bf16*)(lds + mc::VV + vlb) = (bf16)f2bf(vv[i]);
            if (PASS2) { *(LAS bf16*)(lds + mc::QT + chb) = (bf16)f2bf(qv[i] * __expf(fminf(Bt - mid, 80.f)));
                *(LAS bf16*)(lds + mc::KT + chb) = (bf16)f2bf(kk * __expf(fminf(mid - Bt, 80.f)));
                *(LAS bf16*)(lds + mc::QH + chb) = (bf16)f2bf(qv[i] * __expf(Bt)); } }
        if (wave == 0) ((LAS float*)(lds + mc::DD))[lane] = __expf(tot);
        MC_BAR();
        if (wave < 2) {
            const int vt = wave;
            if (PASS2) {
                f32x16 o = {};
#pragma unroll
                for (int kt = 0; kt < 2; ++kt)
#pragma unroll
                    for (int s2 = 0; s2 < 2; ++s2) { const LAS unsigned char* qa = lds + mc::QH + (4 * kt + 2 * s2) * 512 + r32 * 16 + 8 * hi;
                        const v2u a0 = *(const LAS v2u*)qa, a1 = *(const LAS v2u*)(qa + 512); v4u aw; aw.x = a0.x; aw.y = a0.y; aw.z = a1.x; aw.w = a1.y;
                        v4u bw;
                        if (kt == 0) { bw.x = cvtpk(S0[8 * s2 + 0], S0[8 * s2 + 1]); bw.y = cvtpk(S0[8 * s2 + 2], S0[8 * s2 + 3]); bw.z = cvtpk(S0[8 * s2 + 4], S0[8 * s2 + 5]); bw.w = cvtpk(S0[8 * s2 + 6], S0[8 * s2 + 7]); }
                        else { bw.x = cvtpk(S1[8 * s2 + 0], S1[8 * s2 + 1]); bw.y = cvtpk(S1[8 * s2 + 2], S1[8 * s2 + 3]); bw.z = cvtpk(S1[8 * s2 + 4], S1[8 * s2 + 5]); bw.w = cvtpk(S1[8 * s2 + 6], S1[8 * s2 + 7]); }
                        o = __builtin_amdgcn_mfma_f32_32x32x16_bf16(__builtin_bit_cast(bf16x8, aw), __builtin_bit_cast(bf16x8, bw), o, 0, 0, 0); }
#pragma unroll
                for (int r = 0; r < 16; ++r) ((LAS float*)(lds + mc::OE))[crow(r, hi) * 64 + 32 * vt + r32] = o[r];
            }
            { const LAS float* dp = (const LAS float*)(lds + mc::DD) + 4 * hi;
#pragma unroll
                for (int gq = 0; gq < 4; ++gq) { const f32x4 d0 = *(const LAS f32x4*)(dp + 8 * gq), d1 = *(const LAS f32x4*)(dp + 32 + 8 * gq);
#pragma unroll
                    for (int e = 0; e < 4; ++e) { S0[4 * gq + e] *= d0[e]; S1[4 * gq + e] *= d1[e]; } } }
#pragma unroll
            for (int ks = 0; ks < 2; ++ks) {
                const LAS unsigned char* vb = lds + mc::VV + vt * 2048 + ks * 1024 + kt_lane_off; const s16x4 vl = vtr(vb), vh = vtr(vb + 512);
                const bf16x8 bv = (bf16x8){vl[0], vl[1], vl[2], vl[3], vh[0], vh[1], vh[2], vh[3]};
                const LAS unsigned char* k0 = lds + mc::KH + ks * 1024 + kt_lane_off; const s16x4 al = vtr(k0), ah = vtr(k0 + 512), bl = vtr(k0 + 2048), bh_ = vtr(k0 + 2048 + 512);
                const bf16x8 a0 = (bf16x8){al[0], al[1], al[2], al[3], ah[0], ah[1], ah[2], ah[3]}, a1 = (bf16x8){bl[0], bl[1], bl[2], bl[3], bh_[0], bh_[1], bh_[2], bh_[3]};
                S0 = __builtin_amdgcn_mfma_f32_32x32x16_bf16(a0, bv, S0, 0, 0, 0); S1 = __builtin_amdgcn_mfma_f32_32x32x16_bf16(a1, bv, S1, 0, 0, 0); }
        } else if (PASS2 && wave < 4) {
            const int vt = wave - 2;
            f32x16 at = {};
#pragma unroll
            for (int ks = 0; ks < 4; ++ks) { const bf16x8 a = *(const LAS bf16x8*)(lds + mc::KT + (2 * ks + hi) * 512 + r32 * 16), bq = *(const LAS bf16x8*)(lds + mc::QT + (2 * ks + hi) * 512 + r32 * 16);
                at = __builtin_amdgcn_mfma_f32_32x32x16_bf16(a, bq, at, 0, 0, 0); }
            f32x16 o = {};
#pragma unroll
            for (int ks = 0; ks < 2; ++ks) { float m8[8];
#pragma unroll
                for (int j = 0; j < 8; ++j) { const int r = 8 * ks + j; m8[j] = (crow(r, hi) <= r32) ? at[r] : 0.f; }
                v4u pw; pw.x = cvtpk(m8[0], m8[1]); pw.y = cvtpk(m8[2], m8[3]); pw.z = cvtpk(m8[4], m8[5]); pw.w = cvtpk(m8[6], m8[7]);
                const LAS unsigned char* vb = lds + mc::VV + vt * 2048 + ks * 1024 + kt_lane_off; const s16x4 vl = vtr(vb), vh = vtr(vb + 512);
                const bf16x8 bv = (bf16x8){vl[0], vl[1], vl[2], vl[3], vh[0], vh[1], vh[2], vh[3]};
                o = __builtin_amdgcn_mfma_f32_32x32x16_bf16(__builtin_bit_cast(bf16x8, pw), bv, o, 0, 0, 0); }
#pragma unroll
            for (int r = 0; r < 16; ++r) ((LAS float*)(lds + mc::OI))[crow(r, hi) * 64 + 32 * vt + r32] = o[r];
        }
        if (n + 1 < 16) { *(LAS v4u*)(lds + mc::RB + parr * 4096 + rboff) = pf0; if (PASS2) *(LAS v4u*)(lds + mc::RB + (2 + parr) * 4096 + rboff) = pf1; }
        MC_BAR();
        if (PASS2) {
#pragma unroll
            for (int i = 0; i < 4; ++i) { const int t = 4 * wave + i; const float o = ((LAS float*)(lds + mc::OE))[t * 64 + lane] + ((LAS float*)(lds + mc::OI))[t * 64 + lane];
                const float ss = wave_sum(o * o);
                MIXED[(row0 + 32 * n + t) * DM + MX_C + hc * 64 + lane] = (bf16)f2bf(o * rsqrtf(ss * (1.0f / 64.0f) + EPS) * ong * gv[i] * DBG_C); }
        }
    }
    if (!PASS2) {
        if (wave < 2) { float* sp = SEGS + ((size_t)(unit * 2 + wave) * 2) * 16 * 64 + lane;
#pragma unroll
            for (int r = 0; r < 16; ++r) { sp[(size_t)r * 64] = S0[r]; sp[(size_t)(16 + r) * 64] = S1[r]; } }
        if (wave == 0) SEGP[unit * 64 + lane] = __expf(sumtot);
    }
    __syncthreads();
}
__device__ __forceinline__ void ffn_fixup(const Ctx& p, int l, int tid) {
    const float* HG = (const float*)(p.ws + WS_HG); const float* HU = (const float*)(p.ws + WS_HU); bf16* ACT = (bf16*)(p.ws + WS_ACT);
    const float* cw = PIN(p, I_CONVW) + (size_t)l * 3 * DFF; const float* cb = PIN(p, I_CONVB) + (size_t)l * DFF;
    const int total = 512 * 2 * (DFF / 4);
    for (int idx = blockIdx.x * (NWAVES * 64) + tid; idx < total; idx += gridDim.x * (NWAVES * 64)) {
        const int c4 = idx % (DFF / 4), rr = idx / (DFF / 4), rho = rr & 1, blk = rr >> 1, ch = 4 * c4;
        const bool first = (blk % 128) == 0;
        const f32x4 z = (f32x4){0.f, 0.f, 0.f, 0.f};
        const f32x4 g0 = *(const f32x4*)(HG + ((size_t)blk * 4 + rho) * DFF + ch);
        f32x4 g1, g2;
        if (rho == 1) { g1 = *(const f32x4*)(HG + ((size_t)blk * 4 + 0) * DFF + ch); g2 = first ? z : *(const f32x4*)(HG + ((size_t)(blk - 1) * 4 + 3) * DFF + ch); }
        else { g1 = first ? z : *(const f32x4*)(HG + ((size_t)(blk - 1) * 4 + 3) * DFF + ch); g2 = first ? z : *(const f32x4*)(HG + ((size_t)(blk - 1) * 4 + 2) * DFF + ch); }
        const f32x4 up = *(const f32x4*)(HU + ((size_t)blk * 2 + rho) * DFF + ch);
        const f32x4 w0 = *(const f32x4*)(cw + ch), w1 = *(const f32x4*)(cw + DFF + ch), w2 = *(const f32x4*)(cw + 2 * DFF + ch), bb = *(const f32x4*)(cb + ch);
        f32x4 c = bb + w0 * g2 + w1 * g1 + w2 * g0;
#pragma unroll
        for (int j = 0; j < 4; ++j) c[j] = silu_f(c[j]) * up[j];
        v2u w; w.x = pk2(c[0], c[1]); w.y = pk2(c[2], c[3]);
        *(v2u*)(ACT + ((size_t)blk * 64 + rho) * DFF + ch) = w;
    }
}

constexpr int PH_PER_LAYER = 7, N_PHASES = 1 + DEPTH * PH_PER_LAYER;
__global__ void __launch_bounds__(NWAVES * 64, 2) fwd_kernel(Params args) {
    extern __shared__ __attribute__((aligned(16))) unsigned char lds_raw[];
    LAS unsigned char* lds = (LAS unsigned char*)lds_raw;
    volatile LAS unsigned* MISC = (volatile LAS unsigned*)(lds + MISC_OFF);
    volatile LAS unsigned long long* TAB = (volatile LAS unsigned long long*)(lds + TAB_OFF);
    LAS unsigned char* BKT = lds + TAB_OFF + 256;
    if (threadIdx.x < 64) MISC[threadIdx.x] = 0u;
    if (threadIdx.x == 0) {
#pragma unroll
        for (int i = 0; i < 19; ++i) TAB[i] = (unsigned long long)args.in[i];
        TAB[19] = (unsigned long long)args.out;
    }
    if (threadIdx.x >= 64 && threadIdx.x < 192) BKT[threadIdx.x - 64] = args.bucket[threadIdx.x - 64];
    __syncthreads();
    unsigned* barw = (unsigned*)(args.ws + WS_CTL) + CW_BAR + args.bar_region * XCD_BAR_WORDS;
    const int lo = args.ph_lo, hi = args.ph_hi;
    XcdBarrier bar; bar.bar = barw; bar.x = 0; bar.st = nullptr;
    if (hi - lo > 1) bar = xcd_barrier_post(barw, MISC + 8);
    const int G = gridDim.x;
#pragma nounroll
    for (int ph = lo; ph < hi; ++ph) {
        const int l = (ph - 1) / PH_PER_LAYER, k = (ph == 0) ? -1 : (ph - 1) % PH_PER_LAYER;
#ifdef DBG_DOUBLE
        const int nrep = ((ph == 0 ? 7 : k) == DBG_DOUBLE) ? 2 : 1;
#else
        const int nrep = 1;
#endif
#pragma nounroll
        for (int rep = 0; rep < nrep; ++rep) {
        int tid = threadIdx.x; asm volatile("" : "+v"(tid));
        Ctx p; p.tab = TAB; p.bucket = nullptr; { GAS unsigned char* wsg = (GAS unsigned char*)args.ws; asm volatile("" : "+s"(wsg)); p.ws = (unsigned char*)wsg; }
        const int lane = tid & 63, wave = __builtin_amdgcn_readfirstlane(tid >> 6);
        const unsigned char* wl = p.ws + WS_W + (size_t)l * W_LAYER;
        if (ph == 0) {
#ifndef NO_P0
            prologue(p, lds, wave, lane, rep == 0);
#endif
        } else if (k == 0) {
#ifndef NO_P1
            pg8::Gemm g{(const bf16*)(p.ws + WS_XB), (const bf16*)(wl + W_IN), M, INW, DM}; pg8::StaticOrder S; S.init(M, INW, G, (int)blockIdx.x);
            EpiInProj E{(bf16*)(p.ws + WS_PROJ), (const unsigned long long*)(p.ws + WS_SS) + (size_t)(2 * l) * M};
            pg8::gemm_phase<EpiInProj, pg8::StaticOrder, true, true>(lds, g, S, E);
#endif
        } else if (k == 1) {
#ifndef NO_P2A
#ifdef DBG_MIXCMP
            if (args.flags & 1) { for (int u = blockIdx.x; u < 256; u += G) mixer_c_pass1_simple(p, l, u, lds, wave, lane); } else
#endif
            for (int rr = 0; rr < DBG_REP_C1; ++rr)
            for (int u = blockIdx.x; u < 256; u += G) mixer_c_mfma<false>(p, l, u, lds, wave, lane);
#ifdef DBG_MIXCMP
            if (args.flags & 1) { for (int u = blockIdx.x; u < 1024; u += G) mixer_a_simple(p, l, u, lds, wave, lane); } else
#endif
            for (int u = blockIdx.x; u < 1024; u += G) mixer_a_mfma(p, l, u, lds, wave, lane);
#endif
        } else if (k == 2) {
#ifndef NO_P2B
#ifdef DBG_MIXCMP
            if (args.flags & 1) { for (int u = blockIdx.x; u < 256; u += G) mixer_c_pass2_simple(p, l, u, lds, wave, lane); } else
#endif
            for (int rr = 0; rr < DBG_REP_C2; ++rr)
            for (int u = blockIdx.x; u < 256; u += G) mixer_c_mfma<true>(p, l, u, lds, wave, lane);
#ifdef DBG_MIXCMP
            if (args.flags & 1) { for (int u = blockIdx.x; u < 512; u += G) mixer_b_simple(p, l, u, lds, wave, lane); } else
#endif
            for (int rr = 0; rr < DBG_REP_B; ++rr)
            for (int u = blockIdx.x; u < 512; u += G) mixer_b_mfma(p, l, u, lds, wave, lane);
#endif
        } else if (k == 3) {
#ifndef NO_P3
            pg8::Gemm g{(const bf16*)(p.ws + WS_MIXED), (const bf16*)(wl + W_OUT), M, DM, DM}; pg8::StaticOrder S; S.init(M, DM, G, (int)blockIdx.x);
            EpiResid E{(bf16*)(p.ws + WS_XB), nullptr, (unsigned long long*)(p.ws + WS_SS) + (size_t)(2 * l + 1) * M, rep == 0 ? 1 : 0};
            pg8::gemm_phase<EpiResid, pg8::StaticOrder, true, true>(lds, g, S, E);
#endif
        } else if (k == 4) {
#ifndef NO_P4
            pg8::Gemm g{(const bf16*)(p.ws + WS_XB), (const bf16*)(wl + W_GU), M, NGU, DM}; pg8::StaticOrder S; S.init(M, NGU, G, (int)blockIdx.x);
            EpiFFN E{(bf16*)(p.ws + WS_ACT), (const unsigned long long*)(p.ws + WS_SS) + (size_t)(2 * l + 1) * M, PIN(p, I_CONVW) + (size_t)l * 3 * DFF, PIN(p, I_CONVB) + (size_t)l * DFF, (float*)(p.ws + WS_HG), (float*)(p.ws + WS_HU)};
            pg8::gemm_phase<EpiFFN, pg8::StaticOrder, true, true>(lds, g, S, E);
#endif
        } else if (k == 5) {
            ffn_fixup(p, l, tid);
        } else {
#ifndef NO_P5
            pg8::Gemm g{(const bf16*)(p.ws + WS_ACT), (const bf16*)(wl + W_DN), M, DM, DFF}; pg8::StaticOrder S; S.init(M, DM, G, (int)blockIdx.x);
            EpiResid E{(bf16*)(p.ws + WS_XB), POUT(p), (unsigned long long*)(p.ws + WS_SS) + (size_t)(2 * l + 2) * M, rep != 0 ? 0 : ((l + 1 < DEPTH) ? 1 : 2)};
            pg8::gemm_phase<EpiResid, pg8::StaticOrder, true, true>(lds, g, S, E);
#endif
        }
        }
        if (ph + 1 < hi) xcd_barrier(bar);
    }
}


#if defined(DBG_NAIVE_DOWN)
__global__ void __launch_bounds__(256) dbg_down(const bf16* ACT, const float* Wd, const float* X1, float* out) {
    __shared__ float a[4][DFF];
    const int r0 = blockIdx.x * 4, c = threadIdx.x * 4;
    for (int i = threadIdx.x; i < 4 * DFF; i += 256) a[i / DFF][i % DFF] = bf2f(ACT[(size_t)(r0 + i / DFF) * DFF + i % DFF]);
    __syncthreads();
    f32x4 acc[4]; for (int r = 0; r < 4; ++r) acc[r] = (f32x4){0.f, 0.f, 0.f, 0.f};
    for (int k = 0; k < DFF; ++k) { const f32x4 w = *(const f32x4*)(Wd + (size_t)k * DM + c);
        for (int r = 0; r < 4; ++r) acc[r] += w * a[r][k]; }
    for (int r = 0; r < 4; ++r) { const size_t off = (size_t)(r0 + r) * DM + c; *(f32x4*)(out + off) = *(const f32x4*)(X1 + off) + acc[r]; }
}
#endif

#if defined(DBG_FFNCMP)
constexpr int DBG_R = 512;
__global__ void __launch_bounds__(256) dbg_gu(const float* X1, const float* g2, const float* Wg, const float* Wu, float* GU) {
    __shared__ float h[DM];
    const int r = blockIdx.x, c = blockIdx.y * 256 + threadIdx.x;
    float ss = 0.f; for (int k = threadIdx.x; k < DM; k += 256) { const float v = X1[(size_t)r * DM + k]; ss += v * v; }
    __shared__ float red[256]; red[threadIdx.x] = ss; __syncthreads();
    for (int o = 128; o > 0; o >>= 1) { if (threadIdx.x < o) red[threadIdx.x] += red[threadIdx.x + o]; __syncthreads(); }
    const float rstd = rsqrtf(red[0] / DM + EPS);
    for (int k = threadIdx.x; k < DM; k += 256) h[k] = X1[(size_t)r * DM + k] * rstd * g2[k];
    __syncthreads();
    if (c < DFF) { float a = 0.f, b = 0.f; for (int k = 0; k < DM; ++k) { a += h[k] * Wg[(size_t)k * DFF + c]; b += h[k] * Wu[(size_t)k * DFF + c]; }
        GU[((size_t)r * 2 + 0) * DFF + c] = a; GU[((size_t)r * 2 + 1) * DFF + c] = b; }
}
__global__ void __launch_bounds__(256) dbg_cmp(const float* GU, const float* cw, const float* cb, const bf16* ACT, float* acc2) {
    const int r = blockIdx.x, c = blockIdx.y * 256 + threadIdx.x; float num = 0.f, den = 0.f;
    if (c < DFF) { const float g0 = GU[((size_t)r * 2) * DFF + c], g1 = r >= 1 ? GU[((size_t)(r - 1) * 2) * DFF + c] : 0.f, g2 = r >= 2 ? GU[((size_t)(r - 2) * 2) * DFF + c] : 0.f;
#if defined(DBG_TAPS) && DBG_TAPS == 0
        const float cv = cb[c] + cw[2 * DFF + c] * g0;
#elif defined(DBG_TAPS) && DBG_TAPS == 1
        const float cv = cb[c] + cw[DFF + c] * g1 + cw[2 * DFF + c] * g0;
#else
        const float cv = cb[c] + cw[c] * g2 + cw[DFF + c] * g1 + cw[2 * DFF + c] * g0;
#endif
        const float ref = cv / (1.0f + expf(-cv)) * GU[((size_t)r * 2 + 1) * DFF + c];
        const float mine = bf2f(ACT[(size_t)r * DFF + c]);
#if DBG_FFNCMP == 2
        if ((r & 63) < 2) { num = (mine - ref) * (mine - ref); den = ref * ref; }
#elif DBG_FFNCMP == 3
        if ((r & 63) >= 2) { num = (mine - ref) * (mine - ref); den = ref * ref; }
#else
        num = (mine - ref) * (mine - ref); den = ref * ref;
#endif
    }
    __shared__ float rn[256], rd[256]; rn[threadIdx.x] = num; rd[threadIdx.x] = den; __syncthreads();
    for (int o = 128; o > 0; o >>= 1) { if (threadIdx.x < o) { rn[threadIdx.x] += rn[threadIdx.x + o]; rd[threadIdx.x] += rd[threadIdx.x + o]; } __syncthreads(); }
    if (threadIdx.x == 0) { atomicAdd(acc2, rn[0]); atomicAdd(acc2 + 1, rd[0]); }
}
__global__ void dbg_emit(const float* acc2, float* out) { out[0] = 1000.0f * sqrtf(acc2[0] / acc2[1]); }
#endif

#if defined(DBG_MIXCMP)
__global__ void __launch_bounds__(256) dbg_mixcmp(const bf16* A, const bf16* R, int c0, int c1, float* acc2) {
    float num = 0.f, den = 0.f;
    for (size_t r = blockIdx.x; r < (size_t)M; r += gridDim.x)
        for (int c = c0 + threadIdx.x; c < c1; c += 256) { const float a = bf2f(A[r * DM + c]), b = bf2f(R[r * DM + c]); num += (a - b) * (a - b); den += b * b; }
    __shared__ float rn[256], rd[256]; rn[threadIdx.x] = num; rd[threadIdx.x] = den; __syncthreads();
    for (int o = 128; o > 0; o >>= 1) { if (threadIdx.x < o) { rn[threadIdx.x] += rn[threadIdx.x + o]; rd[threadIdx.x] += rd[threadIdx.x + o]; } __syncthreads(); }
    if (threadIdx.x == 0) { atomicAdd(acc2, rn[0]); atomicAdd(acc2 + 1, rd[0]); }
}
__global__ void dbg_emit2(const float* acc2, float* out) { out[0] = 1000.0f * sqrtf(acc2[0] / acc2[1]); }
#endif
#ifndef MK_PER_PHASE
#define MK_PER_PHASE 0
#endif
extern "C" void kernel_launch(void* const* d_in, const int* in_sizes, int n_in, void* d_out, int out_size, void* d_ws, size_t ws_size, hipStream_t stream) {
    static int grid = 0;
    if (grid == 0) {
        if (n_in != 19 || in_sizes[0] != M * DM || out_size != M * DM || ws_size < WS_END) { fprintf(stderr, "kernel_launch: unexpected shapes (n_in %d, in0 %d, out %d, ws %zu)\n", n_in, n_in > 0 ? in_sizes[0] : -1, out_size, ws_size); grid = -1; return; }
        int dev = 0, cus = 0;
        if (hipGetDevice(&dev) != hipSuccess || hipDeviceGetAttribute(&cus, hipDeviceAttributeMultiprocessorCount, dev) != hipSuccess) { grid = -1; return; }
        if (hipFuncSetAttribute((const void*)fwd_kernel, hipFuncAttributeMaxDynamicSharedMemorySize, LDS_BYTES) != hipSuccess) { fprintf(stderr, "kernel_launch: hipFuncSetAttribute failed\n"); grid = -1; return; }
        int per_cu = 0;
        if (hipOccupancyMaxActiveBlocksPerMultiprocessor(&per_cu, (const void*)fwd_kernel, NWAVES * 64, LDS_BYTES) != hipSuccess || per_cu < 1) { fprintf(stderr, "kernel_launch: occupancy query reports %d blocks per CU\n", per_cu); }
        (void)hipGetLastError();
        grid = cus < 256 ? cus : 256;
    }
    if (grid < 0) return;
    (void)hipMemsetAsync((char*)d_ws + WS_CTL, 0, CTL_ZERO_BYTES, stream);
    (void)hipMemsetAsync((char*)d_ws + WS_SS, 0, (size_t)4 * M * 8, stream);
    Params a{};
    for (int i = 0; i < 19; ++i) a.in[i] = (const float*)d_in[i];
    a.out = (float*)d_out; a.ws = (unsigned char*)d_ws;
    for (int n = 0; n < 128; ++n) {
        int bkt;
        if (n < 16) bkt = n; else { const float v = logf((float)n / 16.0f) / (float)log(128.0 / 16.0) * 16.0f; bkt = 16 + (int)v; if (bkt > 31) bkt = 31; }
        a.bucket[n] = (unsigned char)bkt;
    }
#if MK_PER_PHASE
    for (int ph = 0; ph < N_PHASES; ++ph) { a.ph_lo = ph; a.ph_hi = ph + 1; hipLaunchKernelGGL(fwd_kernel, dim3(grid), dim3(NWAVES * 64), LDS_BYTES, stream, a); }
#elif defined(DBG_MIXCMP)
    { float* acc2 = (float*)((char*)d_ws + WS_TAB + 65536); (void)hipMemsetAsync(acc2, 0, 8, stream);
      a.ph_lo = 0; a.ph_hi = 4; a.flags = 1; a.bar_region = 0;
      hipLaunchKernelGGL(fwd_kernel, dim3(grid), dim3(NWAVES * 64), LDS_BYTES, stream, a);
      (void)hipMemcpyAsync((char*)d_ws + WS_X1, (char*)d_ws + WS_MIXED, (size_t)M * DM * 2, hipMemcpyDeviceToDevice, stream);
      (void)hipMemsetAsync((char*)d_ws + WS_MIXED, 0, (size_t)M * DM * 2, stream);
      a.ph_lo = 2; a.ph_hi = 4; a.flags = 0; a.bar_region = 1;
      hipLaunchKernelGGL(fwd_kernel, dim3(grid), dim3(NWAVES * 64), LDS_BYTES, stream, a);
      const int c0 = (DBG_MIXCMP == 1) ? 0 : (DBG_MIXCMP == 2) ? 256 : 768, c1 = (DBG_MIXCMP == 1) ? 256 : (DBG_MIXCMP == 2) ? 768 : 1024;
      hipLaunchKernelGGL(dbg_mixcmp, dim3(1024), dim3(256), 0, stream, (const bf16*)((char*)d_ws + WS_MIXED), (const bf16*)((char*)d_ws + WS_X1), c0, c1, acc2);
      (void)hipMemcpyAsync(d_out, d_in[0], (size_t)M * DM * 4, hipMemcpyDeviceToDevice, stream);
      hipLaunchKernelGGL(dbg_emit2, dim3(1), dim3(1), 0, stream, (const float*)acc2, (float*)d_out); }
#elif defined(DBG_NAIVE_DOWN)
    a.ph_lo = 0; a.ph_hi = 7;
    hipLaunchKernelGGL(fwd_kernel, dim3(grid), dim3(NWAVES * 64), LDS_BYTES, stream, a);
    hipLaunchKernelGGL(dbg_down, dim3(M / 4), dim3(256), 0, stream, (const bf16*)((char*)d_ws + WS_ACT), (const float*)d_in[I_WDOWN], (const float*)((char*)d_ws + WS_X1), (float*)d_out);
#elif defined(DBG_FFNCMP)
    a.ph_lo = 0; a.ph_hi = 7;
    hipLaunchKernelGGL(fwd_kernel, dim3(grid), dim3(NWAVES * 64), LDS_BYTES, stream, a);
    { float* GU = (float*)d_out + (size_t)16 * 1024 * 1024; float* acc2 = (float*)((char*)d_ws + WS_TAB + 65536);
      (void)hipMemsetAsync(acc2, 0, 8, stream);
      hipLaunchKernelGGL(dbg_gu, dim3(DBG_R, 11), dim3(256), 0, stream, (const float*)((char*)d_ws + WS_X1), (const float*)d_in[I_N2G], (const float*)d_in[I_WGATE], (const float*)d_in[I_WUP], GU);
      hipLaunchKernelGGL(dbg_cmp, dim3(DBG_R, 11), dim3(256), 0, stream, (const float*)GU, (const float*)d_in[I_CONVW], (const float*)d_in[I_CONVB], (const bf16*)((char*)d_ws + WS_ACT), acc2);
      (void)hipMemcpyAsync(d_out, d_in[0], (size_t)M * DM * 4, hipMemcpyDeviceToDevice, stream);
      hipLaunchKernelGGL(dbg_emit, dim3(1), dim3(1), 0, stream, (const float*)acc2, (float*)d_out); }
#elif defined(DBG_STOP)
    a.ph_lo = 0; a.ph_hi = DBG_STOP + 1;
    hipLaunchKernelGGL(fwd_kernel, dim3(grid), dim3(NWAVES * 64), LDS_BYTES, stream, a);
    { const int k = (DBG_STOP == 0) ? -1 : (DBG_STOP - 1) % PH_PER_LAYER;
      const float* src = (DBG_STOP == 0) ? (const float*)d_in[0] : ((k >= 3 && k <= 5) ? (const float*)((char*)d_ws + WS_X1) : nullptr);
      if (src) (void)hipMemcpyAsync(d_out, src, (size_t)M * DM * 4, hipMemcpyDeviceToDevice, stream); }
#else
    a.ph_lo = 0; a.ph_hi = N_PHASES;
    hipLaunchKernelGGL(fwd_kernel, dim3(grid), dim3(NWAVES * 64), LDS_BYTES, stream, a);
#endif
    const hipError_t le = hipPeekAtLastError();
    if (le != hipSuccess) fprintf(stderr, "kernel_launch: launch failed: %s\n", hipGetErrorName(le));
}
```

```cpp
#include <hip/hip_runtime.h>
#include <cstdio>
#include <cstdint>
#include <cmath>
namespace pg8 {
#define PG8_LAS __attribute__((address_space(3)))
typedef unsigned short bf16_t;
typedef short bf16x8 __attribute__((ext_vector_type(8)));
typedef float f32x4 __attribute__((ext_vector_type(4)));
typedef unsigned u32x4 __attribute__((ext_vector_type(4)));
constexpr int BM = 256, BK = 64, HALF = 128, HTB = HALF * BK * 2  , STAGE_BYTES = 8 * HTB, NXCD = 8, WGM = 8;

__host__ __device__ __forceinline__ int lds_byte(int r, int c) { const int st = (r >> 4) * 2 + (c >> 5), rr = r & 15, cc = c & 31, ob = rr * 64 + cc * 2; return st * 1024 + (ob ^ (((ob >> 9) & 1) << 5)); }
__host__ __device__ __forceinline__ void stage_rc(int b, int& R, int& C) { const int st = b / 1024, sb = b % 1024, swz = sb ^ (((sb >> 9) & 1) << 5); R = (st >> 1) * 16 + swz / 64; C = (st & 1) * 32 + (swz % 64) / 2; }
__host__ __device__ __forceinline__ int perm32(int rho) { const int n = rho >> 4, i = rho & 15; return 8 * (i >> 2) + 4 * n + (i & 3); }

struct Unit { int pm, pn; };
struct Gemm { const bf16_t* A; const bf16_t* Bt; int M, N, K; };

struct StaticOrder {
    int nM, nN, nwg, G, c;
    __host__ __device__ void init(int M, int N, int G_, int c_) { nM = M / BM; nN = N / BM; nwg = nM * nN; G = G_; c = c_; }
    __host__ __device__ bool next(int i, Unit& u) const {
        const long L = (long)i * G + c; if (L >= nwg) return false;
        int wgid = (int)L; { const int q = nwg / NXCD, r = nwg % NXCD, xcd = wgid % NXCD, off = wgid / NXCD; wgid = (xcd < r ? xcd * (q + 1) : r * (q + 1) + (xcd - r) * q) + off; }
        const int nig = WGM * nN, gid = wgid / nig, fm = gid * WGM, gsz = (nM - fm) < WGM ? (nM - fm) : WGM;
        u.pm = fm + ((wgid % nig) % gsz); u.pn = (wgid % nig) / gsz; return true;
    }
    __device__ __forceinline__ void a_ready(const Unit&) const {}
    __device__ __forceinline__ void done(const Unit&) const {}
};

__device__ __forceinline__ unsigned cvt_pk_bf16(float lo, float hi) { unsigned r; asm volatile("v_cvt_pk_bf16_f32 %0, %1, %2" : "=v"(r) : "v"(lo), "v"(hi)); return r; }
typedef float f32x2 __attribute__((ext_vector_type(2)));
__device__ __forceinline__ f32x2 gelu_pk(f32x2 v) {
    const f32x2 av = __builtin_elementwise_abs(v), d = av * 0.2316418882f + 1.0f;
    f32x2 t; t.x = __builtin_amdgcn_rcpf(d.x); t.y = __builtin_amdgcn_rcpf(d.y);
    f32x2 q = t * 0.5307027145f + (-0.7265760135f); q = q * t + 0.7107068705f; q = q * t + (-0.142248368f); q = q * t + 0.127414796f; q = q * t;
    const f32x2 s = (v * v) * (-0.72134752044f);
    f32x2 e; e.x = __builtin_amdgcn_exp2f(s.x); e.y = __builtin_amdgcn_exp2f(s.y);
    const f32x2 m = v * (q * e), r = v - m;
    f32x2 o; o.x = v.x < 0.f ? m.x : r.x; o.y = v.y < 0.f ? m.y : r.y; return o;
}

template <class Epi, class Sched, bool ALIGN_EPI = false, bool SP2 = false>
__device__ __forceinline__ void gemm_phase(PG8_LAS unsigned char* lds, const Gemm g, const Sched& S, const Epi& E) {
    int tid_l = threadIdx.x; asm volatile("" : "+v"(tid_l));
    const int tid = tid_l, wid = __builtin_amdgcn_readfirstlane(tid >> 6), lane = tid & 63, wr = wid >> 2, wc = wid & 3, fr = lane & 15, fq = lane >> 4;
    const int K = g.K, nt = K / BK;
    unsigned voffA[2], voffB[2];
#pragma unroll
    for (int i = 0; i < 2; ++i) { int R, C; stage_rc(tid * 16 + i * 8192, R, C); const int Rb = Epi::PERM ? ((R & ~31) + perm32(R & 31)) : R;
        voffA[i] = (unsigned)(R * K + C) * 2u; voffB[i] = (unsigned)(Rb * K + C) * 2u; }
    const size_t kstep = (size_t)(BK * 2);
    const size_t hstep = (size_t)HALF * K * 2;
    const size_t tstep = 2 * hstep;
    const unsigned ldsw = (unsigned)wid * 1024u;
    const int aoff = lds_byte(wr * 64 + fr, fq * 8), boff = lds_byte(wc * 32 + fr, fq * 8);
#define PG8_SA(b, h) (((b) * 2 + (h)) * HTB)
#define PG8_SB(b, h) ((4 + (b) * 2 + (h)) * HTB)
#define PG8_STAGE(bufoff, gbase, voff) do { _Pragma("unroll") for (int _i = 0; _i < 2; ++_i) \
        __builtin_amdgcn_global_load_lds((const unsigned*)((const char*)(gbase) + (voff)[_i]), (PG8_LAS unsigned*)(lds + (bufoff) + ldsw + _i * 8192), 16, 0, 0); } while (0)
#define PG8_LDA(dst, b, h) do { _Pragma("unroll") for (int m = 0; m < 4; ++m) _Pragma("unroll") for (int k = 0; k < 2; ++k) dst[m][k] = *(const PG8_LAS bf16x8*)(lds + PG8_SA(b, h) + aoff + m * 2048 + k * 1024); } while (0)
#define PG8_LDB(dst, b, h) do { _Pragma("unroll") for (int n = 0; n < 2; ++n) _Pragma("unroll") for (int k = 0; k < 2; ++k) dst[n][k] = *(const PG8_LAS bf16x8*)(lds + PG8_SB(b, h) + boff + n * 2048 + k * 1024); } while (0)
#define PG8_MMA(ai, bj, At, Bt) do { __builtin_amdgcn_s_setprio(1); _Pragma("unroll") for (int m = 0; m < 4; ++m) _Pragma("unroll") for (int n = 0; n < 2; ++n) _Pragma("unroll") for (int k = 0; k < 2; ++k) \
        acc[ai][bj][m][n] = __builtin_amdgcn_mfma_f32_16x16x32_bf16(Bt[n][k], At[m][k], acc[ai][bj][m][n], 0, 0, 0); __builtin_amdgcn_s_setprio(0); } while (0)
#define PG8_WAIT_V(n) asm volatile("s_waitcnt vmcnt(" #n ")" ::: "memory")
#define PG8_WAIT_L(n) asm volatile("s_waitcnt lgkmcnt(" #n ")" ::: "memory")
#define PG8_BAR __builtin_amdgcn_s_barrier()
#define PG8_SCHED __builtin_amdgcn_sched_barrier(0)
    Unit cur, nxt; int ui = 0;
    if (!S.next(0, cur)) return;
    f32x4 acc[2][2][4][2];
#pragma unroll
    for (int a = 0; a < 2; ++a)
#pragma unroll
        for (int b = 0; b < 2; ++b)
#pragma unroll
            for (int m = 0; m < 4; ++m)
#pragma unroll
                for (int n = 0; n < 2; ++n) acc[a][b][m][n] = (f32x4){0.f, 0.f, 0.f, 0.f};
    bf16x8 At[4][2], B0[2][2], B1[2][2];
    const char* cA = (const char*)g.A + (size_t)cur.pm * tstep; const char* cB = (const char*)g.Bt + (size_t)cur.pn * tstep;
    S.a_ready(cur);
    if constexpr (SP2) {
        PG8_STAGE(PG8_SB(0, 0), cB, voffB); PG8_STAGE(PG8_SB(0, 1), cB + hstep, voffB); PG8_STAGE(PG8_SA(0, 0), cA, voffA); PG8_STAGE(PG8_SA(0, 1), cA + hstep, voffA);
        if (wr == 1) PG8_BAR;
        PG8_WAIT_V(2); PG8_BAR;
        PG8_STAGE(PG8_SB(1, 0), cB + kstep, voffB); PG8_STAGE(PG8_SA(1, 0), cA + kstep, voffA); PG8_STAGE(PG8_SB(1, 1), cB + hstep + kstep, voffB);
        PG8_WAIT_V(6); PG8_BAR;
    } else {
        PG8_STAGE(PG8_SB(0, 0), cB, voffB); PG8_STAGE(PG8_SA(0, 0), cA, voffA); PG8_STAGE(PG8_SB(0, 1), cB + hstep, voffB); PG8_STAGE(PG8_SA(0, 1), cA + hstep, voffA);
        if (wr == 1) PG8_BAR;
        PG8_WAIT_V(4); PG8_BAR;
        PG8_STAGE(PG8_SB(1, 0), cB + kstep, voffB); PG8_STAGE(PG8_SA(1, 0), cA + kstep, voffA); PG8_STAGE(PG8_SB(1, 1), cB + hstep + kstep, voffB);
        PG8_WAIT_V(6); PG8_BAR;
    }
    for (;;) {
        const bool has_next = S.next(ui + 1, nxt);
        const char* nA = has_next ? (const char*)g.A + (size_t)nxt.pm * tstep : cA; const char* nB = has_next ? (const char*)g.Bt + (size_t)nxt.pn * tstep : cB;
        for (int t = 0; t < nt; t += 2) {
            const bool last = (t == nt - 2);
            const char* a1 = cA + (size_t)(t + 1) * kstep;
            const char* a2 = last ? nA : cA + (size_t)(t + 2) * kstep; const char* b2 = last ? nB : cB + (size_t)(t + 2) * kstep;
            const char* a3 = a2 + kstep; const char* b3 = b2 + kstep;
            if (last && has_next) S.a_ready(nxt);
            if constexpr (SP2) {
            PG8_LDB(B0, 0, 0); PG8_LDB(B1, 0, 1); PG8_SCHED; PG8_LDA(At, 0, 0); PG8_STAGE(PG8_SA(1, 1), a1 + hstep, voffA);
            PG8_WAIT_V(8); PG8_WAIT_L(0); PG8_BAR; PG8_MMA(0, 0, At, B0); PG8_MMA(0, 1, At, B1); PG8_BAR; PG8_SCHED;
            PG8_LDA(At, 0, 1); PG8_STAGE(PG8_SB(0, 0), b2, voffB); PG8_STAGE(PG8_SB(0, 1), b2 + hstep, voffB); PG8_STAGE(PG8_SA(0, 0), a2, voffA);
            PG8_WAIT_V(8); PG8_WAIT_L(0); PG8_BAR; PG8_MMA(1, 0, At, B0); PG8_MMA(1, 1, At, B1); PG8_BAR; PG8_SCHED;
            PG8_LDB(B0, 1, 0); PG8_LDB(B1, 1, 1); PG8_SCHED; PG8_LDA(At, 1, 0); PG8_STAGE(PG8_SA(0, 1), a2 + hstep, voffA);
            PG8_WAIT_V(8); PG8_WAIT_L(0); PG8_BAR; PG8_MMA(0, 0, At, B0); PG8_MMA(0, 1, At, B1); PG8_BAR; PG8_SCHED;
            PG8_LDA(At, 1, 1); PG8_STAGE(PG8_SB(1, 0), b3, voffB); PG8_STAGE(PG8_SB(1, 1), b3 + hstep, voffB); PG8_STAGE(PG8_SA(1, 0), a3, voffA);
            PG8_WAIT_V(8); PG8_WAIT_L(0); PG8_BAR; PG8_MMA(1, 0, At, B0); PG8_MMA(1, 1, At, B1); PG8_BAR; PG8_SCHED;
            } else {
            PG8_LDB(B0, 0, 0); PG8_SCHED; PG8_LDA(At, 0, 0); PG8_STAGE(PG8_SA(1, 1), a1 + hstep, voffA);
            PG8_WAIT_L(8); PG8_BAR; PG8_WAIT_L(0); PG8_MMA(0, 0, At, B0); PG8_BAR; PG8_SCHED;
            PG8_LDB(B1, 0, 1); PG8_STAGE(PG8_SB(0, 0), b2, voffB);
            PG8_BAR; PG8_WAIT_L(0); PG8_MMA(0, 1, At, B1); PG8_BAR;
            PG8_LDA(At, 0, 1); PG8_STAGE(PG8_SA(0, 0), a2, voffA);
            PG8_BAR; PG8_WAIT_L(0); PG8_MMA(1, 0, At, B0); PG8_BAR; PG8_SCHED;
            PG8_STAGE(PG8_SB(0, 1), b2 + hstep, voffB);
            PG8_WAIT_V(6); PG8_BAR; PG8_MMA(1, 1, At, B1); PG8_BAR;
            PG8_LDB(B0, 1, 0); PG8_SCHED; PG8_LDA(At, 1, 0); PG8_STAGE(PG8_SA(0, 1), a2 + hstep, voffA);
            PG8_WAIT_L(8); PG8_BAR; PG8_WAIT_L(0); PG8_MMA(0, 0, At, B0); PG8_BAR; PG8_SCHED;
            PG8_LDB(B1, 1, 1); PG8_STAGE(PG8_SB(1, 0), b3, voffB);
            PG8_BAR; PG8_WAIT_L(0); PG8_MMA(0, 1, At, B1); PG8_BAR;
            PG8_LDA(At, 1, 1); PG8_STAGE(PG8_SA(1, 0), a3, voffA);
            PG8_BAR; PG8_WAIT_L(0); PG8_MMA(1, 0, At, B0); PG8_BAR; PG8_SCHED;
            PG8_STAGE(PG8_SB(1, 1), b3 + hstep, voffB);
            PG8_WAIT_V(6); PG8_BAR; PG8_MMA(1, 1, At, B1); PG8_BAR;
            }
        }
        if constexpr (ALIGN_EPI) { if (wr == 0) PG8_BAR; }
        if constexpr (!Epi::AFTER_DRAIN) { E(acc, cur, wr, wc, fr, fq); S.done(cur); }
        if (!has_next) break;
#pragma unroll
        for (int a = 0; a < 2; ++a)
#pragma unroll
            for (int b = 0; b < 2; ++b)
#pragma unroll
                for (int m = 0; m < 4; ++m)
#pragma unroll
                    for (int n = 0; n < 2; ++n) acc[a][b][m][n] = (f32x4){0.f, 0.f, 0.f, 0.f};
        cur = nxt; cA = nA; cB = nB; ++ui;
        if constexpr (ALIGN_EPI) { if (wr == 1) PG8_BAR; }
    }
    PG8_WAIT_V(0);
    if constexpr (!ALIGN_EPI) { if (wr == 0) PG8_BAR; }
    PG8_BAR;
    if constexpr (Epi::AFTER_DRAIN) { E.fused(acc, cur, wr, wc, fr, fq, lds, wid, lane); S.done(cur); }
#undef PG8_SA
#undef PG8_SB
#undef PG8_STAGE
#undef PG8_LDA
#undef PG8_LDB
#undef PG8_MMA
#undef PG8_WAIT_V
#undef PG8_WAIT_L
#undef PG8_BAR
#undef PG8_SCHED
}
}

constexpr int NWAVES = 8;
constexpr int BATCH = 4, SEQ = 8192, DM = 1024, DEPTH = 2;
constexpr int M = BATCH * SEQ;
constexpr int INW = 2304, DFF = 2816, NGU = 2 * DFF;
constexpr float EPS = 1e-6f;
constexpr int C_AU = 0, C_AV = 256, C_BQ = 512, C_BK = 1024, C_BV = 1152, C_CQ = 1280, C_CF = 1536, C_CI = 1792, C_CG = 2048;
constexpr int MX_A = 0, MX_B = 256, MX_C = 768;

constexpr size_t MiB = 1u << 20;
constexpr size_t WS_CTL = 0, CTL_ZERO_BYTES = 2 * MiB;
constexpr size_t WS_TAB = 2 * MiB;
constexpr size_t WS_SS = 1 * MiB;
constexpr size_t WS_SEGS = 4 * MiB;
constexpr size_t WS_SEGP = 8 * MiB;
constexpr size_t WS_HG = 10 * MiB;
constexpr size_t WS_HU = 32 * MiB;
constexpr size_t WS_W = 44 * MiB, W_LAYER = 24 * MiB;
constexpr size_t W_IN = 0, W_OUT = 5 * MiB, W_GU = 7 * MiB, W_DN = 18 * MiB;
constexpr size_t WS_XB = 92 * MiB;
constexpr size_t WS_X1 = 156 * MiB;
constexpr size_t WS_PROJ = 284 * MiB;
constexpr size_t WS_MIXED = 428 * MiB;
constexpr size_t WS_ACT = 284 * MiB;
constexpr size_t WS_END = 492 * MiB;
static_assert((size_t)INW * DM * 2 <= W_OUT - W_IN && (size_t)DM * DM * 2 <= W_GU - W_OUT && (size_t)NGU * DM * 2 <= W_DN - W_GU && W_DN + (size_t)DM * DFF * 2 <= W_LAYER, "weight map");
static_assert(WS_ACT + (size_t)M * DFF * 2 <= WS_END && WS_MIXED + (size_t)M * DM * 2 <= WS_END && WS_PROJ + (size_t)M * INW * 2 <= WS_MIXED, "activation map");
static_assert(WS_HG + (size_t)512 * 4 * DFF * 4 <= WS_HU && WS_HU + (size_t)512 * 2 * DFF * 4 <= WS_W, "halo map");
constexpr int CW_BAR = 4096;

constexpr int LDS_BYTES = 147456;
constexpr int MISC_OFF = LDS_BYTES - 256;

#define GAS __attribute__((address_space(1)))
#define LAS __attribute__((address_space(3)))
typedef unsigned short bf16;
typedef unsigned v4u __attribute__((ext_vector_type(4)));
typedef unsigned v2u __attribute__((ext_vector_type(2)));
typedef float f32x4 __attribute__((ext_vector_type(4)));
typedef float f32x2 __attribute__((ext_vector_type(2)));
#define RLX_AGENT __ATOMIC_RELAXED, __HIP_MEMORY_SCOPE_AGENT
#define LDS_WAIT() asm volatile("s_waitcnt lgkmcnt(0)" ::: "memory")
__device__ __forceinline__ unsigned f2bf(float f) { unsigned u = __builtin_bit_cast(unsigned, f); return (u + 0x7fffu + ((u >> 16) & 1u)) >> 16; }
__device__ __forceinline__ unsigned pk2(float lo, float hi) { return f2bf(lo) | (f2bf(hi) << 16); }
__device__ __forceinline__ float bf2f(unsigned short h) { return __builtin_bit_cast(float, (unsigned)h << 16); }
__device__ __forceinline__ float bflo(unsigned w) { return __builtin_bit_cast(float, w << 16); }
__device__ __forceinline__ float bfhi(unsigned w) { return __builtin_bit_cast(float, w & 0xffff0000u); }
__device__ __forceinline__ float silu_f(float v) { return v * __builtin_amdgcn_rcpf(1.0f + __expf(-v)); }
__device__ __forceinline__ float wave_sum(float v) {
#pragma unroll
    for (int o = 1; o < 64; o <<= 1) v += __shfl_xor(v, o);
    return v;
}
#define XB_TMO      128
#define XB_XCNT(j)  (256  + 64 * (j))
#define XB_XSUB(j)  (1280 + 64 * (j))
#define XB_XGEN(j)  (2304 + 64 * (j))
#define XB_TOP      3328
#define XB_TOPGEN   3392
#define XCD_BAR_WORDS 3456
#define XB_SPIN_CAP (1u << 18)

__device__ __forceinline__ unsigned xb_ld(unsigned* p)              { return __hip_atomic_load(p, __ATOMIC_RELAXED, __HIP_MEMORY_SCOPE_AGENT); }
__device__ __forceinline__ unsigned xb_add(unsigned* p, unsigned v) { return __hip_atomic_fetch_add(p, v, __ATOMIC_RELAXED, __HIP_MEMORY_SCOPE_AGENT); }
__device__ __forceinline__ unsigned xb_xcc_id() { return (unsigned)__builtin_amdgcn_s_getreg((3 << 11) | 20) & 0xFu; }
#define XB_SPIN(cond, bar) do { unsigned _sp = 0; while (cond) { __builtin_amdgcn_s_sleep(1); \
    if ((++_sp & 255u) == 0u) { if (xb_ld(&(bar)[XB_TMO])) break; if (_sp > XB_SPIN_CAP) { atomicAdd(&(bar)[XB_TMO], 1u); break; } } } } while (0)

struct XcdBarrier {
    unsigned* bar; unsigned x;
    volatile LAS unsigned* st;
};

__device__ __forceinline__ XcdBarrier xcd_barrier_post(unsigned* bar, volatile LAS unsigned* st) {
    XcdBarrier b; b.bar = bar; b.x = xb_xcc_id(); b.st = st;
    if (threadIdx.x == 0) (void)xb_add(&bar[XB_XCNT(b.x)], 1u);
    return b;
}
__device__ __forceinline__ void xcd_barrier_complete(unsigned* bar, unsigned x, unsigned& nloc, unsigned& nx) {
    const unsigned G = gridDim.x * gridDim.y * gridDim.z;
    unsigned sum, cnt, mine, sp = 0u;
    for (;;) {
        sum = 0u; cnt = 0u; mine = 0u;
#pragma nounroll
        for (unsigned j = 0; j < 16; ++j) { const unsigned c = xb_ld(&bar[XB_XCNT(j)]); sum += c; cnt += (c > 0u) ? 1u : 0u; mine = (j == x) ? c : mine; }
        if (sum == G) break;
        __builtin_amdgcn_s_sleep(1);
        if ((++sp & 255u) == 0u) { if (xb_ld(&bar[XB_TMO])) break; if (sp > XB_SPIN_CAP) { atomicAdd(&bar[XB_TMO], 1u); break; } }
    }
    nloc = mine > 0u ? mine : 1u; nx = cnt > 0u ? cnt : 1u;
}

__device__ __forceinline__ void xcd_barrier(const XcdBarrier& b) {
    asm volatile("s_waitcnt vmcnt(0)" ::: "memory");
    __syncthreads();
    if (threadIdx.x == 0) {
        unsigned* bar = b.bar;
        __builtin_amdgcn_s_waitcnt(0);
        unsigned nloc = b.st[0], nx = b.st[1];
        if (nloc == 0u) { xcd_barrier_complete(bar, b.x, nloc, nx); b.st[0] = nloc; b.st[1] = nx; }
        const unsigned old = xb_add(&bar[XB_XSUB(b.x)], 1u);
        const unsigned gen = old / nloc;
        if (old + 1u == (gen + 1u) * nloc) {
            __builtin_amdgcn_fence(__ATOMIC_RELEASE, "agent");
            asm volatile("s_waitcnt vmcnt(0)" ::: "memory");
            const unsigned og = xb_add(&bar[XB_TOP], 1u);
            const unsigned tg = og / nx;
            if (og + 1u == (tg + 1u) * nx) xb_add(&bar[XB_TOPGEN], 1u);
            else XB_SPIN(xb_ld(&bar[XB_TOPGEN]) == tg, bar);
            __builtin_amdgcn_fence(__ATOMIC_ACQUIRE, "agent");
            xb_add(&bar[XB_XGEN(b.x)], 1u);
            asm volatile("s_waitcnt vmcnt(0)" ::: "memory");
        } else {
            XB_SPIN(xb_ld(&bar[XB_XGEN(b.x)]) == gen, bar);
            __builtin_amdgcn_fence(__ATOMIC_ACQUIRE, "agent");
            asm volatile("s_waitcnt vmcnt(0)" ::: "memory");
        }
    }
    __syncthreads();
}


#ifndef DBG_MIX
#define DBG_MIX 7
#endif
#ifdef DBG_NULL_EPI
#define DBG_EPI_MODE(rep) ((rep) == 0 ? 1 : DBG_NULL_EPI == 2 ? 2 : 0)
#else
#define DBG_EPI_MODE(rep) 1
#endif
#ifndef SKEW_P4
#define SKEW_P4 0
#endif
#ifndef SKEW_P1
#define SKEW_P1 0
#endif
#ifndef DBG_REP_C1
#define DBG_REP_C1 1
#endif
#ifndef DBG_REP_C2
#define DBG_REP_C2 1
#endif
#ifndef DBG_REP_B
#define DBG_REP_B 1
#endif
#define DBG_A ((DBG_MIX & 1) ? 1.0f : 0.0f)
#define DBG_B ((DBG_MIX & 2) ? 1.0f : 0.0f)
#define DBG_C ((DBG_MIX & 4) ? 1.0f : 0.0f)
typedef float mb_f32x2_t __attribute__((ext_vector_type(2))); typedef __bf16 mb_bf16x2_t __attribute__((ext_vector_type(2)));
__device__ __forceinline__ unsigned mb_cvtpk(float lo, float hi) { mb_f32x2_t v = {lo, hi}; mb_bf16x2_t b = __builtin_convertvector(v, mb_bf16x2_t); return __builtin_bit_cast(unsigned, b); }
struct Params { const float* in[19]; float* out; unsigned char* ws; int ph_lo, ph_hi; int flags, bar_region; unsigned char bucket[128]; };

struct Ctx { volatile LAS unsigned long long* tab; unsigned char* ws; const unsigned char* bucket; };
constexpr int TAB_OFF = LDS_BYTES - 1024;
__device__ __forceinline__ const float* tab_ptr(const Ctx& c, int i) {
    const unsigned long long v = c.tab[i];
    const unsigned lo = (unsigned)__builtin_amdgcn_readfirstlane((int)(unsigned)v), hi = (unsigned)__builtin_amdgcn_readfirstlane((int)(unsigned)(v >> 32));
    return (const float*)(const GAS float*)(((unsigned long long)hi << 32) | lo);
}
#define PIN(c, i) tab_ptr(c, (i))
#define POUT(c) ((float*)tab_ptr(c, 19))
enum { I_X = 0, I_N1G, I_WIN, I_VNG, I_WS, I_BS, I_QNG, I_KNG, I_SINK, I_RELB, I_LBL, I_ONG, I_WOUT, I_N2G, I_WGATE, I_WUP, I_CONVW, I_CONVB, I_WDOWN };

__device__ __forceinline__ float row_rstd(const unsigned long long* SS, int r) {
    return rsqrtf((float)SS[r] * (1.0f / 16777216.0f / DM) + EPS);
}

struct EpiInProj {
    static constexpr bool PERM = true, AFTER_DRAIN = false;
    bf16* O; const unsigned long long* SS; int mode;
    __device__ __forceinline__ void operator()(pg8::f32x4 (&acc)[2][2][4][2], const pg8::Unit& u, int wr, int wc, int fr_in, int fq_in) const {
        int fr = fr_in, fq = fq_in; asm volatile("" : "+v"(fr), "+v"(fq));
        if (mode == 0) return;
        const int row0 = u.pm * 256 + wr * 64 + fr, col0 = u.pn * 256 + wc * 32 + 8 * fq;
        const int act = (u.pn <= 1) ? 1 : ((u.pn == 5 || u.pn == 8) ? 2 : 0);
        unsigned long long ssv[8];
#pragma unroll
        for (int i = 0; i < 8; ++i) ssv[i] = SS[row0 + (i >> 2) * 128 + (i & 3) * 16];
#pragma unroll
        for (int ai = 0; ai < 2; ++ai)
#pragma unroll
            for (int m = 0; m < 4; ++m) {
                const int r = row0 + ai * 128 + m * 16; const float rs = rsqrtf((float)ssv[ai * 4 + m] * (1.0f / 16777216.0f / DM) + EPS);
                bf16* rowp = (mode == 2) ? O + (WS_MIXED - WS_PROJ) / 2 + (size_t)(r & 255) * INW + (col0 & 255) : O + (size_t)r * INW + col0;
#pragma unroll
                for (int bj = 0; bj < 2; ++bj) {
                    f32x4 v0 = acc[ai][bj][m][0] * rs, v1 = acc[ai][bj][m][1] * rs;
                    if (act == 1) { pg8::f32x2 a = pg8::gelu_pk((pg8::f32x2){v0[0], v0[1]}), b = pg8::gelu_pk((pg8::f32x2){v0[2], v0[3]}), c = pg8::gelu_pk((pg8::f32x2){v1[0], v1[1]}), d = pg8::gelu_pk((pg8::f32x2){v1[2], v1[3]});
                        v0 = (f32x4){a.x, a.y, b.x, b.y}; v1 = (f32x4){c.x, c.y, d.x, d.y}; }
                    else if (act == 2) {
#pragma unroll
                        for (int j = 0; j < 4; ++j) { v0[j] = silu_f(v0[j]); v1[j] = silu_f(v1[j]); } }
                    v4u w; w.x = pg8::cvt_pk_bf16(v0[0], v0[1]); w.y = pg8::cvt_pk_bf16(v0[2], v0[3]); w.z = pg8::cvt_pk_bf16(v1[0], v1[1]); w.w = pg8::cvt_pk_bf16(v1[2], v1[3]);
                    *(v4u*)(rowp + bj * 128) = w; }
            }
    }
};
struct EpiResid {
    static constexpr bool PERM = true, AFTER_DRAIN = false;
    bf16* xb; float* out; unsigned long long* SS; int mode;
    __device__ __forceinline__ void operator()(pg8::f32x4 (&acc)[2][2][4][2], const pg8::Unit& u, int wr, int wc, int fr_in, int fq_in) const {
        int fr = fr_in, fq = fq_in; asm volatile("" : "+v"(fr), "+v"(fq));
        if (mode == 0) return;
        const unsigned row0 = (unsigned)(u.pm * 256 + wr * 64 + fr), col0 = (unsigned)(u.pn * 256 + wc * 32 + 8 * fq);
#pragma unroll
        for (int ai = 0; ai < 2; ++ai) {
            v4u raw8[4][2];
#pragma unroll
            for (int m = 0; m < 4; ++m)
#pragma unroll
                for (int bj = 0; bj < 2; ++bj) raw8[m][bj] = *(const v4u*)((const char*)xb + ((row0 + ai * 128 + m * 16) * (unsigned)DM + col0 + bj * 128) * 2u);
#pragma unroll
            for (int m = 0; m < 4; ++m) {
                const unsigned r = row0 + ai * 128 + m * 16, off = r * (unsigned)DM + col0; float ss = 0.f;
#pragma unroll
                for (int bj = 0; bj < 2; ++bj) {
                    const v4u raw = raw8[m][bj];
                    const f32x4 o0 = (f32x4){bflo(raw.x), bfhi(raw.x), bflo(raw.y), bfhi(raw.y)} + acc[ai][bj][m][0], o1 = (f32x4){bflo(raw.z), bfhi(raw.z), bflo(raw.w), bfhi(raw.w)} + acc[ai][bj][m][1];
                    if (mode == 1) { ss += ((o0[0] * o0[0] + o0[1] * o0[1]) + (o0[2] * o0[2] + o0[3] * o0[3])) + ((o1[0] * o1[0] + o1[1] * o1[1]) + (o1[2] * o1[2] + o1[3] * o1[3]));
                        v4u w; w.x = pg8::cvt_pk_bf16(o0[0], o0[1]); w.y = pg8::cvt_pk_bf16(o0[2], o0[3]); w.z = pg8::cvt_pk_bf16(o1[0], o1[1]); w.w = pg8::cvt_pk_bf16(o1[2], o1[3]);
                        *(v4u*)((char*)xb + (off + bj * 128) * 2u) = w; }
                    else { *(f32x4*)((char*)out + (size_t)(off + bj * 128) * 4u) = o0; *(f32x4*)((char*)out + (size_t)(off + bj * 128 + 4) * 4u) = o1; }
                }
                if (mode == 1) { ss += __shfl_xor(ss, 16); ss += __shfl_xor(ss, 32); if (fq == 0) __hip_atomic_fetch_add(SS + r, (unsigned long long)(ss * 16777216.0f), __ATOMIC_RELAXED, __HIP_MEMORY_SCOPE_AGENT); }
            }
            asm volatile("" ::: "memory");
        }
    }
};
struct EpiFFN {
    static constexpr bool PERM = true, AFTER_DRAIN = false;
    bf16* ACT; const unsigned long long* SS; const float* cw; const float* cb; float* HG; float* HU; int mode;
    template <class T> static __device__ __forceinline__ T ldg(const void* base, unsigned boff) { return *(const T*)((const char*)base + boff); }
    template <class T> static __device__ __forceinline__ void stg(void* base, unsigned boff, T v) { *(T*)((char*)base + boff) = v; }
    __device__ __forceinline__ void operator()(pg8::f32x4 (&acc)[2][2][4][2], const pg8::Unit& u, int wr, int wc, int fr_in, int fq_in) const {
        int fr = fr_in, fq = fq_in; asm volatile("" : "+v"(fr), "+v"(fq));
        if (mode == 0) return;
        const unsigned rowb = (unsigned)(u.pm * 256 + wr * 64 + fr), ch0 = (unsigned)(u.pn * 128 + wc * 32 + 8 * fq);
        float rs8[8];
        { unsigned long long ssv[8];
#pragma unroll
            for (int i = 0; i < 8; ++i) ssv[i] = ldg<unsigned long long>(SS, (rowb + (i >> 2) * 128 + (i & 3) * 16) * 8u);
#pragma unroll
            for (int i = 0; i < 8; ++i) rs8[i] = rsqrtf((float)ssv[i] * (1.0f / 16777216.0f / DM) + EPS); }
        if (fr < 2 || fr >= 14) {
#pragma unroll
            for (int ai = 0; ai < 2; ++ai) {
                const unsigned blk = (unsigned)(u.pm * 4 + ai * 2 + wr);
#pragma unroll
                for (int n = 0; n < 2; ++n) { const unsigned ch = ch0 + 4u * n;
                    if (fr < 2) { stg<f32x4>(HG, ((blk * 4u + (unsigned)fr) * (unsigned)DFF + ch) * 4u, acc[ai][0][0][n] * rs8[ai * 4]); stg<f32x4>(HU, ((blk * 2u + (unsigned)fr) * (unsigned)DFF + ch) * 4u, acc[ai][1][0][n] * rs8[ai * 4]); }
                    else { stg<f32x4>(HG, ((blk * 4u + 2u + (unsigned)(fr - 14)) * (unsigned)DFF + ch) * 4u, acc[ai][0][3][n] * rs8[ai * 4 + 3]); } }
            }
        }
        asm volatile("" ::: "memory");
#pragma unroll
        for (int n = 0; n < 2; ++n) {
            const unsigned ch = ch0 + 4u * n;
            const f32x4 w0 = ldg<f32x4>(cw, ch * 4u), w1 = ldg<f32x4>(cw, (DFF + ch) * 4u), w2 = ldg<f32x4>(cw, (2 * DFF + ch) * 4u), bb = ldg<f32x4>(cb, ch * 4u);
#pragma unroll
            for (int ai = 0; ai < 2; ++ai) {
                f32x4 r1p = (f32x4){0.f, 0.f, 0.f, 0.f}, r2p = r1p;
#pragma unroll
                for (int m = 0; m < 4; ++m) {
                    const float rs = rs8[ai * 4 + m];
                    const f32x4 g = acc[ai][0][m][n] * rs, up = acc[ai][1][m][n] * rs;
                    f32x4 r1, r2;
#pragma unroll
                    for (int j = 0; j < 4; ++j) { const float gj = g[j]; const int gi = __float_as_int(gj);
                        r1[j] = __int_as_float(__builtin_amdgcn_update_dpp(0, gi, 0x121, 0xf, 0xf, false));
                        r2[j] = __int_as_float(__builtin_amdgcn_update_dpp(0, gi, 0x122, 0xf, 0xf, false)); }
                    const f32x4 p1 = (fr >= 1) ? r1 : r1p, p2 = (fr >= 2) ? r2 : r2p;
                    f32x4 c = bb + w0 * p2 + w1 * p1 + w2 * g;
#pragma unroll
                    for (int j = 0; j < 4; ++j) c[j] = silu_f(c[j]) * up[j];
                    acc[ai][0][m][n] = c;
                    r1p = r1; r2p = r2;
                }
            }
            asm volatile("" ::: "memory");
        }
#pragma unroll
        for (int ai = 0; ai < 2; ++ai) {
#pragma unroll
            for (int m = 0; m < 4; ++m) {
                const unsigned r = rowb + ai * 128 + m * 16;
                const f32x4 v0 = acc[ai][0][m][0], v1 = acc[ai][0][m][1];
                v4u w; w.x = pg8::cvt_pk_bf16(v0[0], v0[1]); w.y = pg8::cvt_pk_bf16(v0[2], v0[3]); w.z = pg8::cvt_pk_bf16(v1[0], v1[1]); w.w = pg8::cvt_pk_bf16(v1[2], v1[3]);
                unsigned bo = (r * (unsigned)DFF + ch0) * 2u;
                if (m == 0) bo = (fr < 2) ? (unsigned)((size_t)M * DFF * 2) + (threadIdx.x * 16u) : bo;
                stg<v4u>(ACT, bo, w);
            }
            asm volatile("" ::: "memory");
        }
    }
};

__device__ __forceinline__ void p0_transpose_item(const float* W, int K, int N, const float* gk, bf16* WT, int dest_row0, int k0, int n0, LAS float* scr, int lane) {
    const int rr = lane >> 4, c4 = (lane & 15) * 4;
#pragma unroll 4
    for (int i = 0; i < 16; ++i) { const int kk = 4 * i + rr; f32x4 v = *(const f32x4*)(W + (size_t)(k0 + kk) * N + n0 + c4); if (gk) v = v * gk[k0 + kk];
        LAS float* d = scr + kk * 65 + c4; d[0] = v.x; d[1] = v.y; d[2] = v.z; d[3] = v.w; }
    LDS_WAIT(); asm volatile("" ::: "memory");
    const int c = lane & 7;
#pragma unroll
    for (int j = 0; j < 8; ++j) { const int n = (lane >> 3) + 8 * j; const LAS float* s = scr + (8 * c) * 65 + n;
        v4u o; o.x = mb_cvtpk(s[0 * 65], s[1 * 65]); o.y = mb_cvtpk(s[2 * 65], s[3 * 65]); o.z = mb_cvtpk(s[4 * 65], s[5 * 65]); o.w = mb_cvtpk(s[6 * 65], s[7 * 65]);
        *(GAS v4u*)(WT + (size_t)(dest_row0 + n) * K + k0 + 8 * c) = o; }
    LDS_WAIT(); asm volatile("" ::: "memory");
}

__device__ __forceinline__ void prologue(const Ctx& p, LAS unsigned char* lds, int wave, int lane, bool first) {
    LAS float* scr = (LAS float*)(lds + wave * 16640);
    const int gw = blockIdx.x * NWAVES + wave, NGW = gridDim.x * NWAVES;
    constexpr int I_IN = (DM / 64) * (INW / 64), I_OUT = (DM / 64) * (DM / 64), I_G = (DM / 64) * (DFF / 64), I_D = (DFF / 64) * (DM / 64);
    constexpr int PER_L = I_IN + I_OUT + 2 * I_G + I_D;
    for (int it = gw; it < DEPTH * PER_L; it += NGW) {
        const int l = it / PER_L; int r = it % PER_L;
        unsigned char* wl = p.ws + WS_W + (size_t)l * W_LAYER;
        if (r < I_IN) { const int nblk = INW / 64, kb = r / nblk, nb = r % nblk;
            p0_transpose_item(PIN(p, I_WIN) + (size_t)l * DM * INW, DM, INW, PIN(p, I_N1G) + l * DM, (bf16*)(wl + W_IN), 64 * nb, 64 * kb, 64 * nb, scr, lane); continue; } r -= I_IN;
        if (r < I_OUT) { const int nblk = DM / 64, kb = r / nblk, nb = r % nblk;
            p0_transpose_item(PIN(p, I_WOUT) + (size_t)l * DM * DM, DM, DM, nullptr, (bf16*)(wl + W_OUT), 64 * nb, 64 * kb, 64 * nb, scr, lane); continue; } r -= I_OUT;
        if (r < 2 * I_G) { const int up = r >= I_G; if (up) r -= I_G; const int nblk = DFF / 64, kb = r / nblk, nb = r % nblk, n0 = 64 * nb;
            const int dest = 256 * (n0 / 128) + (n0 % 128) + (up ? 128 : 0);
            p0_transpose_item(PIN(p, up ? I_WUP : I_WGATE) + (size_t)l * DM * DFF, DM, DFF, PIN(p, I_N2G) + l * DM, (bf16*)(wl + W_GU), dest, 64 * kb, n0, scr, lane); continue; } r -= 2 * I_G;
        { const int nblk = DM / 64, kb = r / nblk, nb = r % nblk;
            p0_transpose_item(PIN(p, I_WDOWN) + (size_t)l * DFF * DM, DFF, DM, nullptr, (bf16*)(wl + W_DN), 64 * nb, 64 * kb, 64 * nb, scr, lane); }
    }
    const float* x = PIN(p, I_X); bf16* XB = (bf16*)(p.ws + WS_XB); unsigned long long* SS = (unsigned long long*)(p.ws + WS_SS);
    for (int m = gw; m < M; m += NGW) {
        const f32x4* xr = (const f32x4*)(x + (size_t)m * DM) + lane; f32x4 v[4]; float s = 0.f;
#pragma unroll
        for (int j = 0; j < 4; ++j) { v[j] = xr[64 * j]; s += (v[j].x * v[j].x + v[j].y * v[j].y) + (v[j].z * v[j].z + v[j].w * v[j].w); }
        s = wave_sum(s);
        unsigned long long* o8 = (unsigned long long*)(XB + (size_t)m * DM) + lane;
#pragma unroll
        for (int j = 0; j < 4; ++j) o8[64 * j] = (unsigned long long)pk2(v[j].x, v[j].y) | ((unsigned long long)pk2(v[j].z, v[j].w) << 32);
        if (lane == 0 && first) __hip_atomic_fetch_add(SS + m, (unsigned long long)(s * 16777216.0f), __ATOMIC_RELAXED, __HIP_MEMORY_SCOPE_AGENT);
    }
    { bf16* wtb = (bf16*)(p.ws + WS_TAB + 131072); const float* wsrc = PIN(p, I_WS);
        for (int i = gw * 64 + lane; i < DEPTH * 4 * 128 * 128; i += NGW * 64) { const int s_ = i & 127, t_ = (i >> 7) & 127; wtb[i] = (bf16)f2bf(s_ <= t_ ? wsrc[i] : 0.f); } }
    if (blockIdx.x == 0) { float* bt = (float*)(p.ws + WS_TAB);
        for (int i = wave * 64 + lane; i < 1024; i += NWAVES * 64) { const int h = i >> 7, d = i & 127; bt[i] = PIN(p, I_RELB)[(int)((LAS unsigned char*)(lds + TAB_OFF + 256))[d] * 8 + h]; } }
}

#ifdef DBG_MIXCMP
__device__ __forceinline__ void mixer_a_simple(const Ctx& p, int l, int unit, LAS unsigned char* lds, int wave, int lane) {
    LAS float* vn = (LAS float*)lds;
    const int g = unit & 3, ck = unit >> 2; const size_t row0 = (size_t)ck * 128;
    const bf16* PROJ = (const bf16*)(p.ws + WS_PROJ); bf16* MIXED = (bf16*)(p.ws + WS_MIXED);
    const float vg = PIN(p, I_VNG)[(l * 4 + g) * 64 + lane];
#pragma unroll 4
    for (int i = 0; i < 16; ++i) { const int s = wave * 16 + i;
        const float v = bf2f(PROJ[(row0 + s) * INW + C_AV + g * 64 + lane]);
        const float ss = wave_sum(v * v);
        vn[s * 64 + lane] = v * rsqrtf(ss * (1.0f / 64.0f) + EPS) * vg; }
    __syncthreads();
    const float* Wg = PIN(p, I_WS) + (size_t)(l * 4 + g) * 128 * 128; const float* bs = PIN(p, I_BS) + (l * 4 + g) * 128;
    for (int i = 0; i < 16; ++i) { const int t = __builtin_amdgcn_readfirstlane(wave + 8 * i);
        const float* wrow = Wg + t * 128; float a = 0.f;
        for (int s0 = 0; s0 <= t; s0 += 4) { const f32x4 w = *(const f32x4*)(wrow + s0);
#pragma unroll
            for (int j = 0; j < 4; ++j) { const float wj = (s0 + j <= t) ? w[j] : 0.f; a += wj * vn[(s0 + j) * 64 + lane]; } }
        a += bs[t];
        const float uval = bf2f(PROJ[(row0 + t) * INW + C_AU + g * 64 + lane]);
        MIXED[(row0 + t) * DM + MX_A + g * 64 + lane] = (bf16)f2bf(uval * a * DBG_A); }
    __syncthreads();
}

#endif
#ifdef DBG_MIXCMP
constexpr int KVS = 68;
__device__ __forceinline__ void mixer_b_simple(const Ctx& p, int l, int unit, LAS unsigned char* lds, int wave, int lane) {
    LAS float* Kt = (LAS float*)lds; LAS float* Vt = Kt + 256 * KVS;
    const int hk = unit & 1, nb = unit >> 1, n = nb & 63; const long row0 = (long)nb * 128, win0 = row0 - 128;
    const bf16* PROJ = (const bf16*)(p.ws + WS_PROJ); bf16* MIXED = (bf16*)(p.ws + WS_MIXED);
    const int tid = wave * 64 + lane;
    {
        const int row = tid >> 1, half = tid & 1; const bool valid = (n > 0) || (row >= 128);
        float kf[32], vf[32];
        if (valid) { const v4u* kp = (const v4u*)(PROJ + (win0 + row) * INW + C_BK + hk * 64 + half * 32); const v4u* vp = (const v4u*)(PROJ + (win0 + row) * INW + C_BV + hk * 64 + half * 32);
#pragma unroll
            for (int c = 0; c < 4; ++c) { const v4u a = kp[c], b = vp[c];
                kf[8 * c + 0] = bflo(a.x); kf[8 * c + 1] = bfhi(a.x); kf[8 * c + 2] = bflo(a.y); kf[8 * c + 3] = bfhi(a.y); kf[8 * c + 4] = bflo(a.z); kf[8 * c + 5] = bfhi(a.z); kf[8 * c + 6] = bflo(a.w); kf[8 * c + 7] = bfhi(a.w);
                vf[8 * c + 0] = bflo(b.x); vf[8 * c + 1] = bfhi(b.x); vf[8 * c + 2] = bflo(b.y); vf[8 * c + 3] = bfhi(b.y); vf[8 * c + 4] = bflo(b.z); vf[8 * c + 5] = bfhi(b.z); vf[8 * c + 6] = bflo(b.w); vf[8 * c + 7] = bfhi(b.w); } }
        else {
#pragma unroll
            for (int c = 0; c < 32; ++c) { kf[c] = 0.f; vf[c] = 0.f; } }
        float ss = 0.f;
#pragma unroll
        for (int c = 0; c < 32; ++c) ss += kf[c] * kf[c];
        ss += __shfl_xor(ss, 1);
        const float rs = rsqrtf(ss * (1.0f / 64.0f) + EPS); const float* kng = PIN(p, I_KNG) + l * 64 + half * 32;
#pragma unroll
        for (int c = 0; c < 8; ++c) {
            *(LAS f32x4*)(Kt + row * KVS + half * 32 + 4 * c) = (f32x4){kf[4 * c] * rs * kng[4 * c], kf[4 * c + 1] * rs * kng[4 * c + 1], kf[4 * c + 2] * rs * kng[4 * c + 2], kf[4 * c + 3] * rs * kng[4 * c + 3]};
            *(LAS f32x4*)(Vt + row * KVS + half * 32 + 4 * c) = (f32x4){vf[4 * c], vf[4 * c + 1], vf[4 * c + 2], vf[4 * c + 3]}; }
    }
    __syncthreads();
    const int g = wave >> 1, i = (wave & 1) * 64 + lane, h = hk * 4 + g;
    float q[64];
    { const v4u* qp = (const v4u*)(PROJ + (row0 + i) * INW + C_BQ + h * 64); float ss = 0.f;
#pragma unroll
        for (int c = 0; c < 8; ++c) { const v4u a = qp[c];
            q[8 * c + 0] = bflo(a.x); q[8 * c + 1] = bfhi(a.x); q[8 * c + 2] = bflo(a.y); q[8 * c + 3] = bfhi(a.y); q[8 * c + 4] = bflo(a.z); q[8 * c + 5] = bfhi(a.z); q[8 * c + 6] = bflo(a.w); q[8 * c + 7] = bfhi(a.w); }
#pragma unroll
        for (int c = 0; c < 64; ++c) ss += q[c] * q[c];
        const float rs = rsqrtf(ss * (1.0f / 64.0f) + EPS) * 0.125f; const float* qng = PIN(p, I_QNG) + l * 64;
#pragma unroll
        for (int c = 0; c < 64; ++c) q[c] *= rs * qng[c]; }
    float mx = PIN(p, I_SINK)[l * 8 + h], lsum = 1.0f; float o[64];
#pragma unroll
    for (int c = 0; c < 64; ++c) o[c] = 0.f;
    const float* bt = (const float*)(p.ws + WS_TAB) + h * 128;
    for (int dist = 0; dist < 128; ++dist) {
        const int j = i + 128 - dist; const LAS float* kr = Kt + j * KVS; const LAS float* vr = Vt + j * KVS;
        float s0 = 0.f, s1 = 0.f, s2 = 0.f, s3 = 0.f;
#pragma unroll
        for (int c = 0; c < 16; ++c) { const f32x4 kk = *(const LAS f32x4*)(kr + 4 * c); s0 += q[4 * c] * kk.x; s1 += q[4 * c + 1] * kk.y; s2 += q[4 * c + 2] * kk.z; s3 += q[4 * c + 3] * kk.w; }
        float s = (s0 + s1) + (s2 + s3) + bt[dist];
        if (n == 0 && j < 128) s = -1e30f;
        if (s > mx) { const float f = __expf(mx - s); lsum *= f;
#pragma unroll
            for (int c = 0; c < 64; ++c) o[c] *= f;
            mx = s; }
        const float pr = __expf(s - mx); lsum += pr;
#pragma unroll
        for (int c = 0; c < 16; ++c) { const f32x4 vv = *(const LAS f32x4*)(vr + 4 * c); o[4 * c] += pr * vv.x; o[4 * c + 1] += pr * vv.y; o[4 * c + 2] += pr * vv.z; o[4 * c + 3] += pr * vv.w; }
    }
    const float inv = DBG_B / lsum; v4u* op = (v4u*)(MIXED + (row0 + i) * DM + MX_B + h * 64);
#pragma unroll
    for (int c = 0; c < 8; ++c) { v4u w; w.x = pk2(o[8 * c] * inv, o[8 * c + 1] * inv); w.y = pk2(o[8 * c + 2] * inv, o[8 * c + 3] * inv); w.z = pk2(o[8 * c + 4] * inv, o[8 * c + 5] * inv); w.w = pk2(o[8 * c + 6] * inv, o[8 * c + 7] * inv); op[c] = w; }
    __syncthreads();
}

#endif

namespace mb {
typedef short bf16x8 __attribute__((ext_vector_type(8)));
typedef short s16x4 __attribute__((ext_vector_type(4)));
typedef float f32x16 __attribute__((ext_vector_type(16)));
typedef float f32x2_t __attribute__((ext_vector_type(2)));
typedef __bf16 bf16x2_t __attribute__((ext_vector_type(2)));
constexpr int KB_OFF = 0, VB_OFF = 32768, BIAS_OFF = 65536, WS_OFF = 73728, WS_STRIDE = 4608;
__device__ __forceinline__ int crow(int r, int hi) { return (r & 3) + 8 * (r >> 2) + 4 * hi; }
__device__ __forceinline__ unsigned cvtpk(float lo, float hi) { f32x2_t v = {lo, hi}; bf16x2_t b = __builtin_convertvector(v, bf16x2_t); return __builtin_bit_cast(unsigned, b); }
__device__ __forceinline__ s16x4 vtr(LAS const unsigned char* p) { return __builtin_bit_cast(s16x4, __builtin_amdgcn_ds_read_tr16_b64_v4i16((LAS s16x4*)p)); }
}
__device__ __forceinline__ void mixer_b_mfma(const Ctx& p, int l, int unit, LAS unsigned char* lds, int wave, int lane) {
    using namespace mb;
    const int hk = unit & 1, nb = unit >> 1, n = nb & 63; const long row0 = (long)nb * 128, win0 = row0 - 128;
    const bf16* PROJ = (const bf16*)(p.ws + WS_PROJ); bf16* MIXED = (bf16*)(p.ws + WS_MIXED);
    const int tid = wave * 64 + lane, r32 = lane & 31, hi = lane >> 5;
    {
        const int row = tid >> 1, half = tid & 1; const bool valid = (n > 0) || (row >= 128);
        v4u kr[4], vr[4];
        if (valid) { const v4u* kp = (const v4u*)(PROJ + (win0 + row) * INW + C_BK + hk * 64 + half * 32); const v4u* vp = (const v4u*)(PROJ + (win0 + row) * INW + C_BV + hk * 64 + half * 32);
#pragma unroll
            for (int c = 0; c < 4; ++c) { kr[c] = kp[c]; vr[c] = vp[c]; } }
        else {
#pragma unroll
            for (int c = 0; c < 4; ++c) { kr[c] = (v4u){0u, 0u, 0u, 0u}; vr[c] = kr[c]; } }
        float ss = 0.f;
#pragma unroll
        for (int c = 0; c < 4; ++c) { const unsigned w4[4] = {kr[c].x, kr[c].y, kr[c].z, kr[c].w};
#pragma unroll
            for (int e = 0; e < 4; ++e) { const float a = bflo(w4[e]), b = bfhi(w4[e]); ss += a * a + b * b; } }
        ss += __shfl_xor(ss, 1);
        const float rs = rsqrtf(ss * (1.0f / 64.0f) + EPS); const float* kng = PIN(p, I_KNG) + l * 64 + half * 32;
        LAS unsigned char* kdst = lds + KB_OFF + (row >> 6) * 8192 + (half * 4) * 1024 + (row & 63) * 16;
        LAS unsigned char* vdst = lds + VB_OFF + (row >> 6) * 8192 + half * 4096 + ((row & 63) >> 4) * 1024 + (row & 15) * 64;
#pragma unroll
        for (int c = 0; c < 4; ++c) { const unsigned w4[4] = {kr[c].x, kr[c].y, kr[c].z, kr[c].w}; v4u o;
            unsigned ow[4];
#pragma unroll
            for (int e = 0; e < 4; ++e) ow[e] = cvtpk(bflo(w4[e]) * rs * kng[8 * c + 2 * e], bfhi(w4[e]) * rs * kng[8 * c + 2 * e + 1]);
            o.x = ow[0]; o.y = ow[1]; o.z = ow[2]; o.w = ow[3];
            *(LAS v4u*)(kdst + c * 1024) = o;
            *(LAS v4u*)(vdst + c * 16) = vr[c]; }
        const float* bt = (const float*)(p.ws + WS_TAB) + (hk * 4) * 128;
        for (int i = tid; i < 4 * 384; i += NWAVES * 64) { const int g = i / 384, x = i % 384 - 128; ((LAS float*)(lds + BIAS_OFF))[i] = (x >= 0 && x < 128) ? bt[g * 128 + 127 - x] * 1.4426950408889634f : -1e30f; }
    }
    __syncthreads();
    const int g = wave >> 1, h = hk * 4 + g;
    LAS float* wsf = (LAS float*)(lds + WS_OFF + wave * WS_STRIDE);
    LAS bf16* stg = (LAS bf16*)(lds + WS_OFF + wave * WS_STRIDE + 256);
    const float sink2 = PIN(p, I_SINK)[l * 8 + h] * 1.4426950408889634f;
    float gqv[4][8];
    { const float* qng = PIN(p, I_QNG) + l * 64 + hi * 8;
#pragma unroll
        for (int d0 = 0; d0 < 4; ++d0) { const f32x4 a = *(const f32x4*)(qng + d0 * 16), b = *(const f32x4*)(qng + d0 * 16 + 4);
            const float c2 = 0.125f * 1.4426950408889634f;
            gqv[d0][0] = a.x * c2; gqv[d0][1] = a.y * c2; gqv[d0][2] = a.z * c2; gqv[d0][3] = a.w * c2; gqv[d0][4] = b.x * c2; gqv[d0][5] = b.y * c2; gqv[d0][6] = b.z * c2; gqv[d0][7] = b.w * c2; } }
    const LAS unsigned char* vp0 = lds + VB_OFF + ((lane >> 4) & 1) * 32 + (lane & 3) * 8 + (4 * hi + ((lane & 15) >> 2)) * 64;
#pragma unroll
    for (int qt = 0; qt < 2; ++qt) {
        const int i0 = (wave & 1) * 64 + qt * 32, qi = i0 + r32, jt0 = (i0 >= 64) ? 1 : 0;
#define MB_LIVE(jt, hh) ((qt == 0) ? !((jt) == 2 && (hh) == 1) : !((jt) == 0 && (hh) == 0))
        bf16x8 qr[4];
        { const bf16* qp = PROJ + (row0 + qi) * INW + C_BQ + h * 64 + hi * 8; v4u raw[4]; float ss = 0.f;
#pragma unroll
            for (int d0 = 0; d0 < 4; ++d0) { raw[d0] = *(const v4u*)(qp + d0 * 16); const unsigned w4[4] = {raw[d0].x, raw[d0].y, raw[d0].z, raw[d0].w};
#pragma unroll
                for (int e = 0; e < 4; ++e) { const float a = bflo(w4[e]), b = bfhi(w4[e]); ss += a * a + b * b; } }
            ss += __shfl_xor(ss, 32);
            const float rs = rsqrtf(ss * (1.0f / 64.0f) + EPS);
#pragma unroll
            for (int d0 = 0; d0 < 4; ++d0) { const unsigned w4[4] = {raw[d0].x, raw[d0].y, raw[d0].z, raw[d0].w}; unsigned ow[4];
#pragma unroll
                for (int e = 0; e < 4; ++e) ow[e] = cvtpk(bflo(w4[e]) * rs * gqv[d0][2 * e], bfhi(w4[e]) * rs * gqv[d0][2 * e + 1]);
                v4u o; o.x = ow[0]; o.y = ow[1]; o.z = ow[2]; o.w = ow[3]; qr[d0] = __builtin_bit_cast(bf16x8, o); } }
        f32x16 sc[3][2];
#pragma unroll
        for (int jt = 0; jt < 3; ++jt) { const LAS unsigned char* kb = lds + KB_OFF + (jt0 + jt) * 8192 + hi * 1024 + r32 * 16;
            f32x16 a0 = {}, a1 = {};
#pragma unroll
            for (int d0 = 0; d0 < 4; ++d0) {
                if (MB_LIVE(jt, 0)) { const bf16x8 b0 = *(const LAS bf16x8*)(kb + d0 * 2048); a0 = __builtin_amdgcn_mfma_f32_32x32x16_bf16(b0, qr[d0], a0, 0, 0, 0); }
                if (MB_LIVE(jt, 1)) { const bf16x8 b1 = *(const LAS bf16x8*)(kb + d0 * 2048 + 512); a1 = __builtin_amdgcn_mfma_f32_32x32x16_bf16(b1, qr[d0], a1, 0, 0, 0); } }
            sc[jt][0] = a0; sc[jt][1] = a1; }
        const LAS float* tb = (const LAS float*)(lds + BIAS_OFF) + g * 384 + 128;
        float mx = sink2;
#pragma unroll
        for (int jt = 0; jt < 3; ++jt)
#pragma unroll
            for (int hh = 0; hh < 2; ++hh) if (MB_LIVE(jt, hh)) { const int kj0 = 64 * (jt0 + jt) + 32 * hh + 4 * hi;
                const LAS float* tx = tb + (127 - (qi + 128 - kj0));
                const bool first = (n == 0) && (jt0 + jt < 2);
#pragma unroll
                for (int r = 0; r < 16; ++r) { const int kc = (r & 3) + 8 * (r >> 2);
                    float s = sc[jt][hh][r] + tx[kc]; if (first) s = -1e30f;
                    sc[jt][hh][r] = s; mx = fmaxf(mx, s); } }
        mx = fmaxf(mx, __shfl_xor(mx, 32));
        float lsum = 0.f;
#pragma unroll
        for (int jt = 0; jt < 3; ++jt)
#pragma unroll
            for (int hh = 0; hh < 2; ++hh) if (MB_LIVE(jt, hh))
#pragma unroll
                for (int r = 0; r < 16; ++r) { const float e = __builtin_amdgcn_exp2f(sc[jt][hh][r] - mx); sc[jt][hh][r] = e; lsum += e; }
        lsum += __shfl_xor(lsum, 32);
        lsum += __builtin_amdgcn_exp2f(sink2 - mx);
        f32x16 o0 = {}, o1 = {};
#pragma unroll
        for (int jt = 0; jt < 3; ++jt) { const LAS unsigned char* vb = vp0 + (jt0 + jt) * 8192;
#pragma unroll
            for (int ks = 0; ks < 4; ++ks) { const int hh = ks >> 1, rb = (ks & 1) * 8;
                if (MB_LIVE(jt, hh)) {
                v4u pw; pw.x = cvtpk(sc[jt][hh][rb + 0], sc[jt][hh][rb + 1]); pw.y = cvtpk(sc[jt][hh][rb + 2], sc[jt][hh][rb + 3]); pw.z = cvtpk(sc[jt][hh][rb + 4], sc[jt][hh][rb + 5]); pw.w = cvtpk(sc[jt][hh][rb + 6], sc[jt][hh][rb + 7]);
                const bf16x8 pa = __builtin_bit_cast(bf16x8, pw);
                const s16x4 l0 = vtr(vb + ks * 1024), h0 = vtr(vb + ks * 1024 + 512), l1 = vtr(vb + 4096 + ks * 1024), h1 = vtr(vb + 4096 + ks * 1024 + 512);
                const bf16x8 v0 = (bf16x8){l0[0], l0[1], l0[2], l0[3], h0[0], h0[1], h0[2], h0[3]}, v1 = (bf16x8){l1[0], l1[1], l1[2], l1[3], h1[0], h1[1], h1[2], h1[3]};
                o0 = __builtin_amdgcn_mfma_f32_32x32x16_bf16(pa, v0, o0, 0, 0, 0); o1 = __builtin_amdgcn_mfma_f32_32x32x16_bf16(pa, v1, o1, 0, 0, 0); } } }
#undef MB_LIVE
        if (hi == 0) wsf[r32] = lsum;
        LDS_WAIT(); asm volatile("" ::: "memory");
#pragma unroll
        for (int r = 0; r < 16; ++r) { const int orow = crow(r, hi); const float inv = DBG_B / wsf[orow];
            stg[orow * 64 + r32] = (bf16)f2bf(o0[r] * inv); stg[orow * 64 + 32 + r32] = (bf16)f2bf(o1[r] * inv); }
        LDS_WAIT(); asm volatile("" ::: "memory");
        bf16* ow = MIXED + (row0 + i0) * DM + MX_B + h * 64;
#pragma unroll
        for (int i = 0; i < 4; ++i) { const int row = i * 8 + (lane >> 3), ch = lane & 7; const v4u v = *(const LAS v4u*)(stg + row * 64 + ch * 8); *(v4u*)(ow + (long)row * DM + ch * 8) = v; }
        LDS_WAIT(); asm volatile("" ::: "memory");
    }
    __syncthreads();
}

constexpr size_t WS_WTB = WS_TAB + 131072;
constexpr int VNT_STRIDE = 136;
__device__ __forceinline__ void mixer_a_mfma(const Ctx& p, int l, int unit, LAS unsigned char* lds, int wave, int lane) {
    using namespace mb;
    LAS bf16* vnT = (LAS bf16*)lds;
    const int g = unit & 3, ck = unit >> 2; const size_t row0 = (size_t)ck * 128;
    const bf16* PROJ = (const bf16*)(p.ws + WS_PROJ); bf16* MIXED = (bf16*)(p.ws + WS_MIXED);
    const int r32 = lane & 31, hi = lane >> 5;
    {
        const int sub = lane >> 4, d4 = (lane & 15) * 4; const f32x4 vg = *(const f32x4*)(PIN(p, I_VNG) + (l * 4 + g) * 64 + d4);
#pragma unroll
        for (int i = 0; i < 4; ++i) { const int s = wave * 16 + i * 4 + sub;
            const v2u raw = *(const v2u*)(PROJ + (row0 + s) * INW + C_AV + g * 64 + d4);
            const float v0 = bflo(raw.x), v1 = bfhi(raw.x), v2 = bflo(raw.y), v3 = bfhi(raw.y);
            float ss = (v0 * v0 + v1 * v1) + (v2 * v2 + v3 * v3);
            ss += __shfl_xor(ss, 1); ss += __shfl_xor(ss, 2); ss += __shfl_xor(ss, 4); ss += __shfl_xor(ss, 8);
            const float rs = rsqrtf(ss * (1.0f / 64.0f) + EPS);
            vnT[(d4 + 0) * VNT_STRIDE + s] = (bf16)f2bf(v0 * rs * vg.x); vnT[(d4 + 1) * VNT_STRIDE + s] = (bf16)f2bf(v1 * rs * vg.y);
            vnT[(d4 + 2) * VNT_STRIDE + s] = (bf16)f2bf(v2 * rs * vg.z); vnT[(d4 + 3) * VNT_STRIDE + s] = (bf16)f2bf(v3 * rs * vg.w); }
    }
    __syncthreads();
    const int ti = wave >> 1, dt = wave & 1;
    const bf16* Wt = (const bf16*)(p.ws + WS_WTB) + ((size_t)(l * 4 + g) * 128 + 32 * ti + r32) * 128 + 8 * hi;
    const LAS bf16* vb = vnT + (32 * dt + r32) * VNT_STRIDE + 8 * hi;
    f32x16 acc = {};
    for (int ks = 0; ks < 2 * ti + 2; ++ks) {
        const bf16x8 a = __builtin_bit_cast(bf16x8, *(const v4u*)(Wt + 16 * ks)); const bf16x8 b = *(const LAS bf16x8*)(vb + 16 * ks);
        acc = __builtin_amdgcn_mfma_f32_32x32x16_bf16(a, b, acc, 0, 0, 0); }
    const float* bs = PIN(p, I_BS) + (l * 4 + g) * 128 + 32 * ti;
#pragma unroll
    for (int r = 0; r < 16; ++r) { const int t = crow(r, hi); const size_t row = row0 + 32 * ti + t;
        const float uval = bf2f(PROJ[row * INW + C_AU + g * 64 + 32 * dt + r32]);
        MIXED[row * DM + MX_A + g * 64 + 32 * dt + r32] = (bf16)f2bf(uval * (acc[r] + bs[t]) * DBG_A); }
    __syncthreads();
}
__device__ __forceinline__ float hgrn_lb(const Ctx& p, int l, int kidx) { if (l == 0) return 0.f; const float* lg = PIN(p, I_LBL); return 1.0f / (1.0f + __expf(lg[kidx] - lg[256 + kidx])); }
#ifdef DBG_MIXCMP
__device__ __forceinline__ void hgrn_stage(const bf16* PROJ, size_t rowbase, int hc, const float (&lb8)[8], LAS float* F, LAS float* V, LAS float* Q, int tid) {
    const int tt = tid >> 3, k0 = (tid & 7) * 8; const bf16* rp = PROJ + (rowbase + tt) * INW + hc * 64 + k0;
    const v4u z = *(const v4u*)(rp + C_CF), vi = *(const v4u*)(rp + C_CI);
    float zf[8] = {bflo(z.x), bfhi(z.x), bflo(z.y), bfhi(z.y), bflo(z.z), bfhi(z.z), bflo(z.w), bfhi(z.w)}; float ff[8];
#pragma unroll
    for (int j = 0; j < 8; ++j) ff[j] = lb8[j] + (1.0f - lb8[j]) * __builtin_amdgcn_rcpf(1.0f + __expf(-zf[j]));
    *(LAS f32x4*)(F + tt * 64 + k0) = (f32x4){ff[0], ff[1], ff[2], ff[3]}; *(LAS f32x4*)(F + tt * 64 + k0 + 4) = (f32x4){ff[4], ff[5], ff[6], ff[7]};
    *(LAS f32x4*)(V + tt * 64 + k0) = (f32x4){bflo(vi.x), bfhi(vi.x), bflo(vi.y), bfhi(vi.y)}; *(LAS f32x4*)(V + tt * 64 + k0 + 4) = (f32x4){bflo(vi.z), bfhi(vi.z), bflo(vi.w), bfhi(vi.w)};
    if (Q) { const v4u qq = *(const v4u*)(rp + C_CQ);
        *(LAS f32x4*)(Q + tt * 64 + k0) = (f32x4){bflo(qq.x), bfhi(qq.x), bflo(qq.y), bfhi(qq.y)}; *(LAS f32x4*)(Q + tt * 64 + k0 + 4) = (f32x4){bflo(qq.z), bfhi(qq.z), bflo(qq.w), bfhi(qq.w)}; }
}
__device__ __forceinline__ void mixer_c_pass1_simple(const Ctx& p, int l, int unit, LAS unsigned char* lds, int wave, int lane) {
    LAS float* F = (LAS float*)lds; LAS float* V = F + 4096;
    const int bh = unit >> 4, seg = unit & 15, b = bh >> 2, hc = bh & 3; const size_t row0 = (size_t)b * SEQ + (size_t)seg * 512;
    const bf16* PROJ = (const bf16*)(p.ws + WS_PROJ); const int tid = wave * 64 + lane;
    float lb8[8];
#pragma unroll
    for (int j = 0; j < 8; ++j) lb8[j] = hgrn_lb(p, l, hc * 64 + (tid & 7) * 8 + j);
    float S[8], P[8];
#pragma unroll
    for (int j = 0; j < 8; ++j) { S[j] = 0.f; P[j] = 1.f; }
    for (int cks = 0; cks < 8; ++cks) {
        __syncthreads();
        hgrn_stage(PROJ, row0 + cks * 64, hc, lb8, F, V, nullptr, tid);
        __syncthreads();
        for (int tt = 0; tt < 64; ++tt) {
            const f32x4 fa = *(const LAS f32x4*)(F + tt * 64 + wave * 8), fb = *(const LAS f32x4*)(F + tt * 64 + wave * 8 + 4); const float vv = V[tt * 64 + lane];
            const float f8[8] = {fa.x, fa.y, fa.z, fa.w, fb.x, fb.y, fb.z, fb.w};
#pragma unroll
            for (int j = 0; j < 8; ++j) { S[j] = fmaf(f8[j], S[j] - vv, vv); P[j] *= f8[j]; }
        }
    }
    float* SEGS = (float*)(p.ws + WS_SEGS); float* SEGP = (float*)(p.ws + WS_SEGP);
#pragma unroll
    for (int j = 0; j < 8; ++j) { SEGS[(size_t)unit * 4096 + (wave * 8 + j) * 64 + lane] = S[j]; if (lane == 0) SEGP[unit * 64 + wave * 8 + j] = P[j]; }
    __syncthreads();
}
__device__ __forceinline__ void mixer_c_pass2_simple(const Ctx& p, int l, int unit, LAS unsigned char* lds, int wave, int lane) {
    LAS float* F = (LAS float*)lds; LAS float* V = F + 4096; LAS float* Q = V + 4096; LAS float* PO = Q + 4096;
    const int bh = unit >> 4, seg = unit & 15, b = bh >> 2, hc = bh & 3; const size_t row0 = (size_t)b * SEQ + (size_t)seg * 512;
    const bf16* PROJ = (const bf16*)(p.ws + WS_PROJ); bf16* MIXED = (bf16*)(p.ws + WS_MIXED); const int tid = wave * 64 + lane;
    const float* SEGS = (const float*)(p.ws + WS_SEGS); const float* SEGP = (const float*)(p.ws + WS_SEGP);
    float lb8[8];
#pragma unroll
    for (int j = 0; j < 8; ++j) lb8[j] = hgrn_lb(p, l, hc * 64 + (tid & 7) * 8 + j);
    float S[8];
#pragma unroll
    for (int j = 0; j < 8; ++j) S[j] = 0.f;
    for (int s = 0; s < seg; ++s) { const int u2 = bh * 16 + s;
#pragma unroll
        for (int j = 0; j < 8; ++j) S[j] = SEGP[u2 * 64 + wave * 8 + j] * S[j] + SEGS[(size_t)u2 * 4096 + (wave * 8 + j) * 64 + lane]; }
    const float ong = PIN(p, I_ONG)[l * 64 + lane];
    for (int cks = 0; cks < 8; ++cks) {
        __syncthreads();
        hgrn_stage(PROJ, row0 + cks * 64, hc, lb8, F, V, Q, tid);
        __syncthreads();
        for (int tg = 0; tg < 4; ++tg) {
            for (int t16 = 0; t16 < 16; ++t16) { const int tt = tg * 16 + t16;
                const f32x4 fa = *(const LAS f32x4*)(F + tt * 64 + wave * 8), fb = *(const LAS f32x4*)(F + tt * 64 + wave * 8 + 4);
                const f32x4 qa = *(const LAS f32x4*)(Q + tt * 64 + wave * 8), qb = *(const LAS f32x4*)(Q + tt * 64 + wave * 8 + 4); const float vv = V[tt * 64 + lane];
                const float f8[8] = {fa.x, fa.y, fa.z, fa.w, fb.x, fb.y, fb.z, fb.w}; const float q8[8] = {qa.x, qa.y, qa.z, qa.w, qb.x, qb.y, qb.z, qb.w};
                float po = 0.f;
#pragma unroll
                for (int j = 0; j < 8; ++j) { S[j] = fmaf(f8[j], S[j] - vv, vv); po = fmaf(q8[j], S[j], po); }
                PO[(t16 * 8 + wave) * 64 + lane] = po; }
            __syncthreads();
#pragma unroll
            for (int e = 0; e < 2; ++e) { const int t16 = wave * 2 + e; float o = 0.f;
#pragma unroll
                for (int w = 0; w < 8; ++w) o += PO[(t16 * 8 + w) * 64 + lane];
                const float ss = wave_sum(o * o); const size_t row = row0 + cks * 64 + tg * 16 + t16;
                const float gg = bf2f(PROJ[row * INW + C_CG + hc * 64 + lane]);
                MIXED[row * DM + MX_C + hc * 64 + lane] = (bf16)f2bf(o * rsqrtf(ss * (1.0f / 64.0f) + EPS) * ong * gg * DBG_C); }
            __syncthreads();
        }
    }
}

#endif

namespace mc {
constexpr int QT = 0, KT = 4096, QH = 8192, KH = 12288, VV = 16384, DD = 20480, WTO = 20736, OE = 22784, OI = 30976, RB = 39168, LDS_END = 55552;
}
#define MC_BAR() do { asm volatile("s_waitcnt lgkmcnt(0)" ::: "memory"); __builtin_amdgcn_s_barrier(); asm volatile("" ::: "memory"); } while (0)
template <bool PASS2>
__device__ __forceinline__ void mixer_c_mfma(const Ctx& p, int l, int unit, LAS unsigned char* lds, int wave, int lane) {
    using namespace mb;
    const int bh = unit >> 4, seg = unit & 15, b = bh >> 2, hc = bh & 3; const size_t row0 = (size_t)b * SEQ + (size_t)seg * 512;
    const bf16* PROJ = (const bf16*)(p.ws + WS_PROJ); bf16* MIXED = (bf16*)(p.ws + WS_MIXED);
    float* SEGS = (float*)(p.ws + WS_SEGS); float* SEGP = (float*)(p.ws + WS_SEGP);
    const int r32 = lane & 31, hi = lane >> 5, kt_lane_off = ((lane >> 4) & 1) * 32 + (lane & 3) * 8 + (4 * hi + ((lane & 15) >> 2)) * 64;
    const float lb = hgrn_lb(p, l, hc * 64 + lane), omlb = 1.0f - lb;
    const float ong = PASS2 ? PIN(p, I_ONG)[l * 64 + lane] : 0.f;
    f32x16 S0 = {}, S1 = {};
    if (PASS2 && wave < 2) {
        for (int s = 0; s < seg; ++s) { const int u2 = bh * 16 + s; const float* sp = SEGS + ((size_t)(u2 * 2 + wave) * 2) * 16 * 64 + lane; const float* pp = SEGP + u2 * 64 + 4 * hi;
#pragma unroll
            for (int gq = 0; gq < 4; ++gq) { const f32x4 d0 = *(const f32x4*)(pp + 8 * gq), d1 = *(const f32x4*)(pp + 32 + 8 * gq);
#pragma unroll
                for (int e = 0; e < 4; ++e) { const int r = 4 * gq + e; S0[r] = d0[e] * S0[r] + sp[(size_t)r * 64]; S1[r] = d1[e] * S1[r] + sp[(size_t)(16 + r) * 64]; } } }
    }
    float sumtot = 0.f;
    const int tid = wave * 64 + lane, ptok = (tid & 255) >> 3, pch = tid & 7, parr = tid >> 8;
    const bf16* gsrc = PROJ + (row0 + ptok) * INW + hc * 64 + pch * 8;
    const int rboff = ptok * 128 + pch * 16;
    v4u pf0, pf1 = (v4u){0u, 0u, 0u, 0u};
    pf0 = *(const v4u*)(gsrc + (parr ? C_CI : C_CF)); if (PASS2) pf1 = *(const v4u*)(gsrc + (parr ? C_CG : C_CQ));
    *(LAS v4u*)(lds + mc::RB + parr * 4096 + rboff) = pf0; if (PASS2) *(LAS v4u*)(lds + mc::RB + (2 + parr) * 4096 + rboff) = pf1;
    MC_BAR();
#pragma unroll 1
    for (int n = 0; n < 16; ++n) {
        float f[4], c[4], qv[4], vv[4], gv[4];
        if (n + 1 < 16) { const bf16* gn = gsrc + (size_t)(32 * (n + 1)) * INW;
            pf0 = *(const v4u*)(gn + (parr ? C_CI : C_CF)); if (PASS2) pf1 = *(const v4u*)(gn + (parr ? C_CG : C_CQ)); }
#pragma unroll
        for (int i = 0; i < 4; ++i) { const LAS bf16* rp = (const LAS bf16*)(lds + mc::RB) + (4 * wave + i) * 64 + lane;
            const float z = fmaxf(bf2f(rp[0]), -30.f); f[i] = lb + omlb * __builtin_amdgcn_rcpf(1.0f + __expf(-z)); vv[i] = bf2f(rp[2048]); if (PASS2) { qv[i] = bf2f(rp[4096]); gv[i] = bf2f(rp[6144]); } }
        c[0] = __logf(f[0]); c[1] = c[0] + __logf(f[1]); c[2] = c[1] + __logf(f[2]); c[3] = c[2] + __logf(f[3]);
        ((LAS float*)(lds + mc::WTO))[wave * 64 + lane] = c[3];
        MC_BAR();
        float off = 0.f, tot = 0.f, mid = 0.f;
#pragma unroll
        for (int w = 0; w < 8; ++w) { const float tw = ((LAS float*)(lds + mc::WTO))[w * 64 + lane]; if (w < wave) off += tw; if (w < 4) mid += tw; tot += tw; }
        sumtot += tot;
#pragma unroll
        for (int i = 0; i < 4; ++i) { const int t = 4 * wave + i; const float Bt = off + c[i], kk = 1.0f - f[i];
            const int chb = (lane >> 3) * 512 + t * 16 + (lane & 7) * 2, vlb = (lane >> 5) * 2048 + (t >> 4) * 1024 + (t & 15) * 64 + (lane & 31) * 2;
            *(LAS bf16*)(lds + mc::KH + vlb) = (bf16)f2bf(kk * __expf(tot - Bt));
            *(LAS bf16*)(lds + mc::VV + vlb) = (bf16)f2bf(vv[i]);
            if (PASS2) { *(LAS bf16*)(lds + mc::QT + chb) = (bf16)f2bf(qv[i] * __expf(fminf(Bt - mid, 80.f)));
                *(LAS bf16*)(lds + mc::KT + chb) = (bf16)f2bf(kk * __expf(fminf(mid - Bt, 80.f)));
                *(LAS bf16*)(lds + mc::QH + chb) = (bf16)f2bf(qv[i] * __expf(Bt)); } }
        if (wave == 0) ((LAS float*)(lds + mc::DD))[lane] = __expf(tot);
        MC_BAR();
        if (wave < 2) {
            const int vt = wave;
            if (PASS2) {
                f32x16 o = {};
#pragma unroll
                for (int kt = 0; kt < 2; ++kt)
#pragma unroll
                    for (int s2 = 0; s2 < 2; ++s2) { const LAS unsigned char* qa = lds + mc::QH + (4 * kt + 2 * s2) * 512 + r32 * 16 + 8 * hi;
                        const v2u a0 = *(const LAS v2u*)qa, a1 = *(const LAS v2u*)(qa + 512); v4u aw; aw.x = a0.x; aw.y = a0.y; aw.z = a1.x; aw.w = a1.y;
                        v4u bw;
                        if (kt == 0) { bw.x = cvtpk(S0[8 * s2 + 0], S0[8 * s2 + 1]); bw.y = cvtpk(S0[8 * s2 + 2], S0[8 * s2 + 3]); bw.z = cvtpk(S0[8 * s2 + 4], S0[8 * s2 + 5]); bw.w = cvtpk(S0[8 * s2 + 6], S0[8 * s2 + 7]); }
                        else { bw.x = cvtpk(S1[8 * s2 + 0], S1[8 * s2 + 1]); bw.y = cvtpk(S1[8 * s2 + 2], S1[8 * s2 + 3]); bw.z = cvtpk(S1[8 * s2 + 4], S1[8 * s2 + 5]); bw.w = cvtpk(S1[8 * s2 + 6], S1[8 * s2 + 7]); }
                        o = __builtin_amdgcn_mfma_f32_32x32x16_bf16(__builtin_bit_cast(bf16x8, aw), __builtin_bit_cast(bf16x8, bw), o, 0, 0, 0); }
#pragma unroll
                for (int r = 0; r < 16; ++r) ((LAS float*)(lds + mc::OE))[crow(r, hi) * 64 + 32 * vt + r32] = o[r];
            }
            { const LAS float* dp = (const LAS float*)(lds + mc::DD) + 4 * hi;
#pragma unroll
                for (int gq = 0; gq < 4; ++gq) { const f32x4 d0 = *(const LAS f32x4*)(dp + 8 * gq), d1 = *(const LAS f32x4*)(dp + 32 + 8 * gq);
#pragma unroll
                    for (int e = 0; e < 4; ++e) { S0[4 * gq + e] *= d0[e]; S1[4 * gq + e] *= d1[e]; } } }
#pragma unroll
            for (int ks = 0; ks < 2; ++ks) {
                const LAS unsigned char* vb = lds + mc::VV + vt * 2048 + ks * 1024 + kt_lane_off; const s16x4 vl = vtr(vb), vh = vtr(vb + 512);
                const bf16x8 bv = (bf16x8){vl[0], vl[1], vl[2], vl[3], vh[0], vh[1], vh[2], vh[3]};
                const LAS unsigned char* k0 = lds + mc::KH + ks * 1024 + kt_lane_off; const s16x4 al = vtr(k0), ah = vtr(k0 + 512), bl = vtr(k0 + 2048), bh_ = vtr(k0 + 2048 + 512);
                const bf16x8 a0 = (bf16x8){al[0], al[1], al[2], al[3], ah[0], ah[1], ah[2], ah[3]}, a1 = (bf16x8){bl[0], bl[1], bl[2], bl[3], bh_[0], bh_[1], bh_[2], bh_[3]};
                S0 = __builtin_amdgcn_mfma_f32_32x32x16_bf16(a0, bv, S0, 0, 0, 0); S1 = __builtin_amdgcn_mfma_f32_32x32x16_bf16(a1, bv, S1, 0, 0, 0); }
        } else if (PASS2 && wave < 4) {
            const int vt = wave - 2;
            f32x16 at = {};
#pragma unroll
            for (int ks = 0; ks < 4; ++ks) { const bf16x8 a = *(const LAS bf16x8*)(lds + mc::KT + (2 * ks + hi) * 512 + r32 * 16), bq = *(const LAS bf16x8*)(lds + mc::QT + (2 * ks + hi) * 512 + r32 * 16);
                at = __builtin_amdgcn_mfma_f32_32x32x16_bf16(a, bq, at, 0, 0, 0); }
            f32x16 o = {};
#pragma unroll
            for (int ks = 0; ks < 2; ++ks) { float m8[8];
#pragma unroll
                for (int j = 0; j < 8; ++j) { const int r = 8 * ks + j; m8[j] = (crow(r, hi) <= r32) ? at[r] : 0.f; }
                v4u pw; pw.x = cvtpk(m8[0], m8[1]); pw.y = cvtpk(m8[2], m8[3]); pw.z = cvtpk(m8[4], m8[5]); pw.w = cvtpk(m8[6], m8[7]);
                const LAS unsigned char* vb = lds + mc::VV + vt * 2048 + ks * 1024 + kt_lane_off; const s16x4 vl = vtr(vb), vh = vtr(vb + 512);
                const bf16x8 bv = (bf16x8){vl[0], vl[1], vl[2], vl[3], vh[0], vh[1], vh[2], vh[3]};
                o = __builtin_amdgcn_mfma_f32_32x32x16_bf16(__builtin_bit_cast(bf16x8, pw), bv, o, 0, 0, 0); }
#pragma unroll
            for (int r = 0; r < 16; ++r) ((LAS float*)(lds + mc::OI))[crow(r, hi) * 64 + 32 * vt + r32] = o[r];
        }
        if (n + 1 < 16) { *(LAS v4u*)(lds + mc::RB + parr * 4096 + rboff) = pf0; if (PASS2) *(LAS v4u*)(lds + mc::RB + (2 + parr) * 4096 + rboff) = pf1; }
        MC_BAR();
        if (PASS2) {
#pragma unroll
            for (int i = 0; i < 4; ++i) { const int t = 4 * wave + i; const float o = ((LAS float*)(lds + mc::OE))[t * 64 + lane] + ((LAS float*)(lds + mc::OI))[t * 64 + lane];
                const float ss = wave_sum(o * o);
                MIXED[(row0 + 32 * n + t) * DM + MX_C + hc * 64 + lane] = (bf16)f2bf(o * rsqrtf(ss * (1.0f / 64.0f) + EPS) * ong * gv[i] * DBG_C); }
        }
    }
    if (!PASS2) {
        if (wave < 2) { float* sp = SEGS + ((size_t)(unit * 2 + wave) * 2) * 16 * 64 + lane;
#pragma unroll
            for (int r = 0; r < 16; ++r) { sp[(size_t)r * 64] = S0[r]; sp[(size_t)(16 + r) * 64] = S1[r]; } }
        if (wave == 0) SEGP[unit * 64 + lane] = __expf(sumtot);
    }
    __syncthreads();
}
__device__ __forceinline__ void ffn_fixup(const Ctx& p, int l, int tid) {
    const float* HG = (const float*)(p.ws + WS_HG); const float* HU = (const float*)(p.ws + WS_HU); bf16* ACT = (bf16*)(p.ws + WS_ACT);
    const float* cw = PIN(p, I_CONVW) + (size_t)l * 3 * DFF; const float* cb = PIN(p, I_CONVB) + (size_t)l * DFF;
    const int total = 512 * 2 * (DFF / 4);
    for (int idx = blockIdx.x * (NWAVES * 64) + tid; idx < total; idx += gridDim.x * (NWAVES * 64)) {
        const int c4 = idx % (DFF / 4), rr = idx / (DFF / 4), rho = rr & 1, blk = rr >> 1, ch = 4 * c4;
        const bool first = (blk % 128) == 0;
        const f32x4 z = (f32x4){0.f, 0.f, 0.f, 0.f};
        const f32x4 g0 = *(const f32x4*)(HG + ((size_t)blk * 4 + rho) * DFF + ch);
        f32x4 g1, g2;
        if (rho == 1) { g1 = *(const f32x4*)(HG + ((size_t)blk * 4 + 0) * DFF + ch); g2 = first ? z : *(const f32x4*)(HG + ((size_t)(blk - 1) * 4 + 3) * DFF + ch); }
        else { g1 = first ? z : *(const f32x4*)(HG + ((size_t)(blk - 1) * 4 + 3) * DFF + ch); g2 = first ? z : *(const f32x4*)(HG + ((size_t)(blk - 1) * 4 + 2) * DFF + ch); }
        const f32x4 up = *(const f32x4*)(HU + ((size_t)blk * 2 + rho) * DFF + ch);
        const f32x4 w0 = *(const f32x4*)(cw + ch), w1 = *(const f32x4*)(cw + DFF + ch), w2 = *(const f32x4*)(cw + 2 * DFF + ch), bb = *(const f32x4*)(cb + ch);
        f32x4 c = bb + w0 * g2 + w1 * g1 + w2 * g0;
#pragma unroll
        for (int j = 0; j < 4; ++j) c[j] = silu_f(c[j]) * up[j];
        v2u w; w.x = pk2(c[0], c[1]); w.y = pk2(c[2], c[3]);
        *(v2u*)(ACT + ((size_t)blk * 64 + rho) * DFF + ch) = w;
    }
}

constexpr int PH_PER_LAYER = 7, N_PHASES = 1 + DEPTH * PH_PER_LAYER;
__global__ void __launch_bounds__(NWAVES * 64, 2) fwd_kernel(Params args) {
    extern __shared__ __attribute__((aligned(16))) unsigned char lds_raw[];
    LAS unsigned char* lds = (LAS unsigned char*)lds_raw;
    volatile LAS unsigned* MISC = (volatile LAS unsigned*)(lds + MISC_OFF);
    volatile LAS unsigned long long* TAB = (volatile LAS unsigned long long*)(lds + TAB_OFF);
    LAS unsigned char* BKT = lds + TAB_OFF + 256;
    if (threadIdx.x < 64) MISC[threadIdx.x] = 0u;
    if (threadIdx.x == 0) {
#pragma unroll
        for (int i = 0; i < 19; ++i) TAB[i] = (unsigned long long)args.in[i];
        TAB[19] = (unsigned long long)args.out;
    }
    if (threadIdx.x >= 64 && threadIdx.x < 192) BKT[threadIdx.x - 64] = args.bucket[threadIdx.x - 64];
    __syncthreads();
    unsigned* barw = (unsigned*)(args.ws + WS_CTL) + CW_BAR + args.bar_region * XCD_BAR_WORDS;
    const int lo = args.ph_lo, hi = args.ph_hi;
    XcdBarrier bar; bar.bar = barw; bar.x = 0; bar.st = nullptr;
    if (hi - lo > 1) bar = xcd_barrier_post(barw, MISC + 8);
    const int G = gridDim.x;
#pragma nounroll
    for (int ph = lo; ph < hi; ++ph) {
        const int l = (ph - 1) / PH_PER_LAYER, k = (ph == 0) ? -1 : (ph - 1) % PH_PER_LAYER;
#ifdef DBG_DOUBLE
        const int nrep = ((ph == 0 ? 7 : k) == DBG_DOUBLE) ? 2 : 1;
#else
        const int nrep = 1;
#endif
#pragma nounroll
        for (int rep = 0; rep < nrep; ++rep) {
        int tid = threadIdx.x; asm volatile("" : "+v"(tid));
        Ctx p; p.tab = TAB; p.bucket = nullptr; { GAS unsigned char* wsg = (GAS unsigned char*)args.ws; asm volatile("" : "+s"(wsg)); p.ws = (unsigned char*)wsg; }
        const int lane = tid & 63, wave = __builtin_amdgcn_readfirstlane(tid >> 6);
        const unsigned char* wl = p.ws + WS_W + (size_t)l * W_LAYER;
        if (ph == 0) {
#ifndef NO_P0
            prologue(p, lds, wave, lane, rep == 0);
#endif
        } else if (k == 0) {
#ifndef NO_P1
            pg8::Gemm g{(const bf16*)(p.ws + WS_XB), (const bf16*)(wl + W_IN), M, INW, DM}; pg8::StaticOrder S; S.init(M, INW, G, (int)blockIdx.x);
            if (blockIdx.x >= 128 && rep == 0) { for (int z = 0; z < SKEW_P1; ++z) __builtin_amdgcn_s_sleep(127); }
            EpiInProj E{(bf16*)(p.ws + WS_PROJ), (const unsigned long long*)(p.ws + WS_SS) + (size_t)(2 * l) * M, DBG_EPI_MODE(rep)};
            pg8::gemm_phase<EpiInProj, pg8::StaticOrder, true, true>(lds, g, S, E);
#endif
        } else if (k == 1) {
#ifndef NO_P2A
#ifdef DBG_MIXCMP
            if (args.flags & 1) { for (int u = blockIdx.x; u < 256; u += G) mixer_c_pass1_simple(p, l, u, lds, wave, lane); } else
#endif
            for (int rr = 0; rr < DBG_REP_C1; ++rr)
            for (int u = blockIdx.x; u < 256; u += G) mixer_c_mfma<false>(p, l, u, lds, wave, lane);
#ifdef DBG_MIXCMP
            if (args.flags & 1) { for (int u = blockIdx.x; u < 1024; u += G) mixer_a_simple(p, l, u, lds, wave, lane); } else
#endif
            for (int u = blockIdx.x; u < 1024; u += G) mixer_a_mfma(p, l, u, lds, wave, lane);
#endif
        } else if (k == 2) {
#ifndef NO_P2B
#ifdef DBG_MIXCMP
            if (args.flags & 1) { for (int u = blockIdx.x; u < 256; u += G) mixer_c_pass2_simple(p, l, u, lds, wave, lane); } else
#endif
            for (int rr = 0; rr < DBG_REP_C2; ++rr)
            for (int u = blockIdx.x; u < 256; u += G) mixer_c_mfma<true>(p, l, u, lds, wave, lane);
#ifdef DBG_MIXCMP
            if (args.flags & 1) { for (int u = blockIdx.x; u < 512; u += G) mixer_b_simple(p, l, u, lds, wave, lane); } else
#endif
            for (int rr = 0; rr < DBG_REP_B; ++rr)
            for (int u = blockIdx.x; u < 512; u += G) mixer_b_mfma(p, l, u, lds, wave, lane);
#endif
        } else if (k == 3) {
#ifndef NO_P3
            pg8::Gemm g{(const bf16*)(p.ws + WS_MIXED), (const bf16*)(wl + W_OUT), M, DM, DM}; pg8::StaticOrder S; S.init(M, DM, G, (int)blockIdx.x);
            EpiResid E{(bf16*)(p.ws + WS_XB), nullptr, (unsigned long long*)(p.ws + WS_SS) + (size_t)(2 * l + 1) * M, rep == 0 ? 1 : 0};
            pg8::gemm_phase<EpiResid, pg8::StaticOrder, true, true>(lds, g, S, E);
#endif
        } else if (k == 4) {
#ifndef NO_P4
            pg8::Gemm g{(const bf16*)(p.ws + WS_XB), (const bf16*)(wl + W_GU), M, NGU, DM}; pg8::StaticOrder S; S.init(M, NGU, G, (int)blockIdx.x);
            if (((blockIdx.x >> 3) & 1) && rep == 0) { for (int z = 0; z < SKEW_P4; ++z) __builtin_amdgcn_s_sleep(127); }
            EpiFFN E{(bf16*)(p.ws + WS_ACT), (const unsigned long long*)(p.ws + WS_SS) + (size_t)(2 * l + 1) * M, PIN(p, I_CONVW) + (size_t)l * 3 * DFF, PIN(p, I_CONVB) + (size_t)l * DFF, (float*)(p.ws + WS_HG), (float*)(p.ws + WS_HU), DBG_EPI_MODE(rep)};
            pg8::gemm_phase<EpiFFN, pg8::StaticOrder, true, true>(lds, g, S, E);
#endif
        } else if (k == 5) {
            ffn_fixup(p, l, tid);
        } else {
#ifndef NO_P5
            pg8::Gemm g{(const bf16*)(p.ws + WS_ACT), (const bf16*)(wl + W_DN), M, DM, DFF}; pg8::StaticOrder S; S.init(M, DM, G, (int)blockIdx.x);
            EpiResid E{(bf16*)(p.ws + WS_XB), POUT(p), (unsigned long long*)(p.ws + WS_SS) + (size_t)(2 * l + 2) * M, rep != 0 ? 0 : ((l + 1 < DEPTH) ? 1 : 2)};
            pg8::gemm_phase<EpiResid, pg8::StaticOrder, true, true>(lds, g, S, E);
#endif
        }
        }
        if (ph + 1 < hi) xcd_barrier(bar);
    }
}


#if defined(DBG_NAIVE_DOWN)
__global__ void __launch_bounds__(256) dbg_down(const bf16* ACT, const float* Wd, const float* X1, float* out) {
    __shared__ float a[4][DFF];
    const int r0 = blockIdx.x * 4, c = threadIdx.x * 4;
    for (int i = threadIdx.x; i < 4 * DFF; i += 256) a[i / DFF][i % DFF] = bf2f(ACT[(size_t)(r0 + i / DFF) * DFF + i % DFF]);
    __syncthreads();
    f32x4 acc[4]; for (int r = 0; r < 4; ++r) acc[r] = (f32x4){0.f, 0.f, 0.f, 0.f};
    for (int k = 0; k < DFF; ++k) { const f32x4 w = *(const f32x4*)(Wd + (size_t)k * DM + c);
        for (int r = 0; r < 4; ++r) acc[r] += w * a[r][k]; }
    for (int r = 0; r < 4; ++r) { const size_t off = (size_t)(r0 + r) * DM + c; *(f32x4*)(out + off) = *(const f32x4*)(X1 + off) + acc[r]; }
}
#endif

#if defined(DBG_FFNCMP)
constexpr int DBG_R = 512;
__global__ void __launch_bounds__(256) dbg_gu(const float* X1, const float* g2, const float* Wg, const float* Wu, float* GU) {
    __shared__ float h[DM];
    const int r = blockIdx.x, c = blockIdx.y * 256 + threadIdx.x;
    float ss = 0.f; for (int k = threadIdx.x; k < DM; k += 256) { const float v = X1[(size_t)r * DM + k]; ss += v * v; }
    __shared__ float red[256]; red[threadIdx.x] = ss; __syncthreads();
    for (int o = 128; o > 0; o >>= 1) { if (threadIdx.x < o) red[threadIdx.x] += red[threadIdx.x + o]; __syncthreads(); }
    const float rstd = rsqrtf(red[0] / DM + EPS);
    for (int k = threadIdx.x; k < DM; k += 256) h[k] = X1[(size_t)r * DM + k] * rstd * g2[k];
    __syncthreads();
    if (c < DFF) { float a = 0.f, b = 0.f; for (int k = 0; k < DM; ++k) { a += h[k] * Wg[(size_t)k * DFF + c]; b += h[k] * Wu[(size_t)k * DFF + c]; }
        GU[((size_t)r * 2 + 0) * DFF + c] = a; GU[((size_t)r * 2 + 1) * DFF + c] = b; }
}
__global__ void __launch_bounds__(256) dbg_cmp(const float* GU, const float* cw, const float* cb, const bf16* ACT, float* acc2) {
    const int r = blockIdx.x, c = blockIdx.y * 256 + threadIdx.x; float num = 0.f, den = 0.f;
    if (c < DFF) { const float g0 = GU[((size_t)r * 2) * DFF + c], g1 = r >= 1 ? GU[((size_t)(r - 1) * 2) * DFF + c] : 0.f, g2 = r >= 2 ? GU[((size_t)(r - 2) * 2) * DFF + c] : 0.f;
#if defined(DBG_TAPS) && DBG_TAPS == 0
        const float cv = cb[c] + cw[2 * DFF + c] * g0;
#elif defined(DBG_TAPS) && DBG_TAPS == 1
        const float cv = cb[c] + cw[DFF + c] * g1 + cw[2 * DFF + c] * g0;
#else
        const float cv = cb[c] + cw[c] * g2 + cw[DFF + c] * g1 + cw[2 * DFF + c] * g0;
#endif
        const float ref = cv / (1.0f + expf(-cv)) * GU[((size_t)r * 2 + 1) * DFF + c];
        const float mine = bf2f(ACT[(size_t)r * DFF + c]);
#if DBG_FFNCMP == 2
        if ((r & 63) < 2) { num = (mine - ref) * (mine - ref); den = ref * ref; }
#elif DBG_FFNCMP == 3
        if ((r & 63) >= 2) { num = (mine - ref) * (mine - ref); den = ref * ref; }
#else
        num = (mine - ref) * (mine - ref); den = ref * ref;
#endif
    }
    __shared__ float rn[256], rd[256]; rn[threadIdx.x] = num; rd[threadIdx.x] = den; __syncthreads();
    for (int o = 128; o > 0; o >>= 1) { if (threadIdx.x < o) { rn[threadIdx.x] += rn[threadIdx.x + o]; rd[threadIdx.x] += rd[threadIdx.x + o]; } __syncthreads(); }
    if (threadIdx.x == 0) { atomicAdd(acc2, rn[0]); atomicAdd(acc2 + 1, rd[0]); }
}
__global__ void dbg_emit(const float* acc2, float* out) { out[0] = 1000.0f * sqrtf(acc2[0] / acc2[1]); }
#endif

#if defined(DBG_MIXCMP)
__global__ void __launch_bounds__(256) dbg_mixcmp(const bf16* A, const bf16* R, int c0, int c1, float* acc2) {
    float num = 0.f, den = 0.f;
    for (size_t r = blockIdx.x; r < (size_t)M; r += gridDim.x)
        for (int c = c0 + threadIdx.x; c < c1; c += 256) { const float a = bf2f(A[r * DM + c]), b = bf2f(R[r * DM + c]); num += (a - b) * (a - b); den += b * b; }
    __shared__ float rn[256], rd[256]; rn[threadIdx.x] = num; rd[threadIdx.x] = den; __syncthreads();
    for (int o = 128; o > 0; o >>= 1) { if (threadIdx.x < o) { rn[threadIdx.x] += rn[threadIdx.x + o]; rd[threadIdx.x] += rd[threadIdx.x + o]; } __syncthreads(); }
    if (threadIdx.x == 0) { atomicAdd(acc2, rn[0]); atomicAdd(acc2 + 1, rd[0]); }
}
__global__ void dbg_emit2(const float* acc2, float* out) { out[0] = 1000.0f * sqrtf(acc2[0] / acc2[1]); }
#endif
#ifndef MK_PER_PHASE
#define MK_PER_PHASE 0
#endif
extern "C" void kernel_launch(void* const* d_in, const int* in_sizes, int n_in, void* d_out, int out_size, void* d_ws, size_t ws_size, hipStream_t stream) {
    static int grid = 0;
    if (grid == 0) {
        if (n_in != 19 || in_sizes[0] != M * DM || out_size != M * DM || ws_size < WS_END) { fprintf(stderr, "kernel_launch: unexpected shapes (n_in %d, in0 %d, out %d, ws %zu)\n", n_in, n_in > 0 ? in_sizes[0] : -1, out_size, ws_size); grid = -1; return; }
        int dev = 0, cus = 0;
        if (hipGetDevice(&dev) != hipSuccess || hipDeviceGetAttribute(&cus, hipDeviceAttributeMultiprocessorCount, dev) != hipSuccess) { grid = -1; return; }
        if (hipFuncSetAttribute((const void*)fwd_kernel, hipFuncAttributeMaxDynamicSharedMemorySize, LDS_BYTES) != hipSuccess) { fprintf(stderr, "kernel_launch: hipFuncSetAttribute failed\n"); grid = -1; return; }
        int per_cu = 0;
        if (hipOccupancyMaxActiveBlocksPerMultiprocessor(&per_cu, (const void*)fwd_kernel, NWAVES * 64, LDS_BYTES) != hipSuccess || per_cu < 1) { fprintf(stderr, "kernel_launch: occupancy query reports %d blocks per CU\n", per_cu); }
        (void)hipGetLastError();
        grid = cus < 256 ? cus : 256;
    }
    if (grid < 0) return;
    (void)hipMemsetAsync((char*)d_ws + WS_CTL, 0, CTL_ZERO_BYTES, stream);
    Params a{};
    for (int i = 0; i < 19; ++i) a.in[i] = (const float*)d_in[i];
    a.out = (float*)d_out; a.ws = (unsigned char*)d_ws;
    for (int n = 0; n < 128; ++n) {
        int bkt;
        if (n < 16) bkt = n; else { const float v = logf((float)n / 16.0f) / (float)log(128.0 / 16.0) * 16.0f; bkt = 16 + (int)v; if (bkt > 31) bkt = 31; }
        a.bucket[n] = (unsigned char)bkt;
    }
#if MK_PER_PHASE
    for (int ph = 0; ph < N_PHASES; ++ph) { a.ph_lo = ph; a.ph_hi = ph + 1; hipLaunchKernelGGL(fwd_kernel, dim3(grid), dim3(NWAVES * 64), LDS_BYTES, stream, a); }
#elif defined(DBG_MIXCMP)
    { float* acc2 = (float*)((char*)d_ws + WS_TAB + 65536); (void)hipMemsetAsync(acc2, 0, 8, stream);
      a.ph_lo = 0; a.ph_hi = 4; a.flags = 1; a.bar_region = 0;
      hipLaunchKernelGGL(fwd_kernel, dim3(grid), dim3(NWAVES * 64), LDS_BYTES, stream, a);
      (void)hipMemcpyAsync((char*)d_ws + WS_X1, (char*)d_ws + WS_MIXED, (size_t)M * DM * 2, hipMemcpyDeviceToDevice, stream);
      (void)hipMemsetAsync((char*)d_ws + WS_MIXED, 0, (size_t)M * DM * 2, stream);
      a.ph_lo = 2; a.ph_hi = 4; a.flags = 0; a.bar_region = 1;
      hipLaunchKernelGGL(fwd_kernel, dim3(grid), dim3(NWAVES * 64), LDS_BYTES, stream, a);
      const int c0 = (DBG_MIXCMP == 1) ? 0 : (DBG_MIXCMP == 2) ? 256 : 768, c1 = (DBG_MIXCMP == 1) ? 256 : (DBG_MIXCMP == 2) ? 768 : 1024;
      hipLaunchKernelGGL(dbg_mixcmp, dim3(1024), dim3(256), 0, stream, (const bf16*)((char*)d_ws + WS_MIXED), (const bf16*)((char*)d_ws + WS_X1), c0, c1, acc2);
      (void)hipMemcpyAsync(d_out, d_in[0], (size_t)M * DM * 4, hipMemcpyDeviceToDevice, stream);
      hipLaunchKernelGGL(dbg_emit2, dim3(1), dim3(1), 0, stream, (const float*)acc2, (float*)d_out); }
#elif defined(DBG_NAIVE_DOWN)
    a.ph_lo = 0; a.ph_hi = 7;
    hipLaunchKernelGGL(fwd_kernel, dim3(grid), dim3(NWAVES * 64), LDS_BYTES, stream, a);
    hipLaunchKernelGGL(dbg_down, dim3(M / 4), dim3(256), 0, stream, (const bf16*)((char*)d_ws + WS_ACT), (const float*)d_in[I_WDOWN], (const float*)((char*)d_ws + WS_X1), (float*)d_out);
#elif defined(DBG_FFNCMP)
    a.ph_lo = 0; a.ph_hi = 7;
    hipLaunchKernelGGL(fwd_kernel, dim3(grid), dim3(NWAVES * 64), LDS_BYTES, stream, a);
    { float* GU = (float*)d_out + (size_t)16 * 1024 * 1024; float* acc2 = (float*)((char*)d_ws + WS_TAB + 65536);
      (void)hipMemsetAsync(acc2, 0, 8, stream);
      hipLaunchKernelGGL(dbg_gu, dim3(DBG_R, 11), dim3(256), 0, stream, (const float*)((char*)d_ws + WS_X1), (const float*)d_in[I_N2G], (const float*)d_in[I_WGATE], (const float*)d_in[I_WUP], GU);
      hipLaunchKernelGGL(dbg_cmp, dim3(DBG_R, 11), dim3(256), 0, stream, (const float*)GU, (const float*)d_in[I_CONVW], (const float*)d_in[I_CONVB], (const bf16*)((char*)d_ws + WS_ACT), acc2);
      (void)hipMemcpyAsync(d_out, d_in[0], (size_t)M * DM * 4, hipMemcpyDeviceToDevice, stream);
      hipLaunchKernelGGL(dbg_emit, dim3(1), dim3(1), 0, stream, (const float*)acc2, (float*)d_out); }
#elif defined(DBG_STOP)
    a.ph_lo = 0; a.ph_hi = DBG_STOP + 1;
    hipLaunchKernelGGL(fwd_kernel, dim3(grid), dim3(NWAVES * 64), LDS_BYTES, stream, a);
    { const int k = (DBG_STOP == 0) ? -1 : (DBG_STOP - 1) % PH_PER_LAYER;
      const float* src = (DBG_STOP == 0) ? (const float*)d_in[0] : ((k >= 3 && k <= 5) ? (const float*)((char*)d_ws + WS_X1) : nullptr);
      if (src) (void)hipMemcpyAsync(d_out, src, (size_t)M * DM * 4, hipMemcpyDeviceToDevice, stream); }
#else
    a.ph_lo = 0; a.ph_hi = N_PHASES;
    hipLaunchKernelGGL(fwd_kernel, dim3(grid), dim3(NWAVES * 64), LDS_BYTES, stream, a);
#endif
    const hipError_t le = hipPeekAtLastError();
    if (le != hipSuccess) fprintf(stderr, "kernel_launch: launch failed: %s\n", hipGetErrorName(le));
}
```

```cpp
#include <hip/hip_runtime.h>
#include <cstdio>
#include <cstdint>
#include <cmath>
namespace pg8 {
#define PG8_LAS __attribute__((address_space(3)))
typedef unsigned short bf16_t;
typedef short bf16x8 __attribute__((ext_vector_type(8)));
typedef float f32x4 __attribute__((ext_vector_type(4)));
typedef unsigned u32x4 __attribute__((ext_vector_type(4)));
constexpr int BM = 256, BK = 64, HALF = 128, HTB = HALF * BK * 2  , STAGE_BYTES = 8 * HTB, NXCD = 8, WGM = 8;

__host__ __device__ __forceinline__ int lds_byte(int r, int c) { const int st = (r >> 4) * 2 + (c >> 5), rr = r & 15, cc = c & 31, ob = rr * 64 + cc * 2; return st * 1024 + (ob ^ (((ob >> 9) & 1) << 5)); }
__host__ __device__ __forceinline__ void stage_rc(int b, int& R, int& C) { const int st = b / 1024, sb = b % 1024, swz = sb ^ (((sb >> 9) & 1) << 5); R = (st >> 1) * 16 + swz / 64; C = (st & 1) * 32 + (swz % 64) / 2; }
__host__ __device__ __forceinline__ int perm32(int rho) { const int n = rho >> 4, i = rho & 15; return 8 * (i >> 2) + 4 * n + (i & 3); }

struct Unit { int pm, pn; };
struct Gemm { const bf16_t* A; const bf16_t* Bt; int M, N, K; };

struct StaticOrder {
    int nM, nN, nwg, G, c;
    __host__ __device__ void init(int M, int N, int G_, int c_) { nM = M / BM; nN = N / BM; nwg = nM * nN; G = G_; c = c_; }
    __host__ __device__ bool next(int i, Unit& u) const {
        const long L = (long)i * G + c; if (L >= nwg) return false;
        int wgid = (int)L; { const int q = nwg / NXCD, r = nwg % NXCD, xcd = wgid % NXCD, off = wgid / NXCD; wgid = (xcd < r ? xcd * (q + 1) : r * (q + 1) + (xcd - r) * q) + off; }
        const int nig = WGM * nN, gid = wgid / nig, fm = gid * WGM, gsz = (nM - fm) < WGM ? (nM - fm) : WGM;
        u.pm = fm + ((wgid % nig) % gsz); u.pn = (wgid % nig) / gsz; return true;
    }
    __device__ __forceinline__ void a_ready(const Unit&) const {}
    __device__ __forceinline__ void done(const Unit&) const {}
};

__device__ __forceinline__ unsigned cvt_pk_bf16(float lo, float hi) { unsigned r; asm volatile("v_cvt_pk_bf16_f32 %0, %1, %2" : "=v"(r) : "v"(lo), "v"(hi)); return r; }
typedef float f32x2 __attribute__((ext_vector_type(2)));
__device__ __forceinline__ f32x2 gelu_pk(f32x2 v) {
    const f32x2 av = __builtin_elementwise_abs(v), d = av * 0.2316418882f + 1.0f;
    f32x2 t; t.x = __builtin_amdgcn_rcpf(d.x); t.y = __builtin_amdgcn_rcpf(d.y);
    f32x2 q = t * 0.5307027145f + (-0.7265760135f); q = q * t + 0.7107068705f; q = q * t + (-0.142248368f); q = q * t + 0.127414796f; q = q * t;
    const f32x2 s = (v * v) * (-0.72134752044f);
    f32x2 e; e.x = __builtin_amdgcn_exp2f(s.x); e.y = __builtin_amdgcn_exp2f(s.y);
    const f32x2 m = v * (q * e), r = v - m;
    f32x2 o; o.x = v.x < 0.f ? m.x : r.x; o.y = v.y < 0.f ? m.y : r.y; return o;
}

template <class Epi, class Sched, bool ALIGN_EPI = false, bool SP2 = false>
__device__ __forceinline__ void gemm_phase(PG8_LAS unsigned char* lds, const Gemm g, const Sched& S, const Epi& E) {
    int tid_l = threadIdx.x; asm volatile("" : "+v"(tid_l));
    const int tid = tid_l, wid = __builtin_amdgcn_readfirstlane(tid >> 6), lane = tid & 63, wr = wid >> 2, wc = wid & 3, fr = lane & 15, fq = lane >> 4;
    const int K = g.K, nt = K / BK;
    unsigned voffA[2], voffB[2];
#pragma unroll
    for (int i = 0; i < 2; ++i) { int R, C; stage_rc(tid * 16 + i * 8192, R, C); const int Rb = Epi::PERM ? ((R & ~31) + perm32(R & 31)) : R;
        const int Ra = Epi::APERM ? ((R & ~63) | (4 * (R & 15) + ((R >> 4) & 3))) : R;
        voffA[i] = (unsigned)(Ra * K + C) * 2u; voffB[i] = (unsigned)(Rb * K + C) * 2u; }
    const size_t kstep = (size_t)(BK * 2);
    const size_t hstep = (size_t)HALF * K * 2;
    const size_t tstep = 2 * hstep;
    const unsigned ldsw = (unsigned)wid * 1024u;
    const int aoff = lds_byte(wr * 64 + fr, fq * 8), boff = lds_byte(wc * 32 + fr, fq * 8);
#define PG8_SA(b, h) (((b) * 2 + (h)) * HTB)
#define PG8_SB(b, h) ((4 + (b) * 2 + (h)) * HTB)
#define PG8_STAGE(bufoff, gbase, voff) do { _Pragma("unroll") for (int _i = 0; _i < 2; ++_i) \
        __builtin_amdgcn_global_load_lds((const unsigned*)((const char*)(gbase) + (voff)[_i]), (PG8_LAS unsigned*)(lds + (bufoff) + ldsw + _i * 8192), 16, 0, 0); } while (0)
#define PG8_LDA(dst, b, h) do { _Pragma("unroll") for (int m = 0; m < 4; ++m) _Pragma("unroll") for (int k = 0; k < 2; ++k) dst[m][k] = *(const PG8_LAS bf16x8*)(lds + PG8_SA(b, h) + aoff + m * 2048 + k * 1024); } while (0)
#define PG8_LDB(dst, b, h) do { _Pragma("unroll") for (int n = 0; n < 2; ++n) _Pragma("unroll") for (int k = 0; k < 2; ++k) dst[n][k] = *(const PG8_LAS bf16x8*)(lds + PG8_SB(b, h) + boff + n * 2048 + k * 1024); } while (0)
#define PG8_MMA(ai, bj, At, Bt) do { __builtin_amdgcn_s_setprio(1); _Pragma("unroll") for (int m = 0; m < 4; ++m) _Pragma("unroll") for (int n = 0; n < 2; ++n) _Pragma("unroll") for (int k = 0; k < 2; ++k) \
        acc[ai][bj][m][n] = __builtin_amdgcn_mfma_f32_16x16x32_bf16(Bt[n][k], At[m][k], acc[ai][bj][m][n], 0, 0, 0); __builtin_amdgcn_s_setprio(0); } while (0)
#define PG8_WAIT_V(n) asm volatile("s_waitcnt vmcnt(" #n ")" ::: "memory")
#define PG8_WAIT_L(n) asm volatile("s_waitcnt lgkmcnt(" #n ")" ::: "memory")
#define PG8_BAR __builtin_amdgcn_s_barrier()
#define PG8_SCHED __builtin_amdgcn_sched_barrier(0)
    Unit cur, nxt; int ui = 0;
    if (!S.next(0, cur)) return;
    f32x4 acc[2][2][4][2];
#pragma unroll
    for (int a = 0; a < 2; ++a)
#pragma unroll
        for (int b = 0; b < 2; ++b)
#pragma unroll
            for (int m = 0; m < 4; ++m)
#pragma unroll
                for (int n = 0; n < 2; ++n) acc[a][b][m][n] = (f32x4){0.f, 0.f, 0.f, 0.f};
    bf16x8 At[4][2], B0[2][2], B1[2][2];
    const char* cA = (const char*)g.A + (size_t)cur.pm * tstep; const char* cB = (const char*)g.Bt + (size_t)cur.pn * tstep;
    S.a_ready(cur);
    if constexpr (SP2) {
        PG8_STAGE(PG8_SB(0, 0), cB, voffB); PG8_STAGE(PG8_SB(0, 1), cB + hstep, voffB); PG8_STAGE(PG8_SA(0, 0), cA, voffA); PG8_STAGE(PG8_SA(0, 1), cA + hstep, voffA);
        if (wr == 1) PG8_BAR;
        PG8_WAIT_V(2); PG8_BAR;
        PG8_STAGE(PG8_SB(1, 0), cB + kstep, voffB); PG8_STAGE(PG8_SA(1, 0), cA + kstep, voffA); PG8_STAGE(PG8_SB(1, 1), cB + hstep + kstep, voffB);
        PG8_WAIT_V(6); PG8_BAR;
    } else {
        PG8_STAGE(PG8_SB(0, 0), cB, voffB); PG8_STAGE(PG8_SA(0, 0), cA, voffA); PG8_STAGE(PG8_SB(0, 1), cB + hstep, voffB); PG8_STAGE(PG8_SA(0, 1), cA + hstep, voffA);
        if (wr == 1) PG8_BAR;
        PG8_WAIT_V(4); PG8_BAR;
        PG8_STAGE(PG8_SB(1, 0), cB + kstep, voffB); PG8_STAGE(PG8_SA(1, 0), cA + kstep, voffA); PG8_STAGE(PG8_SB(1, 1), cB + hstep + kstep, voffB);
        PG8_WAIT_V(6); PG8_BAR;
    }
    for (;;) {
        const bool has_next = S.next(ui + 1, nxt);
        const char* nA = has_next ? (const char*)g.A + (size_t)nxt.pm * tstep : cA; const char* nB = has_next ? (const char*)g.Bt + (size_t)nxt.pn * tstep : cB;
        for (int t = 0; t < nt; t += 2) {
            const bool last = (t == nt - 2);
            const char* a1 = cA + (size_t)(t + 1) * kstep;
            const char* a2 = last ? nA : cA + (size_t)(t + 2) * kstep; const char* b2 = last ? nB : cB + (size_t)(t + 2) * kstep;
            const char* a3 = a2 + kstep; const char* b3 = b2 + kstep;
            if (last && has_next) S.a_ready(nxt);
            if constexpr (SP2) {
            PG8_LDB(B0, 0, 0); PG8_LDB(B1, 0, 1); PG8_SCHED; PG8_LDA(At, 0, 0); PG8_STAGE(PG8_SA(1, 1), a1 + hstep, voffA);
            PG8_WAIT_V(8); PG8_WAIT_L(0); PG8_BAR; PG8_MMA(0, 0, At, B0); PG8_MMA(0, 1, At, B1); PG8_BAR; PG8_SCHED;
            PG8_LDA(At, 0, 1); PG8_STAGE(PG8_SB(0, 0), b2, voffB); PG8_STAGE(PG8_SB(0, 1), b2 + hstep, voffB); PG8_STAGE(PG8_SA(0, 0), a2, voffA);
            PG8_WAIT_V(8); PG8_WAIT_L(0); PG8_BAR; PG8_MMA(1, 0, At, B0); PG8_MMA(1, 1, At, B1); PG8_BAR; PG8_SCHED;
            PG8_LDB(B0, 1, 0); PG8_LDB(B1, 1, 1); PG8_SCHED; PG8_LDA(At, 1, 0); PG8_STAGE(PG8_SA(0, 1), a2 + hstep, voffA);
            PG8_WAIT_V(8); PG8_WAIT_L(0); PG8_BAR; PG8_MMA(0, 0, At, B0); PG8_MMA(0, 1, At, B1); PG8_BAR; PG8_SCHED;
            PG8_LDA(At, 1, 1); PG8_STAGE(PG8_SB(1, 0), b3, voffB); PG8_STAGE(PG8_SB(1, 1), b3 + hstep, voffB); PG8_STAGE(PG8_SA(1, 0), a3, voffA);
            PG8_WAIT_V(8); PG8_WAIT_L(0); PG8_BAR; PG8_MMA(1, 0, At, B0); PG8_MMA(1, 1, At, B1); PG8_BAR; PG8_SCHED;
            } else {
            PG8_LDB(B0, 0, 0); PG8_SCHED; PG8_LDA(At, 0, 0); PG8_STAGE(PG8_SA(1, 1), a1 + hstep, voffA);
            PG8_WAIT_L(8); PG8_BAR; PG8_WAIT_L(0); PG8_MMA(0, 0, At, B0); PG8_BAR; PG8_SCHED;
            PG8_LDB(B1, 0, 1); PG8_STAGE(PG8_SB(0, 0), b2, voffB);
            PG8_BAR; PG8_WAIT_L(0); PG8_MMA(0, 1, At, B1); PG8_BAR;
            PG8_LDA(At, 0, 1); PG8_STAGE(PG8_SA(0, 0), a2, voffA);
            PG8_BAR; PG8_WAIT_L(0); PG8_MMA(1, 0, At, B0); PG8_BAR; PG8_SCHED;
            PG8_STAGE(PG8_SB(0, 1), b2 + hstep, voffB);
            PG8_WAIT_V(6); PG8_BAR; PG8_MMA(1, 1, At, B1); PG8_BAR;
            PG8_LDB(B0, 1, 0); PG8_SCHED; PG8_LDA(At, 1, 0); PG8_STAGE(PG8_SA(0, 1), a2 + hstep, voffA);
            PG8_WAIT_L(8); PG8_BAR; PG8_WAIT_L(0); PG8_MMA(0, 0, At, B0); PG8_BAR; PG8_SCHED;
            PG8_LDB(B1, 1, 1); PG8_STAGE(PG8_SB(1, 0), b3, voffB);
            PG8_BAR; PG8_WAIT_L(0); PG8_MMA(0, 1, At, B1); PG8_BAR;
            PG8_LDA(At, 1, 1); PG8_STAGE(PG8_SA(1, 0), a3, voffA);
            PG8_BAR; PG8_WAIT_L(0); PG8_MMA(1, 0, At, B0); PG8_BAR; PG8_SCHED;
            PG8_STAGE(PG8_SB(1, 1), b3 + hstep, voffB);
            PG8_WAIT_V(6); PG8_BAR; PG8_MMA(1, 1, At, B1); PG8_BAR;
            }
        }
        if constexpr (ALIGN_EPI) { if (wr == 0) PG8_BAR; }
        if constexpr (!Epi::AFTER_DRAIN) { E(acc, cur, wr, wc, fr, fq); S.done(cur); }
        if (!has_next) break;
#pragma unroll
        for (int a = 0; a < 2; ++a)
#pragma unroll
            for (int b = 0; b < 2; ++b)
#pragma unroll
                for (int m = 0; m < 4; ++m)
#pragma unroll
                    for (int n = 0; n < 2; ++n) acc[a][b][m][n] = (f32x4){0.f, 0.f, 0.f, 0.f};
        cur = nxt; cA = nA; cB = nB; ++ui;
        if constexpr (ALIGN_EPI) { if (wr == 1) PG8_BAR; }
    }
    PG8_WAIT_V(0);
    if constexpr (!ALIGN_EPI) { if (wr == 0) PG8_BAR; }
    PG8_BAR;
    if constexpr (Epi::AFTER_DRAIN) { E.fused(acc, cur, wr, wc, fr, fq, lds, wid, lane); S.done(cur); }
#undef PG8_SA
#undef PG8_SB
#undef PG8_STAGE
#undef PG8_LDA
#undef PG8_LDB
#undef PG8_MMA
#undef PG8_WAIT_V
#undef PG8_WAIT_L
#undef PG8_BAR
#undef PG8_SCHED
}
}

constexpr int NWAVES = 8;
constexpr int BATCH = 4, SEQ = 8192, DM = 1024, DEPTH = 2;
constexpr int M = BATCH * SEQ;
constexpr int INW = 2304, DFF = 2816, NGU = 2 * DFF;
constexpr float EPS = 1e-6f;
constexpr int C_AU = 0, C_AV = 256, C_BQ = 512, C_BK = 1024, C_BV = 1152, C_CQ = 1280, C_CF = 1536, C_CI = 1792, C_CG = 2048;
constexpr int MX_A = 0, MX_B = 256, MX_C = 768;

constexpr size_t MiB = 1u << 20;
constexpr size_t WS_CTL = 0, CTL_ZERO_BYTES = 2 * MiB;
constexpr size_t WS_TAB = 2 * MiB;
constexpr size_t WS_SS = 1 * MiB;
constexpr size_t WS_SEGS = 4 * MiB;
constexpr size_t WS_SEGP = 8 * MiB;
constexpr size_t WS_HG = 10 * MiB;
constexpr size_t WS_HU = 32 * MiB;
constexpr size_t WS_W = 44 * MiB, W_LAYER = 24 * MiB;
constexpr size_t W_IN = 0, W_OUT = 5 * MiB, W_GU = 7 * MiB, W_DN = 18 * MiB;
constexpr size_t WS_XB = 92 * MiB;
constexpr size_t WS_X1 = 156 * MiB;
constexpr size_t WS_PROJ = 284 * MiB;
constexpr size_t WS_MIXED = 428 * MiB;
constexpr size_t WS_ACT = 284 * MiB;
constexpr size_t WS_END = 492 * MiB;
static_assert((size_t)INW * DM * 2 <= W_OUT - W_IN && (size_t)DM * DM * 2 <= W_GU - W_OUT && (size_t)NGU * DM * 2 <= W_DN - W_GU && W_DN + (size_t)DM * DFF * 2 <= W_LAYER, "weight map");
static_assert(WS_ACT + (size_t)M * DFF * 2 <= WS_END && WS_MIXED + (size_t)M * DM * 2 <= WS_END && WS_PROJ + (size_t)M * INW * 2 <= WS_MIXED, "activation map");
static_assert(WS_HG + (size_t)512 * 4 * DFF * 4 <= WS_HU && WS_HU + (size_t)512 * 2 * DFF * 4 <= WS_W, "halo map");
constexpr int CW_BAR = 4096;

constexpr int LDS_BYTES = 147456;
constexpr int MISC_OFF = LDS_BYTES - 256;

#define GAS __attribute__((address_space(1)))
#define LAS __attribute__((address_space(3)))
typedef unsigned short bf16;
typedef unsigned v4u __attribute__((ext_vector_type(4)));
typedef unsigned v2u __attribute__((ext_vector_type(2)));
typedef float f32x4 __attribute__((ext_vector_type(4)));
typedef float f32x2 __attribute__((ext_vector_type(2)));
#define RLX_AGENT __ATOMIC_RELAXED, __HIP_MEMORY_SCOPE_AGENT
#define LDS_WAIT() asm volatile("s_waitcnt lgkmcnt(0)" ::: "memory")
__device__ __forceinline__ unsigned f2bf(float f) { unsigned u = __builtin_bit_cast(unsigned, f); return (u + 0x7fffu + ((u >> 16) & 1u)) >> 16; }
__device__ __forceinline__ unsigned pk2(float lo, float hi) { return f2bf(lo) | (f2bf(hi) << 16); }
__device__ __forceinline__ float bf2f(unsigned short h) { return __builtin_bit_cast(float, (unsigned)h << 16); }
__device__ __forceinline__ float bflo(unsigned w) { return __builtin_bit_cast(float, w << 16); }
__device__ __forceinline__ float bfhi(unsigned w) { return __builtin_bit_cast(float, w & 0xffff0000u); }
__device__ __forceinline__ float silu_f(float v) { return v * __builtin_amdgcn_rcpf(1.0f + __expf(-v)); }
__device__ __forceinline__ float wave_sum(float v) {
#pragma unroll
    for (int o = 1; o < 64; o <<= 1) v += __shfl_xor(v, o);
    return v;
}
#define XB_TMO      128
#define XB_XCNT(j)  (256  + 64 * (j))
#define XB_XSUB(j)  (1280 + 64 * (j))
#define XB_XGEN(j)  (2304 + 64 * (j))
#define XB_TOP      3328
#define XB_TOPGEN   3392
#define XCD_BAR_WORDS 3456
#define XB_SPIN_CAP (1u << 18)

__device__ __forceinline__ unsigned xb_ld(unsigned* p)              { return __hip_atomic_load(p, __ATOMIC_RELAXED, __HIP_MEMORY_SCOPE_AGENT); }
__device__ __forceinline__ unsigned xb_add(unsigned* p, unsigned v) { return __hip_atomic_fetch_add(p, v, __ATOMIC_RELAXED, __HIP_MEMORY_SCOPE_AGENT); }
__device__ __forceinline__ unsigned xb_xcc_id() { return (unsigned)__builtin_amdgcn_s_getreg((3 << 11) | 20) & 0xFu; }
#define XB_SPIN(cond, bar) do { unsigned _sp = 0; while (cond) { __builtin_amdgcn_s_sleep(1); \
    if ((++_sp & 255u) == 0u) { if (xb_ld(&(bar)[XB_TMO])) break; if (_sp > XB_SPIN_CAP) { atomicAdd(&(bar)[XB_TMO], 1u); break; } } } } while (0)

struct XcdBarrier {
    unsigned* bar; unsigned x;
    volatile LAS unsigned* st;
};

__device__ __forceinline__ XcdBarrier xcd_barrier_post(unsigned* bar, volatile LAS unsigned* st) {
    XcdBarrier b; b.bar = bar; b.x = xb_xcc_id(); b.st = st;
    if (threadIdx.x == 0) (void)xb_add(&bar[XB_XCNT(b.x)], 1u);
    return b;
}
__device__ __forceinline__ void xcd_barrier_complete(unsigned* bar, unsigned x, unsigned& nloc, unsigned& nx) {
    const unsigned G = gridDim.x * gridDim.y * gridDim.z;
    unsigned sum, cnt, mine, sp = 0u;
    for (;;) {
        sum = 0u; cnt = 0u; mine = 0u;
#pragma nounroll
        for (unsigned j = 0; j < 16; ++j) { const unsigned c = xb_ld(&bar[XB_XCNT(j)]); sum += c; cnt += (c > 0u) ? 1u : 0u; mine = (j == x) ? c : mine; }
        if (sum == G) break;
        __builtin_amdgcn_s_sleep(1);
        if ((++sp & 255u) == 0u) { if (xb_ld(&bar[XB_TMO])) break; if (sp > XB_SPIN_CAP) { atomicAdd(&bar[XB_TMO], 1u); break; } }
    }
    nloc = mine > 0u ? mine : 1u; nx = cnt > 0u ? cnt : 1u;
}

__device__ __forceinline__ void xcd_barrier(const XcdBarrier& b) {
    asm volatile("s_waitcnt vmcnt(0)" ::: "memory");
    __syncthreads();
    if (threadIdx.x == 0) {
        unsigned* bar = b.bar;
        __builtin_amdgcn_s_waitcnt(0);
        unsigned nloc = b.st[0], nx = b.st[1];
        if (nloc == 0u) { xcd_barrier_complete(bar, b.x, nloc, nx); b.st[0] = nloc; b.st[1] = nx; }
        const unsigned old = xb_add(&bar[XB_XSUB(b.x)], 1u);
        const unsigned gen = old / nloc;
        if (old + 1u == (gen + 1u) * nloc) {
            __builtin_amdgcn_fence(__ATOMIC_RELEASE, "agent");
            asm volatile("s_waitcnt vmcnt(0)" ::: "memory");
            const unsigned og = xb_add(&bar[XB_TOP], 1u);
            const unsigned tg = og / nx;
            if (og + 1u == (tg + 1u) * nx) xb_add(&bar[XB_TOPGEN], 1u);
            else XB_SPIN(xb_ld(&bar[XB_TOPGEN]) == tg, bar);
            __builtin_amdgcn_fence(__ATOMIC_ACQUIRE, "agent");
            xb_add(&bar[XB_XGEN(b.x)], 1u);
            asm volatile("s_waitcnt vmcnt(0)" ::: "memory");
        } else {
            XB_SPIN(xb_ld(&bar[XB_XGEN(b.x)]) == gen, bar);
            __builtin_amdgcn_fence(__ATOMIC_ACQUIRE, "agent");
            asm volatile("s_waitcnt vmcnt(0)" ::: "memory");
        }
    }
    __syncthreads();
}


#ifndef DBG_MIX
#define DBG_MIX 7
#endif
#ifdef DBG_NULL_EPI
#define DBG_EPI_MODE(rep) ((rep) == 0 ? 1 : DBG_NULL_EPI == 2 ? 2 : 0)
#else
#define DBG_EPI_MODE(rep) 1
#endif
#ifndef SKEW_P4
#define SKEW_P4 0
#endif
#ifndef SKEW_P1
#define SKEW_P1 0
#endif
#ifndef DBG_REP_C1
#define DBG_REP_C1 1
#endif
#ifndef DBG_REP_C2
#define DBG_REP_C2 1
#endif
#ifndef DBG_REP_B
#define DBG_REP_B 1
#endif
#define DBG_A ((DBG_MIX & 1) ? 1.0f : 0.0f)
#define DBG_B ((DBG_MIX & 2) ? 1.0f : 0.0f)
#define DBG_C ((DBG_MIX & 4) ? 1.0f : 0.0f)
typedef float mb_f32x2_t __attribute__((ext_vector_type(2))); typedef __bf16 mb_bf16x2_t __attribute__((ext_vector_type(2)));
__device__ __forceinline__ unsigned mb_cvtpk(float lo, float hi) { mb_f32x2_t v = {lo, hi}; mb_bf16x2_t b = __builtin_convertvector(v, mb_bf16x2_t); return __builtin_bit_cast(unsigned, b); }
struct Params { const float* in[19]; float* out; unsigned char* ws; int ph_lo, ph_hi; int flags, bar_region; unsigned char bucket[128]; };

struct Ctx { volatile LAS unsigned long long* tab; unsigned char* ws; const unsigned char* bucket; };
constexpr int TAB_OFF = LDS_BYTES - 1024;
__device__ __forceinline__ const float* tab_ptr(const Ctx& c, int i) {
    const unsigned long long v = c.tab[i];
    const unsigned lo = (unsigned)__builtin_amdgcn_readfirstlane((int)(unsigned)v), hi = (unsigned)__builtin_amdgcn_readfirstlane((int)(unsigned)(v >> 32));
    return (const float*)(const GAS float*)(((unsigned long long)hi << 32) | lo);
}
#define PIN(c, i) tab_ptr(c, (i))
#define POUT(c) ((float*)tab_ptr(c, 19))
enum { I_X = 0, I_N1G, I_WIN, I_VNG, I_WS, I_BS, I_QNG, I_KNG, I_SINK, I_RELB, I_LBL, I_ONG, I_WOUT, I_N2G, I_WGATE, I_WUP, I_CONVW, I_CONVB, I_WDOWN };

__device__ __forceinline__ float row_rstd(const unsigned long long* SS, int r) {
    return rsqrtf((float)SS[r] * (1.0f / 16777216.0f / DM) + EPS);
}

struct EpiInProj {
    static constexpr bool PERM = true, APERM = false, AFTER_DRAIN = false;
    bf16* O; const unsigned long long* SS; int mode;
    __device__ __forceinline__ void operator()(pg8::f32x4 (&acc)[2][2][4][2], const pg8::Unit& u, int wr, int wc, int fr_in, int fq_in) const {
        int fr = fr_in, fq = fq_in; asm volatile("" : "+v"(fr), "+v"(fq));
        if (mode == 0) return;
        const int row0 = u.pm * 256 + wr * 64 + fr, col0 = u.pn * 256 + wc * 32 + 8 * fq;
        const int act = (u.pn <= 1) ? 1 : ((u.pn == 5 || u.pn == 8) ? 2 : 0);
        unsigned long long ssv[8];
#pragma unroll
        for (int i = 0; i < 8; ++i) ssv[i] = SS[row0 + (i >> 2) * 128 + (i & 3) * 16];
        float rs8[8];
#pragma unroll
        for (int i = 0; i < 8; ++i) rs8[i] = rsqrtf((float)ssv[i] * (1.0f / 16777216.0f / DM) + EPS);
        if (act == 1) body<1>(acc, rs8, row0, col0); else if (act == 2) body<2>(acc, rs8, row0, col0); else body<0>(acc, rs8, row0, col0);
    }
    template <int ACT> __device__ __forceinline__ void body(pg8::f32x4 (&acc)[2][2][4][2], const float (&rs8)[8], int row0, int col0) const {
#pragma unroll
        for (int ai = 0; ai < 2; ++ai)
#pragma unroll
            for (int m = 0; m < 4; ++m) {
                const int r = row0 + ai * 128 + m * 16; const float rs = rs8[ai * 4 + m]; bf16* rowp = O + (size_t)r * INW + col0;
#pragma unroll
                for (int bj = 0; bj < 2; ++bj) {
                    f32x4 v0 = acc[ai][bj][m][0] * rs, v1 = acc[ai][bj][m][1] * rs;
                    if (ACT == 1) { pg8::f32x2 a = pg8::gelu_pk((pg8::f32x2){v0[0], v0[1]}), b = pg8::gelu_pk((pg8::f32x2){v0[2], v0[3]}), c = pg8::gelu_pk((pg8::f32x2){v1[0], v1[1]}), d = pg8::gelu_pk((pg8::f32x2){v1[2], v1[3]});
                        v0 = (f32x4){a.x, a.y, b.x, b.y}; v1 = (f32x4){c.x, c.y, d.x, d.y}; }
                    else if (ACT == 2) {
#pragma unroll
                        for (int j = 0; j < 4; ++j) { v0[j] = silu_f(v0[j]); v1[j] = silu_f(v1[j]); } }
                    v4u w; w.x = pg8::cvt_pk_bf16(v0[0], v0[1]); w.y = pg8::cvt_pk_bf16(v0[2], v0[3]); w.z = pg8::cvt_pk_bf16(v1[0], v1[1]); w.w = pg8::cvt_pk_bf16(v1[2], v1[3]);
                    *(v4u*)(rowp + bj * 128) = w; }
            }
    }
};
struct EpiResid {
    static constexpr bool PERM = true, APERM = false, AFTER_DRAIN = false;
    bf16* xb; float* out; unsigned long long* SS; int mode;
    __device__ __forceinline__ void operator()(pg8::f32x4 (&acc)[2][2][4][2], const pg8::Unit& u, int wr, int wc, int fr_in, int fq_in) const {
        int fr = fr_in, fq = fq_in; asm volatile("" : "+v"(fr), "+v"(fq));
        if (mode == 0) return;
        const unsigned row0 = (unsigned)(u.pm * 256 + wr * 64 + fr), col0 = (unsigned)(u.pn * 256 + wc * 32 + 8 * fq);
#pragma unroll
        for (int ai = 0; ai < 2; ++ai) {
            v4u raw8[4][2];
#pragma unroll
            for (int m = 0; m < 4; ++m)
#pragma unroll
                for (int bj = 0; bj < 2; ++bj) raw8[m][bj] = *(const v4u*)((const char*)xb + ((row0 + ai * 128 + m * 16) * (unsigned)DM + col0 + bj * 128) * 2u);
#pragma unroll
            for (int m = 0; m < 4; ++m) {
                const unsigned r = row0 + ai * 128 + m * 16, off = r * (unsigned)DM + col0; float ss = 0.f;
#pragma unroll
                for (int bj = 0; bj < 2; ++bj) {
                    const v4u raw = raw8[m][bj];
                    const f32x4 o0 = (f32x4){bflo(raw.x), bfhi(raw.x), bflo(raw.y), bfhi(raw.y)} + acc[ai][bj][m][0], o1 = (f32x4){bflo(raw.z), bfhi(raw.z), bflo(raw.w), bfhi(raw.w)} + acc[ai][bj][m][1];
                    if (mode == 1) { ss += ((o0[0] * o0[0] + o0[1] * o0[1]) + (o0[2] * o0[2] + o0[3] * o0[3])) + ((o1[0] * o1[0] + o1[1] * o1[1]) + (o1[2] * o1[2] + o1[3] * o1[3]));
                        v4u w; w.x = pg8::cvt_pk_bf16(o0[0], o0[1]); w.y = pg8::cvt_pk_bf16(o0[2], o0[3]); w.z = pg8::cvt_pk_bf16(o1[0], o1[1]); w.w = pg8::cvt_pk_bf16(o1[2], o1[3]);
                        *(v4u*)((char*)xb + (off + bj * 128) * 2u) = w; }
                    else { *(f32x4*)((char*)out + (size_t)(off + bj * 128) * 4u) = o0; *(f32x4*)((char*)out + (size_t)(off + bj * 128 + 4) * 4u) = o1; }
                }
                if (mode == 1) { ss += __shfl_xor(ss, 16); ss += __shfl_xor(ss, 32); if (fq == 0) __hip_atomic_fetch_add(SS + r, (unsigned long long)(ss * 16777216.0f), __ATOMIC_RELAXED, __HIP_MEMORY_SCOPE_AGENT); }
            }
            asm volatile("" ::: "memory");
        }
    }
};
struct EpiFFN {
    static constexpr bool PERM = true, APERM = true, AFTER_DRAIN = false;
    bf16* ACT; const unsigned long long* SS; const float* cw; const float* cb; float* HG; float* HU; int mode;
    template <class T> static __device__ __forceinline__ T ldg(const void* base, unsigned boff) { return *(const T*)((const char*)base + boff); }
    template <class T> static __device__ __forceinline__ void stg(void* base, unsigned boff, T v) { *(T*)((char*)base + boff) = v; }
    static __device__ __forceinline__ f32x4 shr1(const f32x4& g) {
        f32x4 r;
#pragma unroll
        for (int j = 0; j < 4; ++j) { const float gj = g[j]; r[j] = __int_as_float(__builtin_amdgcn_update_dpp(0, __float_as_int(gj), 0x111, 0xf, 0xf, true)); }
        return r; }
    __device__ __forceinline__ void operator()(pg8::f32x4 (&acc)[2][2][4][2], const pg8::Unit& u, int wr, int wc, int fr_in, int fq_in) const {
        int fr = fr_in, fq = fq_in; asm volatile("" : "+v"(fr), "+v"(fq));
        if (mode == 0) return;
        const unsigned rowb = (unsigned)(u.pm * 256 + wr * 64 + 4 * fr), ch0 = (unsigned)(u.pn * 128 + wc * 32 + 8 * fq);
        float rs8[8];
        { unsigned long long ssv[8];
#pragma unroll
            for (int i = 0; i < 8; ++i) ssv[i] = ldg<unsigned long long>(SS, (rowb + (i >> 2) * 128 + (i & 3)) * 8u);
#pragma unroll
            for (int i = 0; i < 8; ++i) rs8[i] = rsqrtf((float)ssv[i] * (1.0f / 16777216.0f / DM) + EPS); }
        if (fr == 0 || fr == 15) {
#pragma unroll
            for (int ai = 0; ai < 2; ++ai) {
                const unsigned blk = (unsigned)(u.pm * 4 + ai * 2 + wr);
#pragma unroll
                for (int n = 0; n < 2; ++n) { const unsigned ch = ch0 + 4u * n;
                    if (fr == 0) {
#pragma unroll
                        for (int m = 0; m < 2; ++m) { stg<f32x4>(HG, ((blk * 4u + m) * (unsigned)DFF + ch) * 4u, acc[ai][0][m][n] * rs8[ai * 4 + m]); stg<f32x4>(HU, ((blk * 2u + m) * (unsigned)DFF + ch) * 4u, acc[ai][1][m][n] * rs8[ai * 4 + m]); } }
                    else {
#pragma unroll
                        for (int m = 2; m < 4; ++m) stg<f32x4>(HG, ((blk * 4u + m) * (unsigned)DFF + ch) * 4u, acc[ai][0][m][n] * rs8[ai * 4 + m]); } }
            }
        }
        asm volatile("" ::: "memory");
#pragma unroll
        for (int n = 0; n < 2; ++n) {
            const unsigned ch = ch0 + 4u * n; const float nl2e = -1.4426950408889634f;
            f32x4 w0 = ldg<f32x4>(cw, ch * 4u) * nl2e, w1 = ldg<f32x4>(cw, (DFF + ch) * 4u) * nl2e, w2 = ldg<f32x4>(cw, (2 * DFF + ch) * 4u) * nl2e, bb = ldg<f32x4>(cb, ch * 4u) * nl2e;
            asm volatile("" : "+v"(w0), "+v"(w1), "+v"(w2), "+v"(bb));
            f32x4 g[2][4];
#pragma unroll
            for (int ai = 0; ai < 2; ++ai)
#pragma unroll
                for (int m = 0; m < 4; ++m) g[ai][m] = acc[ai][0][m][n] * rs8[ai * 4 + m];
            f32x4 h3[2], h2[2];
#pragma unroll
            for (int ai = 0; ai < 2; ++ai) { h3[ai] = shr1(g[ai][3]); h2[ai] = shr1(g[ai][2]); }
#pragma unroll
            for (int ai = 0; ai < 2; ++ai)
#pragma unroll
                for (int m = 0; m < 4; ++m) {
                    const f32x4 p1 = (m == 0) ? h3[ai] : g[ai][m - 1], p2 = (m == 0) ? h2[ai] : (m == 1) ? h3[ai] : g[ai][m - 2];
                    f32x4 c2 = w0 * p2 + bb; c2 = w1 * p1 + c2; c2 = w2 * g[ai][m] + c2;
                    const f32x4 ups = acc[ai][1][m][n] * (rs8[ai * 4 + m] * -0.6931471805599453f);
                    f32x4 e;
#pragma unroll
                    for (int j = 0; j < 4; ++j) e[j] = __builtin_amdgcn_rcpf(1.0f + __builtin_amdgcn_exp2f(c2[j]));
                    acc[ai][0][m][n] = (c2 * e) * ups;
                }
            asm volatile("" ::: "memory");
        }
#pragma unroll
        for (int ai = 0; ai < 2; ++ai) {
#pragma unroll
            for (int m = 0; m < 4; ++m) {
                const unsigned r = rowb + ai * 128 + m;
                const f32x4 v0 = acc[ai][0][m][0], v1 = acc[ai][0][m][1];
                v4u w; w.x = pg8::cvt_pk_bf16(v0[0], v0[1]); w.y = pg8::cvt_pk_bf16(v0[2], v0[3]); w.z = pg8::cvt_pk_bf16(v1[0], v1[1]); w.w = pg8::cvt_pk_bf16(v1[2], v1[3]);
                unsigned bo = (r * (unsigned)DFF + ch0) * 2u;
                if (m < 2) bo = (fr == 0) ? (unsigned)((size_t)M * DFF * 2) + (threadIdx.x * 32u + m * 16u) : bo;
                stg<v4u>(ACT, bo, w);
            }
            asm volatile("" ::: "memory");
        }
    }
};

__device__ __forceinline__ void p0_transpose_item(const float* W, int K, int N, const float* gk, bf16* WT, int dest_row0, int k0, int n0, LAS float* scr, int lane) {
    const int rr = lane >> 4, c4 = (lane & 15) * 4;
#pragma unroll 4
    for (int i = 0; i < 16; ++i) { const int kk = 4 * i + rr; f32x4 v = *(const f32x4*)(W + (size_t)(k0 + kk) * N + n0 + c4); if (gk) v = v * gk[k0 + kk];
        LAS float* d = scr + kk * 65 + c4; d[0] = v.x; d[1] = v.y; d[2] = v.z; d[3] = v.w; }
    LDS_WAIT(); asm volatile("" ::: "memory");
    const int c = lane & 7;
#pragma unroll
    for (int j = 0; j < 8; ++j) { const int n = (lane >> 3) + 8 * j; const LAS float* s = scr + (8 * c) * 65 + n;
        v4u o; o.x = mb_cvtpk(s[0 * 65], s[1 * 65]); o.y = mb_cvtpk(s[2 * 65], s[3 * 65]); o.z = mb_cvtpk(s[4 * 65], s[5 * 65]); o.w = mb_cvtpk(s[6 * 65], s[7 * 65]);
        *(GAS v4u*)(WT + (size_t)(dest_row0 + n) * K + k0 + 8 * c) = o; }
    LDS_WAIT(); asm volatile("" ::: "memory");
}

__device__ __forceinline__ void prologue(const Ctx& p, LAS unsigned char* lds, int wave, int lane, bool first) {
    LAS float* scr = (LAS float*)(lds + wave * 16640);
    const int gw = blockIdx.x * NWAVES + wave, NGW = gridDim.x * NWAVES;
    constexpr int I_IN = (DM / 64) * (INW / 64), I_OUT = (DM / 64) * (DM / 64), I_G = (DM / 64) * (DFF / 64), I_D = (DFF / 64) * (DM / 64);
    constexpr int PER_L = I_IN + I_OUT + 2 * I_G + I_D;
    for (int it = gw; it < DEPTH * PER_L; it += NGW) {
        const int l = it / PER_L; int r = it % PER_L;
        unsigned char* wl = p.ws + WS_W + (size_t)l * W_LAYER;
        if (r < I_IN) { const int nblk = INW / 64, kb = r / nblk, nb = r % nblk;
            p0_transpose_item(PIN(p, I_WIN) + (size_t)l * DM * INW, DM, INW, PIN(p, I_N1G) + l * DM, (bf16*)(wl + W_IN), 64 * nb, 64 * kb, 64 * nb, scr, lane); continue; } r -= I_IN;
        if (r < I_OUT) { const int nblk = DM / 64, kb = r / nblk, nb = r % nblk;
            p0_transpose_item(PIN(p, I_WOUT) + (size_t)l * DM * DM, DM, DM, nullptr, (bf16*)(wl + W_OUT), 64 * nb, 64 * kb, 64 * nb, scr, lane); continue; } r -= I_OUT;
        if (r < 2 * I_G) { const int up = r >= I_G; if (up) r -= I_G; const int nblk = DFF / 64, kb = r / nblk, nb = r % nblk, n0 = 64 * nb;
            const int dest = 256 * (n0 / 128) + (n0 % 128) + (up ? 128 : 0);
            p0_transpose_item(PIN(p, up ? I_WUP : I_WGATE) + (size_t)l * DM * DFF, DM, DFF, PIN(p, I_N2G) + l * DM, (bf16*)(wl + W_GU), dest, 64 * kb, n0, scr, lane); continue; } r -= 2 * I_G;
        { const int nblk = DM / 64, kb = r / nblk, nb = r % nblk;
            p0_transpose_item(PIN(p, I_WDOWN) + (size_t)l * DFF * DM, DFF, DM, nullptr, (bf16*)(wl + W_DN), 64 * nb, 64 * kb, 64 * nb, scr, lane); }
    }
    const float* x = PIN(p, I_X); bf16* XB = (bf16*)(p.ws + WS_XB); unsigned long long* SS = (unsigned long long*)(p.ws + WS_SS);
    for (int m = gw; m < M; m += NGW) {
        const f32x4* xr = (const f32x4*)(x + (size_t)m * DM) + lane; f32x4 v[4]; float s = 0.f;
#pragma unroll
        for (int j = 0; j < 4; ++j) { v[j] = xr[64 * j]; s += (v[j].x * v[j].x + v[j].y * v[j].y) + (v[j].z * v[j].z + v[j].w * v[j].w); }
        s = wave_sum(s);
        unsigned long long* o8 = (unsigned long long*)(XB + (size_t)m * DM) + lane;
#pragma unroll
        for (int j = 0; j < 4; ++j) o8[64 * j] = (unsigned long long)pk2(v[j].x, v[j].y) | ((unsigned long long)pk2(v[j].z, v[j].w) << 32);
        if (lane == 0 && first) __hip_atomic_fetch_add(SS + m, (unsigned long long)(s * 16777216.0f), __ATOMIC_RELAXED, __HIP_MEMORY_SCOPE_AGENT);
    }
    { bf16* wtb = (bf16*)(p.ws + WS_TAB + 131072); const float* wsrc = PIN(p, I_WS);
        for (int i = gw * 64 + lane; i < DEPTH * 4 * 128 * 128; i += NGW * 64) { const int s_ = i & 127, t_ = (i >> 7) & 127; wtb[i] = (bf16)f2bf(s_ <= t_ ? wsrc[i] : 0.f); } }
    if (blockIdx.x == 0) { float* bt = (float*)(p.ws + WS_TAB);
        for (int i = wave * 64 + lane; i < 1024; i += NWAVES * 64) { const int h = i >> 7, d = i & 127; bt[i] = PIN(p, I_RELB)[(int)((LAS unsigned char*)(lds + TAB_OFF + 256))[d] * 8 + h]; } }
}

#ifdef DBG_MIXCMP
__device__ __forceinline__ void mixer_a_simple(const Ctx& p, int l, int unit, LAS unsigned char* lds, int wave, int lane) {
    LAS float* vn = (LAS float*)lds;
    const int g = unit & 3, ck = unit >> 2; const size_t row0 = (size_t)ck * 128;
    const bf16* PROJ = (const bf16*)(p.ws + WS_PROJ); bf16* MIXED = (bf16*)(p.ws + WS_MIXED);
    const float vg = PIN(p, I_VNG)[(l * 4 + g) * 64 + lane];
#pragma unroll 4
    for (int i = 0; i < 16; ++i) { const int s = wave * 16 + i;
        const float v = bf2f(PROJ[(row0 + s) * INW + C_AV + g * 64 + lane]);
        const float ss = wave_sum(v * v);
        vn[s * 64 + lane] = v * rsqrtf(ss * (1.0f / 64.0f) + EPS) * vg; }
    __syncthreads();
    const float* Wg = PIN(p, I_WS) + (size_t)(l * 4 + g) * 128 * 128; const float* bs = PIN(p, I_BS) + (l * 4 + g) * 128;
    for (int i = 0; i < 16; ++i) { const int t = __builtin_amdgcn_readfirstlane(wave + 8 * i);
        const float* wrow = Wg + t * 128; float a = 0.f;
        for (int s0 = 0; s0 <= t; s0 += 4) { const f32x4 w = *(const f32x4*)(wrow + s0);
#pragma unroll
            for (int j = 0; j < 4; ++j) { const float wj = (s0 + j <= t) ? w[j] : 0.f; a += wj * vn[(s0 + j) * 64 + lane]; } }
        a += bs[t];
        const float uval = bf2f(PROJ[(row0 + t) * INW + C_AU + g * 64 + lane]);
        MIXED[(row0 + t) * DM + MX_A + g * 64 + lane] = (bf16)f2bf(uval * a * DBG_A); }
    __syncthreads();
}

#endif
#ifdef DBG_MIXCMP
constexpr int KVS = 68;
__device__ __forceinline__ void mixer_b_simple(const Ctx& p, int l, int unit, LAS unsigned char* lds, int wave, int lane) {
    LAS float* Kt = (LAS float*)lds; LAS float* Vt = Kt + 256 * KVS;
    const int hk = unit & 1, nb = unit >> 1, n = nb & 63; const long row0 = (long)nb * 128, win0 = row0 - 128;
    const bf16* PROJ = (const bf16*)(p.ws + WS_PROJ); bf16* MIXED = (bf16*)(p.ws + WS_MIXED);
    const int tid = wave * 64 + lane;
    {
        const int row = tid >> 1, half = tid & 1; const bool valid = (n > 0) || (row >= 128);
        float kf[32], vf[32];
        if (valid) { const v4u* kp = (const v4u*)(PROJ + (win0 + row) * INW + C_BK + hk * 64 + half * 32); const v4u* vp = (const v4u*)(PROJ + (win0 + row) * INW + C_BV + hk * 64 + half * 32);
#pragma unroll
            for (int c = 0; c < 4; ++c) { const v4u a = kp[c], b = vp[c];
                kf[8 * c + 0] = bflo(a.x); kf[8 * c + 1] = bfhi(a.x); kf[8 * c + 2] = bflo(a.y); kf[8 * c + 3] = bfhi(a.y); kf[8 * c + 4] = bflo(a.z); kf[8 * c + 5] = bfhi(a.z); kf[8 * c + 6] = bflo(a.w); kf[8 * c + 7] = bfhi(a.w);
                vf[8 * c + 0] = bflo(b.x); vf[8 * c + 1] = bfhi(b.x); vf[8 * c + 2] = bflo(b.y); vf[8 * c + 3] = bfhi(b.y); vf[8 * c + 4] = bflo(b.z); vf[8 * c + 5] = bfhi(b.z); vf[8 * c + 6] = bflo(b.w); vf[8 * c + 7] = bfhi(b.w); } }
        else {
#pragma unroll
            for (int c = 0; c < 32; ++c) { kf[c] = 0.f; vf[c] = 0.f; } }
        float ss = 0.f;
#pragma unroll
        for (int c = 0; c < 32; ++c) ss += kf[c] * kf[c];
        ss += __shfl_xor(ss, 1);
        const float rs = rsqrtf(ss * (1.0f / 64.0f) + EPS); const float* kng = PIN(p, I_KNG) + l * 64 + half * 32;
#pragma unroll
        for (int c = 0; c < 8; ++c) {
            *(LAS f32x4*)(Kt + row * KVS + half * 32 + 4 * c) = (f32x4){kf[4 * c] * rs * kng[4 * c], kf[4 * c + 1] * rs * kng[4 * c + 1], kf[4 * c + 2] * rs * kng[4 * c + 2], kf[4 * c + 3] * rs * kng[4 * c + 3]};
            *(LAS f32x4*)(Vt + row * KVS + half * 32 + 4 * c) = (f32x4){vf[4 * c], vf[4 * c + 1], vf[4 * c + 2], vf[4 * c + 3]}; }
    }
    __syncthreads();
    const int g = wave >> 1, i = (wave & 1) * 64 + lane, h = hk * 4 + g;
    float q[64];
    { const v4u* qp = (const v4u*)(PROJ + (row0 + i) * INW + C_BQ + h * 64); float ss = 0.f;
#pragma unroll
        for (int c = 0; c < 8; ++c) { const v4u a = qp[c];
            q[8 * c + 0] = bflo(a.x); q[8 * c + 1] = bfhi(a.x); q[8 * c + 2] = bflo(a.y); q[8 * c + 3] = bfhi(a.y); q[8 * c + 4] = bflo(a.z); q[8 * c + 5] = bfhi(a.z); q[8 * c + 6] = bflo(a.w); q[8 * c + 7] = bfhi(a.w); }
#pragma unroll
        for (int c = 0; c < 64; ++c) ss += q[c] * q[c];
        const float rs = rsqrtf(ss * (1.0f / 64.0f) + EPS) * 0.125f; const float* qng = PIN(p, I_QNG) + l * 64;
#pragma unroll
        for (int c = 0; c < 64; ++c) q[c] *= rs * qng[c]; }
    float mx = PIN(p, I_SINK)[l * 8 + h], lsum = 1.0f; float o[64];
#pragma unroll
    for (int c = 0; c < 64; ++c) o[c] = 0.f;
    const float* bt = (const float*)(p.ws + WS_TAB) + h * 128;
    for (int dist = 0; dist < 128; ++dist) {
        const int j = i + 128 - dist; const LAS float* kr = Kt + j * KVS; const LAS float* vr = Vt + j * KVS;
        float s0 = 0.f, s1 = 0.f, s2 = 0.f, s3 = 0.f;
#pragma unroll
        for (int c = 0; c < 16; ++c) { const f32x4 kk = *(const LAS f32x4*)(kr + 4 * c); s0 += q[4 * c] * kk.x; s1 += q[4 * c + 1] * kk.y; s2 += q[4 * c + 2] * kk.z; s3 += q[4 * c + 3] * kk.w; }
        float s = (s0 + s1) + (s2 + s3) + bt[dist];
        if (n == 0 && j < 128) s = -1e30f;
        if (s > mx) { const float f = __expf(mx - s); lsum *= f;
#pragma unroll
            for (int c = 0; c < 64; ++c) o[c] *= f;
            mx = s; }
        const float pr = __expf(s - mx); lsum += pr;
#pragma unroll
        for (int c = 0; c < 16; ++c) { const f32x4 vv = *(const LAS f32x4*)(vr + 4 * c); o[4 * c] += pr * vv.x; o[4 * c + 1] += pr * vv.y; o[4 * c + 2] += pr * vv.z; o[4 * c + 3] += pr * vv.w; }
    }
    const float inv = DBG_B / lsum; v4u* op = (v4u*)(MIXED + (row0 + i) * DM + MX_B + h * 64);
#pragma unroll
    for (int c = 0; c < 8; ++c) { v4u w; w.x = pk2(o[8 * c] * inv, o[8 * c + 1] * inv); w.y = pk2(o[8 * c + 2] * inv, o[8 * c + 3] * inv); w.z = pk2(o[8 * c + 4] * inv, o[8 * c + 5] * inv); w.w = pk2(o[8 * c + 6] * inv, o[8 * c + 7] * inv); op[c] = w; }
    __syncthreads();
}

#endif

namespace mb {
typedef short bf16x8 __attribute__((ext_vector_type(8)));
typedef short s16x4 __attribute__((ext_vector_type(4)));
typedef float f32x16 __attribute__((ext_vector_type(16)));
typedef float f32x2_t __attribute__((ext_vector_type(2)));
typedef __bf16 bf16x2_t __attribute__((ext_vector_type(2)));
constexpr int KB_OFF = 0, VB_OFF = 32768, BIAS_OFF = 65536, WS_OFF = 71680, WS_STRIDE = 4352;
constexpr int B_LDS_END4 = WS_OFF + 4 * WS_STRIDE;
struct GBar { LAS unsigned* cnt; unsigned want; };
template <int NW> __device__ __forceinline__ void gsync(GBar& b, int lane) {
    asm volatile("s_waitcnt lgkmcnt(0)" ::: "memory");
    if (NW == 8) { __builtin_amdgcn_s_barrier(); }
    else { b.want += NW;
        if (lane == 0) { __hip_atomic_fetch_add(b.cnt, 1u, __ATOMIC_RELAXED, __HIP_MEMORY_SCOPE_WORKGROUP);
            while (__hip_atomic_load(b.cnt, __ATOMIC_RELAXED, __HIP_MEMORY_SCOPE_WORKGROUP) < b.want) __builtin_amdgcn_s_sleep(1); } }
    asm volatile("" ::: "memory");
}
__device__ __forceinline__ int crow(int r, int hi) { return (r & 3) + 8 * (r >> 2) + 4 * hi; }
__device__ __forceinline__ unsigned cvtpk(float lo, float hi) { f32x2_t v = {lo, hi}; bf16x2_t b = __builtin_convertvector(v, bf16x2_t); return __builtin_bit_cast(unsigned, b); }
__device__ __forceinline__ s16x4 vtr(LAS const unsigned char* p) { return __builtin_bit_cast(s16x4, __builtin_amdgcn_ds_read_tr16_b64_v4i16((LAS s16x4*)p)); }
}
template <int NW>
__device__ __forceinline__ void mixer_b_mfma(const Ctx& p, int l, int unit, LAS unsigned char* lds, int wave, int lane, mb::GBar& gb) {
    using namespace mb;
    constexpr int NTHR = NW * 64;
    const int hk = unit & 1, nb = unit >> 1, n = nb & 63; const long row0 = (long)nb * 128, win0 = row0 - 128;
    const bf16* PROJ = (const bf16*)(p.ws + WS_PROJ); bf16* MIXED = (bf16*)(p.ws + WS_MIXED);
    const int tid = wave * 64 + lane, r32 = lane & 31, hi = lane >> 5;
    {
#pragma unroll
      for (int pp = 0; pp < 512 / NTHR; ++pp) {
        const int pidx = tid + pp * NTHR, row = pidx >> 1, half = pidx & 1; const bool valid = (n > 0) || (row >= 128);
        v4u kr[4], vr[4];
        if (valid) { const v4u* kp = (const v4u*)(PROJ + (win0 + row) * INW + C_BK + hk * 64 + half * 32); const v4u* vp = (const v4u*)(PROJ + (win0 + row) * INW + C_BV + hk * 64 + half * 32);
#pragma unroll
            for (int c = 0; c < 4; ++c) { kr[c] = kp[c]; vr[c] = vp[c]; } }
        else {
#pragma unroll
            for (int c = 0; c < 4; ++c) { kr[c] = (v4u){0u, 0u, 0u, 0u}; vr[c] = kr[c]; } }
        float ss = 0.f;
#pragma unroll
        for (int c = 0; c < 4; ++c) { const unsigned w4[4] = {kr[c].x, kr[c].y, kr[c].z, kr[c].w};
#pragma unroll
            for (int e = 0; e < 4; ++e) { const float a = bflo(w4[e]), b = bfhi(w4[e]); ss += a * a + b * b; } }
        ss += __shfl_xor(ss, 1);
        const float rs = rsqrtf(ss * (1.0f / 64.0f) + EPS); const float* kng = PIN(p, I_KNG) + l * 64 + half * 32;
        LAS unsigned char* kdst = lds + KB_OFF + (row >> 6) * 8192 + (half * 4) * 1024 + (row & 63) * 16;
        LAS unsigned char* vdst = lds + VB_OFF + (row >> 6) * 8192 + half * 4096 + ((row & 63) >> 4) * 1024 + (row & 15) * 64;
#pragma unroll
        for (int c = 0; c < 4; ++c) { const unsigned w4[4] = {kr[c].x, kr[c].y, kr[c].z, kr[c].w}; v4u o;
            unsigned ow[4];
#pragma unroll
            for (int e = 0; e < 4; ++e) ow[e] = cvtpk(bflo(w4[e]) * rs * kng[8 * c + 2 * e], bfhi(w4[e]) * rs * kng[8 * c + 2 * e + 1]);
            o.x = ow[0]; o.y = ow[1]; o.z = ow[2]; o.w = ow[3];
            *(LAS v4u*)(kdst + c * 1024) = o;
            *(LAS v4u*)(vdst + c * 16) = vr[c]; }
      }
        const float* bt = (const float*)(p.ws + WS_TAB) + (hk * 4) * 128;
        for (int i = tid; i < 4 * 384; i += NTHR) { const int g = i / 384, x = i % 384 - 128; ((LAS float*)(lds + BIAS_OFF))[i] = (x >= 0 && x < 128) ? bt[g * 128 + 127 - x] * 1.4426950408889634f : -1e30f; }
    }
    gsync<NW>(gb, lane);
    const int g = (NW == 8) ? (wave >> 1) : wave, h = hk * 4 + g, qbase = (NW == 8) ? (wave & 1) * 64 : 0;
    LAS float* wsf = (LAS float*)(lds + WS_OFF + wave * WS_STRIDE);
    LAS bf16* stg = (LAS bf16*)(lds + WS_OFF + wave * WS_STRIDE + 256);
    const float sink2 = PIN(p, I_SINK)[l * 8 + h] * 1.4426950408889634f;
    float gqv[4][8];
    { const float* qng = PIN(p, I_QNG) + l * 64 + hi * 8;
#pragma unroll
        for (int d0 = 0; d0 < 4; ++d0) { const f32x4 a = *(const f32x4*)(qng + d0 * 16), b = *(const f32x4*)(qng + d0 * 16 + 4);
            const float c2 = 0.125f * 1.4426950408889634f;
            gqv[d0][0] = a.x * c2; gqv[d0][1] = a.y * c2; gqv[d0][2] = a.z * c2; gqv[d0][3] = a.w * c2; gqv[d0][4] = b.x * c2; gqv[d0][5] = b.y * c2; gqv[d0][6] = b.z * c2; gqv[d0][7] = b.w * c2; } }
    const LAS unsigned char* vp0 = lds + VB_OFF + ((lane >> 4) & 1) * 32 + (lane & 3) * 8 + (4 * hi + ((lane & 15) >> 2)) * 64;
#pragma unroll 1
    for (int qq = 0; qq < (NW == 8 ? 1 : 2); ++qq)
#pragma unroll
    for (int qt = 0; qt < 2; ++qt) {
        const int i0 = qbase + qq * 64 + qt * 32, qi = i0 + r32, jt0 = (i0 >= 64) ? 1 : 0;
#define MB_LIVE(jt, hh) ((qt == 0) ? !((jt) == 2 && (hh) == 1) : !((jt) == 0 && (hh) == 0))
        bf16x8 qr[4];
        { const bf16* qp = PROJ + (row0 + qi) * INW + C_BQ + h * 64 + hi * 8; v4u raw[4]; float ss = 0.f;
#pragma unroll
            for (int d0 = 0; d0 < 4; ++d0) { raw[d0] = *(const v4u*)(qp + d0 * 16); const unsigned w4[4] = {raw[d0].x, raw[d0].y, raw[d0].z, raw[d0].w};
#pragma unroll
                for (int e = 0; e < 4; ++e) { const float a = bflo(w4[e]), b = bfhi(w4[e]); ss += a * a + b * b; } }
            ss += __shfl_xor(ss, 32);
            const float rs = rsqrtf(ss * (1.0f / 64.0f) + EPS);
#pragma unroll
            for (int d0 = 0; d0 < 4; ++d0) { const unsigned w4[4] = {raw[d0].x, raw[d0].y, raw[d0].z, raw[d0].w}; unsigned ow[4];
#pragma unroll
                for (int e = 0; e < 4; ++e) ow[e] = cvtpk(bflo(w4[e]) * rs * gqv[d0][2 * e], bfhi(w4[e]) * rs * gqv[d0][2 * e + 1]);
                v4u o; o.x = ow[0]; o.y = ow[1]; o.z = ow[2]; o.w = ow[3]; qr[d0] = __builtin_bit_cast(bf16x8, o); } }
        f32x16 sc[3][2];
#pragma unroll
        for (int jt = 0; jt < 3; ++jt) { const LAS unsigned char* kb = lds + KB_OFF + (jt0 + jt) * 8192 + hi * 1024 + r32 * 16;
            f32x16 a0 = {}, a1 = {};
#pragma unroll
            for (int d0 = 0; d0 < 4; ++d0) {
                if (MB_LIVE(jt, 0)) { const bf16x8 b0 = *(const LAS bf16x8*)(kb + d0 * 2048); a0 = __builtin_amdgcn_mfma_f32_32x32x16_bf16(b0, qr[d0], a0, 0, 0, 0); }
                if (MB_LIVE(jt, 1)) { const bf16x8 b1 = *(const LAS bf16x8*)(kb + d0 * 2048 + 512); a1 = __builtin_amdgcn_mfma_f32_32x32x16_bf16(b1, qr[d0], a1, 0, 0, 0); } }
            sc[jt][0] = a0; sc[jt][1] = a1; }
        const LAS float* tb = (const LAS float*)(lds + BIAS_OFF) + g * 384 + 128;
        float mx = sink2;
#pragma unroll
        for (int jt = 0; jt < 3; ++jt)
#pragma unroll
            for (int hh = 0; hh < 2; ++hh) if (MB_LIVE(jt, hh)) { const int kj0 = 64 * (jt0 + jt) + 32 * hh + 4 * hi;
                const LAS float* tx = tb + (127 - (qi + 128 - kj0));
                const bool first = (n == 0) && (jt0 + jt < 2);
#pragma unroll
                for (int r = 0; r < 16; ++r) { const int kc = (r & 3) + 8 * (r >> 2);
                    float s = sc[jt][hh][r] + tx[kc]; if (first) s = -1e30f;
                    sc[jt][hh][r] = s; mx = fmaxf(mx, s); } }
        mx = fmaxf(mx, __shfl_xor(mx, 32));
        float lsum = 0.f;
#pragma unroll
        for (int jt = 0; jt < 3; ++jt)
#pragma unroll
            for (int hh = 0; hh < 2; ++hh) if (MB_LIVE(jt, hh))
#pragma unroll
                for (int r = 0; r < 16; ++r) { const float e = __builtin_amdgcn_exp2f(sc[jt][hh][r] - mx); sc[jt][hh][r] = e; lsum += e; }
        lsum += __shfl_xor(lsum, 32);
        lsum += __builtin_amdgcn_exp2f(sink2 - mx);
        f32x16 o0 = {}, o1 = {};
#pragma unroll
        for (int jt = 0; jt < 3; ++jt) { const LAS unsigned char* vb = vp0 + (jt0 + jt) * 8192;
#pragma unroll
            for (int ks = 0; ks < 4; ++ks) { const int hh = ks >> 1, rb = (ks & 1) * 8;
                if (MB_LIVE(jt, hh)) {
                v4u pw; pw.x = cvtpk(sc[jt][hh][rb + 0], sc[jt][hh][rb + 1]); pw.y = cvtpk(sc[jt][hh][rb + 2], sc[jt][hh][rb + 3]); pw.z = cvtpk(sc[jt][hh][rb + 4], sc[jt][hh][rb + 5]); pw.w = cvtpk(sc[jt][hh][rb + 6], sc[jt][hh][rb + 7]);
                const bf16x8 pa = __builtin_bit_cast(bf16x8, pw);
                const s16x4 l0 = vtr(vb + ks * 1024), h0 = vtr(vb + ks * 1024 + 512), l1 = vtr(vb + 4096 + ks * 1024), h1 = vtr(vb + 4096 + ks * 1024 + 512);
                const bf16x8 v0 = (bf16x8){l0[0], l0[1], l0[2], l0[3], h0[0], h0[1], h0[2], h0[3]}, v1 = (bf16x8){l1[0], l1[1], l1[2], l1[3], h1[0], h1[1], h1[2], h1[3]};
                o0 = __builtin_amdgcn_mfma_f32_32x32x16_bf16(pa, v0, o0, 0, 0, 0); o1 = __builtin_amdgcn_mfma_f32_32x32x16_bf16(pa, v1, o1, 0, 0, 0); } } }
#undef MB_LIVE
        if (hi == 0) wsf[r32] = lsum;
        LDS_WAIT(); asm volatile("" ::: "memory");
#pragma unroll
        for (int r = 0; r < 16; ++r) { const int orow = crow(r, hi); const float inv = DBG_B * __builtin_amdgcn_rcpf(wsf[orow]);
            const unsigned pk = cvtpk(o0[r] * inv, o1[r] * inv);
            stg[orow * 64 + r32] = (bf16)(pk & 0xffffu); stg[orow * 64 + 32 + r32] = (bf16)(pk >> 16); }
        LDS_WAIT(); asm volatile("" ::: "memory");
        bf16* ow = MIXED + (row0 + i0) * DM + MX_B + h * 64;
#pragma unroll
        for (int i = 0; i < 4; ++i) { const int row = i * 8 + (lane >> 3), ch = lane & 7; const v4u v = *(const LAS v4u*)(stg + row * 64 + ch * 8); *(v4u*)(ow + (long)row * DM + ch * 8) = v; }
        LDS_WAIT(); asm volatile("" ::: "memory");
    }
    gsync<NW>(gb, lane);
}

constexpr size_t WS_WTB = WS_TAB + 131072;
constexpr int VNT_STRIDE = 136;
template <int NW>
__device__ __forceinline__ void mixer_a_mfma(const Ctx& p, int l, int unit, LAS unsigned char* lds, int wave, int lane, mb::GBar& gb) {
    using namespace mb;
    LAS bf16* vnT = (LAS bf16*)lds;
    const int g = unit & 3, ck = unit >> 2; const size_t row0 = (size_t)ck * 128;
    const bf16* PROJ = (const bf16*)(p.ws + WS_PROJ); bf16* MIXED = (bf16*)(p.ws + WS_MIXED);
    const int r32 = lane & 31, hi = lane >> 5;
    {
        const int sub = lane >> 4, d4 = (lane & 15) * 4; const f32x4 vg = *(const f32x4*)(PIN(p, I_VNG) + (l * 4 + g) * 64 + d4);
#pragma unroll
        for (int i = 0; i < 32 / NW; ++i) { const int s = wave * (128 / NW) + i * 4 + sub;
            const v2u raw = *(const v2u*)(PROJ + (row0 + s) * INW + C_AV + g * 64 + d4);
            const float v0 = bflo(raw.x), v1 = bfhi(raw.x), v2 = bflo(raw.y), v3 = bfhi(raw.y);
            float ss = (v0 * v0 + v1 * v1) + (v2 * v2 + v3 * v3);
            ss += __shfl_xor(ss, 1); ss += __shfl_xor(ss, 2); ss += __shfl_xor(ss, 4); ss += __shfl_xor(ss, 8);
            const float rs = rsqrtf(ss * (1.0f / 64.0f) + EPS);
            vnT[(d4 + 0) * VNT_STRIDE + s] = (bf16)f2bf(v0 * rs * vg.x); vnT[(d4 + 1) * VNT_STRIDE + s] = (bf16)f2bf(v1 * rs * vg.y);
            vnT[(d4 + 2) * VNT_STRIDE + s] = (bf16)f2bf(v2 * rs * vg.z); vnT[(d4 + 3) * VNT_STRIDE + s] = (bf16)f2bf(v3 * rs * vg.w); }
    }
    gsync<NW>(gb, lane);
#pragma unroll 1
    for (int tile = wave; tile < 8; tile += NW) {
    const int ti = tile >> 1, dt = tile & 1;
    const bf16* Wt = (const bf16*)(p.ws + WS_WTB) + ((size_t)(l * 4 + g) * 128 + 32 * ti + r32) * 128 + 8 * hi;
    const LAS bf16* vb = vnT + (32 * dt + r32) * VNT_STRIDE + 8 * hi;
    f32x16 acc = {};
    for (int ks = 0; ks < 2 * ti + 2; ++ks) {
        const bf16x8 a = __builtin_bit_cast(bf16x8, *(const v4u*)(Wt + 16 * ks)); const bf16x8 b = *(const LAS bf16x8*)(vb + 16 * ks);
        acc = __builtin_amdgcn_mfma_f32_32x32x16_bf16(a, b, acc, 0, 0, 0); }
    const float* bs = PIN(p, I_BS) + (l * 4 + g) * 128 + 32 * ti;
#pragma unroll
    for (int r = 0; r < 16; ++r) { const int t = crow(r, hi); const size_t row = row0 + 32 * ti + t;
        const float uval = bf2f(PROJ[row * INW + C_AU + g * 64 + 32 * dt + r32]);
        MIXED[row * DM + MX_A + g * 64 + 32 * dt + r32] = (bf16)f2bf(uval * (acc[r] + bs[t]) * DBG_A); }
    }
    gsync<NW>(gb, lane);
}
__device__ __forceinline__ float hgrn_lb(const Ctx& p, int l, int kidx) { if (l == 0) return 0.f; const float* lg = PIN(p, I_LBL); return 1.0f / (1.0f + __expf(lg[kidx] - lg[256 + kidx])); }
#ifdef DBG_MIXCMP
__device__ __forceinline__ void hgrn_stage(const bf16* PROJ, size_t rowbase, int hc, const float (&lb8)[8], LAS float* F, LAS float* V, LAS float* Q, int tid) {
    const int tt = tid >> 3, k0 = (tid & 7) * 8; const bf16* rp = PROJ + (rowbase + tt) * INW + hc * 64 + k0;
    const v4u z = *(const v4u*)(rp + C_CF), vi = *(const v4u*)(rp + C_CI);
    float zf[8] = {bflo(z.x), bfhi(z.x), bflo(z.y), bfhi(z.y), bflo(z.z), bfhi(z.z), bflo(z.w), bfhi(z.w)}; float ff[8];
#pragma unroll
    for (int j = 0; j < 8; ++j) ff[j] = lb8[j] + (1.0f - lb8[j]) * __builtin_amdgcn_rcpf(1.0f + __expf(-zf[j]));
    *(LAS f32x4*)(F + tt * 64 + k0) = (f32x4){ff[0], ff[1], ff[2], ff[3]}; *(LAS f32x4*)(F + tt * 64 + k0 + 4) = (f32x4){ff[4], ff[5], ff[6], ff[7]};
    *(LAS f32x4*)(V + tt * 64 + k0) = (f32x4){bflo(vi.x), bfhi(vi.x), bflo(vi.y), bfhi(vi.y)}; *(LAS f32x4*)(V + tt * 64 + k0 + 4) = (f32x4){bflo(vi.z), bfhi(vi.z), bflo(vi.w), bfhi(vi.w)};
    if (Q) { const v4u qq = *(const v4u*)(rp + C_CQ);
        *(LAS f32x4*)(Q + tt * 64 + k0) = (f32x4){bflo(qq.x), bfhi(qq.x), bflo(qq.y), bfhi(qq.y)}; *(LAS f32x4*)(Q + tt * 64 + k0 + 4) = (f32x4){bflo(qq.z), bfhi(qq.z), bflo(qq.w), bfhi(qq.w)}; }
}
__device__ __forceinline__ void mixer_c_pass1_simple(const Ctx& p, int l, int unit, LAS unsigned char* lds, int wave, int lane) {
    LAS float* F = (LAS float*)lds; LAS float* V = F + 4096;
    const int bh = unit >> 4, seg = unit & 15, b = bh >> 2, hc = bh & 3; const size_t row0 = (size_t)b * SEQ + (size_t)seg * 512;
    const bf16* PROJ = (const bf16*)(p.ws + WS_PROJ); const int tid = wave * 64 + lane;
    float lb8[8];
#pragma unroll
    for (int j = 0; j < 8; ++j) lb8[j] = hgrn_lb(p, l, hc * 64 + (tid & 7) * 8 + j);
    float S[8], P[8];
#pragma unroll
    for (int j = 0; j < 8; ++j) { S[j] = 0.f; P[j] = 1.f; }
    for (int cks = 0; cks < 8; ++cks) {
        __syncthreads();
        hgrn_stage(PROJ, row0 + cks * 64, hc, lb8, F, V, nullptr, tid);
        __syncthreads();
        for (int tt = 0; tt < 64; ++tt) {
            const f32x4 fa = *(const LAS f32x4*)(F + tt * 64 + wave * 8), fb = *(const LAS f32x4*)(F + tt * 64 + wave * 8 + 4); const float vv = V[tt * 64 + lane];
            const float f8[8] = {fa.x, fa.y, fa.z, fa.w, fb.x, fb.y, fb.z, fb.w};
#pragma unroll
            for (int j = 0; j < 8; ++j) { S[j] = fmaf(f8[j], S[j] - vv, vv); P[j] *= f8[j]; }
        }
    }
    float* SEGS = (float*)(p.ws + WS_SEGS); float* SEGP = (float*)(p.ws + WS_SEGP);
#pragma unroll
    for (int j = 0; j < 8; ++j) { SEGS[(size_t)unit * 4096 + (wave * 8 + j) * 64 + lane] = S[j]; if (lane == 0) SEGP[unit * 64 + wave * 8 + j] = P[j]; }
    __syncthreads();
}
__device__ __forceinline__ void mixer_c_pass2_simple(const Ctx& p, int l, int unit, LAS unsigned char* lds, int wave, int lane) {
    LAS float* F = (LAS float*)lds; LAS float* V = F + 4096; LAS float* Q = V + 4096; LAS float* PO = Q + 4096;
    const int bh = unit >> 4, seg = unit & 15, b = bh >> 2, hc = bh & 3; const size_t row0 = (size_t)b * SEQ + (size_t)seg * 512;
    const bf16* PROJ = (const bf16*)(p.ws + WS_PROJ); bf16* MIXED = (bf16*)(p.ws + WS_MIXED); const int tid = wave * 64 + lane;
    const float* SEGS = (const float*)(p.ws + WS_SEGS); const float* SEGP = (const float*)(p.ws + WS_SEGP);
    float lb8[8];
#pragma unroll
    for (int j = 0; j < 8; ++j) lb8[j] = hgrn_lb(p, l, hc * 64 + (tid & 7) * 8 + j);
    float S[8];
#pragma unroll
    for (int j = 0; j < 8; ++j) S[j] = 0.f;
    for (int s = 0; s < seg; ++s) { const int u2 = bh * 16 + s;
#pragma unroll
        for (int j = 0; j < 8; ++j) S[j] = SEGP[u2 * 64 + wave * 8 + j] * S[j] + SEGS[(size_t)u2 * 4096 + (wave * 8 + j) * 64 + lane]; }
    const float ong = PIN(p, I_ONG)[l * 64 + lane];
    for (int cks = 0; cks < 8; ++cks) {
        __syncthreads();
        hgrn_stage(PROJ, row0 + cks * 64, hc, lb8, F, V, Q, tid);
        __syncthreads();
        for (int tg = 0; tg < 4; ++tg) {
            for (int t16 = 0; t16 < 16; ++t16) { const int tt = tg * 16 + t16;
                const f32x4 fa = *(const LAS f32x4*)(F + tt * 64 + wave * 8), fb = *(const LAS f32x4*)(F + tt * 64 + wave * 8 + 4);
                const f32x4 qa = *(const LAS f32x4*)(Q + tt * 64 + wave * 8), qb = *(const LAS f32x4*)(Q + tt * 64 + wave * 8 + 4); const float vv = V[tt * 64 + lane];
                const float f8[8] = {fa.x, fa.y, fa.z, fa.w, fb.x, fb.y, fb.z, fb.w}; const float q8[8] = {qa.x, qa.y, qa.z, qa.w, qb.x, qb.y, qb.z, qb.w};
                float po = 0.f;
#pragma unroll
                for (int j = 0; j < 8; ++j) { S[j] = fmaf(f8[j], S[j] - vv, vv); po = fmaf(q8[j], S[j], po); }
                PO[(t16 * 8 + wave) * 64 + lane] = po; }
            __syncthreads();
#pragma unroll
            for (int e = 0; e < 2; ++e) { const int t16 = wave * 2 + e; float o = 0.f;
#pragma unroll
                for (int w = 0; w < 8; ++w) o += PO[(t16 * 8 + w) * 64 + lane];
                const float ss = wave_sum(o * o); const size_t row = row0 + cks * 64 + tg * 16 + t16;
                const float gg = bf2f(PROJ[row * INW + C_CG + hc * 64 + lane]);
                MIXED[row * DM + MX_C + hc * 64 + lane] = (bf16)f2bf(o * rsqrtf(ss * (1.0f / 64.0f) + EPS) * ong * gg * DBG_C); }
            __syncthreads();
        }
    }
}

#endif


__device__ __forceinline__ float wave_sum_dpp(float v) {
    v += __int_as_float(__builtin_amdgcn_update_dpp(0, __float_as_int(v), 0xB1, 0xf, 0xf, true));
    v += __int_as_float(__builtin_amdgcn_update_dpp(0, __float_as_int(v), 0x4E, 0xf, 0xf, true));
    v += __int_as_float(__builtin_amdgcn_update_dpp(0, __float_as_int(v), 0x141, 0xf, 0xf, true));
    v += __int_as_float(__builtin_amdgcn_update_dpp(0, __float_as_int(v), 0x140, 0xf, 0xf, true));
    const int vi = __float_as_int(v);
    return (__int_as_float(__builtin_amdgcn_readlane(vi, 0)) + __int_as_float(__builtin_amdgcn_readlane(vi, 16))) + (__int_as_float(__builtin_amdgcn_readlane(vi, 32)) + __int_as_float(__builtin_amdgcn_readlane(vi, 48)));
}
namespace mc {
constexpr int QT = 0, KT = 4096, QH = 8192, KH = 12288, VV = 16384, DD = 20480, WTO = 20736, OE = 22784, OI = 30976, RB = 39168, LDS_END = 55552;
}
#define MC_BAR() mb::gsync<NW>(gb, lane)
template <bool PASS2, int NW>
__device__ __forceinline__ void mixer_c_mfma(const Ctx& p, int l, int unit, LAS unsigned char* lds, int wave, int lane, mb::GBar& gb) {
    constexpr int TPW = 32 / NW, HT = TPW / 2, NTHR = NW * 64, NP = (PASS2 ? 1024 : 512) / NTHR;
    using namespace mb;
    const int bh = unit >> 4, seg = unit & 15, b = bh >> 2, hc = bh & 3; const size_t row0 = (size_t)b * SEQ + (size_t)seg * 512;
    const bf16* PROJ = (const bf16*)(p.ws + WS_PROJ); bf16* MIXED = (bf16*)(p.ws + WS_MIXED);
    float* SEGS = (float*)(p.ws + WS_SEGS); float* SEGP = (float*)(p.ws + WS_SEGP);
    const int r32 = lane & 31, hi = lane >> 5, kt_lane_off = ((lane >> 4) & 1) * 32 + (lane & 3) * 8 + (4 * hi + ((lane & 15) >> 2)) * 64;
    const int cp = lane & 31, th = lane >> 5;
    const f32x2 lb2 = (f32x2){hgrn_lb(p, l, hc * 64 + 2 * cp), hgrn_lb(p, l, hc * 64 + 2 * cp + 1)}, omlb2 = (f32x2){1.0f - lb2.x, 1.0f - lb2.y};
    const float ong = PASS2 ? PIN(p, I_ONG)[l * 64 + lane] : 0.f;
    f32x16 S0 = {}, S1 = {};
    if (PASS2 && wave < 2) {
        for (int s = 0; s < seg; ++s) { const int u2 = bh * 16 + s; const float* sp = SEGS + ((size_t)(u2 * 2 + wave) * 2) * 16 * 64 + lane; const float* pp = SEGP + u2 * 64 + 4 * hi;
#pragma unroll
            for (int gq = 0; gq < 4; ++gq) { const f32x4 d0 = *(const f32x4*)(pp + 8 * gq), d1 = *(const f32x4*)(pp + 32 + 8 * gq);
#pragma unroll
                for (int e = 0; e < 4; ++e) { const int r = 4 * gq + e; S0[r] = d0[e] * S0[r] + sp[(size_t)r * 64]; S1[r] = d1[e] * S1[r] + sp[(size_t)(16 + r) * 64]; } } }
    }
    f32x2 sumtot = (f32x2){0.f, 0.f};
    const int tid = wave * 64 + lane;
    v4u pf[NP];
#define MC_PIECE_SRC(k, blk) (PROJ + (row0 + 32 * (blk) + (((tid + (k) * NTHR) & 255) >> 3)) * INW + hc * 64 + ((tid + (k) * NTHR) & 7) * 8 + ((((tid + (k) * NTHR) >> 8) == 0) ? C_CF : (((tid + (k) * NTHR) >> 8) == 1) ? C_CI : (((tid + (k) * NTHR) >> 8) == 2) ? C_CQ : C_CG))
#define MC_PIECE_DST(k) (lds + mc::RB + ((tid + (k) * NTHR) >> 8) * 4096 + (((tid + (k) * NTHR) & 255) >> 3) * 128 + ((tid + (k) * NTHR) & 7) * 16)
#pragma unroll
    for (int k = 0; k < NP; ++k) pf[k] = *(const v4u*)MC_PIECE_SRC(k, 0);
#pragma unroll
    for (int k = 0; k < NP; ++k) *(LAS v4u*)MC_PIECE_DST(k) = pf[k];
    MC_BAR();
#pragma unroll 1
    for (int n = 0; n < 16; ++n) {
        if (n + 1 < 16) {
#pragma unroll
            for (int k = 0; k < NP; ++k) pf[k] = *(const v4u*)MC_PIECE_SRC(k, n + 1); }
        float gv[TPW];
        if (PASS2) {
#pragma unroll
            for (int i = 0; i < TPW; ++i) gv[i] = bf2f(((const LAS bf16*)(lds + mc::RB))[6144 + (TPW * wave + i) * 64 + lane]); }
        f32x2 fg[HT], cs[HT], qv[HT], vv[HT];
#pragma unroll
        for (int i = 0; i < HT; ++i) { const LAS unsigned* rp = (const LAS unsigned*)(lds + mc::RB) + (TPW * wave + HT * th + i) * 32 + cp;
            const unsigned zw = rp[0], vw = rp[1024];
            const float z0 = fmaxf(bflo(zw), -30.f), z1 = fmaxf(bfhi(zw), -30.f);
            fg[i] = (f32x2){lb2.x + omlb2.x * __builtin_amdgcn_rcpf(1.0f + __expf(-z0)), lb2.y + omlb2.y * __builtin_amdgcn_rcpf(1.0f + __expf(-z1))};
            vv[i] = (f32x2){bflo(vw), bfhi(vw)};
            if (PASS2) { const unsigned qw = rp[2048]; qv[i] = (f32x2){bflo(qw), bfhi(qw)}; } }
        cs[0] = (f32x2){__logf(fg[0].x), __logf(fg[0].y)};
#pragma unroll
        for (int i = 1; i < HT; ++i) cs[i] = cs[i - 1] + (f32x2){__logf(fg[i].x), __logf(fg[i].y)};
        { const f32x2 other = (f32x2){__shfl_xor(cs[HT - 1].x, 32), __shfl_xor(cs[HT - 1].y, 32)};
            if (th) {
#pragma unroll
                for (int i = 0; i < HT; ++i) cs[i] = cs[i] + other;
                ((LAS f32x2*)(lds + mc::WTO))[wave * 32 + cp] = cs[HT - 1]; } }
        MC_BAR();
        f32x2 off = (f32x2){0.f, 0.f}, tot = off, mid = off;
#pragma unroll
        for (int w = 0; w < NW; ++w) { const f32x2 tw = ((const LAS f32x2*)(lds + mc::WTO))[w * 32 + cp]; if (w < wave) off = off + tw; if (w < NW / 2) mid = mid + tw; tot = tot + tw; }
        sumtot = sumtot + tot;
#pragma unroll
        for (int i = 0; i < HT; ++i) { const int t = TPW * wave + HT * th + i; const f32x2 Bt = off + cs[i], kk = (f32x2){1.0f - fg[i].x, 1.0f - fg[i].y};
            const int chb = (cp >> 2) * 512 + t * 16 + (cp & 3) * 4, vlb = (cp >> 4) * 2048 + (t >> 4) * 1024 + (t & 15) * 64 + (cp & 15) * 4;
            *(LAS unsigned*)(lds + mc::KH + vlb) = cvtpk(kk.x * __expf(tot.x - Bt.x), kk.y * __expf(tot.y - Bt.y));
            *(LAS unsigned*)(lds + mc::VV + vlb) = cvtpk(vv[i].x, vv[i].y);
            if (PASS2) { *(LAS unsigned*)(lds + mc::QT + chb) = cvtpk(qv[i].x * __expf(fminf(Bt.x - mid.x, 80.f)), qv[i].y * __expf(fminf(Bt.y - mid.y, 80.f)));
                *(LAS unsigned*)(lds + mc::KT + chb) = cvtpk(kk.x * __expf(fminf(mid.x - Bt.x, 80.f)), kk.y * __expf(fminf(mid.y - Bt.y, 80.f)));
                *(LAS unsigned*)(lds + mc::QH + chb) = cvtpk(qv[i].x * __expf(Bt.x), qv[i].y * __expf(Bt.y)); } }
        if (wave == 0 && th == 0) ((LAS f32x2*)(lds + mc::DD))[cp] = (f32x2){__expf(tot.x), __expf(tot.y)};
        MC_BAR();
        if (wave < 2) {
            const int vt = wave;
            if (PASS2) {
                f32x16 o = {};
#pragma unroll
                for (int kt = 0; kt < 2; ++kt)
#pragma unroll
                    for (int s2 = 0; s2 < 2; ++s2) { const LAS unsigned char* qa = lds + mc::QH + (4 * kt + 2 * s2) * 512 + r32 * 16 + 8 * hi;
                        const v2u a0 = *(const LAS v2u*)qa, a1 = *(const LAS v2u*)(qa + 512); v4u aw; aw.x = a0.x; aw.y = a0.y; aw.z = a1.x; aw.w = a1.y;
                        v4u bw;
                        if (kt == 0) { bw.x = cvtpk(S0[8 * s2 + 0], S0[8 * s2 + 1]); bw.y = cvtpk(S0[8 * s2 + 2], S0[8 * s2 + 3]); bw.z = cvtpk(S0[8 * s2 + 4], S0[8 * s2 + 5]); bw.w = cvtpk(S0[8 * s2 + 6], S0[8 * s2 + 7]); }
                        else { bw.x = cvtpk(S1[8 * s2 + 0], S1[8 * s2 + 1]); bw.y = cvtpk(S1[8 * s2 + 2], S1[8 * s2 + 3]); bw.z = cvtpk(S1[8 * s2 + 4], S1[8 * s2 + 5]); bw.w = cvtpk(S1[8 * s2 + 6], S1[8 * s2 + 7]); }
                        o = __builtin_amdgcn_mfma_f32_32x32x16_bf16(__builtin_bit_cast(bf16x8, aw), __builtin_bit_cast(bf16x8, bw), o, 0, 0, 0); }
#pragma unroll
                for (int r = 0; r < 16; ++r) ((LAS float*)(lds + mc::OE))[crow(r, hi) * 64 + 32 * vt + r32] = o[r];
            }
            { const LAS float* dp = (const LAS float*)(lds + mc::DD) + 4 * hi;
#pragma unroll
                for (int gq = 0; gq < 4; ++gq) { const f32x4 d0 = *(const LAS f32x4*)(dp + 8 * gq), d1 = *(const LAS f32x4*)(dp + 32 + 8 * gq);
#pragma unroll
                    for (int e = 0; e < 4; ++e) { S0[4 * gq + e] *= d0[e]; S1[4 * gq + e] *= d1[e]; } } }
#pragma unroll
            for (int ks = 0; ks < 2; ++ks) {
                const LAS unsigned char* vb = lds + mc::VV + vt * 2048 + ks * 1024 + kt_lane_off; const s16x4 vl = vtr(vb), vh = vtr(vb + 512);
                const bf16x8 bv = (bf16x8){vl[0], vl[1], vl[2], vl[3], vh[0], vh[1], vh[2], vh[3]};
                const LAS unsigned char* k0 = lds + mc::KH + ks * 1024 + kt_lane_off; const s16x4 al = vtr(k0), ah = vtr(k0 + 512), bl = vtr(k0 + 2048), bh_ = vtr(k0 + 2048 + 512);
                const bf16x8 a0 = (bf16x8){al[0], al[1], al[2], al[3], ah[0], ah[1], ah[2], ah[3]}, a1 = (bf16x8){bl[0], bl[1], bl[2], bl[3], bh_[0], bh_[1], bh_[2], bh_[3]};
                S0 = __builtin_amdgcn_mfma_f32_32x32x16_bf16(a0, bv, S0, 0, 0, 0); S1 = __builtin_amdgcn_mfma_f32_32x32x16_bf16(a1, bv, S1, 0, 0, 0); }
        } else if (PASS2 && wave < 4) {
            const int vt = wave - 2;
            f32x16 at = {};
#pragma unroll
            for (int ks = 0; ks < 4; ++ks) { const bf16x8 a = *(const LAS bf16x8*)(lds + mc::KT + (2 * ks + hi) * 512 + r32 * 16), bq = *(const LAS bf16x8*)(lds + mc::QT + (2 * ks + hi) * 512 + r32 * 16);
                at = __builtin_amdgcn_mfma_f32_32x32x16_bf16(a, bq, at, 0, 0, 0); }
            f32x16 o = {};
#pragma unroll
            for (int ks = 0; ks < 2; ++ks) { float m8[8];
#pragma unroll
                for (int j = 0; j < 8; ++j) { const int r = 8 * ks + j; m8[j] = (crow(r, hi) <= r32) ? at[r] : 0.f; }
                v4u pw; pw.x = cvtpk(m8[0], m8[1]); pw.y = cvtpk(m8[2], m8[3]); pw.z = cvtpk(m8[4], m8[5]); pw.w = cvtpk(m8[6], m8[7]);
                const LAS unsigned char* vb = lds + mc::VV + vt * 2048 + ks * 1024 + kt_lane_off; const s16x4 vl = vtr(vb), vh = vtr(vb + 512);
                const bf16x8 bv = (bf16x8){vl[0], vl[1], vl[2], vl[3], vh[0], vh[1], vh[2], vh[3]};
                o = __builtin_amdgcn_mfma_f32_32x32x16_bf16(__builtin_bit_cast(bf16x8, pw), bv, o, 0, 0, 0); }
#pragma unroll
            for (int r = 0; r < 16; ++r) ((LAS float*)(lds + mc::OI))[crow(r, hi) * 64 + 32 * vt + r32] = o[r];
        }
        if (n + 1 < 16) {
#pragma unroll
            for (int k = 0; k < NP; ++k) *(LAS v4u*)MC_PIECE_DST(k) = pf[k]; }
        MC_BAR();
        if (PASS2) {
#pragma unroll
            for (int i = 0; i < TPW; ++i) { const int t = TPW * wave + i; const float o = ((LAS float*)(lds + mc::OE))[t * 64 + lane] + ((LAS float*)(lds + mc::OI))[t * 64 + lane];
                const float ss = wave_sum_dpp(o * o);
                MIXED[(row0 + 32 * n + t) * DM + MX_C + hc * 64 + lane] = (bf16)f2bf(o * rsqrtf(ss * (1.0f / 64.0f) + EPS) * ong * gv[i] * DBG_C); }
        }
    }
    if (!PASS2) {
        if (wave < 2) { float* sp = SEGS + ((size_t)(unit * 2 + wave) * 2) * 16 * 64 + lane;
#pragma unroll
            for (int r = 0; r < 16; ++r) { sp[(size_t)r * 64] = S0[r]; sp[(size_t)(16 + r) * 64] = S1[r]; } }
        if (wave == 0 && th == 0) { SEGP[unit * 64 + 2 * cp] = __expf(sumtot.x); SEGP[unit * 64 + 2 * cp + 1] = __expf(sumtot.y); }
    }
    MC_BAR();
#undef MC_PIECE_SRC
#undef MC_PIECE_DST
}
#undef MC_BAR
__device__ __forceinline__ void ffn_fixup(const Ctx& p, int l, int tid) {
    const float* HG = (const float*)(p.ws + WS_HG); const float* HU = (const float*)(p.ws + WS_HU); bf16* ACT = (bf16*)(p.ws + WS_ACT);
    const float* cw = PIN(p, I_CONVW) + (size_t)l * 3 * DFF; const float* cb = PIN(p, I_CONVB) + (size_t)l * DFF;
    const int total = 512 * 2 * (DFF / 4);
    for (int idx = blockIdx.x * (NWAVES * 64) + tid; idx < total; idx += gridDim.x * (NWAVES * 64)) {
        const int c4 = idx % (DFF / 4), rr = idx / (DFF / 4), rho = rr & 1, blk = rr >> 1, ch = 4 * c4;
        const bool first = (blk % 128) == 0;
        const f32x4 z = (f32x4){0.f, 0.f, 0.f, 0.f};
        const f32x4 g0 = *(const f32x4*)(HG + ((size_t)blk * 4 + rho) * DFF + ch);
        f32x4 g1, g2;
        if (rho == 1) { g1 = *(const f32x4*)(HG + ((size_t)blk * 4 + 0) * DFF + ch); g2 = first ? z : *(const f32x4*)(HG + ((size_t)(blk - 1) * 4 + 3) * DFF + ch); }
        else { g1 = first ? z : *(const f32x4*)(HG + ((size_t)(blk - 1) * 4 + 3) * DFF + ch); g2 = first ? z : *(const f32x4*)(HG + ((size_t)(blk - 1) * 4 + 2) * DFF + ch); }
        const f32x4 up = *(const f32x4*)(HU + ((size_t)blk * 2 + rho) * DFF + ch);
        const f32x4 w0 = *(const f32x4*)(cw + ch), w1 = *(const f32x4*)(cw + DFF + ch), w2 = *(const f32x4*)(cw + 2 * DFF + ch), bb = *(const f32x4*)(cb + ch);
        f32x4 c = bb + w0 * g2 + w1 * g1 + w2 * g0;
#pragma unroll
        for (int j = 0; j < 4; ++j) c[j] = silu_f(c[j]) * up[j];
        v2u w; w.x = pk2(c[0], c[1]); w.y = pk2(c[2], c[3]);
        *(v2u*)(ACT + ((size_t)blk * 64 + rho) * DFF + ch) = w;
    }
}

constexpr int PH_PER_LAYER = 7, N_PHASES = 1 + DEPTH * PH_PER_LAYER;
__global__ void __launch_bounds__(NWAVES * 64, 2) fwd_kernel(Params args) {
    extern __shared__ __attribute__((aligned(16))) unsigned char lds_raw[];
    LAS unsigned char* lds = (LAS unsigned char*)lds_raw;
    volatile LAS unsigned* MISC = (volatile LAS unsigned*)(lds + MISC_OFF);
    volatile LAS unsigned long long* TAB = (volatile LAS unsigned long long*)(lds + TAB_OFF);
    LAS unsigned char* BKT = lds + TAB_OFF + 256;
    if (threadIdx.x < 64) MISC[threadIdx.x] = 0u;
    if (threadIdx.x == 0) {
#pragma unroll
        for (int i = 0; i < 19; ++i) TAB[i] = (unsigned long long)args.in[i];
        TAB[19] = (unsigned long long)args.out;
    }
    if (threadIdx.x >= 64 && threadIdx.x < 192) BKT[threadIdx.x - 64] = args.bucket[threadIdx.x - 64];
    __syncthreads();
    unsigned* barw = (unsigned*)(args.ws + WS_CTL) + CW_BAR + args.bar_region * XCD_BAR_WORDS;
    const int lo = args.ph_lo, hi = args.ph_hi;
    XcdBarrier bar; bar.bar = barw; bar.x = 0; bar.st = nullptr;
    if (hi - lo > 1) bar = xcd_barrier_post(barw, MISC + 8);
    const int G = gridDim.x;
#pragma nounroll
    for (int ph = lo; ph < hi; ++ph) {
        const int l = (ph - 1) / PH_PER_LAYER, k = (ph == 0) ? -1 : (ph - 1) % PH_PER_LAYER;
#ifdef DBG_DOUBLE
        const int nrep = ((ph == 0 ? 7 : k) == DBG_DOUBLE) ? 2 : 1;
#else
        const int nrep = 1;
#endif
#pragma nounroll
        for (int rep = 0; rep < nrep; ++rep) {
        int tid = threadIdx.x; asm volatile("" : "+v"(tid));
        Ctx p; p.tab = TAB; p.bucket = nullptr; { GAS unsigned char* wsg = (GAS unsigned char*)args.ws; asm volatile("" : "+s"(wsg)); p.ws = (unsigned char*)wsg; }
        const int lane = tid & 63, wave = __builtin_amdgcn_readfirstlane(tid >> 6);
        const unsigned char* wl = p.ws + WS_W + (size_t)l * W_LAYER;
        if (ph == 0) {
#ifndef NO_P0
            prologue(p, lds, wave, lane, rep == 0);
#endif
        } else if (k == 0) {
#ifndef NO_P1
            pg8::Gemm g{(const bf16*)(p.ws + WS_XB), (const bf16*)(wl + W_IN), M, INW, DM}; pg8::StaticOrder S; S.init(M, INW, G, (int)blockIdx.x);
            if (blockIdx.x >= 128 && rep == 0) { for (int z = 0; z < SKEW_P1; ++z) __builtin_amdgcn_s_sleep(127); }
            EpiInProj E{(bf16*)(p.ws + WS_PROJ), (const unsigned long long*)(p.ws + WS_SS) + (size_t)(2 * l) * M, DBG_EPI_MODE(rep)};
            pg8::gemm_phase<EpiInProj, pg8::StaticOrder, true, true>(lds, g, S, E);
#endif
        } else if (k == 1 || k == 2) {
#if !defined(NO_P2A) && !defined(NO_P2B)
            constexpr int C_LDS = mb::B_LDS_END4;
            static_assert(C_LDS + mc::LDS_END <= TAB_OFF, "mixer LDS regions");
            __syncthreads();
            if (tid == 0) { MISC[16] = 0u; MISC[17] = 0u; }
            __syncthreads();
#ifdef DBG_MIXCMP
            if (args.flags & 1) {
                if (k == 1) { for (int u = blockIdx.x; u < 256; u += G) mixer_c_pass1_simple(p, l, u, lds, wave, lane); for (int u = blockIdx.x; u < 1024; u += G) mixer_a_simple(p, l, u, lds, wave, lane); }
                else { for (int u = blockIdx.x; u < 256; u += G) mixer_c_pass2_simple(p, l, u, lds, wave, lane); for (int u = blockIdx.x; u < 512; u += G) mixer_b_simple(p, l, u, lds, wave, lane); }
            } else
#endif
            if (wave < 4) { mb::GBar gb{(LAS unsigned*)(lds + MISC_OFF + 64), 0u};
                if (k == 1) { for (int u = blockIdx.x; u < 256; u += G) mixer_c_mfma<false, 4>(p, l, u, lds + C_LDS, wave, lane, gb); }
                else { for (int u = blockIdx.x; u < 256; u += G) mixer_c_mfma<true, 4>(p, l, u, lds + C_LDS, wave, lane, gb); } }
            else { mb::GBar gb{(LAS unsigned*)(lds + MISC_OFF + 68), 0u};
                if (k == 1) { for (int u = blockIdx.x; u < 1024; u += G) mixer_a_mfma<4>(p, l, u, lds, wave - 4, lane, gb); }
                else { for (int u = blockIdx.x; u < 512; u += G) mixer_b_mfma<4>(p, l, u, lds, wave - 4, lane, gb); } }
#endif
        } else if (k == 3) {
#ifndef NO_P3
            pg8::Gemm g{(const bf16*)(p.ws + WS_MIXED), (const bf16*)(wl + W_OUT), M, DM, DM}; pg8::StaticOrder S; S.init(M, DM, G, (int)blockIdx.x);
            EpiResid E{(bf16*)(p.ws + WS_XB), nullptr, (unsigned long long*)(p.ws + WS_SS) + (size_t)(2 * l + 1) * M, rep == 0 ? 1 : 0};
            pg8::gemm_phase<EpiResid, pg8::StaticOrder, true, true>(lds, g, S, E);
#endif
        } else if (k == 4) {
#ifndef NO_P4
            pg8::Gemm g{(const bf16*)(p.ws + WS_XB), (const bf16*)(wl + W_GU), M, NGU, DM}; pg8::StaticOrder S; S.init(M, NGU, G, (int)blockIdx.x);
            if (((blockIdx.x >> 3) & 1) && rep == 0) { for (int z = 0; z < SKEW_P4; ++z) __builtin_amdgcn_s_sleep(127); }
            EpiFFN E{(bf16*)(p.ws + WS_ACT), (const unsigned long long*)(p.ws + WS_SS) + (size_t)(2 * l + 1) * M, PIN(p, I_CONVW) + (size_t)l * 3 * DFF, PIN(p, I_CONVB) + (size_t)l * DFF, (float*)(p.ws + WS_HG), (float*)(p.ws + WS_HU), DBG_EPI_MODE(rep)};
            pg8::gemm_phase<EpiFFN, pg8::StaticOrder, true, true>(lds, g, S, E);
#endif
        } else if (k == 5) {
            ffn_fixup(p, l, tid);
        } else {
#ifndef NO_P5
            pg8::Gemm g{(const bf16*)(p.ws + WS_ACT), (const bf16*)(wl + W_DN), M, DM, DFF}; pg8::StaticOrder S; S.init(M, DM, G, (int)blockIdx.x);
            EpiResid E{(bf16*)(p.ws + WS_XB), POUT(p), (unsigned long long*)(p.ws + WS_SS) + (size_t)(2 * l + 2) * M, rep != 0 ? 0 : ((l + 1 < DEPTH) ? 1 : 2)};
            pg8::gemm_phase<EpiResid, pg8::StaticOrder, true, true>(lds, g, S, E);
#endif
        }
        }
        if (ph + 1 < hi) { xcd_barrier(bar);
#ifdef DBG_EXTRA_BAR
            for (int z = 0; z < DBG_EXTRA_BAR; ++z) xcd_barrier(bar);
#endif
        }
    }
}


#if defined(DBG_NAIVE_DOWN)
__global__ void __launch_bounds__(256) dbg_down(const bf16* ACT, const float* Wd, const float* X1, float* out) {
    __shared__ float a[4][DFF];
    const int r0 = blockIdx.x * 4, c = threadIdx.x * 4;
    for (int i = threadIdx.x; i < 4 * DFF; i += 256) a[i / DFF][i % DFF] = bf2f(ACT[(size_t)(r0 + i / DFF) * DFF + i % DFF]);
    __syncthreads();
    f32x4 acc[4]; for (int r = 0; r < 4; ++r) acc[r] = (f32x4){0.f, 0.f, 0.f, 0.f};
    for (int k = 0; k < DFF; ++k) { const f32x4 w = *(const f32x4*)(Wd + (size_t)k * DM + c);
        for (int r = 0; r < 4; ++r) acc[r] += w * a[r][k]; }
    for (int r = 0; r < 4; ++r) { const size_t off = (size_t)(r0 + r) * DM + c; *(f32x4*)(out + off) = *(const f32x4*)(X1 + off) + acc[r]; }
}
#endif

#if defined(DBG_FFNCMP)
constexpr int DBG_R = 512;
__global__ void __launch_bounds__(256) dbg_gu(const float* X1, const float* g2, const float* Wg, const float* Wu, float* GU) {
    __shared__ float h[DM];
    const int r = blockIdx.x, c = blockIdx.y * 256 + threadIdx.x;
    float ss = 0.f; for (int k = threadIdx.x; k < DM; k += 256) { const float v = X1[(size_t)r * DM + k]; ss += v * v; }
    __shared__ float red[256]; red[threadIdx.x] = ss; __syncthreads();
    for (int o = 128; o > 0; o >>= 1) { if (threadIdx.x < o) red[threadIdx.x] += red[threadIdx.x + o]; __syncthreads(); }
    const float rstd = rsqrtf(red[0] / DM + EPS);
    for (int k = threadIdx.x; k < DM; k += 256) h[k] = X1[(size_t)r * DM + k] * rstd * g2[k];
    __syncthreads();
    if (c < DFF) { float a = 0.f, b = 0.f; for (int k = 0; k < DM; ++k) { a += h[k] * Wg[(size_t)k * DFF + c]; b += h[k] * Wu[(size_t)k * DFF + c]; }
        GU[((size_t)r * 2 + 0) * DFF + c] = a; GU[((size_t)r * 2 + 1) * DFF + c] = b; }
}
__global__ void __launch_bounds__(256) dbg_cmp(const float* GU, const float* cw, const float* cb, const bf16* ACT, float* acc2) {
    const int r = blockIdx.x, c = blockIdx.y * 256 + threadIdx.x; float num = 0.f, den = 0.f;
    if (c < DFF) { const float g0 = GU[((size_t)r * 2) * DFF + c], g1 = r >= 1 ? GU[((size_t)(r - 1) * 2) * DFF + c] : 0.f, g2 = r >= 2 ? GU[((size_t)(r - 2) * 2) * DFF + c] : 0.f;
#if defined(DBG_TAPS) && DBG_TAPS == 0
        const float cv = cb[c] + cw[2 * DFF + c] * g0;
#elif defined(DBG_TAPS) && DBG_TAPS == 1
        const float cv = cb[c] + cw[DFF + c] * g1 + cw[2 * DFF + c] * g0;
#else
        const float cv = cb[c] + cw[c] * g2 + cw[DFF + c] * g1 + cw[2 * DFF + c] * g0;
#endif
        const float ref = cv / (1.0f + expf(-cv)) * GU[((size_t)r * 2 + 1) * DFF + c];
        const float mine = bf2f(ACT[(size_t)r * DFF + c]);
#if DBG_FFNCMP == 2
        if ((r & 63) < 2) { num = (mine - ref) * (mine - ref); den = ref * ref; }
#elif DBG_FFNCMP == 3
        if ((r & 63) >= 2) { num = (mine - ref) * (mine - ref); den = ref * ref; }
#else
        num = (mine - ref) * (mine - ref); den = ref * ref;
#endif
    }
    __shared__ float rn[256], rd[256]; rn[threadIdx.x] = num; rd[threadIdx.x] = den; __syncthreads();
    for (int o = 128; o > 0; o >>= 1) { if (threadIdx.x < o) { rn[threadIdx.x] += rn[threadIdx.x + o]; rd[threadIdx.x] += rd[threadIdx.x + o]; } __syncthreads(); }
    if (threadIdx.x == 0) { atomicAdd(acc2, rn[0]); atomicAdd(acc2 + 1, rd[0]); }
}
__global__ void dbg_emit(const float* acc2, float* out) { out[0] = 1000.0f * sqrtf(acc2[0] / acc2[1]); }
#endif

#if defined(DBG_MIXCMP)
__global__ void __launch_bounds__(256) dbg_mixcmp(const bf16* A, const bf16* R, int c0, int c1, float* acc2) {
    float num = 0.f, den = 0.f;
    for (size_t r = blockIdx.x; r < (size_t)M; r += gridDim.x)
        for (int c = c0 + threadIdx.x; c < c1; c += 256) { const float a = bf2f(A[r * DM + c]), b = bf2f(R[r * DM + c]); num += (a - b) * (a - b); den += b * b; }
    __shared__ float rn[256], rd[256]; rn[threadIdx.x] = num; rd[threadIdx.x] = den; __syncthreads();
    for (int o = 128; o > 0; o >>= 1) { if (threadIdx.x < o) { rn[threadIdx.x] += rn[threadIdx.x + o]; rd[threadIdx.x] += rd[threadIdx.x + o]; } __syncthreads(); }
    if (threadIdx.x == 0) { atomicAdd(acc2, rn[0]); atomicAdd(acc2 + 1, rd[0]); }
}
__global__ void dbg_emit2(const float* acc2, float* out) { out[0] = 1000.0f * sqrtf(acc2[0] / acc2[1]); }
#endif
#if defined(DBG_TIMEC)
__global__ void dbg_emit3(const float* dv, float* out) { out[0] = 10.0f * (floorf(log2f(dv[4]) * 4.0f) * 0.25f - 8.0f); }
#endif
#ifndef MK_PER_PHASE
#define MK_PER_PHASE 0
#endif
extern "C" void kernel_launch(void* const* d_in, const int* in_sizes, int n_in, void* d_out, int out_size, void* d_ws, size_t ws_size, hipStream_t stream) {
    static int grid = 0;
    if (grid == 0) {
        if (n_in != 19 || in_sizes[0] != M * DM || out_size != M * DM || ws_size < WS_END) { fprintf(stderr, "kernel_launch: unexpected shapes (n_in %d, in0 %d, out %d, ws %zu)\n", n_in, n_in > 0 ? in_sizes[0] : -1, out_size, ws_size); grid = -1; return; }
        int dev = 0, cus = 0;
        if (hipGetDevice(&dev) != hipSuccess || hipDeviceGetAttribute(&cus, hipDeviceAttributeMultiprocessorCount, dev) != hipSuccess) { grid = -1; return; }
        if (hipFuncSetAttribute((const void*)fwd_kernel, hipFuncAttributeMaxDynamicSharedMemorySize, LDS_BYTES) != hipSuccess) { fprintf(stderr, "kernel_launch: hipFuncSetAttribute failed\n"); grid = -1; return; }
        int per_cu = 0;
        if (hipOccupancyMaxActiveBlocksPerMultiprocessor(&per_cu, (const void*)fwd_kernel, NWAVES * 64, LDS_BYTES) != hipSuccess || per_cu < 1) { fprintf(stderr, "kernel_launch: occupancy query reports %d blocks per CU\n", per_cu); }
        (void)hipGetLastError();
        grid = cus < 256 ? cus : 256;
    }
    if (grid < 0) return;
    (void)hipMemsetAsync((char*)d_ws + WS_CTL, 0, CTL_ZERO_BYTES, stream);
    Params a{};
    for (int i = 0; i < 19; ++i) a.in[i] = (const float*)d_in[i];
    a.out = (float*)d_out; a.ws = (unsigned char*)d_ws;
    for (int n = 0; n < 128; ++n) {
        int bkt;
        if (n < 16) bkt = n; else { const float v = logf((float)n / 16.0f) / (float)log(128.0 / 16.0) * 16.0f; bkt = 16 + (int)v; if (bkt > 31) bkt = 31; }
        a.bucket[n] = (unsigned char)bkt;
    }
#if MK_PER_PHASE
    for (int ph = 0; ph < N_PHASES; ++ph) { a.ph_lo = ph; a.ph_hi = ph + 1; hipLaunchKernelGGL(fwd_kernel, dim3(grid), dim3(NWAVES * 64), LDS_BYTES, stream, a); }
#elif defined(DBG_MIXCMP)
    { float* acc2 = (float*)((char*)d_ws + WS_TAB + 65536); (void)hipMemsetAsync(acc2, 0, 8, stream);
      a.ph_lo = 0; a.ph_hi = 4; a.flags = 1; a.bar_region = 0;
      hipLaunchKernelGGL(fwd_kernel, dim3(grid), dim3(NWAVES * 64), LDS_BYTES, stream, a);
      (void)hipMemcpyAsync((char*)d_ws + WS_X1, (char*)d_ws + WS_MIXED, (size_t)M * DM * 2, hipMemcpyDeviceToDevice, stream);
      (void)hipMemsetAsync((char*)d_ws + WS_MIXED, 0, (size_t)M * DM * 2, stream);
      a.ph_lo = 2; a.ph_hi = 4; a.flags = 0; a.bar_region = 1;
      hipLaunchKernelGGL(fwd_kernel, dim3(grid), dim3(NWAVES * 64), LDS_BYTES, stream, a);
      const int c0 = (DBG_MIXCMP == 1) ? 0 : (DBG_MIXCMP == 2) ? 256 : 768, c1 = (DBG_MIXCMP == 1) ? 256 : (DBG_MIXCMP == 2) ? 768 : 1024;
      hipLaunchKernelGGL(dbg_mixcmp, dim3(1024), dim3(256), 0, stream, (const bf16*)((char*)d_ws + WS_MIXED), (const bf16*)((char*)d_ws + WS_X1), c0, c1, acc2);
      (void)hipMemcpyAsync(d_out, d_in[0], (size_t)M * DM * 4, hipMemcpyDeviceToDevice, stream);
      hipLaunchKernelGGL(dbg_emit2, dim3(1), dim3(1), 0, stream, (const float*)acc2, (float*)d_out); }
#elif defined(DBG_TIMEC)
    a.ph_lo = 0; a.ph_hi = N_PHASES;
    hipLaunchKernelGGL(fwd_kernel, dim3(grid), dim3(NWAVES * 64), LDS_BYTES, stream, a);
    (void)hipMemcpyAsync(d_out, d_in[0], (size_t)M * DM * 4, hipMemcpyDeviceToDevice, stream);
    hipLaunchKernelGGL(dbg_emit3, dim3(1), dim3(1), 0, stream, (const float*)((char*)d_ws + WS_TAB + 65536), (float*)d_out);
#elif defined(DBG_NAIVE_DOWN)
    a.ph_lo = 0; a.ph_hi = 7;
    hipLaunchKernelGGL(fwd_kernel, dim3(grid), dim3(NWAVES * 64), LDS_BYTES, stream, a);
    hipLaunchKernelGGL(dbg_down, dim3(M / 4), dim3(256), 0, stream, (const bf16*)((char*)d_ws + WS_ACT), (const float*)d_in[I_WDOWN], (const float*)((char*)d_ws + WS_X1), (float*)d_out);
#elif defined(DBG_FFNCMP)
    a.ph_lo = 0; a.ph_hi = 7;
    hipLaunchKernelGGL(fwd_kernel, dim3(grid), dim3(NWAVES * 64), LDS_BYTES, stream, a);
    { float* GU = (float*)d_out + (size_t)16 * 1024 * 1024; float* acc2 = (float*)((char*)d_ws + WS_TAB + 65536);
      (void)hipMemsetAsync(acc2, 0, 8, stream);
      hipLaunchKernelGGL(dbg_gu, dim3(DBG_R, 11), dim3(256), 0, stream, (const float*)((char*)d_ws + WS_X1), (const float*)d_in[I_N2G], (const float*)d_in[I_WGATE], (const float*)d_in[I_WUP], GU);
      hipLaunchKernelGGL(dbg_cmp, dim3(DBG_R, 11), dim3(256), 0, stream, (const float*)GU, (const float*)d_in[I_CONVW], (const float*)d_in[I_CONVB], (const bf16*)((char*)d_ws + WS_ACT), acc2);
      (void)hipMemcpyAsync(d_out, d_in[0], (size_t)M * DM * 4, hipMemcpyDeviceToDevice, stream);
      hipLaunchKernelGGL(dbg_emit, dim3(1), dim3(1), 0, stream, (const float*)acc2, (float*)d_out); }
#elif defined(DBG_STOP)
    a.ph_lo = 0; a.ph_hi = DBG_STOP + 1;
    hipLaunchKernelGGL(fwd_kernel, dim3(grid), dim3(NWAVES * 64), LDS_BYTES, stream, a);
    { const int k = (DBG_STOP == 0) ? -1 : (DBG_STOP - 1) % PH_PER_LAYER;
      const float* src = (DBG_STOP == 0) ? (const float*)d_in[0] : ((k >= 3 && k <= 5) ? (const float*)((char*)d_ws + WS_X1) : nullptr);
      if (src) (void)hipMemcpyAsync(d_out, src, (size_t)M * DM * 4, hipMemcpyDeviceToDevice, stream); }
#else
    a.ph_lo = 0; a.ph_hi = N_PHASES;
    hipLaunchKernelGGL(fwd_kernel, dim3(grid), dim3(NWAVES * 64), LDS_BYTES, stream, a);
#endif
    const hipError_t le = hipPeekAtLastError();
    if (le != hipSuccess) fprintf(stderr, "kernel_launch: launch failed: %s\n", hipGetErrorName(le));
}
```

```cpp
#include <hip/hip_runtime.h>
#include <cstdio>
#include <cstdint>
#include <cmath>
#define NOPK 1
namespace pg8 {
#define PG8_LAS __attribute__((address_space(3)))
typedef unsigned short bf16_t;
typedef short bf16x8 __attribute__((ext_vector_type(8)));
typedef float f32x4 __attribute__((ext_vector_type(4)));
typedef unsigned u32x4 __attribute__((ext_vector_type(4)));
constexpr int BM = 256, BK = 64, HALF = 128, HTB = HALF * BK * 2  , STAGE_BYTES = 8 * HTB, NXCD = 8, WGM = 8;

__host__ __device__ __forceinline__ int lds_byte(int r, int c) { const int st = (r >> 4) * 2 + (c >> 5), rr = r & 15, cc = c & 31, ob = rr * 64 + cc * 2; return st * 1024 + (ob ^ (((ob >> 9) & 1) << 5)); }
__host__ __device__ __forceinline__ void stage_rc(int b, int& R, int& C) { const int st = b / 1024, sb = b % 1024, swz = sb ^ (((sb >> 9) & 1) << 5); R = (st >> 1) * 16 + swz / 64; C = (st & 1) * 32 + (swz % 64) / 2; }
__host__ __device__ __forceinline__ int perm32(int rho) { const int n = rho >> 4, i = rho & 15; return 8 * (i >> 2) + 4 * n + (i & 3); }

struct Unit { int pm, pn; };
struct Gemm { const bf16_t* A; const bf16_t* Bt; int M, N, K; int preb; int wv; };

struct StaticOrder {
    int nM, nN, nwg, G, c;
    __host__ __device__ __forceinline__ void init(int M, int N, int G_, int c_) { nM = M / BM; nN = N / BM; nwg = nM * nN; G = G_; c = c_; }
    __host__ __device__ __forceinline__ bool next(int i, Unit& u) const {
        const int L = i * G + c; if (L >= nwg) return false;
        int wgid = L; { const int q = nwg / NXCD, r = nwg % NXCD, xcd = wgid % NXCD, off = wgid / NXCD; wgid = (xcd < r ? xcd * (q + 1) : r * (q + 1) + (xcd - r) * q) + off; }
        const int nig = WGM * nN, gid = wgid / nig, fm = gid * WGM, gsz = (nM - fm) < WGM ? (nM - fm) : WGM;
        u.pm = fm + ((wgid % nig) % gsz); u.pn = (wgid % nig) / gsz; return true;
    }
    __device__ __forceinline__ void a_ready(const Unit&) const {}
    __device__ __forceinline__ void done(const Unit&) const {}
};

__device__ __forceinline__ unsigned cvt_pk_bf16(float lo, float hi) { unsigned r; asm volatile("v_cvt_pk_bf16_f32 %0, %1, %2" : "=v"(r) : "v"(lo), "v"(hi)); return r; }
typedef float f32x2 __attribute__((ext_vector_type(2)));
__device__ __forceinline__ f32x2 gelu_pk(f32x2 v) {
    const f32x2 av = __builtin_elementwise_abs(v), d = av * 0.2316418882f + 1.0f;
    f32x2 t; t.x = __builtin_amdgcn_rcpf(d.x); t.y = __builtin_amdgcn_rcpf(d.y);
    f32x2 q = t * 0.5307027145f + (-0.7265760135f); q = q * t + 0.7107068705f; q = q * t + (-0.142248368f); q = q * t + 0.127414796f; q = q * t;
    const f32x2 s = (v * v) * (-0.72134752044f);
    f32x2 e; e.x = __builtin_amdgcn_exp2f(s.x); e.y = __builtin_amdgcn_exp2f(s.y);
    const f32x2 m = v * (q * e), r = v - m;
    f32x2 o; o.x = v.x < 0.f ? m.x : r.x; o.y = v.y < 0.f ? m.y : r.y; return o;
}

#define PG8_ZERO4(x) do { f32x2 _z0, _z1; asm volatile("v_mov_b64 %0, 0\n\tv_mov_b64 %1, 0" : "=v"(_z0), "=v"(_z1)); (x) = (f32x4){_z0[0], _z0[1], _z1[0], _z1[1]}; } while (0)
template <class Epi, class Sched, bool ALIGN_EPI = false, bool SP2 = false>
__device__ __forceinline__ void gemm_phase(PG8_LAS unsigned char* lds, const Gemm g, const Sched& S, const Epi& E) {
    int tid_l = threadIdx.x; asm volatile("" : "+v"(tid_l));
    const int tid = tid_l, wid = __builtin_amdgcn_readfirstlane(tid >> 6), lane = tid & 63, wr = wid >> 2, wc = wid & 3, fr = lane & 15, fq = lane >> 4;
    const int K = g.K, nt = K / BK;
    unsigned voffA[2], voffB[2];
#pragma unroll
    for (int i = 0; i < 2; ++i) { int R, C; stage_rc(tid * 16 + i * 8192, R, C); const int Rb = Epi::PERM ? ((R & ~31) + perm32(R & 31)) : R;
        const int Ra = Epi::APERM ? ((R & ~63) | (4 * (R & 15) + ((R >> 4) & 3))) : R;
        voffA[i] = (unsigned)(Ra * K + C) * 2u; voffB[i] = (unsigned)(Rb * K + C) * 2u; }
    const size_t kstep = (size_t)(BK * 2);
    const size_t hstep = (size_t)HALF * K * 2;
    const size_t tstep = 2 * hstep;
    const unsigned ldsw = (unsigned)wid * 1024u;
    const int aoff = lds_byte(wr * 64 + fr, fq * 8), boff = lds_byte(wc * 32 + fr, fq * 8);
#define PG8_SA(b, h) (((b) * 2 + (h)) * HTB)
#define PG8_SB(b, h) ((4 + (b) * 2 + (h)) * HTB)
#define PG8_STAGE(bufoff, gbase, voff) do { _Pragma("unroll") for (int _i = 0; _i < 2; ++_i) \
        __builtin_amdgcn_global_load_lds((const unsigned*)((const char*)(gbase) + (voff)[_i]), (PG8_LAS unsigned*)(lds + (bufoff) + ldsw + _i * 8192), 16, 0, 0); } while (0)
#define PG8_LDA(dst, b, h) do { _Pragma("unroll") for (int m = 0; m < 4; ++m) _Pragma("unroll") for (int k = 0; k < 2; ++k) dst[m][k] = *(const PG8_LAS bf16x8*)(lds + PG8_SA(b, h) + aoff + m * 2048 + k * 1024); } while (0)
#define PG8_LDB(dst, b, h) do { _Pragma("unroll") for (int n = 0; n < 2; ++n) _Pragma("unroll") for (int k = 0; k < 2; ++k) dst[n][k] = *(const PG8_LAS bf16x8*)(lds + PG8_SB(b, h) + boff + n * 2048 + k * 1024); } while (0)
#define PG8_MMA(ai, bj, At, Bt) do { __builtin_amdgcn_s_setprio(1); _Pragma("unroll") for (int m = 0; m < 4; ++m) _Pragma("unroll") for (int n = 0; n < 2; ++n) _Pragma("unroll") for (int k = 0; k < 2; ++k) \
        acc[ai][bj][m][n] = __builtin_amdgcn_mfma_f32_16x16x32_bf16(Bt[n][k], At[m][k], acc[ai][bj][m][n], 0, 0, 0); __builtin_amdgcn_s_setprio(0); } while (0)
#define PG8_WAIT_V(n) asm volatile("s_waitcnt vmcnt(" #n ")" ::: "memory")
#define PG8_WAIT_VN(n) asm volatile("s_waitcnt vmcnt(%0)" :: "n"(n) : "memory")
#define PG8_WAIT_L(n) asm volatile("s_waitcnt lgkmcnt(" #n ")" ::: "memory")
#define PG8_BAR __builtin_amdgcn_s_barrier()
#define PG8_SCHED __builtin_amdgcn_sched_barrier(0)
    Unit cur{0, 0}, nxt{0, 0}; int ui = 0;
    if (!S.next(0, cur)) return;
    f32x4 acc[2][2][4][2];
#pragma unroll
    for (int a = 0; a < 2; ++a)
#pragma unroll
        for (int b = 0; b < 2; ++b)
#pragma unroll
            for (int m = 0; m < 4; ++m)
#pragma unroll
                for (int n = 0; n < 2; ++n) PG8_ZERO4(acc[a][b][m][n]);
    bf16x8 At[4][2], B0[2][2], B1[2][2];
    const char* cA = (const char*)g.A + (size_t)cur.pm * tstep; const char* cB = (const char*)g.Bt + (size_t)cur.pn * tstep;
    S.a_ready(cur);
    if constexpr (SP2) {
        if (g.preb) {
            PG8_STAGE(PG8_SA(0, 0), cA, voffA); PG8_STAGE(PG8_SA(0, 1), cA + hstep, voffA);
            if (wr == 1) PG8_BAR;
            PG8_WAIT_V(2); PG8_BAR;
            PG8_STAGE(PG8_SA(1, 0), cA + kstep, voffA);
            PG8_WAIT_V(2); PG8_BAR;
        } else {
        PG8_STAGE(PG8_SB(0, 0), cB, voffB); PG8_STAGE(PG8_SB(0, 1), cB + hstep, voffB); PG8_STAGE(PG8_SA(0, 0), cA, voffA); PG8_STAGE(PG8_SA(0, 1), cA + hstep, voffA);
        if (wr == 1) PG8_BAR;
        PG8_WAIT_V(2); PG8_BAR;
        PG8_STAGE(PG8_SB(1, 0), cB + kstep, voffB); PG8_STAGE(PG8_SA(1, 0), cA + kstep, voffA); PG8_STAGE(PG8_SB(1, 1), cB + hstep + kstep, voffB);
        PG8_WAIT_V(6); PG8_BAR;
        }
    } else {
        PG8_STAGE(PG8_SB(0, 0), cB, voffB); PG8_STAGE(PG8_SA(0, 0), cA, voffA); PG8_STAGE(PG8_SB(0, 1), cB + hstep, voffB); PG8_STAGE(PG8_SA(0, 1), cA + hstep, voffA);
        if (wr == 1) PG8_BAR;
        PG8_WAIT_V(4); PG8_BAR;
        PG8_STAGE(PG8_SB(1, 0), cB + kstep, voffB); PG8_STAGE(PG8_SA(1, 0), cA + kstep, voffA); PG8_STAGE(PG8_SB(1, 1), cB + hstep + kstep, voffB);
        PG8_WAIT_V(6); PG8_BAR;
    }
    for (;;) {
        const bool has_next = S.next(ui + 1, nxt);
        const char* nA = has_next ? (const char*)g.A + (size_t)nxt.pm * tstep : cA; const char* nB = has_next ? (const char*)g.Bt + (size_t)nxt.pn * tstep : cB;
        typename Epi::Pre pre;
        for (int t = 0; t < nt; t += 2) {
            const bool last = (t == nt - 2);
            const char* a1 = cA + (size_t)(t + 1) * kstep;
            const char* a2 = last ? nA : cA + (size_t)(t + 2) * kstep; const char* b2 = last ? nB : cB + (size_t)(t + 2) * kstep;
            const char* a3 = a2 + kstep; const char* b3 = b2 + kstep;
            if (last && has_next) S.a_ready(nxt);
            if constexpr (SP2) {
            PG8_LDB(B0, 0, 0); PG8_LDB(B1, 0, 1); PG8_SCHED; PG8_LDA(At, 0, 0); PG8_STAGE(PG8_SA(1, 1), a1 + hstep, voffA);
            if (Epi::NPRE > 0 && last) { pre = E.preload(cur, wr, wc, fr, fq); PG8_WAIT_VN(8 + Epi::NPRE); } else PG8_WAIT_V(8);
            PG8_WAIT_L(0); PG8_BAR; PG8_MMA(0, 0, At, B0); PG8_MMA(0, 1, At, B1); PG8_BAR; PG8_SCHED;
            PG8_LDA(At, 0, 1); PG8_STAGE(PG8_SB(0, 0), b2, voffB); PG8_STAGE(PG8_SB(0, 1), b2 + hstep, voffB); PG8_STAGE(PG8_SA(0, 0), a2, voffA);
            if (Epi::NPRE > 0 && last) PG8_WAIT_VN(8 + Epi::NPRE); else PG8_WAIT_V(8);
            PG8_WAIT_L(0); PG8_BAR; PG8_MMA(1, 0, At, B0); PG8_MMA(1, 1, At, B1); PG8_BAR; PG8_SCHED;
            PG8_LDB(B0, 1, 0); PG8_LDB(B1, 1, 1); PG8_SCHED; PG8_LDA(At, 1, 0); PG8_STAGE(PG8_SA(0, 1), a2 + hstep, voffA);
            if (Epi::NPRE > 0 && last) PG8_WAIT_VN(8 + Epi::NPRE); else PG8_WAIT_V(8);
            PG8_WAIT_L(0); PG8_BAR; PG8_MMA(0, 0, At, B0); PG8_MMA(0, 1, At, B1); PG8_BAR; PG8_SCHED;
            PG8_LDA(At, 1, 1); PG8_STAGE(PG8_SB(1, 0), b3, voffB); PG8_STAGE(PG8_SB(1, 1), b3 + hstep, voffB); PG8_STAGE(PG8_SA(1, 0), a3, voffA);
            PG8_WAIT_V(8); PG8_WAIT_L(0); PG8_BAR; PG8_MMA(1, 0, At, B0); PG8_MMA(1, 1, At, B1); PG8_BAR; PG8_SCHED;
            } else {
            PG8_LDB(B0, 0, 0); PG8_SCHED; PG8_LDA(At, 0, 0); PG8_STAGE(PG8_SA(1, 1), a1 + hstep, voffA);
            PG8_WAIT_L(8); PG8_BAR; PG8_WAIT_L(0); PG8_MMA(0, 0, At, B0); PG8_BAR; PG8_SCHED;
            PG8_LDB(B1, 0, 1); PG8_STAGE(PG8_SB(0, 0), b2, voffB);
            PG8_BAR; PG8_WAIT_L(0); PG8_MMA(0, 1, At, B1); PG8_BAR;
            PG8_LDA(At, 0, 1); PG8_STAGE(PG8_SA(0, 0), a2, voffA);
            PG8_BAR; PG8_WAIT_L(0); PG8_MMA(1, 0, At, B0); PG8_BAR; PG8_SCHED;
            PG8_STAGE(PG8_SB(0, 1), b2 + hstep, voffB);
            PG8_WAIT_V(6); PG8_BAR; PG8_MMA(1, 1, At, B1); PG8_BAR;
            PG8_LDB(B0, 1, 0); PG8_SCHED; PG8_LDA(At, 1, 0); PG8_STAGE(PG8_SA(0, 1), a2 + hstep, voffA);
            PG8_WAIT_L(8); PG8_BAR; PG8_WAIT_L(0); PG8_MMA(0, 0, At, B0); PG8_BAR; PG8_SCHED;
            PG8_LDB(B1, 1, 1); PG8_STAGE(PG8_SB(1, 0), b3, voffB);
            PG8_BAR; PG8_WAIT_L(0); PG8_MMA(0, 1, At, B1); PG8_BAR;
            PG8_LDA(At, 1, 1); PG8_STAGE(PG8_SA(1, 0), a3, voffA);
            PG8_BAR; PG8_WAIT_L(0); PG8_MMA(1, 0, At, B0); PG8_BAR; PG8_SCHED;
            PG8_STAGE(PG8_SB(1, 1), b3 + hstep, voffB);
            PG8_WAIT_V(6); PG8_BAR; PG8_MMA(1, 1, At, B1); PG8_BAR;
            }
        }
        if constexpr (ALIGN_EPI) { if (wr == 0) PG8_BAR; }
        if constexpr (!Epi::AFTER_DRAIN) { E(acc, cur, wr, wc, fr, fq, pre); S.done(cur); }
        if (!has_next) break;
#pragma unroll
        for (int a = 0; a < 2; ++a)
#pragma unroll
            for (int b = 0; b < 2; ++b)
#pragma unroll
                for (int m = 0; m < 4; ++m)
#pragma unroll
                    for (int n = 0; n < 2; ++n) PG8_ZERO4(acc[a][b][m][n]);
        cur = nxt; cA = nA; cB = nB; ++ui;
        if constexpr (ALIGN_EPI) { if (wr == 1) PG8_BAR; }
    }
    PG8_WAIT_V(0);
    if constexpr (!ALIGN_EPI) { if (wr == 0) PG8_BAR; }
    PG8_BAR;
    if constexpr (Epi::AFTER_DRAIN) { E.fused(acc, cur, wr, wc, fr, fq, lds, wid, lane); S.done(cur); }
#undef PG8_SA
#undef PG8_SB
#undef PG8_STAGE
#undef PG8_LDA
#undef PG8_LDB
#undef PG8_MMA
#undef PG8_WAIT_V
#undef PG8_WAIT_VN
#undef PG8_WAIT_L
#undef PG8_BAR
#undef PG8_SCHED
}
__device__ __forceinline__ void gemm_prefetch_b(PG8_LAS unsigned char* lds, const bf16_t* Bt, int K, int pn, int wv) {
    int tid_l = threadIdx.x; asm volatile("" : "+v"(tid_l));
    const int tid = tid_l, wid = __builtin_amdgcn_readfirstlane(tid >> 6);
    const size_t hstep = (size_t)HALF * K * 2, kstep = (size_t)(BK * 2);
    const char* cB = (const char*)Bt + (size_t)pn * 2 * hstep;
    const unsigned ldsw = (unsigned)wid * 1024u;
#pragma unroll
    for (int i = 0; i < 2; ++i) { int R, C; stage_rc(tid * 16 + i * 8192, R, C); const int Rb = (R & ~31) + perm32(R & 31); const unsigned voff = (unsigned)(Rb * K + C) * 2u;
#pragma unroll
        for (int b = 0; b < 2; ++b)
#pragma unroll
            for (int h = 0; h < 2; ++h)
                __builtin_amdgcn_global_load_lds((const unsigned*)(cB + (size_t)b * kstep + (size_t)h * hstep + voff), (PG8_LAS unsigned*)(lds + (4 + b * 2 + h) * HTB + ldsw + i * 8192), 16, 0, 0); }
}
}

constexpr int NWAVES = 8;
constexpr int BATCH = 4, SEQ = 8192, DM = 1024, DEPTH = 2;
constexpr int M = BATCH * SEQ;
constexpr int INW = 2304, DFF = 2816, NGU = 2 * DFF;
constexpr float EPS = 1e-6f;
constexpr int C_AU = 0, C_AV = 256, C_BQ = 512, C_BK = 1024, C_BV = 1152, C_CQ = 1280, C_CF = 1536, C_CI = 1792, C_CG = 2048;
constexpr int MX_A = 0, MX_B = 256, MX_C = 768;

constexpr size_t MiB = 1u << 20;
constexpr size_t WS_CTL = 0, CTL_ZERO_BYTES = 2 * MiB;
constexpr size_t WS_TAB = 2 * MiB;
constexpr size_t WS_SS = 1 * MiB;
constexpr size_t WS_SEGS = 4 * MiB;
constexpr size_t WS_SEGP = 8 * MiB;
constexpr size_t WS_HG = 10 * MiB;
constexpr size_t WS_HU = 32 * MiB;
constexpr size_t WS_W = 44 * MiB, W_LAYER = 24 * MiB;
constexpr size_t W_IN = 0, W_OUT = 5 * MiB, W_GU = 7 * MiB, W_DN = 18 * MiB;
constexpr size_t WS_XB = 92 * MiB;
constexpr size_t WS_X1 = 156 * MiB;
constexpr size_t WS_PROJ = 284 * MiB;
constexpr size_t WS_MIXED = 428 * MiB;
constexpr size_t WS_ACT = 284 * MiB;
constexpr size_t WS_END = 492 * MiB;
static_assert((size_t)INW * DM * 2 <= W_OUT - W_IN && (size_t)DM * DM * 2 <= W_GU - W_OUT && (size_t)NGU * DM * 2 <= W_DN - W_GU && W_DN + (size_t)DM * DFF * 2 <= W_LAYER, "weight map");
static_assert(WS_ACT + (size_t)M * DFF * 2 <= WS_END && WS_MIXED + (size_t)M * DM * 2 <= WS_END && WS_PROJ + (size_t)M * INW * 2 <= WS_MIXED, "activation map");
static_assert(WS_HG + (size_t)512 * 4 * DFF * 4 <= WS_HU && WS_HU + (size_t)512 * 2 * DFF * 4 <= WS_W, "halo map");
constexpr int CW_BAR = 4096;

constexpr int LDS_BYTES = 147456;
constexpr int MISC_OFF = LDS_BYTES - 256;

#define GAS __attribute__((address_space(1)))
#define LAS __attribute__((address_space(3)))
typedef unsigned short bf16;
typedef unsigned v4u __attribute__((ext_vector_type(4)));
typedef unsigned v2u __attribute__((ext_vector_type(2)));
typedef float f32x4 __attribute__((ext_vector_type(4)));
typedef float f32x2 __attribute__((ext_vector_type(2)));
#define RLX_AGENT __ATOMIC_RELAXED, __HIP_MEMORY_SCOPE_AGENT
#define LDS_WAIT() asm volatile("s_waitcnt lgkmcnt(0)" ::: "memory")
__device__ __forceinline__ unsigned f2bf(float f) { unsigned u = __builtin_bit_cast(unsigned, f); return (u + 0x7fffu + ((u >> 16) & 1u)) >> 16; }
__device__ __forceinline__ unsigned pk2(float lo, float hi) { return f2bf(lo) | (f2bf(hi) << 16); }
__device__ __forceinline__ float bf2f(unsigned short h) { return __builtin_bit_cast(float, (unsigned)h << 16); }
__device__ __forceinline__ float bflo(unsigned w) { return __builtin_bit_cast(float, w << 16); }
__device__ __forceinline__ float bfhi(unsigned w) { return __builtin_bit_cast(float, w & 0xffff0000u); }
__device__ __forceinline__ float silu_f(float v) { return v * __builtin_amdgcn_rcpf(1.0f + __builtin_amdgcn_exp2f(v * -1.4426950408889634f)); }
__device__ __forceinline__ float wave_sum(float v) {
#pragma unroll
    for (int o = 1; o < 64; o <<= 1) v += __shfl_xor(v, o);
    return v;
}
#define XB_TMO      128
#define XB_XCNT(j)  (256  + 64 * (j))
#define XB_XSUB(j)  (1280 + 64 * (j))
#define XB_XGEN(j)  (2304 + 64 * (j))
#define XB_TOP      3328
#define XB_TOPGEN   3392
#define XCD_BAR_WORDS 3456
#define XB_SPIN_CAP (1u << 18)

__device__ __forceinline__ unsigned xb_ld(unsigned* p)              { return __hip_atomic_load(p, __ATOMIC_RELAXED, __HIP_MEMORY_SCOPE_AGENT); }
__device__ __forceinline__ unsigned xb_add(unsigned* p, unsigned v) { return __hip_atomic_fetch_add(p, v, __ATOMIC_RELAXED, __HIP_MEMORY_SCOPE_AGENT); }
__device__ __forceinline__ unsigned xb_xcc_id() { return (unsigned)__builtin_amdgcn_s_getreg((3 << 11) | 20) & 0xFu; }
#define XB_SPIN(cond, bar) do { unsigned _sp = 0; while (cond) { __builtin_amdgcn_s_sleep(1); \
    if ((++_sp & 255u) == 0u) { if (xb_ld(&(bar)[XB_TMO])) break; if (_sp > XB_SPIN_CAP) { atomicAdd(&(bar)[XB_TMO], 1u); break; } } } } while (0)

struct XcdBarrier {
    unsigned* bar; unsigned x;
    int wv;
    volatile LAS unsigned* st;
};

__device__ __forceinline__ XcdBarrier xcd_barrier_post(unsigned* bar, volatile LAS unsigned* st) {
    XcdBarrier b; b.bar = bar; b.x = xb_xcc_id(); b.st = st; b.wv = 0;
    if (threadIdx.x == 0) (void)xb_add(&bar[XB_XCNT(b.x)], 1u);
    return b;
}
__device__ __forceinline__ void xcd_barrier_complete(unsigned* bar, unsigned x, unsigned& nloc, unsigned& nx) {
    const unsigned G = gridDim.x * gridDim.y * gridDim.z;
    unsigned sum, cnt, mine, sp = 0u;
    for (;;) {
        sum = 0u; cnt = 0u; mine = 0u;
#pragma nounroll
        for (unsigned j = 0; j < 16; ++j) { const unsigned c = xb_ld(&bar[XB_XCNT(j)]); sum += c; cnt += (c > 0u) ? 1u : 0u; mine = (j == x) ? c : mine; }
        if (sum == G) break;
        __builtin_amdgcn_s_sleep(1);
        if ((++sp & 255u) == 0u) { if (xb_ld(&bar[XB_TMO])) break; if (sp > XB_SPIN_CAP) { atomicAdd(&bar[XB_TMO], 1u); break; } }
    }
    nloc = mine > 0u ? mine : 1u; nx = cnt > 0u ? cnt : 1u;
}

__device__ __forceinline__ void xcd_barrier_head() {
    asm volatile("s_waitcnt vmcnt(0)" ::: "memory");
    __syncthreads();
}
__device__ __forceinline__ void xcd_barrier_tail(const XcdBarrier& b) {
    if (threadIdx.x == 0) {
        unsigned* bar = b.bar;
        __builtin_amdgcn_s_waitcnt(0);
        unsigned nloc = b.st[0], nx = b.st[1];
        if (nloc == 0u) { xcd_barrier_complete(bar, b.x, nloc, nx); b.st[0] = nloc; b.st[1] = nx; }
        const unsigned old = xb_add(&bar[XB_XSUB(b.x)], 1u);
        const unsigned gen = old / nloc;
        if (old + 1u == (gen + 1u) * nloc) {
            __builtin_amdgcn_fence(__ATOMIC_RELEASE, "agent");
            asm volatile("s_waitcnt vmcnt(0)" ::: "memory");
            const unsigned og = xb_add(&bar[XB_TOP], 1u);
            const unsigned tg = og / nx;
            if (og + 1u == (tg + 1u) * nx) xb_add(&bar[XB_TOPGEN], 1u);
            else XB_SPIN(xb_ld(&bar[XB_TOPGEN]) == tg, bar);
            __builtin_amdgcn_fence(__ATOMIC_ACQUIRE, "agent");
            xb_add(&bar[XB_XGEN(b.x)], 1u);
            asm volatile("s_waitcnt vmcnt(0)" ::: "memory");
        } else {
            XB_SPIN(xb_ld(&bar[XB_XGEN(b.x)]) == gen, bar);
            __builtin_amdgcn_fence(__ATOMIC_ACQUIRE, "agent");
            asm volatile("s_waitcnt vmcnt(0)" ::: "memory");
        }
    }
    asm volatile("s_waitcnt vmcnt(0)" ::: "memory");
    __syncthreads();
}
__device__ __forceinline__ void xcd_barrier(const XcdBarrier& b) { xcd_barrier_head(); xcd_barrier_tail(b); }


#ifndef DBG_MIX
#define DBG_MIX 7
#endif
#ifdef DBG_NULL_EPI
#define DBG_EPI_MODE(rep) ((rep) == 0 ? 1 : DBG_NULL_EPI == 2 ? 2 : 0)
#else
#define DBG_EPI_MODE(rep) 1
#endif
#ifndef SKEW_P4
#define SKEW_P4 0
#endif
#ifndef SKEW_P1
#define SKEW_P1 0
#endif
#ifndef DBG_REP_C1
#define DBG_REP_C1 1
#endif
#ifndef DBG_REP_C2
#define DBG_REP_C2 1
#endif
#ifndef DBG_REP_B
#define DBG_REP_B 1
#endif
#define DBG_A ((DBG_MIX & 1) ? 1.0f : 0.0f)
#define DBG_B ((DBG_MIX & 2) ? 1.0f : 0.0f)
#define DBG_C ((DBG_MIX & 4) ? 1.0f : 0.0f)
typedef float mb_f32x2_t __attribute__((ext_vector_type(2))); typedef __bf16 mb_bf16x2_t __attribute__((ext_vector_type(2)));
__device__ __forceinline__ unsigned mb_cvtpk(float lo, float hi) { mb_f32x2_t v = {lo, hi}; mb_bf16x2_t b = __builtin_convertvector(v, mb_bf16x2_t); return __builtin_bit_cast(unsigned, b); }
struct Params { const float* in[19]; float* out; unsigned char* ws; int ph_lo, ph_hi; int flags, bar_region; unsigned char bucket[128]; };

struct Ctx { volatile LAS unsigned long long* tab; unsigned char* ws; const unsigned char* bucket; };
constexpr int TAB_OFF = LDS_BYTES - 1024;
__device__ __forceinline__ const float* tab_ptr(const Ctx& c, int i) {
    const unsigned long long v = c.tab[i];
    const unsigned lo = (unsigned)__builtin_amdgcn_readfirstlane((int)(unsigned)v), hi = (unsigned)__builtin_amdgcn_readfirstlane((int)(unsigned)(v >> 32));
    return (const float*)(const GAS float*)(((unsigned long long)hi << 32) | lo);
}
#define PIN(c, i) tab_ptr(c, (i))
#define POUT(c) ((float*)tab_ptr(c, 19))
enum { I_X = 0, I_N1G, I_WIN, I_VNG, I_WS, I_BS, I_QNG, I_KNG, I_SINK, I_RELB, I_LBL, I_ONG, I_WOUT, I_N2G, I_WGATE, I_WUP, I_CONVW, I_CONVB, I_WDOWN };

__device__ __forceinline__ float u64f(unsigned long long v) { return fmaf((float)(unsigned)(v >> 32), 4294967296.0f, (float)(unsigned)v); }
__device__ __forceinline__ float row_rstd(const unsigned long long* SS, int r) {
    return rsqrtf(u64f(SS[r]) * (1.0f / 16777216.0f / DM) + EPS);
}

constexpr int CW_LDS = 131072, SS_LDS = 133120;
struct EpiInProj {
    static constexpr bool PERM = true, APERM = false, AFTER_DRAIN = false;
    bf16* O; const unsigned long long* SS; int mode; LAS unsigned char* lds;
    static constexpr int NPRE = 1;
    struct Pre {};
    __device__ __forceinline__ Pre preload(const pg8::Unit& u, int wr, int wc, int fr_in, int fq_in) const {
        int fr = fr_in, fq = fq_in; asm volatile("" : "+v"(fr), "+v"(fq));
        const int wid = wr * 4 + wc, lane = fq * 16 + fr;
        __builtin_amdgcn_global_load_lds((const unsigned*)(SS + (size_t)u.pm * 256) + wid * 64 + lane, (LAS unsigned*)(lds + SS_LDS + wid * 256), 4, 0, 0);
        return Pre{};
    }
    __device__ __forceinline__ void operator()(pg8::f32x4 (&acc)[2][2][4][2], const pg8::Unit& u, int wr, int wc, int fr_in, int fq_in, const Pre& pre) const {
        int fr = fr_in, fq = fq_in; asm volatile("" : "+v"(fr), "+v"(fq));
        if (mode == 0) return;
        const int row0 = u.pm * 256 + wr * 64 + fr, col0 = u.pn * 256 + wc * 32 + 8 * fq;
        const int act = (u.pn <= 1) ? 1 : ((u.pn == 5 || u.pn == 8) ? 2 : 0);
        float rs8[8];
#pragma unroll
        for (int i = 0; i < 8; ++i) rs8[i] = rsqrtf(u64f(*(const LAS unsigned long long*)(lds + SS_LDS + (wr * 64 + fr + (i >> 2) * 128 + (i & 3) * 16) * 8)) * (1.0f / 16777216.0f / DM) + EPS);
        if (act == 1) body<1>(acc, rs8, row0, col0); else if (act == 2) body<2>(acc, rs8, row0, col0); else body<0>(acc, rs8, row0, col0);
    }
    template <int ACT> __device__ __forceinline__ void body(pg8::f32x4 (&acc)[2][2][4][2], const float (&rs8)[8], int row0, int col0) const {
#pragma unroll
        for (int ai = 0; ai < 2; ++ai)
#pragma unroll
            for (int m = 0; m < 4; ++m) {
                const int r = row0 + ai * 128 + m * 16; const float rs = rs8[ai * 4 + m]; bf16* rowp = O + (size_t)r * INW + col0;
#pragma unroll
                for (int bj = 0; bj < 2; ++bj) {
                    f32x4 v0 = acc[ai][bj][m][0] * rs, v1 = acc[ai][bj][m][1] * rs;
                    if (ACT == 1) { pg8::f32x2 a = pg8::gelu_pk((pg8::f32x2){v0[0], v0[1]}), b = pg8::gelu_pk((pg8::f32x2){v0[2], v0[3]}), c = pg8::gelu_pk((pg8::f32x2){v1[0], v1[1]}), d = pg8::gelu_pk((pg8::f32x2){v1[2], v1[3]});
                        v0 = (f32x4){a.x, a.y, b.x, b.y}; v1 = (f32x4){c.x, c.y, d.x, d.y}; }
                    else if (ACT == 2) {
#pragma unroll
                        for (int j = 0; j < 4; ++j) { v0[j] = silu_f(v0[j]); v1[j] = silu_f(v1[j]); } }
                    v4u w; w.x = pg8::cvt_pk_bf16(v0[0], v0[1]); w.y = pg8::cvt_pk_bf16(v0[2], v0[3]); w.z = pg8::cvt_pk_bf16(v1[0], v1[1]); w.w = pg8::cvt_pk_bf16(v1[2], v1[3]);
                    *(v4u*)(rowp + bj * 128) = w; }
            }
    }
};
struct EpiResid {
    static constexpr bool PERM = true, APERM = false, AFTER_DRAIN = false;
    bf16* xb; float* out; unsigned long long* SS; int mode;
    static constexpr int NPRE = 0;
    struct Pre {};
    __device__ __forceinline__ Pre preload(const pg8::Unit&, int, int, int, int) const { return Pre{}; }
    __device__ __forceinline__ void operator()(pg8::f32x4 (&acc)[2][2][4][2], const pg8::Unit& u, int wr, int wc, int fr_in, int fq_in, const Pre&) const {
        int fr = fr_in, fq = fq_in; asm volatile("" : "+v"(fr), "+v"(fq));
        if (mode == 0) return;
        const unsigned row0 = (unsigned)(u.pm * 256 + wr * 64 + fr), col0 = (unsigned)(u.pn * 256 + wc * 32 + 8 * fq);
        v4u rawall[2][4][2];
#pragma unroll
        for (int ai = 0; ai < 2; ++ai)
#pragma unroll
            for (int m = 0; m < 4; ++m)
#pragma unroll
                for (int bj = 0; bj < 2; ++bj) rawall[ai][m][bj] = *(const v4u*)((const char*)xb + ((row0 + ai * 128 + m * 16) * (unsigned)DM + col0 + bj * 128) * 2u);
#pragma unroll
        for (int ai = 0; ai < 2; ++ai) {
            v4u raw8[4][2];
#pragma unroll
            for (int m = 0; m < 4; ++m)
#pragma unroll
                for (int bj = 0; bj < 2; ++bj) raw8[m][bj] = rawall[ai][m][bj];
#pragma unroll
            for (int m = 0; m < 4; ++m) {
                const unsigned r = row0 + ai * 128 + m * 16, off = r * (unsigned)DM + col0; float ss = 0.f;
#pragma unroll
                for (int bj = 0; bj < 2; ++bj) {
                    const v4u raw = raw8[m][bj];
                    const f32x4 o0 = (f32x4){bflo(raw.x), bfhi(raw.x), bflo(raw.y), bfhi(raw.y)} + acc[ai][bj][m][0], o1 = (f32x4){bflo(raw.z), bfhi(raw.z), bflo(raw.w), bfhi(raw.w)} + acc[ai][bj][m][1];
                    if (mode == 1) { ss += ((o0[0] * o0[0] + o0[1] * o0[1]) + (o0[2] * o0[2] + o0[3] * o0[3])) + ((o1[0] * o1[0] + o1[1] * o1[1]) + (o1[2] * o1[2] + o1[3] * o1[3]));
                        v4u w; w.x = pg8::cvt_pk_bf16(o0[0], o0[1]); w.y = pg8::cvt_pk_bf16(o0[2], o0[3]); w.z = pg8::cvt_pk_bf16(o1[0], o1[1]); w.w = pg8::cvt_pk_bf16(o1[2], o1[3]);
                        *(v4u*)((char*)xb + (off + bj * 128) * 2u) = w; }
                    else { *(f32x4*)((char*)out + (size_t)(off + bj * 128) * 4u) = o0; *(f32x4*)((char*)out + (size_t)(off + bj * 128 + 4) * 4u) = o1; }
                }
                if (mode == 1) { ss += __shfl_xor(ss, 16); ss += __shfl_xor(ss, 32); if (fq == 0) __hip_atomic_fetch_add(SS + r, (unsigned long long)(ss * 16777216.0f), __ATOMIC_RELAXED, __HIP_MEMORY_SCOPE_AGENT); }
            }
            asm volatile("" ::: "memory");
        }
    }
};
struct EpiFFN {
    static constexpr bool PERM = true, APERM = true, AFTER_DRAIN = false;
    bf16* ACT; const unsigned long long* SS; const float* cw; const float* cb; float* HG; float* HU; int mode; LAS unsigned char* lds;
    template <class T> static __device__ __forceinline__ T ldg(const void* base, unsigned boff) { return *(const T*)((const char*)base + boff); }
    template <class T> static __device__ __forceinline__ void stg(void* base, unsigned boff, T v) { *(T*)((char*)base + boff) = v; }
    static __device__ __forceinline__ f32x4 shr1(const f32x4& g) {
        f32x4 r;
#pragma unroll
        for (int j = 0; j < 4; ++j) { const float gj = g[j]; r[j] = __int_as_float(__builtin_amdgcn_update_dpp(0, __float_as_int(gj), 0x111, 0xf, 0xf, true)); }
        return r; }
    static constexpr int NPRE = 2;
    struct Pre {};
    __device__ __forceinline__ Pre preload(const pg8::Unit& u, int wr, int wc, int fr_in, int fq_in) const {
        int fr = fr_in, fq = fq_in; asm volatile("" : "+v"(fr), "+v"(fq));
        const int wid = wr * 4 + wc, lane = fq * 16 + fr, trow = wid >> 1;
        __builtin_amdgcn_global_load_lds((const unsigned*)(SS + (size_t)u.pm * 256) + wid * 64 + lane, (LAS unsigned*)(lds + SS_LDS + wid * 256), 4, 0, 0);
        const unsigned ch = (unsigned)(u.pn * 128 + (wid & 1) * 64 + lane);
        const float* src = (trow < 3) ? cw + (size_t)trow * DFF + ch : cb + ch;
        __builtin_amdgcn_global_load_lds((const unsigned*)src, (LAS unsigned*)(lds + CW_LDS + wid * 256), 4, 0, 0);
        return Pre{};
    }
    __device__ __forceinline__ void operator()(pg8::f32x4 (&acc)[2][2][4][2], const pg8::Unit& u, int wr, int wc, int fr_in, int fq_in, const Pre& pre) const {
        int fr = fr_in, fq = fq_in; asm volatile("" : "+v"(fr), "+v"(fq));
        if (mode == 0) return;
        const unsigned rowb = (unsigned)(u.pm * 256 + wr * 64 + 4 * fr), ch0 = (unsigned)(u.pn * 128 + wc * 32 + 8 * fq);
        float rs8[8];
#pragma unroll
        for (int i = 0; i < 8; ++i) rs8[i] = rsqrtf(u64f(*(const LAS unsigned long long*)(lds + SS_LDS + (wr * 64 + 4 * fr + (i >> 2) * 128 + (i & 3)) * 8)) * (1.0f / 16777216.0f / DM) + EPS);
        if (fr == 0 || fr == 15) {
#pragma unroll
            for (int ai = 0; ai < 2; ++ai) {
                const unsigned blk = (unsigned)(u.pm * 4 + ai * 2 + wr);
#pragma unroll
                for (int n = 0; n < 2; ++n) { const unsigned ch = ch0 + 4u * n;
                    if (fr == 0) {
#pragma unroll
                        for (int m = 0; m < 2; ++m) { stg<f32x4>(HG, ((blk * 4u + m) * (unsigned)DFF + ch) * 4u, acc[ai][0][m][n] * rs8[ai * 4 + m]); stg<f32x4>(HU, ((blk * 2u + m) * (unsigned)DFF + ch) * 4u, acc[ai][1][m][n] * rs8[ai * 4 + m]); } }
                    else {
#pragma unroll
                        for (int m = 2; m < 4; ++m) stg<f32x4>(HG, ((blk * 4u + m) * (unsigned)DFF + ch) * 4u, acc[ai][0][m][n] * rs8[ai * 4 + m]); } }
            }
        }
        asm volatile("" ::: "memory");
#pragma unroll
        for (int n = 0; n < 2; ++n) {
            const unsigned ch = ch0 + 4u * n; const float nl2e = -1.4426950408889634f;
            const LAS float* wt = (const LAS float*)(lds + CW_LDS) + (wc * 32 + 8 * fq + 4 * n);
            f32x4 w0 = *(const LAS f32x4*)wt * nl2e, w1 = *(const LAS f32x4*)(wt + 128) * nl2e, w2 = *(const LAS f32x4*)(wt + 256) * nl2e, bb = *(const LAS f32x4*)(wt + 384) * nl2e;
            asm volatile("" : "+v"(w0), "+v"(w1), "+v"(w2), "+v"(bb));
            f32x4 g[2][4];
#pragma unroll
            for (int ai = 0; ai < 2; ++ai)
#pragma unroll
                for (int m = 0; m < 4; ++m) g[ai][m] = acc[ai][0][m][n] * rs8[ai * 4 + m];
            f32x4 h3[2], h2[2];
#pragma unroll
            for (int ai = 0; ai < 2; ++ai) { h3[ai] = shr1(g[ai][3]); h2[ai] = shr1(g[ai][2]); }
#pragma unroll
            for (int ai = 0; ai < 2; ++ai)
#pragma unroll
                for (int m = 0; m < 4; ++m) {
                    const f32x4 p1 = (m == 0) ? h3[ai] : g[ai][m - 1], p2 = (m == 0) ? h2[ai] : (m == 1) ? h3[ai] : g[ai][m - 2];
                    f32x4 c2 = w0 * p2 + bb; c2 = w1 * p1 + c2; c2 = w2 * g[ai][m] + c2;
                    const f32x4 ups = acc[ai][1][m][n] * (rs8[ai * 4 + m] * -0.6931471805599453f);
                    f32x4 e;
#pragma unroll
                    for (int j = 0; j < 4; ++j) e[j] = __builtin_amdgcn_rcpf(1.0f + __builtin_amdgcn_exp2f(c2[j]));
                    acc[ai][0][m][n] = (c2 * e) * ups;
                }
            asm volatile("" ::: "memory");
        }
#pragma unroll
        for (int ai = 0; ai < 2; ++ai) {
#pragma unroll
            for (int m = 0; m < 4; ++m) {
                const unsigned r = rowb + ai * 128 + m;
                const f32x4 v0 = acc[ai][0][m][0], v1 = acc[ai][0][m][1];
                v4u w; w.x = pg8::cvt_pk_bf16(v0[0], v0[1]); w.y = pg8::cvt_pk_bf16(v0[2], v0[3]); w.z = pg8::cvt_pk_bf16(v1[0], v1[1]); w.w = pg8::cvt_pk_bf16(v1[2], v1[3]);
                unsigned bo = (r * (unsigned)DFF + ch0) * 2u;
                if (m < 2) bo = (fr == 0) ? (unsigned)((size_t)M * DFF * 2) + ((unsigned)(((wr * 4 + wc) * 64 + fq * 16 + fr) * 32) + m * 16u) : bo;
                stg<v4u>(ACT, bo, w);
            }
            asm volatile("" ::: "memory");
        }
    }
};


struct InProjOrder {
    int G, c; pg8::StaticOrder fb;
    __device__ __forceinline__ void init(int M_, int N_, int G_, int c_) { G = G_; c = c_; fb.init(M_, N_, G_, c_); }
    __device__ __forceinline__ bool next(int i, pg8::Unit& u) const {
        if (G != 256) return fb.next(i, u);
        const int x = c & 7, j = c >> 3;
        if (j < 16) { if (i >= 5) return false; const int idx = i * 16 + j, grp = idx / 40, r = idx % 40, t = r >> 3;
            u.pm = 16 * x + 8 * grp + (r & 7); u.pn = (t == 0) ? 2 : (t == 1) ? 3 : (t == 2) ? 4 : (t == 3) ? 6 : 7; }
        else { if (i >= 4) return false; const int idx = i * 16 + (j - 16), grp = idx >> 5, r = idx & 31, t = r >> 3;
            u.pm = 16 * x + 8 * grp + (r & 7); u.pn = (t == 0) ? 0 : (t == 1) ? 1 : (t == 2) ? 5 : 8; }
        return true;
    }
    __device__ __forceinline__ void a_ready(const pg8::Unit&) const {}
    __device__ __forceinline__ void done(const pg8::Unit&) const {}
};
__device__ __forceinline__ void p0_transpose_item(const float* W, int K, int N, const float* gk, bf16* WT, int dest_row0, int k0, int n0, LAS float* scr, int lane) {
    const int rr = lane >> 4, c4 = (lane & 15) * 4;
#pragma unroll
    for (int i = 0; i < 16; ++i) { const int kk = 4 * i + rr; f32x4 v = *(const f32x4*)(W + (size_t)(k0 + kk) * N + n0 + c4); if (gk) v = v * gk[k0 + kk];
        LAS float* d = scr + kk * 65 + c4; d[0] = v.x; d[1] = v.y; d[2] = v.z; d[3] = v.w; }
    LDS_WAIT(); asm volatile("" ::: "memory");
    const int c = lane & 7;
#pragma unroll
    for (int j = 0; j < 8; ++j) { const int n = (lane >> 3) + 8 * j; const LAS float* s = scr + (8 * c) * 65 + n;
        v4u o; o.x = mb_cvtpk(s[0 * 65], s[1 * 65]); o.y = mb_cvtpk(s[2 * 65], s[3 * 65]); o.z = mb_cvtpk(s[4 * 65], s[5 * 65]); o.w = mb_cvtpk(s[6 * 65], s[7 * 65]);
        *(GAS v4u*)(WT + (size_t)(dest_row0 + n) * K + k0 + 8 * c) = o; }
    LDS_WAIT(); asm volatile("" ::: "memory");
}

__device__ __forceinline__ void prologue(const Ctx& p, LAS unsigned char* lds, int wave, int lane, bool first) {
    LAS float* scr = (LAS float*)(lds + wave * 16640);
    const int gw = blockIdx.x * NWAVES + wave, NGW = gridDim.x * NWAVES;
    constexpr int I_IN = (DM / 64) * (INW / 64), I_OUT = (DM / 64) * (DM / 64), I_G = (DM / 64) * (DFF / 64), I_D = (DFF / 64) * (DM / 64);
    constexpr int PER_L = I_IN + I_OUT + 2 * I_G + I_D;
    for (int it = gw; it < DEPTH * PER_L; it += NGW) {
        const int l = it / PER_L; int r = it % PER_L;
        unsigned char* wl = p.ws + WS_W + (size_t)l * W_LAYER;
        if (r < I_IN) { const int nblk = INW / 64, kb = r / nblk, nb = r % nblk;
            p0_transpose_item(PIN(p, I_WIN) + (size_t)l * DM * INW, DM, INW, PIN(p, I_N1G) + l * DM, (bf16*)(wl + W_IN), 64 * nb, 64 * kb, 64 * nb, scr, lane); continue; } r -= I_IN;
        if (r < I_OUT) { const int nblk = DM / 64, kb = r / nblk, nb = r % nblk;
            p0_transpose_item(PIN(p, I_WOUT) + (size_t)l * DM * DM, DM, DM, nullptr, (bf16*)(wl + W_OUT), 64 * nb, 64 * kb, 64 * nb, scr, lane); continue; } r -= I_OUT;
        if (r < 2 * I_G) { const int up = r >= I_G; if (up) r -= I_G; const int nblk = DFF / 64, kb = r / nblk, nb = r % nblk, n0 = 64 * nb;
            const int dest = 256 * (n0 / 128) + (n0 % 128) + (up ? 128 : 0);
            p0_transpose_item(PIN(p, up ? I_WUP : I_WGATE) + (size_t)l * DM * DFF, DM, DFF, PIN(p, I_N2G) + l * DM, (bf16*)(wl + W_GU), dest, 64 * kb, n0, scr, lane); continue; } r -= 2 * I_G;
        { const int nblk = DM / 64, kb = r / nblk, nb = r % nblk;
            p0_transpose_item(PIN(p, I_WDOWN) + (size_t)l * DFF * DM, DFF, DM, nullptr, (bf16*)(wl + W_DN), 64 * nb, 64 * kb, 64 * nb, scr, lane); }
    }
    const float* x = PIN(p, I_X); bf16* XB = (bf16*)(p.ws + WS_XB); unsigned long long* SS = (unsigned long long*)(p.ws + WS_SS);
    for (int m0 = gw; m0 < M; m0 += 4 * NGW) {
        f32x4 v[4][4]; float s[4];
#pragma unroll
        for (int q = 0; q < 4; ++q) { const int m = (m0 + q * NGW < M) ? m0 + q * NGW : m0; const f32x4* xr = (const f32x4*)(x + (size_t)m * DM) + lane;
#pragma unroll
            for (int j = 0; j < 4; ++j) v[q][j] = xr[64 * j]; }
#pragma unroll
        for (int q = 0; q < 4; ++q) { s[q] = 0.f;
#pragma unroll
            for (int j = 0; j < 4; ++j) s[q] += (v[q][j].x * v[q][j].x + v[q][j].y * v[q][j].y) + (v[q][j].z * v[q][j].z + v[q][j].w * v[q][j].w); }
#pragma unroll
        for (int o = 1; o < 64; o <<= 1) {
#pragma unroll
            for (int q = 0; q < 4; ++q) s[q] += __shfl_xor(s[q], o); }
#pragma unroll
        for (int q = 0; q < 4; ++q) { const int m = m0 + q * NGW; if (m < M) {
            unsigned long long* o8 = (unsigned long long*)(XB + (size_t)m * DM) + lane;
#pragma unroll
            for (int j = 0; j < 4; ++j) o8[64 * j] = (unsigned long long)pk2(v[q][j].x, v[q][j].y) | ((unsigned long long)pk2(v[q][j].z, v[q][j].w) << 32);
            if (lane == 0 && first) __hip_atomic_fetch_add(SS + m, (unsigned long long)(s[q] * 16777216.0f), __ATOMIC_RELAXED, __HIP_MEMORY_SCOPE_AGENT); } }
    }
    { bf16* wtb = (bf16*)(p.ws + WS_TAB + 131072); const float* wsrc = PIN(p, I_WS);
        for (int i = gw * 64 + lane; i < DEPTH * 4 * 128 * 128; i += NGW * 64) { const int s_ = i & 127, t_ = (i >> 7) & 127; wtb[i] = (bf16)f2bf(s_ <= t_ ? wsrc[i] : 0.f); } }
    if (blockIdx.x == 0) { float* bt = (float*)(p.ws + WS_TAB);
        for (int i = wave * 64 + lane; i < 1024; i += NWAVES * 64) { const int h = i >> 7, d = i & 127; bt[i] = PIN(p, I_RELB)[(int)((LAS unsigned char*)(lds + TAB_OFF + 256))[d] * 8 + h]; } }
    if (blockIdx.x == 1) {
        for (int idx = wave; idx < DEPTH * 8; idx += NWAVES) { const int l_ = idx >> 3, h = idx & 7;
            float gm = fabsf(PIN(p, I_QNG)[l_ * 64 + lane] * PIN(p, I_KNG)[l_ * 64 + lane]);
            const LAS unsigned char* bk = (const LAS unsigned char*)(lds + TAB_OFF + 256);
            float bm = fmaxf(PIN(p, I_RELB)[(int)bk[lane] * 8 + h], PIN(p, I_RELB)[(int)bk[lane + 64] * 8 + h]);
#pragma unroll
            for (int o = 1; o < 64; o <<= 1) { gm = fmaxf(gm, __shfl_xor(gm, o)); bm = fmaxf(bm, __shfl_xor(bm, o)); }
            if (lane == 0) ((float*)(p.ws + WS_TAB))[1024 + idx] = (8.0f * gm + fmaxf(bm, PIN(p, I_SINK)[idx])) * 1.4426950408889634f; } }
}

#ifdef DBG_MIXCMP
__device__ __forceinline__ void mixer_a_simple(const Ctx& p, int l, int unit, LAS unsigned char* lds, int wave, int lane) {
    LAS float* vn = (LAS float*)lds;
    const int g = unit & 3, ck = unit >> 2; const size_t row0 = (size_t)ck * 128;
    const bf16* PROJ = (const bf16*)(p.ws + WS_PROJ); bf16* MIXED = (bf16*)(p.ws + WS_MIXED);
    const float vg = PIN(p, I_VNG)[(l * 4 + g) * 64 + lane];
#pragma unroll 4
    for (int i = 0; i < 16; ++i) { const int s = wave * 16 + i;
        const float v = bf2f(PROJ[(row0 + s) * INW + C_AV + g * 64 + lane]);
        const float ss = wave_sum(v * v);
        vn[s * 64 + lane] = v * rsqrtf(ss * (1.0f / 64.0f) + EPS) * vg; }
    __syncthreads();
    const float* Wg = PIN(p, I_WS) + (size_t)(l * 4 + g) * 128 * 128; const float* bs = PIN(p, I_BS) + (l * 4 + g) * 128;
    for (int i = 0; i < 16; ++i) { const int t = __builtin_amdgcn_readfirstlane(wave + 8 * i);
        const float* wrow = Wg + t * 128; float a = 0.f;
        for (int s0 = 0; s0 <= t; s0 += 4) { const f32x4 w = *(const f32x4*)(wrow + s0);
#pragma unroll
            for (int j = 0; j < 4; ++j) { const float wj = (s0 + j <= t) ? w[j] : 0.f; a += wj * vn[(s0 + j) * 64 + lane]; } }
        a += bs[t];
        const float uval = bf2f(PROJ[(row0 + t) * INW + C_AU + g * 64 + lane]);
        MIXED[(row0 + t) * DM + MX_A + g * 64 + lane] = (bf16)f2bf(uval * a * DBG_A); }
    __syncthreads();
}

#endif
#ifdef DBG_MIXCMP
constexpr int KVS = 68;
__device__ __forceinline__ void mixer_b_simple(const Ctx& p, int l, int unit, LAS unsigned char* lds, int wave, int lane) {
    LAS float* Kt = (LAS float*)lds; LAS float* Vt = Kt + 256 * KVS;
    const int hk = unit & 1, nb = unit >> 1, n = nb & 63; const long row0 = (long)nb * 128, win0 = row0 - 128;
    const bf16* PROJ = (const bf16*)(p.ws + WS_PROJ); bf16* MIXED = (bf16*)(p.ws + WS_MIXED);
    const int tid = wave * 64 + lane;
    {
        const int row = tid >> 1, half = tid & 1; const bool valid = (n > 0) || (row >= 128);
        float kf[32], vf[32];
        if (valid) { const v4u* kp = (const v4u*)(PROJ + (win0 + row) * INW + C_BK + hk * 64 + half * 32); const v4u* vp = (const v4u*)(PROJ + (win0 + row) * INW + C_BV + hk * 64 + half * 32);
#pragma unroll
            for (int c = 0; c < 4; ++c) { const v4u a = kp[c], b = vp[c];
                kf[8 * c + 0] = bflo(a.x); kf[8 * c + 1] = bfhi(a.x); kf[8 * c + 2] = bflo(a.y); kf[8 * c + 3] = bfhi(a.y); kf[8 * c + 4] = bflo(a.z); kf[8 * c + 5] = bfhi(a.z); kf[8 * c + 6] = bflo(a.w); kf[8 * c + 7] = bfhi(a.w);
                vf[8 * c + 0] = bflo(b.x); vf[8 * c + 1] = bfhi(b.x); vf[8 * c + 2] = bflo(b.y); vf[8 * c + 3] = bfhi(b.y); vf[8 * c + 4] = bflo(b.z); vf[8 * c + 5] = bfhi(b.z); vf[8 * c + 6] = bflo(b.w); vf[8 * c + 7] = bfhi(b.w); } }
        else {
#pragma unroll
            for (int c = 0; c < 32; ++c) { kf[c] = 0.f; vf[c] = 0.f; } }
        float ss = 0.f;
#pragma unroll
        for (int c = 0; c < 32; ++c) ss += kf[c] * kf[c];
        ss += __shfl_xor(ss, 1);
        const float rs = rsqrtf(ss * (1.0f / 64.0f) + EPS); const float* kng = PIN(p, I_KNG) + l * 64 + half * 32;
#pragma unroll
        for (int c = 0; c < 8; ++c) {
            *(LAS f32x4*)(Kt + row * KVS + half * 32 + 4 * c) = (f32x4){kf[4 * c] * rs * kng[4 * c], kf[4 * c + 1] * rs * kng[4 * c + 1], kf[4 * c + 2] * rs * kng[4 * c + 2], kf[4 * c + 3] * rs * kng[4 * c + 3]};
            *(LAS f32x4*)(Vt + row * KVS + half * 32 + 4 * c) = (f32x4){vf[4 * c], vf[4 * c + 1], vf[4 * c + 2], vf[4 * c + 3]}; }
    }
    __syncthreads();
    const int g = wave >> 1, i = (wave & 1) * 64 + lane, h = hk * 4 + g;
    float q[64];
    { const v4u* qp = (const v4u*)(PROJ + (row0 + i) * INW + C_BQ + h * 64); float ss = 0.f;
#pragma unroll
        for (int c = 0; c < 8; ++c) { const v4u a = qp[c];
            q[8 * c + 0] = bflo(a.x); q[8 * c + 1] = bfhi(a.x); q[8 * c + 2] = bflo(a.y); q[8 * c + 3] = bfhi(a.y); q[8 * c + 4] = bflo(a.z); q[8 * c + 5] = bfhi(a.z); q[8 * c + 6] = bflo(a.w); q[8 * c + 7] = bfhi(a.w); }
#pragma unroll
        for (int c = 0; c < 64; ++c) ss += q[c] * q[c];
        const float rs = rsqrtf(ss * (1.0f / 64.0f) + EPS) * 0.125f; const float* qng = PIN(p, I_QNG) + l * 64;
#pragma unroll
        for (int c = 0; c < 64; ++c) q[c] *= rs * qng[c]; }
    float mx = PIN(p, I_SINK)[l * 8 + h], lsum = 1.0f; float o[64];
#pragma unroll
    for (int c = 0; c < 64; ++c) o[c] = 0.f;
    const float* bt = (const float*)(p.ws + WS_TAB) + h * 128;
    for (int dist = 0; dist < 128; ++dist) {
        const int j = i + 128 - dist; const LAS float* kr = Kt + j * KVS; const LAS float* vr = Vt + j * KVS;
        float s0 = 0.f, s1 = 0.f, s2 = 0.f, s3 = 0.f;
#pragma unroll
        for (int c = 0; c < 16; ++c) { const f32x4 kk = *(const LAS f32x4*)(kr + 4 * c); s0 += q[4 * c] * kk.x; s1 += q[4 * c + 1] * kk.y; s2 += q[4 * c + 2] * kk.z; s3 += q[4 * c + 3] * kk.w; }
        float s = (s0 + s1) + (s2 + s3) + bt[dist];
        if (n == 0 && j < 128) s = -1e30f;
        if (s > mx) { const float f = __expf(mx - s); lsum *= f;
#pragma unroll
            for (int c = 0; c < 64; ++c) o[c] *= f;
            mx = s; }
        const float pr = __expf(s - mx); lsum += pr;
#pragma unroll
        for (int c = 0; c < 16; ++c) { const f32x4 vv = *(const LAS f32x4*)(vr + 4 * c); o[4 * c] += pr * vv.x; o[4 * c + 1] += pr * vv.y; o[4 * c + 2] += pr * vv.z; o[4 * c + 3] += pr * vv.w; }
    }
    const float inv = DBG_B / lsum; v4u* op = (v4u*)(MIXED + (row0 + i) * DM + MX_B + h * 64);
#pragma unroll
    for (int c = 0; c < 8; ++c) { v4u w; w.x = pk2(o[8 * c] * inv, o[8 * c + 1] * inv); w.y = pk2(o[8 * c + 2] * inv, o[8 * c + 3] * inv); w.z = pk2(o[8 * c + 4] * inv, o[8 * c + 5] * inv); w.w = pk2(o[8 * c + 6] * inv, o[8 * c + 7] * inv); op[c] = w; }
    __syncthreads();
}

#endif

namespace mb {
typedef short bf16x8 __attribute__((ext_vector_type(8)));
typedef short s16x4 __attribute__((ext_vector_type(4)));
typedef float f32x16 __attribute__((ext_vector_type(16)));
typedef float f32x2_t __attribute__((ext_vector_type(2)));
typedef __bf16 bf16x2_t __attribute__((ext_vector_type(2)));
constexpr int KB_OFF = 0, VB_OFF = 32768, BIAS_OFF = 65536, WS_OFF = 73728, WS_STRIDE = 4608;
__device__ __forceinline__ int crow(int r, int hi) { return (r & 3) + 8 * (r >> 2) + 4 * hi; }
__device__ __forceinline__ unsigned cvtpk(float lo, float hi) { f32x2_t v = {lo, hi}; bf16x2_t b = __builtin_convertvector(v, bf16x2_t); return __builtin_bit_cast(unsigned, b); }
__device__ __forceinline__ s16x4 vtr(LAS const unsigned char* p) { return __builtin_bit_cast(s16x4, __builtin_amdgcn_ds_read_tr16_b64_v4i16((LAS s16x4*)p)); }
}
__device__ __forceinline__ void mixer_b_mfma(const Ctx& p, int l, int unit, LAS unsigned char* lds, int wave, int lane) {
    using namespace mb;
    const int hk = unit & 1, nb = unit >> 1, n = nb & 63; const long row0 = (long)nb * 128, win0 = row0 - 128;
    const bf16* PROJ = (const bf16*)(p.ws + WS_PROJ); bf16* MIXED = (bf16*)(p.ws + WS_MIXED);
    const int tid = wave * 64 + lane, r32 = lane & 31, hi = lane >> 5;
    {
        const int row = tid >> 1, half = tid & 1; const bool valid = (n > 0) || (row >= 128);
        v4u kr[4], vr[4];
        if (valid) { const v4u* kp = (const v4u*)(PROJ + (win0 + row) * INW + C_BK + hk * 64 + half * 32); const v4u* vp = (const v4u*)(PROJ + (win0 + row) * INW + C_BV + hk * 64 + half * 32);
#pragma unroll
            for (int c = 0; c < 4; ++c) { kr[c] = kp[c]; vr[c] = vp[c]; } }
        else {
#pragma unroll
            for (int c = 0; c < 4; ++c) { kr[c] = (v4u){0u, 0u, 0u, 0u}; vr[c] = kr[c]; } }
        float ss = 0.f;
#pragma unroll
        for (int c = 0; c < 4; ++c) { const unsigned w4[4] = {kr[c].x, kr[c].y, kr[c].z, kr[c].w};
#pragma unroll
            for (int e = 0; e < 4; ++e) { const float a = bflo(w4[e]), b = bfhi(w4[e]); ss += a * a + b * b; } }
        ss += __shfl_xor(ss, 1);
        const float rs = rsqrtf(ss * (1.0f / 64.0f) + EPS) * (0.125f * 1.4426950408889634f); const float* kng = PIN(p, I_KNG) + l * 64 + half * 32; const float* qng = PIN(p, I_QNG) + l * 64 + half * 32;
        LAS unsigned char* kdst = lds + KB_OFF + (row >> 6) * 8192 + (half * 4) * 1024 + (row & 63) * 16;
        LAS unsigned char* vdst = lds + VB_OFF + (row >> 6) * 8192 + half * 4096 + ((row & 63) >> 4) * 1024 + (row & 15) * 64;
#pragma unroll
        for (int c = 0; c < 4; ++c) { const unsigned w4[4] = {kr[c].x, kr[c].y, kr[c].z, kr[c].w}; v4u o;
            unsigned ow[4];
#pragma unroll
            for (int e = 0; e < 4; ++e) ow[e] = cvtpk(bflo(w4[e]) * (rs * kng[8 * c + 2 * e] * qng[8 * c + 2 * e]), bfhi(w4[e]) * (rs * kng[8 * c + 2 * e + 1] * qng[8 * c + 2 * e + 1]));
            o.x = ow[0]; o.y = ow[1]; o.z = ow[2]; o.w = ow[3];
            *(LAS v4u*)(kdst + c * 1024) = o;
            *(LAS v4u*)(vdst + c * 16) = vr[c]; }
        const float* bt = (const float*)(p.ws + WS_TAB) + (hk * 4) * 128;
        const float* shp = (const float*)(p.ws + WS_TAB) + 1024 + l * 8 + hk * 4;
        for (int i = tid; i < 4 * 384; i += NWAVES * 64) { const int g = i / 384, x = i % 384 - 128; ((LAS float*)(lds + BIAS_OFF))[i] = (x >= 0 && x < 128) ? bt[g * 128 + 127 - x] * 1.4426950408889634f - shp[g] : -1e30f; }
    }
    __syncthreads();
    const int g = wave >> 1, h = hk * 4 + g;
    LAS float* wsf = (LAS float*)(lds + WS_OFF + wave * WS_STRIDE);
    LAS bf16* stg = (LAS bf16*)(lds + WS_OFF + wave * WS_STRIDE + 256);
    const float sinke = __builtin_amdgcn_exp2f(PIN(p, I_SINK)[l * 8 + h] * 1.4426950408889634f - ((const float*)(p.ws + WS_TAB))[1024 + l * 8 + h]);
    const LAS unsigned char* vp0 = lds + VB_OFF + ((lane >> 4) & 1) * 32 + (lane & 3) * 8 + (4 * hi + ((lane & 15) >> 2)) * 64;
#pragma unroll
    for (int qt = 0; qt < 2; ++qt) {
        const int i0 = (wave & 1) * 64 + qt * 32, qi = i0 + r32, jt0 = (i0 >= 64) ? 1 : 0;
#define MB_LIVE(jt, hh) ((qt == 0) ? !((jt) == 2 && (hh) == 1) : !((jt) == 0 && (hh) == 0))
        bf16x8 qr[4];
        { const bf16* qp = PROJ + (row0 + qi) * INW + C_BQ + h * 64 + hi * 8; v4u raw[4]; float ss = 0.f;
#pragma unroll
            for (int d0 = 0; d0 < 4; ++d0) { raw[d0] = *(const v4u*)(qp + d0 * 16); const unsigned w4[4] = {raw[d0].x, raw[d0].y, raw[d0].z, raw[d0].w};
#pragma unroll
                for (int e = 0; e < 4; ++e) { const float a = bflo(w4[e]), b = bfhi(w4[e]); ss += a * a + b * b; } }
            ss += __shfl_xor(ss, 32);
            const float rs = rsqrtf(ss * (1.0f / 64.0f) + EPS);
#pragma unroll
            for (int d0 = 0; d0 < 4; ++d0) { const unsigned w4[4] = {raw[d0].x, raw[d0].y, raw[d0].z, raw[d0].w}; unsigned ow[4];
#pragma unroll
                for (int e = 0; e < 4; ++e) ow[e] = cvtpk(bflo(w4[e]) * rs, bfhi(w4[e]) * rs);
                v4u o; o.x = ow[0]; o.y = ow[1]; o.z = ow[2]; o.w = ow[3]; qr[d0] = __builtin_bit_cast(bf16x8, o); } }
        f32x16 sc[3][2];
#pragma unroll
        for (int jt = 0; jt < 3; ++jt) { const LAS unsigned char* kb = lds + KB_OFF + (jt0 + jt) * 8192 + hi * 1024 + r32 * 16;
            f32x16 a0 = {}, a1 = {};
#pragma unroll
            for (int d0 = 0; d0 < 4; ++d0) {
                if (MB_LIVE(jt, 0)) { const bf16x8 b0 = *(const LAS bf16x8*)(kb + d0 * 2048); a0 = __builtin_amdgcn_mfma_f32_32x32x16_bf16(b0, qr[d0], a0, 0, 0, 0); }
                if (MB_LIVE(jt, 1)) { const bf16x8 b1 = *(const LAS bf16x8*)(kb + d0 * 2048 + 512); a1 = __builtin_amdgcn_mfma_f32_32x32x16_bf16(b1, qr[d0], a1, 0, 0, 0); } }
            sc[jt][0] = a0; sc[jt][1] = a1; }
        const LAS float* tb = (const LAS float*)(lds + BIAS_OFF) + g * 384 + 128;
        float lsum = 0.f;
#pragma unroll
        for (int jt = 0; jt < 3; ++jt)
#pragma unroll
            for (int hh = 0; hh < 2; ++hh) if (MB_LIVE(jt, hh)) { const int kj0 = 64 * (jt0 + jt) + 32 * hh + 4 * hi;
                const bool first = (n == 0) && (jt0 + jt < 2);
                const LAS float* tx = first ? (tb + 130) : (tb + (127 - (qi + 128 - kj0)));
#pragma unroll
                for (int r = 0; r < 16; ++r) { const int kc = (r & 3) + 8 * (r >> 2);
                    const float e = __builtin_amdgcn_exp2f(sc[jt][hh][r] + tx[kc]); sc[jt][hh][r] = e; lsum += e; } }
        lsum += __shfl_xor(lsum, 32);
        lsum += sinke;
        f32x16 o0 = {}, o1 = {};
#pragma unroll
        for (int jt = 0; jt < 3; ++jt) { const LAS unsigned char* vb = vp0 + (jt0 + jt) * 8192;
#pragma unroll
            for (int ks = 0; ks < 4; ++ks) { const int hh = ks >> 1, rb = (ks & 1) * 8;
                if (MB_LIVE(jt, hh)) {
                v4u pw; pw.x = cvtpk(sc[jt][hh][rb + 0], sc[jt][hh][rb + 1]); pw.y = cvtpk(sc[jt][hh][rb + 2], sc[jt][hh][rb + 3]); pw.z = cvtpk(sc[jt][hh][rb + 4], sc[jt][hh][rb + 5]); pw.w = cvtpk(sc[jt][hh][rb + 6], sc[jt][hh][rb + 7]);
                const bf16x8 pa = __builtin_bit_cast(bf16x8, pw);
                const s16x4 l0 = vtr(vb + ks * 1024), h0 = vtr(vb + ks * 1024 + 512), l1 = vtr(vb + 4096 + ks * 1024), h1 = vtr(vb + 4096 + ks * 1024 + 512);
                const bf16x8 v0 = (bf16x8){l0[0], l0[1], l0[2], l0[3], h0[0], h0[1], h0[2], h0[3]}, v1 = (bf16x8){l1[0], l1[1], l1[2], l1[3], h1[0], h1[1], h1[2], h1[3]};
                o0 = __builtin_amdgcn_mfma_f32_32x32x16_bf16(pa, v0, o0, 0, 0, 0); o1 = __builtin_amdgcn_mfma_f32_32x32x16_bf16(pa, v1, o1, 0, 0, 0); } } }
#undef MB_LIVE
        if (hi == 0) wsf[r32] = lsum;
        LDS_WAIT(); asm volatile("" ::: "memory");
#pragma unroll
        for (int r = 0; r < 16; ++r) { const int orow = crow(r, hi); const float inv = DBG_B * __builtin_amdgcn_rcpf(wsf[orow]);
            const unsigned pk = cvtpk(o0[r] * inv, o1[r] * inv);
            stg[orow * 64 + r32] = (bf16)(pk & 0xffffu); stg[orow * 64 + 32 + r32] = (bf16)(pk >> 16); }
        LDS_WAIT(); asm volatile("" ::: "memory");
        bf16* ow = MIXED + (row0 + i0) * DM + MX_B + h * 64;
#pragma unroll
        for (int i = 0; i < 4; ++i) { const int row = i * 8 + (lane >> 3), ch = lane & 7; const v4u v = *(const LAS v4u*)(stg + row * 64 + ch * 8); *(v4u*)(ow + (long)row * DM + ch * 8) = v; }
        LDS_WAIT(); asm volatile("" ::: "memory");
    }
    __syncthreads();
}

constexpr size_t WS_WTB = WS_TAB + 131072;
constexpr int VNT_STRIDE = 136;
constexpr int A_STG_OFF = 4 * 64 * VNT_STRIDE * 2, A_STG_BYTES = 32 * 36 * 4;
__device__ __forceinline__ float rowsum16_dpp(float v) {
    v += __int_as_float(__builtin_amdgcn_update_dpp(0, __float_as_int(v), 0xB1, 0xf, 0xf, true));
    v += __int_as_float(__builtin_amdgcn_update_dpp(0, __float_as_int(v), 0x4E, 0xf, 0xf, true));
    v += __int_as_float(__builtin_amdgcn_update_dpp(0, __float_as_int(v), 0x141, 0xf, 0xf, true));
    v += __int_as_float(__builtin_amdgcn_update_dpp(0, __float_as_int(v), 0x140, 0xf, 0xf, true));
    return v;
}
__device__ __forceinline__ void mixer_a_mfma(const Ctx& p, int l, int unit, LAS unsigned char* lds, int wave, int lane) {
    using namespace mb;
    LAS bf16* vnT = (LAS bf16*)lds;
    const int ck = unit; const size_t row0 = (size_t)ck * 128;
    const bf16* PROJ = (const bf16*)(p.ws + WS_PROJ); bf16* MIXED = (bf16*)(p.ws + WS_MIXED);
    const int r32 = lane & 31, hi = lane >> 5, g = wave >> 1, dt = wave & 1;
    const bf16* Wg = (const bf16*)(p.ws + WS_WTB) + ((size_t)(l * 4 + g) * 128 + r32) * 128 + 8 * hi;
    v4u wf[20];
#pragma unroll
    for (int ti = 0; ti < 3; ++ti)
#pragma unroll
        for (int ks = 0; ks < 2 * ti + 2; ++ks) wf[ti * (ti + 1) + ks] = *(const v4u*)(Wg + (size_t)(32 * ti) * 128 + 16 * ks);
    const int orow = lane >> 2, od8 = 8 * (lane & 3);
    v4u uv[4][2]; float bsv[4][2];
    { const float* bs = PIN(p, I_BS) + (l * 4 + g) * 128;
#pragma unroll
        for (int ti = 0; ti < 4; ++ti)
#pragma unroll
            for (int j = 0; j < 2; ++j) { const int t = 32 * ti + orow + 16 * j; uv[ti][j] = *(const v4u*)(PROJ + (row0 + t) * INW + C_AU + g * 64 + 32 * dt + od8); bsv[ti][j] = bs[t]; } }
    {
        const int sub = lane >> 4, d4 = (lane & 15) * 4;
        v2u raw[16];
#pragma unroll
        for (int it = 0; it < 16; ++it) raw[it] = *(const v2u*)(PROJ + (row0 + wave * 16 + (it >> 2) * 4 + sub) * INW + C_AV + (it & 3) * 64 + d4);
        const float* vgp = PIN(p, I_VNG) + l * 256 + d4;
#pragma unroll
        for (int it = 0; it < 16; ++it) { const int gg = it & 3, s = wave * 16 + (it >> 2) * 4 + sub;
            const float v0 = bflo(raw[it].x), v1 = bfhi(raw[it].x), v2 = bflo(raw[it].y), v3 = bfhi(raw[it].y);
            const float ss = rowsum16_dpp((v0 * v0 + v1 * v1) + (v2 * v2 + v3 * v3));
            const float rs = rsqrtf(ss * (1.0f / 64.0f) + EPS); const f32x4 vgg = *(const f32x4*)(vgp + gg * 64);
            LAS bf16* dst = vnT + gg * (64 * VNT_STRIDE) + d4 * VNT_STRIDE + s;
            const unsigned p01 = mb_cvtpk(v0 * rs * vgg.x, v1 * rs * vgg.y), p23 = mb_cvtpk(v2 * rs * vgg.z, v3 * rs * vgg.w);
            dst[0] = (bf16)(p01 & 0xffffu); dst[VNT_STRIDE] = (bf16)(p01 >> 16); dst[2 * VNT_STRIDE] = (bf16)(p23 & 0xffffu); dst[3 * VNT_STRIDE] = (bf16)(p23 >> 16); }
    }
    __syncthreads();
#pragma unroll
    for (int ks = 0; ks < 8; ++ks) wf[12 + ks] = *(const v4u*)(Wg + (size_t)96 * 128 + 16 * ks);
    const LAS bf16* vb = vnT + g * (64 * VNT_STRIDE) + (32 * dt + r32) * VNT_STRIDE + 8 * hi;
    LAS float* stf = (LAS float*)(lds + A_STG_OFF + wave * A_STG_BYTES);
#pragma unroll
    for (int ti = 0; ti < 4; ++ti) {
        f32x16 acc = {};
#pragma unroll
        for (int ks = 0; ks < 2 * ti + 2; ++ks) { const bf16x8 b = *(const LAS bf16x8*)(vb + 16 * ks);
            acc = __builtin_amdgcn_mfma_f32_32x32x16_bf16(__builtin_bit_cast(bf16x8, wf[ti * (ti + 1) + ks]), b, acc, 0, 0, 0); }
#pragma unroll
        for (int r = 0; r < 16; ++r) stf[crow(r, hi) * 36 + r32] = acc[r];
        LDS_WAIT(); asm volatile("" ::: "memory");
#pragma unroll
        for (int j = 0; j < 2; ++j) { const int trow = orow + 16 * j; const LAS float* sp = stf + trow * 36 + od8;
            const f32x4 a0 = *(const LAS f32x4*)sp, a1 = *(const LAS f32x4*)(sp + 4); const v4u uu = uv[ti][j]; const float bb = bsv[ti][j];
            v4u o; o.x = mb_cvtpk(bflo(uu.x) * (a0[0] + bb) * DBG_A, bfhi(uu.x) * (a0[1] + bb) * DBG_A); o.y = mb_cvtpk(bflo(uu.y) * (a0[2] + bb) * DBG_A, bfhi(uu.y) * (a0[3] + bb) * DBG_A);
            o.z = mb_cvtpk(bflo(uu.z) * (a1[0] + bb) * DBG_A, bfhi(uu.z) * (a1[1] + bb) * DBG_A); o.w = mb_cvtpk(bflo(uu.w) * (a1[2] + bb) * DBG_A, bfhi(uu.w) * (a1[3] + bb) * DBG_A);
            *(v4u*)(MIXED + (row0 + 32 * ti + trow) * DM + MX_A + g * 64 + 32 * dt + od8) = o; }
        LDS_WAIT(); asm volatile("" ::: "memory");
    }
    __syncthreads();
}
__device__ __forceinline__ float hgrn_lb(const Ctx& p, int l, int kidx) { if (l == 0) return 0.f; const float* lg = PIN(p, I_LBL); return 1.0f / (1.0f + __expf(lg[kidx] - lg[256 + kidx])); }
#ifdef DBG_MIXCMP
__device__ __forceinline__ void hgrn_stage(const bf16* PROJ, size_t rowbase, int hc, const float (&lb8)[8], LAS float* F, LAS float* V, LAS float* Q, int tid) {
    const int tt = tid >> 3, k0 = (tid & 7) * 8; const bf16* rp = PROJ + (rowbase + tt) * INW + hc * 64 + k0;
    const v4u z = *(const v4u*)(rp + C_CF), vi = *(const v4u*)(rp + C_CI);
    float zf[8] = {bflo(z.x), bfhi(z.x), bflo(z.y), bfhi(z.y), bflo(z.z), bfhi(z.z), bflo(z.w), bfhi(z.w)}; float ff[8];
#pragma unroll
    for (int j = 0; j < 8; ++j) ff[j] = lb8[j] + (1.0f - lb8[j]) * __builtin_amdgcn_rcpf(1.0f + __expf(-zf[j]));
    *(LAS f32x4*)(F + tt * 64 + k0) = (f32x4){ff[0], ff[1], ff[2], ff[3]}; *(LAS f32x4*)(F + tt * 64 + k0 + 4) = (f32x4){ff[4], ff[5], ff[6], ff[7]};
    *(LAS f32x4*)(V + tt * 64 + k0) = (f32x4){bflo(vi.x), bfhi(vi.x), bflo(vi.y), bfhi(vi.y)}; *(LAS f32x4*)(V + tt * 64 + k0 + 4) = (f32x4){bflo(vi.z), bfhi(vi.z), bflo(vi.w), bfhi(vi.w)};
    if (Q) { const v4u qq = *(const v4u*)(rp + C_CQ);
        *(LAS f32x4*)(Q + tt * 64 + k0) = (f32x4){bflo(qq.x), bfhi(qq.x), bflo(qq.y), bfhi(qq.y)}; *(LAS f32x4*)(Q + tt * 64 + k0 + 4) = (f32x4){bflo(qq.z), bfhi(qq.z), bflo(qq.w), bfhi(qq.w)}; }
}
__device__ __forceinline__ void mixer_c_pass1_simple(const Ctx& p, int l, int unit, LAS unsigned char* lds, int wave, int lane) {
    LAS float* F = (LAS float*)lds; LAS float* V = F + 4096;
    const int bh = unit >> 4, seg = unit & 15, b = bh >> 2, hc = bh & 3; const size_t row0 = (size_t)b * SEQ + (size_t)seg * 512;
    const bf16* PROJ = (const bf16*)(p.ws + WS_PROJ); const int tid = wave * 64 + lane;
    float lb8[8];
#pragma unroll
    for (int j = 0; j < 8; ++j) lb8[j] = hgrn_lb(p, l, hc * 64 + (tid & 7) * 8 + j);
    float S[8], P[8];
#pragma unroll
    for (int j = 0; j < 8; ++j) { S[j] = 0.f; P[j] = 1.f; }
    for (int cks = 0; cks < 8; ++cks) {
        __syncthreads();
        hgrn_stage(PROJ, row0 + cks * 64, hc, lb8, F, V, nullptr, tid);
        __syncthreads();
        for (int tt = 0; tt < 64; ++tt) {
            const f32x4 fa = *(const LAS f32x4*)(F + tt * 64 + wave * 8), fb = *(const LAS f32x4*)(F + tt * 64 + wave * 8 + 4); const float vv = V[tt * 64 + lane];
            const float f8[8] = {fa.x, fa.y, fa.z, fa.w, fb.x, fb.y, fb.z, fb.w};
#pragma unroll
            for (int j = 0; j < 8; ++j) { S[j] = fmaf(f8[j], S[j] - vv, vv); P[j] *= f8[j]; }
        }
    }
    float* SEGS = (float*)(p.ws + WS_SEGS); float* SEGP = (float*)(p.ws + WS_SEGP);
#pragma unroll
    for (int j = 0; j < 8; ++j) { SEGS[(size_t)unit * 4096 + (wave * 8 + j) * 64 + lane] = S[j]; if (lane == 0) SEGP[unit * 64 + wave * 8 + j] = P[j]; }
    __syncthreads();
}
__device__ __forceinline__ void mixer_c_pass2_simple(const Ctx& p, int l, int unit, LAS unsigned char* lds, int wave, int lane) {
    LAS float* F = (LAS float*)lds; LAS float* V = F + 4096; LAS float* Q = V + 4096; LAS float* PO = Q + 4096;
    const int bh = unit >> 4, seg = unit & 15, b = bh >> 2, hc = bh & 3; const size_t row0 = (size_t)b * SEQ + (size_t)seg * 512;
    const bf16* PROJ = (const bf16*)(p.ws + WS_PROJ); bf16* MIXED = (bf16*)(p.ws + WS_MIXED); const int tid = wave * 64 + lane;
    const float* SEGS = (const float*)(p.ws + WS_SEGS); const float* SEGP = (const float*)(p.ws + WS_SEGP);
    float lb8[8];
#pragma unroll
    for (int j = 0; j < 8; ++j) lb8[j] = hgrn_lb(p, l, hc * 64 + (tid & 7) * 8 + j);
    float S[8];
#pragma unroll
    for (int j = 0; j < 8; ++j) S[j] = 0.f;
    for (int s = 0; s < seg; ++s) { const int u2 = bh * 16 + s;
#pragma unroll
        for (int j = 0; j < 8; ++j) S[j] = SEGP[u2 * 64 + wave * 8 + j] * S[j] + SEGS[(size_t)u2 * 4096 + (wave * 8 + j) * 64 + lane]; }
    const float ong = PIN(p, I_ONG)[l * 64 + lane];
    for (int cks = 0; cks < 8; ++cks) {
        __syncthreads();
        hgrn_stage(PROJ, row0 + cks * 64, hc, lb8, F, V, Q, tid);
        __syncthreads();
        for (int tg = 0; tg < 4; ++tg) {
            for (int t16 = 0; t16 < 16; ++t16) { const int tt = tg * 16 + t16;
                const f32x4 fa = *(const LAS f32x4*)(F + tt * 64 + wave * 8), fb = *(const LAS f32x4*)(F + tt * 64 + wave * 8 + 4);
                const f32x4 qa = *(const LAS f32x4*)(Q + tt * 64 + wave * 8), qb = *(const LAS f32x4*)(Q + tt * 64 + wave * 8 + 4); const float vv = V[tt * 64 + lane];
                const float f8[8] = {fa.x, fa.y, fa.z, fa.w, fb.x, fb.y, fb.z, fb.w}; const float q8[8] = {qa.x, qa.y, qa.z, qa.w, qb.x, qb.y, qb.z, qb.w};
                float po = 0.f;
#pragma unroll
                for (int j = 0; j < 8; ++j) { S[j] = fmaf(f8[j], S[j] - vv, vv); po = fmaf(q8[j], S[j], po); }
                PO[(t16 * 8 + wave) * 64 + lane] = po; }
            __syncthreads();
#pragma unroll
            for (int e = 0; e < 2; ++e) { const int t16 = wave * 2 + e; float o = 0.f;
#pragma unroll
                for (int w = 0; w < 8; ++w) o += PO[(t16 * 8 + w) * 64 + lane];
                const float ss = wave_sum(o * o); const size_t row = row0 + cks * 64 + tg * 16 + t16;
                const float gg = bf2f(PROJ[row * INW + C_CG + hc * 64 + lane]);
                MIXED[row * DM + MX_C + hc * 64 + lane] = (bf16)f2bf(o * rsqrtf(ss * (1.0f / 64.0f) + EPS) * ong * gg * DBG_C); }
            __syncthreads();
        }
    }
}

#endif


__device__ __forceinline__ float wave_sum_dpp(float v) {
    v += __int_as_float(__builtin_amdgcn_update_dpp(0, __float_as_int(v), 0xB1, 0xf, 0xf, true));
    v += __int_as_float(__builtin_amdgcn_update_dpp(0, __float_as_int(v), 0x4E, 0xf, 0xf, true));
    v += __int_as_float(__builtin_amdgcn_update_dpp(0, __float_as_int(v), 0x141, 0xf, 0xf, true));
    v += __int_as_float(__builtin_amdgcn_update_dpp(0, __float_as_int(v), 0x140, 0xf, 0xf, true));
    const int vi = __float_as_int(v);
    return (__int_as_float(__builtin_amdgcn_readlane(vi, 0)) + __int_as_float(__builtin_amdgcn_readlane(vi, 16))) + (__int_as_float(__builtin_amdgcn_readlane(vi, 32)) + __int_as_float(__builtin_amdgcn_readlane(vi, 48)));
}
namespace mc {
constexpr int QT = 0, KT = 4096, QH = 8192, KH = 12288, VV = 16384, DD = 20480, WTO = 20736, OE = 22784, OI = 30976, RB = 39168, LDS_END = 55552, OG = 55552;
}
#define MC_BAR() do { asm volatile("s_waitcnt lgkmcnt(0)" ::: "memory"); __builtin_amdgcn_s_barrier(); asm volatile("" ::: "memory"); } while (0)
template <bool PASS2>
__device__ __forceinline__ void mixer_c_mfma(const Ctx& p, int l, int unit, LAS unsigned char* lds, int wave, int lane) {
    using namespace mb;
    const int bh = unit >> 4, seg = unit & 15, b = bh >> 2, hc = bh & 3; const size_t row0 = (size_t)b * SEQ + (size_t)seg * 512;
    const bf16* PROJ = (const bf16*)(p.ws + WS_PROJ); bf16* MIXED = (bf16*)(p.ws + WS_MIXED);
    float* SEGS = (float*)(p.ws + WS_SEGS); float* SEGP = (float*)(p.ws + WS_SEGP);
    const int r32 = lane & 31, hi = lane >> 5, kt_lane_off = ((lane >> 4) & 1) * 32 + (lane & 3) * 8 + (4 * hi + ((lane & 15) >> 2)) * 64;
    const int cp = lane & 31, th = lane >> 5;
    const f32x2 lb2 = (f32x2){hgrn_lb(p, l, hc * 64 + 2 * cp), hgrn_lb(p, l, hc * 64 + 2 * cp + 1)}, omlb2 = (f32x2){1.0f - lb2.x, 1.0f - lb2.y};
    const int st = (((wave & 3) * 64 + lane) >> 3), sc8 = (lane & 7) * 8;
    if (PASS2 && wave == 7) ((LAS float*)(lds + mc::OG))[lane] = PIN(p, I_ONG)[l * 64 + lane] * DBG_C;
    f32x16 S0 = {}, S1 = {};
    if (PASS2) {
        LAS float* Ptab = (LAS float*)(lds + mc::OE);
        { const float* ps = SEGP + (size_t)bh * 16 * 64; const int t_ = wave * 64 + lane; const float p0_ = ps[t_], p1_ = ps[t_ + 512]; Ptab[t_] = p0_; Ptab[t_ + 512] = p1_; }
        MC_BAR();
        if (wave < 2) {
            const float* sbase = SEGS + (size_t)bh * 16 * 4096 + wave * 2048 + lane;
            for (int s = 0; s < seg; s += 4) {
                float buf[4][32];
#pragma unroll
                for (int j = 0; j < 4; ++j) { const int sj = (s + j < seg) ? s + j : seg - 1;
#pragma unroll
                    for (int r = 0; r < 32; ++r) buf[j][r] = sbase[(size_t)sj * 4096 + r * 64]; }
#pragma unroll
                for (int j = 0; j < 4; ++j) if (s + j < seg) { const LAS float* pp = Ptab + (s + j) * 64 + 4 * hi;
#pragma unroll
                    for (int gq = 0; gq < 4; ++gq) { const f32x4 d0 = *(const LAS f32x4*)(pp + 8 * gq), d1 = *(const LAS f32x4*)(pp + 32 + 8 * gq);
#pragma unroll
                        for (int e = 0; e < 4; ++e) { const int r = 4 * gq + e; S0[r] = d0[e] * S0[r] + buf[j][r]; S1[r] = d1[e] * S1[r] + buf[j][16 + r]; } } }
            }
        }
    }
    f32x2 sumtot = (f32x2){0.f, 0.f};
    const int tid = wave * 64 + lane, ptok = (tid & 255) >> 3, pch = tid & 7, parr = tid >> 8;
    const bf16* gsrc = PROJ + (row0 + ptok) * INW + hc * 64 + pch * 8;
    const int rboff = ptok * 128 + pch * 16;
    v4u pf0, pf1 = (v4u){0u, 0u, 0u, 0u};
    pf0 = *(const v4u*)(gsrc + (parr ? C_CI : C_CF)); if (PASS2) pf1 = *(const v4u*)(gsrc + (parr ? C_CG : C_CQ));
    *(LAS v4u*)(lds + mc::RB + parr * 4096 + rboff) = pf0; if (PASS2) *(LAS v4u*)(lds + mc::RB + (2 + parr) * 4096 + rboff) = pf1;
    MC_BAR();
#ifdef DBG_TIMEC
    long long tacc = 0; const long long tunit0 = clock64();
#endif
#pragma unroll 1
    for (int n = 0; n < 16; ++n) {
#ifdef DBG_TIMEC
        const long long ts1 = clock64();
#endif
        if (n + 1 < 16) { const bf16* gn = gsrc + (size_t)(32 * (n + 1)) * INW;
            pf0 = *(const v4u*)(gn + (parr ? C_CI : C_CF)); if (PASS2) pf1 = *(const v4u*)(gn + (parr ? C_CG : C_CQ)); }
        v4u gvr = (v4u){0u, 0u, 0u, 0u};
        if (PASS2 && wave >= 4) gvr = *(const LAS v4u*)(lds + mc::RB + (6144 + st * 64 + sc8) * 2);
        f32x2 fg[2], cs[2], qv[2], vv[2];
#pragma unroll
        for (int i = 0; i < 2; ++i) { const LAS unsigned* rp = (const LAS unsigned*)(lds + mc::RB) + (4 * wave + 2 * th + i) * 32 + cp;
            const unsigned zw = rp[0], vw = rp[1024];
            const float z0 = fmaxf(bflo(zw), -30.f), z1 = fmaxf(bfhi(zw), -30.f);
            fg[i] = (f32x2){lb2.x + omlb2.x * __builtin_amdgcn_rcpf(1.0f + __builtin_amdgcn_exp2f(z0 * -1.4426950408889634f)), lb2.y + omlb2.y * __builtin_amdgcn_rcpf(1.0f + __builtin_amdgcn_exp2f(z1 * -1.4426950408889634f))};
            vv[i] = (f32x2){bflo(vw), bfhi(vw)};
            if (PASS2) { const unsigned qw = rp[2048]; qv[i] = (f32x2){bflo(qw), bfhi(qw)}; } }
        cs[0] = (f32x2){__builtin_amdgcn_logf(fg[0].x), __builtin_amdgcn_logf(fg[0].y)}; cs[1] = cs[0] + (f32x2){__builtin_amdgcn_logf(fg[1].x), __builtin_amdgcn_logf(fg[1].y)};
        { const f32x2 other = (f32x2){__shfl_xor(cs[1].x, 32), __shfl_xor(cs[1].y, 32)};
            if (th) { cs[0] = cs[0] + other; cs[1] = cs[1] + other; ((LAS f32x2*)(lds + mc::WTO))[wave * 32 + cp] = cs[1]; } }
#ifdef DBG_TIMEC
        const long long tb1a = clock64(); if (DBG_TIMEC == 11) tacc += tb1a - ts1;
#endif
        MC_BAR();
#ifdef DBG_TIMEC
        const long long tb1b = clock64(); if (DBG_TIMEC == 12) tacc += tb1b - tb1a;
#endif
        f32x2 off = (f32x2){0.f, 0.f}, tot = off, mid = off;
#pragma unroll
        for (int w = 0; w < 8; ++w) { const f32x2 tw = ((const LAS f32x2*)(lds + mc::WTO))[w * 32 + cp]; if (w < wave) off = off + tw; if (w < 4) mid = mid + tw; tot = tot + tw; }
        sumtot = sumtot + tot;
#pragma unroll
        for (int i = 0; i < 2; ++i) { const int t = 4 * wave + 2 * th + i; const f32x2 Bt = off + cs[i], kk = (f32x2){1.0f - fg[i].x, 1.0f - fg[i].y};
            const int chb = (cp >> 2) * 512 + t * 16 + (cp & 3) * 4, vlb = (cp >> 4) * 2048 + (t >> 4) * 1024 + (t & 15) * 64 + (cp & 15) * 4;
            *(LAS unsigned*)(lds + mc::KH + vlb) = cvtpk(kk.x * __builtin_amdgcn_exp2f(tot.x - Bt.x), kk.y * __builtin_amdgcn_exp2f(tot.y - Bt.y));
            *(LAS unsigned*)(lds + mc::VV + vlb) = cvtpk(vv[i].x, vv[i].y);
            if (PASS2) { *(LAS unsigned*)(lds + mc::QT + chb) = cvtpk(qv[i].x * __builtin_amdgcn_exp2f(fminf(Bt.x - mid.x, 115.f)), qv[i].y * __builtin_amdgcn_exp2f(fminf(Bt.y - mid.y, 115.f)));
                *(LAS unsigned*)(lds + mc::KT + chb) = cvtpk(kk.x * __builtin_amdgcn_exp2f(fminf(mid.x - Bt.x, 115.f)), kk.y * __builtin_amdgcn_exp2f(fminf(mid.y - Bt.y, 115.f)));
                *(LAS unsigned*)(lds + mc::QH + chb) = cvtpk(qv[i].x * __builtin_amdgcn_exp2f(Bt.x), qv[i].y * __builtin_amdgcn_exp2f(Bt.y)); } }
        if (wave == 0 && th == 0) ((LAS f32x2*)(lds + mc::DD))[cp] = (f32x2){__builtin_amdgcn_exp2f(tot.x), __builtin_amdgcn_exp2f(tot.y)};
#ifdef DBG_TIMEC
        const long long tb2a = clock64(); if (DBG_TIMEC == 13) tacc += tb2a - tb1b;
#endif
        MC_BAR();
#ifdef DBG_TIMEC
        const long long ts2 = clock64(); if (DBG_TIMEC == 14) tacc += ts2 - tb2a; if (DBG_TIMEC == 1) tacc += ts2 - ts1;
#endif
        if (wave < 2) {
            const int vt = wave;
            if (PASS2) {
                f32x16 o = {};
#pragma unroll
                for (int kt = 0; kt < 2; ++kt)
#pragma unroll
                    for (int s2 = 0; s2 < 2; ++s2) { const LAS unsigned char* qa = lds + mc::QH + (4 * kt + 2 * s2) * 512 + r32 * 16 + 8 * hi;
                        const v2u a0 = *(const LAS v2u*)qa, a1 = *(const LAS v2u*)(qa + 512); v4u aw; aw.x = a0.x; aw.y = a0.y; aw.z = a1.x; aw.w = a1.y;
                        v4u bw;
                        if (kt == 0) { bw.x = cvtpk(S0[8 * s2 + 0], S0[8 * s2 + 1]); bw.y = cvtpk(S0[8 * s2 + 2], S0[8 * s2 + 3]); bw.z = cvtpk(S0[8 * s2 + 4], S0[8 * s2 + 5]); bw.w = cvtpk(S0[8 * s2 + 6], S0[8 * s2 + 7]); }
                        else { bw.x = cvtpk(S1[8 * s2 + 0], S1[8 * s2 + 1]); bw.y = cvtpk(S1[8 * s2 + 2], S1[8 * s2 + 3]); bw.z = cvtpk(S1[8 * s2 + 4], S1[8 * s2 + 5]); bw.w = cvtpk(S1[8 * s2 + 6], S1[8 * s2 + 7]); }
                        o = __builtin_amdgcn_mfma_f32_32x32x16_bf16(__builtin_bit_cast(bf16x8, aw), __builtin_bit_cast(bf16x8, bw), o, 0, 0, 0); }
#pragma unroll
                for (int r = 0; r < 16; ++r) ((LAS float*)(lds + mc::OE))[crow(r, hi) * 64 + 32 * vt + r32] = o[r];
            }
            { const LAS float* dp = (const LAS float*)(lds + mc::DD) + 4 * hi;
#pragma unroll
                for (int gq = 0; gq < 4; ++gq) { const f32x4 d0 = *(const LAS f32x4*)(dp + 8 * gq), d1 = *(const LAS f32x4*)(dp + 32 + 8 * gq);
#pragma unroll
                    for (int e = 0; e < 4; ++e) { S0[4 * gq + e] *= d0[e]; S1[4 * gq + e] *= d1[e]; } } }
#pragma unroll
            for (int ks = 0; ks < 2; ++ks) {
                const LAS unsigned char* vb = lds + mc::VV + vt * 2048 + ks * 1024 + kt_lane_off; const s16x4 vl = vtr(vb), vh = vtr(vb + 512);
                const bf16x8 bv = (bf16x8){vl[0], vl[1], vl[2], vl[3], vh[0], vh[1], vh[2], vh[3]};
                const LAS unsigned char* k0 = lds + mc::KH + ks * 1024 + kt_lane_off; const s16x4 al = vtr(k0), ah = vtr(k0 + 512), bl = vtr(k0 + 2048), bh_ = vtr(k0 + 2048 + 512);
                const bf16x8 a0 = (bf16x8){al[0], al[1], al[2], al[3], ah[0], ah[1], ah[2], ah[3]}, a1 = (bf16x8){bl[0], bl[1], bl[2], bl[3], bh_[0], bh_[1], bh_[2], bh_[3]};
                S0 = __builtin_amdgcn_mfma_f32_32x32x16_bf16(a0, bv, S0, 0, 0, 0); S1 = __builtin_amdgcn_mfma_f32_32x32x16_bf16(a1, bv, S1, 0, 0, 0); }
        } else if (PASS2 && wave < 4) {
            const int vt = wave - 2;
            f32x16 at = {};
#pragma unroll
            for (int ks = 0; ks < 4; ++ks) { const bf16x8 a = *(const LAS bf16x8*)(lds + mc::KT + (2 * ks + hi) * 512 + r32 * 16), bq = *(const LAS bf16x8*)(lds + mc::QT + (2 * ks + hi) * 512 + r32 * 16);
                at = __builtin_amdgcn_mfma_f32_32x32x16_bf16(a, bq, at, 0, 0, 0); }
            f32x16 o = {};
#pragma unroll
            for (int ks = 0; ks < 2; ++ks) { float m8[8];
#pragma unroll
                for (int j = 0; j < 8; ++j) { const int r = 8 * ks + j; m8[j] = (crow(r, hi) <= r32) ? at[r] : 0.f; }
                v4u pw; pw.x = cvtpk(m8[0], m8[1]); pw.y = cvtpk(m8[2], m8[3]); pw.z = cvtpk(m8[4], m8[5]); pw.w = cvtpk(m8[6], m8[7]);
                const LAS unsigned char* vb = lds + mc::VV + vt * 2048 + ks * 1024 + kt_lane_off; const s16x4 vl = vtr(vb), vh = vtr(vb + 512);
                const bf16x8 bv = (bf16x8){vl[0], vl[1], vl[2], vl[3], vh[0], vh[1], vh[2], vh[3]};
                o = __builtin_amdgcn_mfma_f32_32x32x16_bf16(__builtin_bit_cast(bf16x8, pw), bv, o, 0, 0, 0); }
#pragma unroll
            for (int r = 0; r < 16; ++r) ((LAS float*)(lds + mc::OI))[crow(r, hi) * 64 + 32 * vt + r32] = o[r];
        }
#ifdef DBG_TIMEC
        const long long ts2b = clock64(); if (DBG_TIMEC == 2) tacc += ts2b - ts2;
#endif
        if (n + 1 < 16) { *(LAS v4u*)(lds + mc::RB + parr * 4096 + rboff) = pf0; if (PASS2) *(LAS v4u*)(lds + mc::RB + (2 + parr) * 4096 + rboff) = pf1; }
        MC_BAR();
#ifdef DBG_TIMEC
        const long long ts3 = clock64(); if (DBG_TIMEC == 6) tacc += ts3 - ts2b;
#endif
        if (PASS2 && wave >= 4) {
            const LAS float* oe = (const LAS float*)(lds + mc::OE) + st * 64 + sc8; const LAS float* oi = (const LAS float*)(lds + mc::OI) + st * 64 + sc8;
            const f32x4 o0 = *(const LAS f32x4*)oe + *(const LAS f32x4*)oi, o1 = *(const LAS f32x4*)(oe + 4) + *(const LAS f32x4*)(oi + 4);
            float ss = ((o0[0] * o0[0] + o0[1] * o0[1]) + (o0[2] * o0[2] + o0[3] * o0[3])) + ((o1[0] * o1[0] + o1[1] * o1[1]) + (o1[2] * o1[2] + o1[3] * o1[3]));
            ss += __int_as_float(__builtin_amdgcn_update_dpp(0, __float_as_int(ss), 0xB1, 0xf, 0xf, true));
            ss += __int_as_float(__builtin_amdgcn_update_dpp(0, __float_as_int(ss), 0x4E, 0xf, 0xf, true));
            ss += __int_as_float(__builtin_amdgcn_update_dpp(0, __float_as_int(ss), 0x141, 0xf, 0xf, true));
            const float rs = rsqrtf(ss * (1.0f / 64.0f) + EPS);
            const f32x4 g0 = (f32x4){bflo(gvr.x), bfhi(gvr.x), bflo(gvr.y), bfhi(gvr.y)}, g1 = (f32x4){bflo(gvr.z), bfhi(gvr.z), bflo(gvr.w), bfhi(gvr.w)};
            const LAS float* ogp = (const LAS float*)(lds + mc::OG) + sc8; const f32x4 ong0 = *(const LAS f32x4*)ogp, ong1 = *(const LAS f32x4*)(ogp + 4);
            const f32x4 y0 = o0 * rs * ong0 * g0, y1 = o1 * rs * ong1 * g1;
            v4u w; w.x = cvtpk(y0[0], y0[1]); w.y = cvtpk(y0[2], y0[3]); w.z = cvtpk(y1[0], y1[1]); w.w = cvtpk(y1[2], y1[3]);
            *(v4u*)(MIXED + (row0 + 32 * n + st) * DM + MX_C + hc * 64 + sc8) = w;
        }
    }
#ifdef DBG_TIMEC
    if (PASS2 && unit == DBG_TIMEC_UNIT && wave == DBG_TIMEC_WAVE && lane == 0) { if (DBG_TIMEC == 4) tacc = clock64() - tunit0; ((float*)(p.ws + WS_TAB + 65536))[4] = (float)tacc; }
#endif
    if (!PASS2) {
        if (wave < 2) { float* sp = SEGS + ((size_t)(unit * 2 + wave) * 2) * 16 * 64 + lane;
#pragma unroll
            for (int r = 0; r < 16; ++r) { sp[(size_t)r * 64] = S0[r]; sp[(size_t)(16 + r) * 64] = S1[r]; } }
        if (wave == 0 && th == 0) { SEGP[unit * 64 + 2 * cp] = __builtin_amdgcn_exp2f(sumtot.x); SEGP[unit * 64 + 2 * cp + 1] = __builtin_amdgcn_exp2f(sumtot.y); }
    }
    __syncthreads();
}
__device__ __forceinline__ void ffn_fixup(const Ctx& p, int l, int tid) {
    const float* HG = (const float*)(p.ws + WS_HG); const float* HU = (const float*)(p.ws + WS_HU); bf16* ACT = (bf16*)(p.ws + WS_ACT);
    const float* cw = PIN(p, I_CONVW) + (size_t)l * 3 * DFF; const float* cb = PIN(p, I_CONVB) + (size_t)l * DFF;
    const int total = 512 * 2 * (DFF / 4);
    for (int idx = blockIdx.x * (NWAVES * 64) + tid; idx < total; idx += gridDim.x * (NWAVES * 64)) {
        const int c4 = idx % (DFF / 4), rr = idx / (DFF / 4), rho = rr & 1, blk = rr >> 1, ch = 4 * c4;
        const bool first = (blk % 128) == 0;
        const f32x4 z = (f32x4){0.f, 0.f, 0.f, 0.f};
        const f32x4 g0 = *(const f32x4*)(HG + ((size_t)blk * 4 + rho) * DFF + ch);
        f32x4 g1, g2;
        if (rho == 1) { g1 = *(const f32x4*)(HG + ((size_t)blk * 4 + 0) * DFF + ch); g2 = first ? z : *(const f32x4*)(HG + ((size_t)(blk - 1) * 4 + 3) * DFF + ch); }
        else { g1 = first ? z : *(const f32x4*)(HG + ((size_t)(blk - 1) * 4 + 3) * DFF + ch); g2 = first ? z : *(const f32x4*)(HG + ((size_t)(blk - 1) * 4 + 2) * DFF + ch); }
        const f32x4 up = *(const f32x4*)(HU + ((size_t)blk * 2 + rho) * DFF + ch);
        const f32x4 w0 = *(const f32x4*)(cw + ch), w1 = *(const f32x4*)(cw + DFF + ch), w2 = *(const f32x4*)(cw + 2 * DFF + ch), bb = *(const f32x4*)(cb + ch);
        f32x4 c = bb + w0 * g2 + w1 * g1 + w2 * g0;
#pragma unroll
        for (int j = 0; j < 4; ++j) c[j] = silu_f(c[j]) * up[j];
        v2u w; w.x = pk2(c[0], c[1]); w.y = pk2(c[2], c[3]);
        *(v2u*)(ACT + ((size_t)blk * 64 + rho) * DFF + ch) = w;
    }
}

#ifndef PREB_ON
#define PREB_ON 0
#endif
#ifdef NOPK
#define NOPK_ATTR __attribute__((target("no-packed-fp32-ops")))
#else
#define NOPK_ATTR
#endif
constexpr int PH_PER_LAYER = 7, N_PHASES = 1 + DEPTH * PH_PER_LAYER;
__global__ void __launch_bounds__(NWAVES * 64, 2) NOPK_ATTR fwd_kernel(Params args) {
    extern __shared__ __attribute__((aligned(16))) unsigned char lds_raw[];
    LAS unsigned char* lds = (LAS unsigned char*)lds_raw;
    volatile LAS unsigned* MISC = (volatile LAS unsigned*)(lds + MISC_OFF);
    volatile LAS unsigned long long* TAB = (volatile LAS unsigned long long*)(lds + TAB_OFF);
    LAS unsigned char* BKT = lds + TAB_OFF + 256;
    if (threadIdx.x < 64) MISC[threadIdx.x] = 0u;
    if (threadIdx.x == 0) {
#pragma unroll
        for (int i = 0; i < 19; ++i) TAB[i] = (unsigned long long)args.in[i];
        TAB[19] = (unsigned long long)args.out;
    }
    if (threadIdx.x >= 64 && threadIdx.x < 192) BKT[threadIdx.x - 64] = args.bucket[threadIdx.x - 64];
    __builtin_amdgcn_fence(__ATOMIC_RELEASE, "workgroup"); __builtin_amdgcn_s_barrier(); __builtin_amdgcn_fence(__ATOMIC_ACQUIRE, "workgroup");
    unsigned* barw = (unsigned*)(args.ws + WS_CTL) + CW_BAR + args.bar_region * XCD_BAR_WORDS;
    const int lo = args.ph_lo, hi = args.ph_hi;
    XcdBarrier bar; bar.bar = barw; bar.x = 0; bar.st = nullptr;
    if (hi - lo > 1) bar = xcd_barrier_post(barw, MISC + 8);
    const int wave_s = 0; bar.wv = 0;
    const int G_raw = gridDim.x;
#pragma nounroll
    for (int ph = lo; ph < hi; ++ph) {
        const int l = (ph - 1) / PH_PER_LAYER, k = (ph == 0) ? -1 : (ph - 1) % PH_PER_LAYER;
#ifdef DBG_DOUBLE
        const int nrep = ((ph == 0 ? 7 : k) == DBG_DOUBLE) ? 2 : 1;
#else
        const int nrep = 1;
#endif
#pragma nounroll
        for (int rep = 0; rep < nrep; ++rep) {
        int bid = (int)blockIdx.x, G = G_raw; asm volatile("" : "+s"(bid), "+s"(G));
        int tid = threadIdx.x; asm volatile("" : "+v"(tid));
        Ctx p; p.tab = TAB; p.bucket = nullptr; { GAS unsigned char* wsg = (GAS unsigned char*)args.ws; asm volatile("" : "+s"(wsg)); p.ws = (unsigned char*)wsg; }
        const int lane = tid & 63, wave = __builtin_amdgcn_readfirstlane(tid >> 6);
        const unsigned char* wl = p.ws + WS_W + (size_t)l * W_LAYER;
        if (ph == 0) {
#ifndef NO_P0
            prologue(p, lds, wave, lane, rep == 0);
#endif
        } else if (k == 0) {
#ifndef NO_P1
            pg8::Gemm g{(const bf16*)(p.ws + WS_XB), (const bf16*)(wl + W_IN), M, INW, DM, (PREB_ON && hi - lo > 1 && ph > 1) ? 1 : 0, wave_s}; InProjOrder S; S.init(M, INW, G, bid);
            if (bid >= 128 && rep == 0) { for (int z = 0; z < SKEW_P1; ++z) __builtin_amdgcn_s_sleep(127); }
            EpiInProj E{(bf16*)(p.ws + WS_PROJ), (const unsigned long long*)(p.ws + WS_SS) + (size_t)(2 * l) * M, DBG_EPI_MODE(rep), lds};
            pg8::gemm_phase<EpiInProj, InProjOrder, true, true>(lds, g, S, E);
#endif
        } else if (k == 1) {
#ifndef NO_P2A
#ifdef DBG_MIXCMP
            if (args.flags & 1) { for (int u = bid; u < 256; u += G) mixer_c_pass1_simple(p, l, u, lds, wave, lane); } else
#endif
            for (int rr = 0; rr < DBG_REP_C1; ++rr)
            for (int u = bid; u < 256; u += G) mixer_c_mfma<false>(p, l, u, lds, wave, lane);
#ifdef DBG_MIXCMP
            if (args.flags & 1) { for (int u = bid; u < 1024; u += G) mixer_a_simple(p, l, u, lds, wave, lane); } else
#endif
            for (int u = bid; u < 256; u += G) mixer_a_mfma(p, l, u, lds, wave, lane);
#endif
        } else if (k == 2) {
#ifndef NO_P2B
#ifdef DBG_MIXCMP
            if (args.flags & 1) { for (int u = bid; u < 256; u += G) mixer_c_pass2_simple(p, l, u, lds, wave, lane); } else
#endif
            for (int rr = 0; rr < DBG_REP_C2; ++rr)
            for (int u = bid; u < 256; u += G) mixer_c_mfma<true>(p, l, u, lds, wave, lane);
#ifdef DBG_MIXCMP
            if (args.flags & 1) { for (int u = bid; u < 512; u += G) mixer_b_simple(p, l, u, lds, wave, lane); } else
#endif
            for (int rr = 0; rr < DBG_REP_B; ++rr)
            for (int u = bid; u < 512; u += G) mixer_b_mfma(p, l, u, lds, wave, lane);
#endif
        } else if (k == 3) {
#ifndef NO_P3
            pg8::Gemm g{(const bf16*)(p.ws + WS_MIXED), (const bf16*)(wl + W_OUT), M, DM, DM, (PREB_ON && hi - lo > 1) ? 1 : 0, wave_s}; pg8::StaticOrder S; S.init(M, DM, G, bid);
            EpiResid E{(bf16*)(p.ws + WS_XB), nullptr, (unsigned long long*)(p.ws + WS_SS) + (size_t)(2 * l + 1) * M, rep == 0 ? 1 : 0};
            pg8::gemm_phase<EpiResid, pg8::StaticOrder, true, true>(lds, g, S, E);
#endif
        } else if (k == 4) {
#ifndef NO_P4
            pg8::Gemm g{(const bf16*)(p.ws + WS_XB), (const bf16*)(wl + W_GU), M, NGU, DM, (PREB_ON && hi - lo > 1) ? 1 : 0, wave_s}; pg8::StaticOrder S; S.init(M, NGU, G, bid);
            if (((bid >> 3) & 1) && rep == 0) { for (int z = 0; z < SKEW_P4; ++z) __builtin_amdgcn_s_sleep(127); }
            EpiFFN E{(bf16*)(p.ws + WS_ACT), (const unsigned long long*)(p.ws + WS_SS) + (size_t)(2 * l + 1) * M, PIN(p, I_CONVW) + (size_t)l * 3 * DFF, PIN(p, I_CONVB) + (size_t)l * DFF, (float*)(p.ws + WS_HG), (float*)(p.ws + WS_HU), DBG_EPI_MODE(rep), lds};
            pg8::gemm_phase<EpiFFN, pg8::StaticOrder, true, true>(lds, g, S, E);
#endif
        } else if (k == 5) {
            ffn_fixup(p, l, tid);
        } else {
#ifndef NO_P5
            pg8::Gemm g{(const bf16*)(p.ws + WS_ACT), (const bf16*)(wl + W_DN), M, DM, DFF, (PREB_ON && hi - lo > 1) ? 1 : 0, wave_s}; pg8::StaticOrder S; S.init(M, DM, G, bid);
            EpiResid E{(bf16*)(p.ws + WS_XB), POUT(p), (unsigned long long*)(p.ws + WS_SS) + (size_t)(2 * l + 2) * M, rep != 0 ? 0 : ((l + 1 < DEPTH) ? 1 : 2)};
            pg8::gemm_phase<EpiResid, pg8::StaticOrder, true, true>(lds, g, S, E);
#endif
        }
        }
        if (ph + 1 < hi) {
            xcd_barrier_head();
            if (PREB_ON && hi - lo > 1 && ph >= 1) {
                const int k2 = ph % PH_PER_LAYER, l2 = ph / PH_PER_LAYER;
                const int N2 = (k2 == 0) ? INW : (k2 == 3 || k2 == 6) ? DM : (k2 == 4) ? NGU : 0, K2 = (k2 == 6) ? DFF : DM;
                const size_t wo2 = (k2 == 0) ? W_IN : (k2 == 3) ? W_OUT : (k2 == 4) ? W_GU : W_DN;
                if (N2 != 0) { pg8::Unit u2{0, 0}; bool ok2; int bid = (int)blockIdx.x, G = G_raw; asm volatile("" : "+s"(bid), "+s"(G));
                    if (k2 == 0) { InProjOrder S; S.init(M, INW, G, bid); ok2 = S.next(0, u2); } else { pg8::StaticOrder S; S.init(M, N2, G, bid); ok2 = S.next(0, u2); }
                    GAS unsigned char* wsg = (GAS unsigned char*)args.ws; asm volatile("" : "+s"(wsg));
                    if (ok2) pg8::gemm_prefetch_b(lds, (const bf16*)((const unsigned char*)wsg + WS_W + (size_t)l2 * W_LAYER + wo2), K2, u2.pn, wave_s); }
            }
            xcd_barrier_tail(bar);
#ifdef DBG_EXTRA_BAR
            for (int z = 0; z < DBG_EXTRA_BAR; ++z) xcd_barrier(bar);
#endif
        }
    }
}


#if defined(DBG_NAIVE_DOWN)
__global__ void __launch_bounds__(256) dbg_down(const bf16* ACT, const float* Wd, const float* X1, float* out) {
    __shared__ float a[4][DFF];
    const int r0 = blockIdx.x * 4, c = threadIdx.x * 4;
    for (int i = threadIdx.x; i < 4 * DFF; i += 256) a[i / DFF][i % DFF] = bf2f(ACT[(size_t)(r0 + i / DFF) * DFF + i % DFF]);
    __syncthreads();
    f32x4 acc[4]; for (int r = 0; r < 4; ++r) acc[r] = (f32x4){0.f, 0.f, 0.f, 0.f};
    for (int k = 0; k < DFF; ++k) { const f32x4 w = *(const f32x4*)(Wd + (size_t)k * DM + c);
        for (int r = 0; r < 4; ++r) acc[r] += w * a[r][k]; }
    for (int r = 0; r < 4; ++r) { const size_t off = (size_t)(r0 + r) * DM + c; *(f32x4*)(out + off) = *(const f32x4*)(X1 + off) + acc[r]; }
}
#endif

#if defined(DBG_FFNCMP)
constexpr int DBG_R = 512;
__global__ void __launch_bounds__(256) dbg_gu(const float* X1, const float* g2, const float* Wg, const float* Wu, float* GU) {
    __shared__ float h[DM];
    const int r = blockIdx.x, c = blockIdx.y * 256 + threadIdx.x;
    float ss = 0.f; for (int k = threadIdx.x; k < DM; k += 256) { const float v = X1[(size_t)r * DM + k]; ss += v * v; }
    __shared__ float red[256]; red[threadIdx.x] = ss; __syncthreads();
    for (int o = 128; o > 0; o >>= 1) { if (threadIdx.x < o) red[threadIdx.x] += red[threadIdx.x + o]; __syncthreads(); }
    const float rstd = rsqrtf(red[0] / DM + EPS);
    for (int k = threadIdx.x; k < DM; k += 256) h[k] = X1[(size_t)r * DM + k] * rstd * g2[k];
    __syncthreads();
    if (c < DFF) { float a = 0.f, b = 0.f; for (int k = 0; k < DM; ++k) { a += h[k] * Wg[(size_t)k * DFF + c]; b += h[k] * Wu[(size_t)k * DFF + c]; }
        GU[((size_t)r * 2 + 0) * DFF + c] = a; GU[((size_t)r * 2 + 1) * DFF + c] = b; }
}
__global__ void __launch_bounds__(256) dbg_cmp(const float* GU, const float* cw, const float* cb, const bf16* ACT, float* acc2) {
    const int r = blockIdx.x, c = blockIdx.y * 256 + threadIdx.x; float num = 0.f, den = 0.f;
    if (c < DFF) { const float g0 = GU[((size_t)r * 2) * DFF + c], g1 = r >= 1 ? GU[((size_t)(r - 1) * 2) * DFF + c] : 0.f, g2 = r >= 2 ? GU[((size_t)(r - 2) * 2) * DFF + c] : 0.f;
#if defined(DBG_TAPS) && DBG_TAPS == 0
        const float cv = cb[c] + cw[2 * DFF + c] * g0;
#elif defined(DBG_TAPS) && DBG_TAPS == 1
        const float cv = cb[c] + cw[DFF + c] * g1 + cw[2 * DFF + c] * g0;
#else
        const float cv = cb[c] + cw[c] * g2 + cw[DFF + c] * g1 + cw[2 * DFF + c] * g0;
#endif
        const float ref = cv / (1.0f + expf(-cv)) * GU[((size_t)r * 2 + 1) * DFF + c];
        const float mine = bf2f(ACT[(size_t)r * DFF + c]);
#if DBG_FFNCMP == 2
        if ((r & 63) < 2) { num = (mine - ref) * (mine - ref); den = ref * ref; }
#elif DBG_FFNCMP == 3
        if ((r & 63) >= 2) { num = (mine - ref) * (mine - ref); den = ref * ref; }
#else
        num = (mine - ref) * (mine - ref); den = ref * ref;
#endif
    }
    __shared__ float rn[256], rd[256]; rn[threadIdx.x] = num; rd[threadIdx.x] = den; __syncthreads();
    for (int o = 128; o > 0; o >>= 1) { if (threadIdx.x < o) { rn[threadIdx.x] += rn[threadIdx.x + o]; rd[threadIdx.x] += rd[threadIdx.x + o]; } __syncthreads(); }
    if (threadIdx.x == 0) { atomicAdd(acc2, rn[0]); atomicAdd(acc2 + 1, rd[0]); }
}
__global__ void dbg_emit(const float* acc2, float* out) { out[0] = 1000.0f * sqrtf(acc2[0] / acc2[1]); }
#endif

#if defined(DBG_MIXCMP)
__global__ void __launch_bounds__(256) dbg_mixcmp(const bf16* A, const bf16* R, int c0, int c1, float* acc2) {
    float num = 0.f, den = 0.f;
    for (size_t r = blockIdx.x; r < (size_t)M; r += gridDim.x)
        for (int c = c0 + threadIdx.x; c < c1; c += 256) { const float a = bf2f(A[r * DM + c]), b = bf2f(R[r * DM + c]); num += (a - b) * (a - b); den += b * b; }
    __shared__ float rn[256], rd[256]; rn[threadIdx.x] = num; rd[threadIdx.x] = den; __syncthreads();
    for (int o = 128; o > 0; o >>= 1) { if (threadIdx.x < o) { rn[threadIdx.x] += rn[threadIdx.x + o]; rd[threadIdx.x] += rd[threadIdx.x + o]; } __syncthreads(); }
    if (threadIdx.x == 0) { atomicAdd(acc2, rn[0]); atomicAdd(acc2 + 1, rd[0]); }
}
__global__ void dbg_emit2(const float* acc2, float* out) { out[0] = 1000.0f * sqrtf(acc2[0] / acc2[1]); }
#endif
#if defined(DBG_TIMEC)
__global__ void dbg_emit3(const float* dv, float* out) { out[0] = 10.0f * (floorf(log2f(dv[4]) * 4.0f) * 0.25f - 8.0f); }
#endif
#ifndef MK_PER_PHASE
#define MK_PER_PHASE 0
#endif
extern "C" void kernel_launch(void* const* d_in, const int* in_sizes, int n_in, void* d_out, int out_size, void* d_ws, size_t ws_size, hipStream_t stream) {
    static int grid = 0;
    if (grid == 0) {
        if (n_in != 19 || in_sizes[0] != M * DM || out_size != M * DM || ws_size < WS_END) { fprintf(stderr, "kernel_launch: unexpected shapes (n_in %d, in0 %d, out %d, ws %zu)\n", n_in, n_in > 0 ? in_sizes[0] : -1, out_size, ws_size); grid = -1; return; }
        int dev = 0, cus = 0;
        if (hipGetDevice(&dev) != hipSuccess || hipDeviceGetAttribute(&cus, hipDeviceAttributeMultiprocessorCount, dev) != hipSuccess) { grid = -1; return; }
        if (hipFuncSetAttribute((const void*)fwd_kernel, hipFuncAttributeMaxDynamicSharedMemorySize, LDS_BYTES) != hipSuccess) { fprintf(stderr, "kernel_launch: hipFuncSetAttribute failed\n"); grid = -1; return; }
        int per_cu = 0;
        if (hipOccupancyMaxActiveBlocksPerMultiprocessor(&per_cu, (const void*)fwd_kernel, NWAVES * 64, LDS_BYTES) != hipSuccess || per_cu < 1) { fprintf(stderr, "kernel_launch: occupancy query reports %d blocks per CU\n", per_cu); }
        (void)hipGetLastError();
        grid = cus < 256 ? cus : 256;
    }
    if (grid < 0) return;
    (void)hipMemsetAsync((char*)d_ws + WS_CTL, 0, CTL_ZERO_BYTES, stream);
    Params a{};
    for (int i = 0; i < 19; ++i) a.in[i] = (const float*)d_in[i];
    a.out = (float*)d_out; a.ws = (unsigned char*)d_ws;
    for (int n = 0; n < 128; ++n) {
        int bkt;
        if (n < 16) bkt = n; else { const float v = logf((float)n / 16.0f) / (float)log(128.0 / 16.0) * 16.0f; bkt = 16 + (int)v; if (bkt > 31) bkt = 31; }
        a.bucket[n] = (unsigned char)bkt;
    }
#if MK_PER_PHASE
    for (int ph = 0; ph < N_PHASES; ++ph) { a.ph_lo = ph; a.ph_hi = ph + 1; hipLaunchKernelGGL(fwd_kernel, dim3(grid), dim3(NWAVES * 64), LDS_BYTES, stream, a); }
#elif defined(DBG_MIXCMP)
    { float* acc2 = (float*)((char*)d_ws + WS_TAB + 65536); (void)hipMemsetAsync(acc2, 0, 8, stream);
      a.ph_lo = 0; a.ph_hi = 4; a.flags = 1; a.bar_region = 0;
      hipLaunchKernelGGL(fwd_kernel, dim3(grid), dim3(NWAVES * 64), LDS_BYTES, stream, a);
      (void)hipMemcpyAsync((char*)d_ws + WS_X1, (char*)d_ws + WS_MIXED, (size_t)M * DM * 2, hipMemcpyDeviceToDevice, stream);
      (void)hipMemsetAsync((char*)d_ws + WS_MIXED, 0, (size_t)M * DM * 2, stream);
      a.ph_lo = 2; a.ph_hi = 4; a.flags = 0; a.bar_region = 1;
      hipLaunchKernelGGL(fwd_kernel, dim3(grid), dim3(NWAVES * 64), LDS_BYTES, stream, a);
      const int c0 = (DBG_MIXCMP == 1) ? 0 : (DBG_MIXCMP == 2) ? 256 : 768, c1 = (DBG_MIXCMP == 1) ? 256 : (DBG_MIXCMP == 2) ? 768 : 1024;
      hipLaunchKernelGGL(dbg_mixcmp, dim3(1024), dim3(256), 0, stream, (const bf16*)((char*)d_ws + WS_MIXED), (const bf16*)((char*)d_ws + WS_X1), c0, c1, acc2);
      (void)hipMemcpyAsync(d_out, d_in[0], (size_t)M * DM * 4, hipMemcpyDeviceToDevice, stream);
      hipLaunchKernelGGL(dbg_emit2, dim3(1), dim3(1), 0, stream, (const float*)acc2, (float*)d_out); }
#elif defined(DBG_TIMEC)
    a.ph_lo = 0; a.ph_hi = N_PHASES;
    hipLaunchKernelGGL(fwd_kernel, dim3(grid), dim3(NWAVES * 64), LDS_BYTES, stream, a);
    (void)hipMemcpyAsync(d_out, d_in[0], (size_t)M * DM * 4, hipMemcpyDeviceToDevice, stream);
    hipLaunchKernelGGL(dbg_emit3, dim3(1), dim3(1), 0, stream, (const float*)((char*)d_ws + WS_TAB + 65536), (float*)d_out);
#elif defined(DBG_NAIVE_DOWN)
    a.ph_lo = 0; a.ph_hi = 7;
    hipLaunchKernelGGL(fwd_kernel, dim3(grid), dim3(NWAVES * 64), LDS_BYTES, stream, a);
    hipLaunchKernelGGL(dbg_down, dim3(M / 4), dim3(256), 0, stream, (const bf16*)((char*)d_ws + WS_ACT), (const float*)d_in[I_WDOWN], (const float*)((char*)d_ws + WS_X1), (float*)d_out);
#elif defined(DBG_FFNCMP)
    a.ph_lo = 0; a.ph_hi = 7;
    hipLaunchKernelGGL(fwd_kernel, dim3(grid), dim3(NWAVES * 64), LDS_BYTES, stream, a);
    { float* GU = (float*)d_out + (size_t)16 * 1024 * 1024; float* acc2 = (float*)((char*)d_ws + WS_TAB + 65536);
      (void)hipMemsetAsync(acc2, 0, 8, stream);
      hipLaunchKernelGGL(dbg_gu, dim3(DBG_R, 11), dim3(256), 0, stream, (const float*)((char*)d_ws + WS_X1), (const float*)d_in[I_N2G], (const float*)d_in[I_WGATE], (const float*)d_in[I_WUP], GU);
      hipLaunchKernelGGL(dbg_cmp, dim3(DBG_R, 11), dim3(256), 0, stream, (const float*)GU, (const float*)d_in[I_CONVW], (const float*)d_in[I_CONVB], (const bf16*)((char*)d_ws + WS_ACT), acc2);
      (void)hipMemcpyAsync(d_out, d_in[0], (size_t)M * DM * 4, hipMemcpyDeviceToDevice, stream);
      hipLaunchKernelGGL(dbg_emit, dim3(1), dim3(1), 0, stream, (const float*)acc2, (float*)d_out); }
#elif defined(DBG_STOP)
    a.ph_lo = 0; a.ph_hi = DBG_STOP + 1;
    hipLaunchKernelGGL(fwd_kernel, dim3(grid), dim3(NWAVES * 64), LDS_BYTES, stream, a);
    { const int k = (DBG_STOP == 0) ? -1 : (DBG_STOP - 1) % PH_PER_LAYER;
      const float* src = (DBG_STOP == 0) ? (const float*)d_in[0] : ((k >= 3 && k <= 5) ? (const float*)((char*)d_ws + WS_X1) : nullptr);
      if (src) (void)hipMemcpyAsync(d_out, src, (size_t)M * DM * 4, hipMemcpyDeviceToDevice, stream); }
#else
    a.ph_lo = 0; a.ph_hi = N_PHASES;
    hipLaunchKernelGGL(fwd_kernel, dim3(grid), dim3(NWAVES * 64), LDS_BYTES, stream, a);
#endif
    const hipError_t le = hipPeekAtLastError();
    if (le != hipSuccess) fprintf(stderr, "kernel_launch: launch failed: %s\n", hipGetErrorName(le));
}
```

```cpp
#include <hip/hip_runtime.h>
#include <cstdio>
#include <cstdint>
#include <cmath>
namespace pg8 {
#define PG8_LAS __attribute__((address_space(3)))
typedef unsigned short bf16_t;
typedef short bf16x8 __attribute__((ext_vector_type(8)));
typedef float f32x4 __attribute__((ext_vector_type(4)));
typedef unsigned u32x4 __attribute__((ext_vector_type(4)));
constexpr int BM = 256, BK = 64, HALF = 128, HTB = HALF * BK * 2  , STAGE_BYTES = 8 * HTB, NXCD = 8, WGM = 8;

__host__ __device__ __forceinline__ int lds_byte(int r, int c) { const int st = (r >> 4) * 2 + (c >> 5), rr = r & 15, cc = c & 31, ob = rr * 64 + cc * 2; return st * 1024 + (ob ^ (((ob >> 9) & 1) << 5)); }
__host__ __device__ __forceinline__ void stage_rc(int b, int& R, int& C) { const int st = b / 1024, sb = b % 1024, swz = sb ^ (((sb >> 9) & 1) << 5); R = (st >> 1) * 16 + swz / 64; C = (st & 1) * 32 + (swz % 64) / 2; }
__host__ __device__ __forceinline__ int perm32(int rho) { const int n = rho >> 4, i = rho & 15; return 8 * (i >> 2) + 4 * n + (i & 3); }

struct Unit { int pm, pn; };
struct Gemm { const bf16_t* A; const bf16_t* Bt; int M, N, K; int preb; int wv; };

struct StaticOrder {
    int nM, nN, nwg, G, c;
    __host__ __device__ void init(int M, int N, int G_, int c_) { nM = M / BM; nN = N / BM; nwg = nM * nN; G = G_; c = c_; }
    __host__ __device__ bool next(int i, Unit& u) const {
        const int L = i * G + c; if (L >= nwg) return false;
        int wgid = L; { const int q = nwg / NXCD, r = nwg % NXCD, xcd = wgid % NXCD, off = wgid / NXCD; wgid = (xcd < r ? xcd * (q + 1) : r * (q + 1) + (xcd - r) * q) + off; }
        const int nig = WGM * nN, gid = wgid / nig, fm = gid * WGM, gsz = (nM - fm) < WGM ? (nM - fm) : WGM;
        u.pm = fm + ((wgid % nig) % gsz); u.pn = (wgid % nig) / gsz; return true;
    }
    __device__ __forceinline__ void a_ready(const Unit&) const {}
    __device__ __forceinline__ void done(const Unit&) const {}
};

__device__ __forceinline__ unsigned cvt_pk_bf16(float lo, float hi) { unsigned r; asm volatile("v_cvt_pk_bf16_f32 %0, %1, %2" : "=v"(r) : "v"(lo), "v"(hi)); return r; }
typedef float f32x2 __attribute__((ext_vector_type(2)));
__device__ __forceinline__ f32x2 gelu_pk(f32x2 v) {
    const f32x2 av = __builtin_elementwise_abs(v), d = av * 0.2316418882f + 1.0f;
    f32x2 t; t.x = __builtin_amdgcn_rcpf(d.x); t.y = __builtin_amdgcn_rcpf(d.y);
    f32x2 q = t * 0.5307027145f + (-0.7265760135f); q = q * t + 0.7107068705f; q = q * t + (-0.142248368f); q = q * t + 0.127414796f; q = q * t;
    const f32x2 s = (v * v) * (-0.72134752044f);
    f32x2 e; e.x = __builtin_amdgcn_exp2f(s.x); e.y = __builtin_amdgcn_exp2f(s.y);
    const f32x2 m = v * (q * e), r = v - m;
    f32x2 o; o.x = v.x < 0.f ? m.x : r.x; o.y = v.y < 0.f ? m.y : r.y; return o;
}

#define PG8_ZERO4(x) do { f32x2 _z0, _z1; asm volatile("v_mov_b64 %0, 0\n\tv_mov_b64 %1, 0" : "=v"(_z0), "=v"(_z1)); (x) = (f32x4){_z0[0], _z0[1], _z1[0], _z1[1]}; } while (0)
template <class Epi, class Sched, bool ALIGN_EPI = false, bool SP2 = false>
__device__ __forceinline__ void gemm_phase(PG8_LAS unsigned char* lds, const Gemm g, const Sched& S, const Epi& E) {
    int tid_l = threadIdx.x; asm volatile("" : "+v"(tid_l));
    const int tid = tid_l, wid = __builtin_amdgcn_readfirstlane(tid >> 6), lane = tid & 63, wr = wid >> 2, wc = wid & 3, fr = lane & 15, fq = lane >> 4;
    const int K = g.K, nt = K / BK;
    unsigned voffA[2], voffB[2];
#pragma unroll
    for (int i = 0; i < 2; ++i) { int R, C; stage_rc(tid * 16 + i * 8192, R, C); const int Rb = Epi::PERM ? ((R & ~31) + perm32(R & 31)) : R;
        const int Ra = Epi::APERM ? ((R & ~63) | (4 * (R & 15) + ((R >> 4) & 3))) : R;
        voffA[i] = (unsigned)(Ra * K + C) * 2u; voffB[i] = (unsigned)(Rb * K + C) * 2u; }
    const size_t kstep = (size_t)(BK * 2);
    const size_t hstep = (size_t)HALF * K * 2;
    const size_t tstep = 2 * hstep;
    const unsigned ldsw = (unsigned)wid * 1024u;
    const int aoff = lds_byte(wr * 64 + fr, fq * 8), boff = lds_byte(wc * 32 + fr, fq * 8);
#define PG8_SA(b, h) (((b) * 2 + (h)) * HTB)
#define PG8_SB(b, h) ((4 + (b) * 2 + (h)) * HTB)
#define PG8_STAGE(bufoff, gbase, voff) do { _Pragma("unroll") for (int _i = 0; _i < 2; ++_i) \
        __builtin_amdgcn_global_load_lds((const unsigned*)((const char*)(gbase) + (voff)[_i]), (PG8_LAS unsigned*)(lds + (bufoff) + ldsw + _i * 8192), 16, 0, 0); } while (0)
#define PG8_LDA(dst, b, h) do { _Pragma("unroll") for (int m = 0; m < 4; ++m) _Pragma("unroll") for (int k = 0; k < 2; ++k) dst[m][k] = *(const PG8_LAS bf16x8*)(lds + PG8_SA(b, h) + aoff + m * 2048 + k * 1024); } while (0)
#define PG8_LDB(dst, b, h) do { _Pragma("unroll") for (int n = 0; n < 2; ++n) _Pragma("unroll") for (int k = 0; k < 2; ++k) dst[n][k] = *(const PG8_LAS bf16x8*)(lds + PG8_SB(b, h) + boff + n * 2048 + k * 1024); } while (0)
#define PG8_MMA(ai, bj, At, Bt) do { __builtin_amdgcn_s_setprio(1); _Pragma("unroll") for (int m = 0; m < 4; ++m) _Pragma("unroll") for (int n = 0; n < 2; ++n) _Pragma("unroll") for (int k = 0; k < 2; ++k) \
        acc[ai][bj][m][n] = __builtin_amdgcn_mfma_f32_16x16x32_bf16(Bt[n][k], At[m][k], acc[ai][bj][m][n], 0, 0, 0); __builtin_amdgcn_s_setprio(0); } while (0)
#define PG8_WAIT_V(n) asm volatile("s_waitcnt vmcnt(" #n ")" ::: "memory")
#define PG8_WAIT_VN(n) asm volatile("s_waitcnt vmcnt(%0)" :: "n"(n) : "memory")
#define PG8_WAIT_L(n) asm volatile("s_waitcnt lgkmcnt(" #n ")" ::: "memory")
#define PG8_BAR __builtin_amdgcn_s_barrier()
#define PG8_SCHED __builtin_amdgcn_sched_barrier(0)
    Unit cur, nxt; int ui = 0;
    if (!S.next(0, cur)) return;
    f32x4 acc[2][2][4][2];
#pragma unroll
    for (int a = 0; a < 2; ++a)
#pragma unroll
        for (int b = 0; b < 2; ++b)
#pragma unroll
            for (int m = 0; m < 4; ++m)
#pragma unroll
                for (int n = 0; n < 2; ++n) PG8_ZERO4(acc[a][b][m][n]);
    bf16x8 At[4][2], B0[2][2], B1[2][2];
    const char* cA = (const char*)g.A + (size_t)cur.pm * tstep; const char* cB = (const char*)g.Bt + (size_t)cur.pn * tstep;
    S.a_ready(cur);
    if constexpr (SP2) {
        if (g.preb) {
            PG8_STAGE(PG8_SA(0, 0), cA, voffA); PG8_STAGE(PG8_SA(0, 1), cA + hstep, voffA);
            if (wr == 1) PG8_BAR;
            PG8_WAIT_V(2); PG8_BAR;
            PG8_STAGE(PG8_SA(1, 0), cA + kstep, voffA);
            PG8_WAIT_V(2); PG8_BAR;
        } else {
        PG8_STAGE(PG8_SB(0, 0), cB, voffB); PG8_STAGE(PG8_SB(0, 1), cB + hstep, voffB); PG8_STAGE(PG8_SA(0, 0), cA, voffA); PG8_STAGE(PG8_SA(0, 1), cA + hstep, voffA);
        if (wr == 1) PG8_BAR;
        PG8_WAIT_V(2); PG8_BAR;
        PG8_STAGE(PG8_SB(1, 0), cB + kstep, voffB); PG8_STAGE(PG8_SA(1, 0), cA + kstep, voffA); PG8_STAGE(PG8_SB(1, 1), cB + hstep + kstep, voffB);
        PG8_WAIT_V(6); PG8_BAR;
        }
    } else {
        PG8_STAGE(PG8_SB(0, 0), cB, voffB); PG8_STAGE(PG8_SA(0, 0), cA, voffA); PG8_STAGE(PG8_SB(0, 1), cB + hstep, voffB); PG8_STAGE(PG8_SA(0, 1), cA + hstep, voffA);
        if (wr == 1) PG8_BAR;
        PG8_WAIT_V(4); PG8_BAR;
        PG8_STAGE(PG8_SB(1, 0), cB + kstep, voffB); PG8_STAGE(PG8_SA(1, 0), cA + kstep, voffA); PG8_STAGE(PG8_SB(1, 1), cB + hstep + kstep, voffB);
        PG8_WAIT_V(6); PG8_BAR;
    }
    for (;;) {
        const bool has_next = S.next(ui + 1, nxt);
        const char* nA = has_next ? (const char*)g.A + (size_t)nxt.pm * tstep : cA; const char* nB = has_next ? (const char*)g.Bt + (size_t)nxt.pn * tstep : cB;
        typename Epi::Pre pre;
        for (int t = 0; t < nt; t += 2) {
            const bool last = (t == nt - 2);
            const char* a1 = cA + (size_t)(t + 1) * kstep;
            const char* a2 = last ? nA : cA + (size_t)(t + 2) * kstep; const char* b2 = last ? nB : cB + (size_t)(t + 2) * kstep;
            const char* a3 = a2 + kstep; const char* b3 = b2 + kstep;
            if (last && has_next) S.a_ready(nxt);
            if constexpr (SP2) {
            PG8_LDB(B0, 0, 0); PG8_LDB(B1, 0, 1); PG8_SCHED; PG8_LDA(At, 0, 0); PG8_STAGE(PG8_SA(1, 1), a1 + hstep, voffA);
            if (Epi::NPRE > 0 && last) { pre = E.preload(cur, wr, wc, fr, fq); PG8_WAIT_VN(8 + Epi::NPRE); } else PG8_WAIT_V(8);
            PG8_WAIT_L(0); PG8_BAR; PG8_MMA(0, 0, At, B0); PG8_MMA(0, 1, At, B1); PG8_BAR; PG8_SCHED;
            PG8_LDA(At, 0, 1); PG8_STAGE(PG8_SB(0, 0), b2, voffB); PG8_STAGE(PG8_SB(0, 1), b2 + hstep, voffB); PG8_STAGE(PG8_SA(0, 0), a2, voffA);
            if (Epi::NPRE > 0 && last) PG8_WAIT_VN(8 + Epi::NPRE); else PG8_WAIT_V(8);
            PG8_WAIT_L(0); PG8_BAR; PG8_MMA(1, 0, At, B0); PG8_MMA(1, 1, At, B1); PG8_BAR; PG8_SCHED;
            PG8_LDB(B0, 1, 0); PG8_LDB(B1, 1, 1); PG8_SCHED; PG8_LDA(At, 1, 0); PG8_STAGE(PG8_SA(0, 1), a2 + hstep, voffA);
            if (Epi::NPRE > 0 && last) PG8_WAIT_VN(8 + Epi::NPRE); else PG8_WAIT_V(8);
            PG8_WAIT_L(0); PG8_BAR; PG8_MMA(0, 0, At, B0); PG8_MMA(0, 1, At, B1); PG8_BAR; PG8_SCHED;
            PG8_LDA(At, 1, 1); PG8_STAGE(PG8_SB(1, 0), b3, voffB); PG8_STAGE(PG8_SB(1, 1), b3 + hstep, voffB); PG8_STAGE(PG8_SA(1, 0), a3, voffA);
            PG8_WAIT_V(8); PG8_WAIT_L(0); PG8_BAR; PG8_MMA(1, 0, At, B0); PG8_MMA(1, 1, At, B1); PG8_BAR; PG8_SCHED;
            } else {
            PG8_LDB(B0, 0, 0); PG8_SCHED; PG8_LDA(At, 0, 0); PG8_STAGE(PG8_SA(1, 1), a1 + hstep, voffA);
            PG8_WAIT_L(8); PG8_BAR; PG8_WAIT_L(0); PG8_MMA(0, 0, At, B0); PG8_BAR; PG8_SCHED;
            PG8_LDB(B1, 0, 1); PG8_STAGE(PG8_SB(0, 0), b2, voffB);
            PG8_BAR; PG8_WAIT_L(0); PG8_MMA(0, 1, At, B1); PG8_BAR;
            PG8_LDA(At, 0, 1); PG8_STAGE(PG8_SA(0, 0), a2, voffA);
            PG8_BAR; PG8_WAIT_L(0); PG8_MMA(1, 0, At, B0); PG8_BAR; PG8_SCHED;
            PG8_STAGE(PG8_SB(0, 1), b2 + hstep, voffB);
            PG8_WAIT_V(6); PG8_BAR; PG8_MMA(1, 1, At, B1); PG8_BAR;
            PG8_LDB(B0, 1, 0); PG8_SCHED; PG8_LDA(At, 1, 0); PG8_STAGE(PG8_SA(0, 1), a2 + hstep, voffA);
            PG8_WAIT_L(8); PG8_BAR; PG8_WAIT_L(0); PG8_MMA(0, 0, At, B0); PG8_BAR; PG8_SCHED;
            PG8_LDB(B1, 1, 1); PG8_STAGE(PG8_SB(1, 0), b3, voffB);
            PG8_BAR; PG8_WAIT_L(0); PG8_MMA(0, 1, At, B1); PG8_BAR;
            PG8_LDA(At, 1, 1); PG8_STAGE(PG8_SA(1, 0), a3, voffA);
            PG8_BAR; PG8_WAIT_L(0); PG8_MMA(1, 0, At, B0); PG8_BAR; PG8_SCHED;
            PG8_STAGE(PG8_SB(1, 1), b3 + hstep, voffB);
            PG8_WAIT_V(6); PG8_BAR; PG8_MMA(1, 1, At, B1); PG8_BAR;
            }
        }
        if constexpr (ALIGN_EPI) { if (wr == 0) PG8_BAR; }
        if constexpr (!Epi::AFTER_DRAIN) { E(acc, cur, wr, wc, fr, fq, pre); S.done(cur); }
        if (!has_next) break;
#pragma unroll
        for (int a = 0; a < 2; ++a)
#pragma unroll
            for (int b = 0; b < 2; ++b)
#pragma unroll
                for (int m = 0; m < 4; ++m)
#pragma unroll
                    for (int n = 0; n < 2; ++n) PG8_ZERO4(acc[a][b][m][n]);
        cur = nxt; cA = nA; cB = nB; ++ui;
        if constexpr (ALIGN_EPI) { if (wr == 1) PG8_BAR; }
    }
    PG8_WAIT_V(0);
    if constexpr (!ALIGN_EPI) { if (wr == 0) PG8_BAR; }
    PG8_BAR;
    if constexpr (Epi::AFTER_DRAIN) { E.fused(acc, cur, wr, wc, fr, fq, lds, wid, lane); S.done(cur); }
#undef PG8_SA
#undef PG8_SB
#undef PG8_STAGE
#undef PG8_LDA
#undef PG8_LDB
#undef PG8_MMA
#undef PG8_WAIT_V
#undef PG8_WAIT_VN
#undef PG8_WAIT_L
#undef PG8_BAR
#undef PG8_SCHED
}
__device__ __forceinline__ void gemm_prefetch_b(PG8_LAS unsigned char* lds, const bf16_t* Bt, int K, int pn, int wv) {
    int tid_l = threadIdx.x; asm volatile("" : "+v"(tid_l));
    const int tid = tid_l, wid = __builtin_amdgcn_readfirstlane(tid >> 6);
    const size_t hstep = (size_t)HALF * K * 2, kstep = (size_t)(BK * 2);
    const char* cB = (const char*)Bt + (size_t)pn * 2 * hstep;
    const unsigned ldsw = (unsigned)wid * 1024u;
#pragma unroll
    for (int i = 0; i < 2; ++i) { int R, C; stage_rc(tid * 16 + i * 8192, R, C); const int Rb = (R & ~31) + perm32(R & 31); const unsigned voff = (unsigned)(Rb * K + C) * 2u;
#pragma unroll
        for (int b = 0; b < 2; ++b)
#pragma unroll
            for (int h = 0; h < 2; ++h)
                __builtin_amdgcn_global_load_lds((const unsigned*)(cB + (size_t)b * kstep + (size_t)h * hstep + voff), (PG8_LAS unsigned*)(lds + (4 + b * 2 + h) * HTB + ldsw + i * 8192), 16, 0, 0); }
}
}

constexpr int NWAVES = 8;
constexpr int BATCH = 4, SEQ = 8192, DM = 1024, DEPTH = 2;
constexpr int M = BATCH * SEQ;
constexpr int INW = 2304, DFF = 2816, NGU = 2 * DFF;
constexpr float EPS = 1e-6f;
constexpr int C_AU = 0, C_AV = 256, C_BQ = 512, C_BK = 1024, C_BV = 1152, C_CQ = 1280, C_CF = 1536, C_CI = 1792, C_CG = 2048;
constexpr int MX_A = 0, MX_B = 256, MX_C = 768;

constexpr size_t MiB = 1u << 20;
constexpr size_t WS_CTL = 0, CTL_ZERO_BYTES = 2 * MiB;
constexpr size_t WS_TAB = 2 * MiB;
constexpr size_t WS_SS = 1 * MiB;
constexpr size_t WS_SEGS = 4 * MiB;
constexpr size_t WS_SEGP = 8 * MiB;
constexpr size_t WS_HG = 10 * MiB;
constexpr size_t WS_HU = 32 * MiB;
constexpr size_t WS_W = 44 * MiB, W_LAYER = 24 * MiB;
constexpr size_t W_IN = 0, W_OUT = 5 * MiB, W_GU = 7 * MiB, W_DN = 18 * MiB;
constexpr size_t WS_XB = 92 * MiB;
constexpr size_t WS_X1 = 156 * MiB;
constexpr size_t WS_PROJ = 284 * MiB;
constexpr size_t WS_MIXED = 428 * MiB;
constexpr size_t WS_ACT = 284 * MiB;
constexpr size_t WS_END = 492 * MiB;
static_assert((size_t)INW * DM * 2 <= W_OUT - W_IN && (size_t)DM * DM * 2 <= W_GU - W_OUT && (size_t)NGU * DM * 2 <= W_DN - W_GU && W_DN + (size_t)DM * DFF * 2 <= W_LAYER, "weight map");
static_assert(WS_ACT + (size_t)M * DFF * 2 <= WS_END && WS_MIXED + (size_t)M * DM * 2 <= WS_END && WS_PROJ + (size_t)M * INW * 2 <= WS_MIXED, "activation map");
static_assert(WS_HG + (size_t)512 * 4 * DFF * 4 <= WS_HU && WS_HU + (size_t)512 * 2 * DFF * 4 <= WS_W, "halo map");
constexpr int CW_BAR = 4096;

constexpr int LDS_BYTES = 147456;
constexpr int MISC_OFF = LDS_BYTES - 256;

#define GAS __attribute__((address_space(1)))
#define LAS __attribute__((address_space(3)))
typedef unsigned short bf16;
typedef unsigned v4u __attribute__((ext_vector_type(4)));
typedef unsigned v2u __attribute__((ext_vector_type(2)));
typedef float f32x4 __attribute__((ext_vector_type(4)));
typedef float f32x2 __attribute__((ext_vector_type(2)));
#define RLX_AGENT __ATOMIC_RELAXED, __HIP_MEMORY_SCOPE_AGENT
#define LDS_WAIT() asm volatile("s_waitcnt lgkmcnt(0)" ::: "memory")
__device__ __forceinline__ unsigned f2bf(float f) { unsigned u = __builtin_bit_cast(unsigned, f); return (u + 0x7fffu + ((u >> 16) & 1u)) >> 16; }
__device__ __forceinline__ unsigned pk2(float lo, float hi) { return f2bf(lo) | (f2bf(hi) << 16); }
__device__ __forceinline__ float bf2f(unsigned short h) { return __builtin_bit_cast(float, (unsigned)h << 16); }
__device__ __forceinline__ float bflo(unsigned w) { return __builtin_bit_cast(float, w << 16); }
__device__ __forceinline__ float bfhi(unsigned w) { return __builtin_bit_cast(float, w & 0xffff0000u); }
__device__ __forceinline__ float silu_f(float v) { return v * __builtin_amdgcn_rcpf(1.0f + __builtin_amdgcn_exp2f(v * -1.4426950408889634f)); }
__device__ __forceinline__ float wave_sum(float v) {
#pragma unroll
    for (int o = 1; o < 64; o <<= 1) v += __shfl_xor(v, o);
    return v;
}
#define XB_TMO      128
#define XB_XCNT(j)  (256  + 64 * (j))
#define XB_XSUB(j)  (1280 + 64 * (j))
#define XB_XGEN(j)  (2304 + 64 * (j))
#define XB_TOP      3328
#define XB_TOPGEN   3392
#define XCD_BAR_WORDS 3456
#define XB_SPIN_CAP (1u << 18)

__device__ __forceinline__ unsigned xb_ld(unsigned* p)              { return __hip_atomic_load(p, __ATOMIC_RELAXED, __HIP_MEMORY_SCOPE_AGENT); }
__device__ __forceinline__ unsigned xb_add(unsigned* p, unsigned v) { return __hip_atomic_fetch_add(p, v, __ATOMIC_RELAXED, __HIP_MEMORY_SCOPE_AGENT); }
__device__ __forceinline__ unsigned xb_xcc_id() { return (unsigned)__builtin_amdgcn_s_getreg((3 << 11) | 20) & 0xFu; }
#define XB_SPIN(cond, bar) do { unsigned _sp = 0; while (cond) { __builtin_amdgcn_s_sleep(1); \
    if ((++_sp & 255u) == 0u) { if (xb_ld(&(bar)[XB_TMO])) break; if (_sp > XB_SPIN_CAP) { atomicAdd(&(bar)[XB_TMO], 1u); break; } } } } while (0)

struct XcdBarrier {
    unsigned* bar; unsigned x;
    int wv;
    volatile LAS unsigned* st;
};

__device__ __forceinline__ XcdBarrier xcd_barrier_post(unsigned* bar, volatile LAS unsigned* st) {
    XcdBarrier b; b.bar = bar; b.x = xb_xcc_id(); b.st = st; b.wv = 0;
    if (threadIdx.x == 0) (void)xb_add(&bar[XB_XCNT(b.x)], 1u);
    return b;
}
__device__ __forceinline__ void xcd_barrier_complete(unsigned* bar, unsigned x, unsigned& nloc, unsigned& nx) {
    const unsigned G = gridDim.x * gridDim.y * gridDim.z;
    unsigned sum, cnt, mine, sp = 0u;
    for (;;) {
        sum = 0u; cnt = 0u; mine = 0u;
#pragma nounroll
        for (unsigned j = 0; j < 16; ++j) { const unsigned c = xb_ld(&bar[XB_XCNT(j)]); sum += c; cnt += (c > 0u) ? 1u : 0u; mine = (j == x) ? c : mine; }
        if (sum == G) break;
        __builtin_amdgcn_s_sleep(1);
        if ((++sp & 255u) == 0u) { if (xb_ld(&bar[XB_TMO])) break; if (sp > XB_SPIN_CAP) { atomicAdd(&bar[XB_TMO], 1u); break; } }
    }
    nloc = mine > 0u ? mine : 1u; nx = cnt > 0u ? cnt : 1u;
}

__device__ __forceinline__ void xcd_barrier_head() {
    asm volatile("s_waitcnt vmcnt(0)" ::: "memory");
    __syncthreads();
}
__device__ __forceinline__ void xcd_barrier_tail(const XcdBarrier& b) {
    if (threadIdx.x == 0) {
        unsigned* bar = b.bar;
        __builtin_amdgcn_s_waitcnt(0);
        unsigned nloc = b.st[0], nx = b.st[1];
        if (nloc == 0u) { xcd_barrier_complete(bar, b.x, nloc, nx); b.st[0] = nloc; b.st[1] = nx; }
        const unsigned old = xb_add(&bar[XB_XSUB(b.x)], 1u);
        const unsigned gen = old / nloc;
        if (old + 1u == (gen + 1u) * nloc) {
            __builtin_amdgcn_fence(__ATOMIC_RELEASE, "agent");
            asm volatile("s_waitcnt vmcnt(0)" ::: "memory");
            const unsigned og = xb_add(&bar[XB_TOP], 1u);
            const unsigned tg = og / nx;
            if (og + 1u == (tg + 1u) * nx) xb_add(&bar[XB_TOPGEN], 1u);
            else XB_SPIN(xb_ld(&bar[XB_TOPGEN]) == tg, bar);
            __builtin_amdgcn_fence(__ATOMIC_ACQUIRE, "agent");
            xb_add(&bar[XB_XGEN(b.x)], 1u);
            asm volatile("s_waitcnt vmcnt(0)" ::: "memory");
        } else {
            XB_SPIN(xb_ld(&bar[XB_XGEN(b.x)]) == gen, bar);
            __builtin_amdgcn_fence(__ATOMIC_ACQUIRE, "agent");
            asm volatile("s_waitcnt vmcnt(0)" ::: "memory");
        }
    }
    asm volatile("s_waitcnt vmcnt(0)" ::: "memory");
    __syncthreads();
}
__device__ __forceinline__ void xcd_barrier(const XcdBarrier& b) { xcd_barrier_head(); xcd_barrier_tail(b); }


#ifndef DBG_MIX
#define DBG_MIX 7
#endif
#ifdef DBG_NULL_EPI
#define DBG_EPI_MODE(rep) ((rep) == 0 ? 1 : DBG_NULL_EPI == 2 ? 2 : 0)
#else
#define DBG_EPI_MODE(rep) 1
#endif
#ifndef SKEW_P4
#define SKEW_P4 0
#endif
#ifndef SKEW_P1
#define SKEW_P1 0
#endif
#ifndef DBG_REP_C1
#define DBG_REP_C1 1
#endif
#ifndef DBG_REP_C2
#define DBG_REP_C2 1
#endif
#ifndef DBG_REP_B
#define DBG_REP_B 1
#endif
#define DBG_A ((DBG_MIX & 1) ? 1.0f : 0.0f)
#define DBG_B ((DBG_MIX & 2) ? 1.0f : 0.0f)
#define DBG_C ((DBG_MIX & 4) ? 1.0f : 0.0f)
typedef float mb_f32x2_t __attribute__((ext_vector_type(2))); typedef __bf16 mb_bf16x2_t __attribute__((ext_vector_type(2)));
__device__ __forceinline__ unsigned mb_cvtpk(float lo, float hi) { mb_f32x2_t v = {lo, hi}; mb_bf16x2_t b = __builtin_convertvector(v, mb_bf16x2_t); return __builtin_bit_cast(unsigned, b); }
struct Params { const float* in[19]; float* out; unsigned char* ws; int ph_lo, ph_hi; int flags, bar_region; unsigned char bucket[128]; };

struct Ctx { volatile LAS unsigned long long* tab; unsigned char* ws; const unsigned char* bucket; };
constexpr int TAB_OFF = LDS_BYTES - 1024;
__device__ __forceinline__ const float* tab_ptr(const Ctx& c, int i) {
    const unsigned long long v = c.tab[i];
    const unsigned lo = (unsigned)__builtin_amdgcn_readfirstlane((int)(unsigned)v), hi = (unsigned)__builtin_amdgcn_readfirstlane((int)(unsigned)(v >> 32));
    return (const float*)(const GAS float*)(((unsigned long long)hi << 32) | lo);
}
#define PIN(c, i) tab_ptr(c, (i))
#define POUT(c) ((float*)tab_ptr(c, 19))
enum { I_X = 0, I_N1G, I_WIN, I_VNG, I_WS, I_BS, I_QNG, I_KNG, I_SINK, I_RELB, I_LBL, I_ONG, I_WOUT, I_N2G, I_WGATE, I_WUP, I_CONVW, I_CONVB, I_WDOWN };

__device__ __forceinline__ float u64f(unsigned long long v) { return fmaf((float)(unsigned)(v >> 32), 4294967296.0f, (float)(unsigned)v); }
__device__ __forceinline__ float row_rstd(const unsigned long long* SS, int r) {
    return rsqrtf(u64f(SS[r]) * (1.0f / 16777216.0f / DM) + EPS);
}

constexpr int CW_LDS = 131072, SS_LDS = 133120;
struct EpiInProj {
    static constexpr bool PERM = true, APERM = false, AFTER_DRAIN = false;
    bf16* O; const unsigned long long* SS; int mode; LAS unsigned char* lds;
    static constexpr int NPRE = 1;
    struct Pre {};
    __device__ __forceinline__ Pre preload(const pg8::Unit& u, int wr, int wc, int fr_in, int fq_in) const {
        int fr = fr_in, fq = fq_in; asm volatile("" : "+v"(fr), "+v"(fq));
        const int wid = wr * 4 + wc, lane = fq * 16 + fr;
        __builtin_amdgcn_global_load_lds((const unsigned*)(SS + (size_t)u.pm * 256) + wid * 64 + lane, (LAS unsigned*)(lds + SS_LDS + wid * 256), 4, 0, 0);
        return Pre{};
    }
    __device__ __forceinline__ void operator()(pg8::f32x4 (&acc)[2][2][4][2], const pg8::Unit& u, int wr, int wc, int fr_in, int fq_in, const Pre& pre) const {
        int fr = fr_in, fq = fq_in; asm volatile("" : "+v"(fr), "+v"(fq));
        if (mode == 0) return;
        const int row0 = u.pm * 256 + wr * 64 + fr, col0 = u.pn * 256 + wc * 32 + 8 * fq;
        const int act = (u.pn <= 1) ? 1 : ((u.pn == 5 || u.pn == 8) ? 2 : 0);
        float rs8[8];
#pragma unroll
        for (int i = 0; i < 8; ++i) rs8[i] = rsqrtf(u64f(*(const LAS unsigned long long*)(lds + SS_LDS + (wr * 64 + fr + (i >> 2) * 128 + (i & 3) * 16) * 8)) * (1.0f / 16777216.0f / DM) + EPS);
        if (act == 1) body<1>(acc, rs8, row0, col0); else if (act == 2) body<2>(acc, rs8, row0, col0); else body<0>(acc, rs8, row0, col0);
    }
    template <int ACT> __device__ __forceinline__ void body(pg8::f32x4 (&acc)[2][2][4][2], const float (&rs8)[8], int row0, int col0) const {
#pragma unroll
        for (int ai = 0; ai < 2; ++ai)
#pragma unroll
            for (int m = 0; m < 4; ++m) {
                const int r = row0 + ai * 128 + m * 16; const float rs = rs8[ai * 4 + m]; bf16* rowp = O + (size_t)r * INW + col0;
#pragma unroll
                for (int bj = 0; bj < 2; ++bj) {
                    f32x4 v0 = acc[ai][bj][m][0] * rs, v1 = acc[ai][bj][m][1] * rs;
                    if (ACT == 1) { pg8::f32x2 a = pg8::gelu_pk((pg8::f32x2){v0[0], v0[1]}), b = pg8::gelu_pk((pg8::f32x2){v0[2], v0[3]}), c = pg8::gelu_pk((pg8::f32x2){v1[0], v1[1]}), d = pg8::gelu_pk((pg8::f32x2){v1[2], v1[3]});
                        v0 = (f32x4){a.x, a.y, b.x, b.y}; v1 = (f32x4){c.x, c.y, d.x, d.y}; }
                    else if (ACT == 2) {
#pragma unroll
                        for (int j = 0; j < 4; ++j) { v0[j] = silu_f(v0[j]); v1[j] = silu_f(v1[j]); } }
                    v4u w; w.x = pg8::cvt_pk_bf16(v0[0], v0[1]); w.y = pg8::cvt_pk_bf16(v0[2], v0[3]); w.z = pg8::cvt_pk_bf16(v1[0], v1[1]); w.w = pg8::cvt_pk_bf16(v1[2], v1[3]);
                    *(v4u*)(rowp + bj * 128) = w; }
            }
    }
};
struct EpiResid {
    static constexpr bool PERM = true, APERM = false, AFTER_DRAIN = false;
    bf16* xb; float* out; unsigned long long* SS; int mode;
    static constexpr int NPRE = 0;
    struct Pre {};
    __device__ __forceinline__ Pre preload(const pg8::Unit&, int, int, int, int) const { return Pre{}; }
    __device__ __forceinline__ void operator()(pg8::f32x4 (&acc)[2][2][4][2], const pg8::Unit& u, int wr, int wc, int fr_in, int fq_in, const Pre&) const {
        int fr = fr_in, fq = fq_in; asm volatile("" : "+v"(fr), "+v"(fq));
        if (mode == 0) return;
        const unsigned row0 = (unsigned)(u.pm * 256 + wr * 64 + fr), col0 = (unsigned)(u.pn * 256 + wc * 32 + 8 * fq);
        v4u rawall[2][4][2];
#pragma unroll
        for (int ai = 0; ai < 2; ++ai)
#pragma unroll
            for (int m = 0; m < 4; ++m)
#pragma unroll
                for (int bj = 0; bj < 2; ++bj) rawall[ai][m][bj] = *(const v4u*)((const char*)xb + ((row0 + ai * 128 + m * 16) * (unsigned)DM + col0 + bj * 128) * 2u);
#pragma unroll
        for (int ai = 0; ai < 2; ++ai) {
            v4u raw8[4][2];
#pragma unroll
            for (int m = 0; m < 4; ++m)
#pragma unroll
                for (int bj = 0; bj < 2; ++bj) raw8[m][bj] = rawall[ai][m][bj];
#pragma unroll
            for (int m = 0; m < 4; ++m) {
                const unsigned r = row0 + ai * 128 + m * 16, off = r * (unsigned)DM + col0; float ss = 0.f;
#pragma unroll
                for (int bj = 0; bj < 2; ++bj) {
                    const v4u raw = raw8[m][bj];
                    const f32x4 o0 = (f32x4){bflo(raw.x), bfhi(raw.x), bflo(raw.y), bfhi(raw.y)} + acc[ai][bj][m][0], o1 = (f32x4){bflo(raw.z), bfhi(raw.z), bflo(raw.w), bfhi(raw.w)} + acc[ai][bj][m][1];
                    if (mode == 1) { ss += ((o0[0] * o0[0] + o0[1] * o0[1]) + (o0[2] * o0[2] + o0[3] * o0[3])) + ((o1[0] * o1[0] + o1[1] * o1[1]) + (o1[2] * o1[2] + o1[3] * o1[3]));
                        v4u w; w.x = pg8::cvt_pk_bf16(o0[0], o0[1]); w.y = pg8::cvt_pk_bf16(o0[2], o0[3]); w.z = pg8::cvt_pk_bf16(o1[0], o1[1]); w.w = pg8::cvt_pk_bf16(o1[2], o1[3]);
                        *(v4u*)((char*)xb + (off + bj * 128) * 2u) = w; }
                    else { *(f32x4*)((char*)out + (size_t)(off + bj * 128) * 4u) = o0; *(f32x4*)((char*)out + (size_t)(off + bj * 128 + 4) * 4u) = o1; }
                }
                if (mode == 1) { ss += __shfl_xor(ss, 16); ss += __shfl_xor(ss, 32); if (fq == 0) __hip_atomic_fetch_add(SS + r, (unsigned long long)(ss * 16777216.0f), __ATOMIC_RELAXED, __HIP_MEMORY_SCOPE_AGENT); }
            }
            asm volatile("" ::: "memory");
        }
    }
};
struct EpiFFN {
    static constexpr bool PERM = true, APERM = true, AFTER_DRAIN = false;
    bf16* ACT; const unsigned long long* SS; const float* cw; const float* cb; float* HG; float* HU; int mode; LAS unsigned char* lds;
    template <class T> static __device__ __forceinline__ T ldg(const void* base, unsigned boff) { return *(const T*)((const char*)base + boff); }
    template <class T> static __device__ __forceinline__ void stg(void* base, unsigned boff, T v) { *(T*)((char*)base + boff) = v; }
    static __device__ __forceinline__ f32x4 shr1(const f32x4& g) {
        f32x4 r;
#pragma unroll
        for (int j = 0; j < 4; ++j) { const float gj = g[j]; r[j] = __int_as_float(__builtin_amdgcn_update_dpp(0, __float_as_int(gj), 0x111, 0xf, 0xf, true)); }
        return r; }
    static constexpr int NPRE = 2;
    struct Pre {};
    __device__ __forceinline__ Pre preload(const pg8::Unit& u, int wr, int wc, int fr_in, int fq_in) const {
        int fr = fr_in, fq = fq_in; asm volatile("" : "+v"(fr), "+v"(fq));
        const int wid = wr * 4 + wc, lane = fq * 16 + fr, trow = wid >> 1;
        __builtin_amdgcn_global_load_lds((const unsigned*)(SS + (size_t)u.pm * 256) + wid * 64 + lane, (LAS unsigned*)(lds + SS_LDS + wid * 256), 4, 0, 0);
        const unsigned ch = (unsigned)(u.pn * 128 + (wid & 1) * 64 + lane);
        const float* src = (trow < 3) ? cw + (size_t)trow * DFF + ch : cb + ch;
        __builtin_amdgcn_global_load_lds((const unsigned*)src, (LAS unsigned*)(lds + CW_LDS + wid * 256), 4, 0, 0);
        return Pre{};
    }
    __device__ __forceinline__ void operator()(pg8::f32x4 (&acc)[2][2][4][2], const pg8::Unit& u, int wr, int wc, int fr_in, int fq_in, const Pre& pre) const {
        int fr = fr_in, fq = fq_in; asm volatile("" : "+v"(fr), "+v"(fq));
        if (mode == 0) return;
        const unsigned rowb = (unsigned)(u.pm * 256 + wr * 64 + 4 * fr), ch0 = (unsigned)(u.pn * 128 + wc * 32 + 8 * fq);
        float rs8[8];
#pragma unroll
        for (int i = 0; i < 8; ++i) rs8[i] = rsqrtf(u64f(*(const LAS unsigned long long*)(lds + SS_LDS + (wr * 64 + 4 * fr + (i >> 2) * 128 + (i & 3)) * 8)) * (1.0f / 16777216.0f / DM) + EPS);
        if (fr == 0 || fr == 15) {
#pragma unroll
            for (int ai = 0; ai < 2; ++ai) {
                const unsigned blk = (unsigned)(u.pm * 4 + ai * 2 + wr);
#pragma unroll
                for (int n = 0; n < 2; ++n) { const unsigned ch = ch0 + 4u * n;
                    if (fr == 0) {
#pragma unroll
                        for (int m = 0; m < 2; ++m) { stg<f32x4>(HG, ((blk * 4u + m) * (unsigned)DFF + ch) * 4u, acc[ai][0][m][n] * rs8[ai * 4 + m]); stg<f32x4>(HU, ((blk * 2u + m) * (unsigned)DFF + ch) * 4u, acc[ai][1][m][n] * rs8[ai * 4 + m]); } }
                    else {
#pragma unroll
                        for (int m = 2; m < 4; ++m) stg<f32x4>(HG, ((blk * 4u + m) * (unsigned)DFF + ch) * 4u, acc[ai][0][m][n] * rs8[ai * 4 + m]); } }
            }
        }
        asm volatile("" ::: "memory");
#pragma unroll
        for (int n = 0; n < 2; ++n) {
            const unsigned ch = ch0 + 4u * n; const float nl2e = -1.4426950408889634f;
            const LAS float* wt = (const LAS float*)(lds + CW_LDS) + (wc * 32 + 8 * fq + 4 * n);
            f32x4 w0 = *(const LAS f32x4*)wt * nl2e, w1 = *(const LAS f32x4*)(wt + 128) * nl2e, w2 = *(const LAS f32x4*)(wt + 256) * nl2e, bb = *(const LAS f32x4*)(wt + 384) * nl2e;
            asm volatile("" : "+v"(w0), "+v"(w1), "+v"(w2), "+v"(bb));
            f32x4 g[2][4];
#pragma unroll
            for (int ai = 0; ai < 2; ++ai)
#pragma unroll
                for (int m = 0; m < 4; ++m) g[ai][m] = acc[ai][0][m][n] * rs8[ai * 4 + m];
            f32x4 h3[2], h2[2];
#pragma unroll
            for (int ai = 0; ai < 2; ++ai) { h3[ai] = shr1(g[ai][3]); h2[ai] = shr1(g[ai][2]); }
#pragma unroll
            for (int ai = 0; ai < 2; ++ai)
#pragma unroll
                for (int m = 0; m < 4; ++m) {
                    const f32x4 p1 = (m == 0) ? h3[ai] : g[ai][m - 1], p2 = (m == 0) ? h2[ai] : (m == 1) ? h3[ai] : g[ai][m - 2];
                    f32x4 c2 = w0 * p2 + bb; c2 = w1 * p1 + c2; c2 = w2 * g[ai][m] + c2;
                    const f32x4 ups = acc[ai][1][m][n] * (rs8[ai * 4 + m] * -0.6931471805599453f);
                    f32x4 e;
#pragma unroll
                    for (int j = 0; j < 4; ++j) e[j] = __builtin_amdgcn_rcpf(1.0f + __builtin_amdgcn_exp2f(c2[j]));
                    acc[ai][0][m][n] = (c2 * e) * ups;
                }
            asm volatile("" ::: "memory");
        }
#pragma unroll
        for (int ai = 0; ai < 2; ++ai) {
#pragma unroll
            for (int m = 0; m < 4; ++m) {
                const unsigned r = rowb + ai * 128 + m;
                const f32x4 v0 = acc[ai][0][m][0], v1 = acc[ai][0][m][1];
                v4u w; w.x = pg8::cvt_pk_bf16(v0[0], v0[1]); w.y = pg8::cvt_pk_bf16(v0[2], v0[3]); w.z = pg8::cvt_pk_bf16(v1[0], v1[1]); w.w = pg8::cvt_pk_bf16(v1[2], v1[3]);
                unsigned bo = (r * (unsigned)DFF + ch0) * 2u;
                if (m < 2) bo = (fr == 0) ? (unsigned)((size_t)M * DFF * 2) + ((unsigned)(((wr * 4 + wc) * 64 + fq * 16 + fr) * 32) + m * 16u) : bo;
                stg<v4u>(ACT, bo, w);
            }
            asm volatile("" ::: "memory");
        }
    }
};


struct InProjOrder {
    int G, c; pg8::StaticOrder fb;
    __device__ void init(int M_, int N_, int G_, int c_) { G = G_; c = c_; fb.init(M_, N_, G_, c_); }
    __device__ bool next(int i, pg8::Unit& u) const {
        if (G != 256) return fb.next(i, u);
        const int x = c & 7, j = c >> 3;
        if (j < 16) { if (i >= 5) return false; const int idx = i * 16 + j, grp = idx / 40, r = idx % 40, t = r >> 3;
            u.pm = 16 * x + 8 * grp + (r & 7); u.pn = (t == 0) ? 2 : (t == 1) ? 3 : (t == 2) ? 4 : (t == 3) ? 6 : 7; }
        else { if (i >= 4) return false; const int idx = i * 16 + (j - 16), grp = idx >> 5, r = idx & 31, t = r >> 3;
            u.pm = 16 * x + 8 * grp + (r & 7); u.pn = (t == 0) ? 0 : (t == 1) ? 1 : (t == 2) ? 5 : 8; }
        return true;
    }
    __device__ __forceinline__ void a_ready(const pg8::Unit&) const {}
    __device__ __forceinline__ void done(const pg8::Unit&) const {}
};
__device__ __forceinline__ void p0_transpose_item(const float* W, int K, int N, const float* gk, bf16* WT, int dest_row0, int k0, int n0, LAS float* scr, int lane) {
    const int rr = lane >> 4, c4 = (lane & 15) * 4;
#pragma unroll
    for (int i = 0; i < 16; ++i) { const int kk = 4 * i + rr; f32x4 v = *(const f32x4*)(W + (size_t)(k0 + kk) * N + n0 + c4); if (gk) v = v * gk[k0 + kk];
        LAS float* d = scr + kk * 65 + c4; d[0] = v.x; d[1] = v.y; d[2] = v.z; d[3] = v.w; }
    LDS_WAIT(); asm volatile("" ::: "memory");
    const int c = lane & 7;
#pragma unroll
    for (int j = 0; j < 8; ++j) { const int n = (lane >> 3) + 8 * j; const LAS float* s = scr + (8 * c) * 65 + n;
        v4u o; o.x = mb_cvtpk(s[0 * 65], s[1 * 65]); o.y = mb_cvtpk(s[2 * 65], s[3 * 65]); o.z = mb_cvtpk(s[4 * 65], s[5 * 65]); o.w = mb_cvtpk(s[6 * 65], s[7 * 65]);
        *(GAS v4u*)(WT + (size_t)(dest_row0 + n) * K + k0 + 8 * c) = o; }
    LDS_WAIT(); asm volatile("" ::: "memory");
}

__device__ __forceinline__ void prologue(const Ctx& p, LAS unsigned char* lds, int wave, int lane, bool first) {
    LAS float* scr = (LAS float*)(lds + wave * 16640);
    const int gw = blockIdx.x * NWAVES + wave, NGW = gridDim.x * NWAVES;
    constexpr int I_IN = (DM / 64) * (INW / 64), I_OUT = (DM / 64) * (DM / 64), I_G = (DM / 64) * (DFF / 64), I_D = (DFF / 64) * (DM / 64);
    constexpr int PER_L = I_IN + I_OUT + 2 * I_G + I_D;
    for (int it = gw; it < DEPTH * PER_L; it += NGW) {
        const int l = it / PER_L; int r = it % PER_L;
        unsigned char* wl = p.ws + WS_W + (size_t)l * W_LAYER;
        if (r < I_IN) { const int nblk = INW / 64, kb = r / nblk, nb = r % nblk;
            p0_transpose_item(PIN(p, I_WIN) + (size_t)l * DM * INW, DM, INW, PIN(p, I_N1G) + l * DM, (bf16*)(wl + W_IN), 64 * nb, 64 * kb, 64 * nb, scr, lane); continue; } r -= I_IN;
        if (r < I_OUT) { const int nblk = DM / 64, kb = r / nblk, nb = r % nblk;
            p0_transpose_item(PIN(p, I_WOUT) + (size_t)l * DM * DM, DM, DM, nullptr, (bf16*)(wl + W_OUT), 64 * nb, 64 * kb, 64 * nb, scr, lane); continue; } r -= I_OUT;
        if (r < 2 * I_G) { const int up = r >= I_G; if (up) r -= I_G; const int nblk = DFF / 64, kb = r / nblk, nb = r % nblk, n0 = 64 * nb;
            const int dest = 256 * (n0 / 128) + (n0 % 128) + (up ? 128 : 0);
            p0_transpose_item(PIN(p, up ? I_WUP : I_WGATE) + (size_t)l * DM * DFF, DM, DFF, PIN(p, I_N2G) + l * DM, (bf16*)(wl + W_GU), dest, 64 * kb, n0, scr, lane); continue; } r -= 2 * I_G;
        { const int nblk = DM / 64, kb = r / nblk, nb = r % nblk;
            p0_transpose_item(PIN(p, I_WDOWN) + (size_t)l * DFF * DM, DFF, DM, nullptr, (bf16*)(wl + W_DN), 64 * nb, 64 * kb, 64 * nb, scr, lane); }
    }
    const float* x = PIN(p, I_X); bf16* XB = (bf16*)(p.ws + WS_XB); unsigned long long* SS = (unsigned long long*)(p.ws + WS_SS);
    for (int m0 = gw; m0 < M; m0 += 4 * NGW) {
        f32x4 v[4][4]; float s[4];
#pragma unroll
        for (int q = 0; q < 4; ++q) { const int m = (m0 + q * NGW < M) ? m0 + q * NGW : m0; const f32x4* xr = (const f32x4*)(x + (size_t)m * DM) + lane;
#pragma unroll
            for (int j = 0; j < 4; ++j) v[q][j] = xr[64 * j]; }
#pragma unroll
        for (int q = 0; q < 4; ++q) { s[q] = 0.f;
#pragma unroll
            for (int j = 0; j < 4; ++j) s[q] += (v[q][j].x * v[q][j].x + v[q][j].y * v[q][j].y) + (v[q][j].z * v[q][j].z + v[q][j].w * v[q][j].w); }
#pragma unroll
        for (int o = 1; o < 64; o <<= 1) {
#pragma unroll
            for (int q = 0; q < 4; ++q) s[q] += __shfl_xor(s[q], o); }
#pragma unroll
        for (int q = 0; q < 4; ++q) { const int m = m0 + q * NGW; if (m < M) {
            unsigned long long* o8 = (unsigned long long*)(XB + (size_t)m * DM) + lane;
#pragma unroll
            for (int j = 0; j < 4; ++j) o8[64 * j] = (unsigned long long)pk2(v[q][j].x, v[q][j].y) | ((unsigned long long)pk2(v[q][j].z, v[q][j].w) << 32);
            if (lane == 0 && first) __hip_atomic_fetch_add(SS + m, (unsigned long long)(s[q] * 16777216.0f), __ATOMIC_RELAXED, __HIP_MEMORY_SCOPE_AGENT); } }
    }
    { bf16* wtb = (bf16*)(p.ws + WS_TAB + 131072); const float* wsrc = PIN(p, I_WS);
        for (int i = gw * 64 + lane; i < DEPTH * 4 * 128 * 128; i += NGW * 64) { const int s_ = i & 127, t_ = (i >> 7) & 127; wtb[i] = (bf16)f2bf(s_ <= t_ ? wsrc[i] : 0.f); } }
    if (blockIdx.x == 0) { float* bt = (float*)(p.ws + WS_TAB);
        for (int i = wave * 64 + lane; i < 1024; i += NWAVES * 64) { const int h = i >> 7, d = i & 127; bt[i] = PIN(p, I_RELB)[(int)((LAS unsigned char*)(lds + TAB_OFF + 256))[d] * 8 + h]; } }
    if (blockIdx.x == 1) {
        for (int idx = wave; idx < DEPTH * 8; idx += NWAVES) { const int l_ = idx >> 3, h = idx & 7;
            float gm = fabsf(PIN(p, I_QNG)[l_ * 64 + lane] * PIN(p, I_KNG)[l_ * 64 + lane]);
            const LAS unsigned char* bk = (const LAS unsigned char*)(lds + TAB_OFF + 256);
            float bm = fmaxf(PIN(p, I_RELB)[(int)bk[lane] * 8 + h], PIN(p, I_RELB)[(int)bk[lane + 64] * 8 + h]);
#pragma unroll
            for (int o = 1; o < 64; o <<= 1) { gm = fmaxf(gm, __shfl_xor(gm, o)); bm = fmaxf(bm, __shfl_xor(bm, o)); }
            if (lane == 0) ((float*)(p.ws + WS_TAB))[1024 + idx] = (8.0f * gm + fmaxf(bm, PIN(p, I_SINK)[idx])) * 1.4426950408889634f; } }
}

#ifdef DBG_MIXCMP
__device__ __forceinline__ void mixer_a_simple(const Ctx& p, int l, int unit, LAS unsigned char* lds, int wave, int lane) {
    LAS float* vn = (LAS float*)lds;
    const int g = unit & 3, ck = unit >> 2; const size_t row0 = (size_t)ck * 128;
    const bf16* PROJ = (const bf16*)(p.ws + WS_PROJ); bf16* MIXED = (bf16*)(p.ws + WS_MIXED);
    const float vg = PIN(p, I_VNG)[(l * 4 + g) * 64 + lane];
#pragma unroll 4
    for (int i = 0; i < 16; ++i) { const int s = wave * 16 + i;
        const float v = bf2f(PROJ[(row0 + s) * INW + C_AV + g * 64 + lane]);
        const float ss = wave_sum(v * v);
        vn[s * 64 + lane] = v * rsqrtf(ss * (1.0f / 64.0f) + EPS) * vg; }
    __syncthreads();
    const float* Wg = PIN(p, I_WS) + (size_t)(l * 4 + g) * 128 * 128; const float* bs = PIN(p, I_BS) + (l * 4 + g) * 128;
    for (int i = 0; i < 16; ++i) { const int t = __builtin_amdgcn_readfirstlane(wave + 8 * i);
        const float* wrow = Wg + t * 128; float a = 0.f;
        for (int s0 = 0; s0 <= t; s0 += 4) { const f32x4 w = *(const f32x4*)(wrow + s0);
#pragma unroll
            for (int j = 0; j < 4; ++j) { const float wj = (s0 + j <= t) ? w[j] : 0.f; a += wj * vn[(s0 + j) * 64 + lane]; } }
        a += bs[t];
        const float uval = bf2f(PROJ[(row0 + t) * INW + C_AU + g * 64 + lane]);
        MIXED[(row0 + t) * DM + MX_A + g * 64 + lane] = (bf16)f2bf(uval * a * DBG_A); }
    __syncthreads();
}

#endif
#ifdef DBG_MIXCMP
constexpr int KVS = 68;
__device__ __forceinline__ void mixer_b_simple(const Ctx& p, int l, int unit, LAS unsigned char* lds, int wave, int lane) {
    LAS float* Kt = (LAS float*)lds; LAS float* Vt = Kt + 256 * KVS;
    const int hk = unit & 1, nb = unit >> 1, n = nb & 63; const long row0 = (long)nb * 128, win0 = row0 - 128;
    const bf16* PROJ = (const bf16*)(p.ws + WS_PROJ); bf16* MIXED = (bf16*)(p.ws + WS_MIXED);
    const int tid = wave * 64 + lane;
    {
        const int row = tid >> 1, half = tid & 1; const bool valid = (n > 0) || (row >= 128);
        float kf[32], vf[32];
        if (valid) { const v4u* kp = (const v4u*)(PROJ + (win0 + row) * INW + C_BK + hk * 64 + half * 32); const v4u* vp = (const v4u*)(PROJ + (win0 + row) * INW + C_BV + hk * 64 + half * 32);
#pragma unroll
            for (int c = 0; c < 4; ++c) { const v4u a = kp[c], b = vp[c];
                kf[8 * c + 0] = bflo(a.x); kf[8 * c + 1] = bfhi(a.x); kf[8 * c + 2] = bflo(a.y); kf[8 * c + 3] = bfhi(a.y); kf[8 * c + 4] = bflo(a.z); kf[8 * c + 5] = bfhi(a.z); kf[8 * c + 6] = bflo(a.w); kf[8 * c + 7] = bfhi(a.w);
                vf[8 * c + 0] = bflo(b.x); vf[8 * c + 1] = bfhi(b.x); vf[8 * c + 2] = bflo(b.y); vf[8 * c + 3] = bfhi(b.y); vf[8 * c + 4] = bflo(b.z); vf[8 * c + 5] = bfhi(b.z); vf[8 * c + 6] = bflo(b.w); vf[8 * c + 7] = bfhi(b.w); } }
        else {
#pragma unroll
            for (int c = 0; c < 32; ++c) { kf[c] = 0.f; vf[c] = 0.f; } }
        float ss = 0.f;
#pragma unroll
        for (int c = 0; c < 32; ++c) ss += kf[c] * kf[c];
        ss += __shfl_xor(ss, 1);
        const float rs = rsqrtf(ss * (1.0f / 64.0f) + EPS); const float* kng = PIN(p, I_KNG) + l * 64 + half * 32;
#pragma unroll
        for (int c = 0; c < 8; ++c) {
            *(LAS f32x4*)(Kt + row * KVS + half * 32 + 4 * c) = (f32x4){kf[4 * c] * rs * kng[4 * c], kf[4 * c + 1] * rs * kng[4 * c + 1], kf[4 * c + 2] * rs * kng[4 * c + 2], kf[4 * c + 3] * rs * kng[4 * c + 3]};
            *(LAS f32x4*)(Vt + row * KVS + half * 32 + 4 * c) = (f32x4){vf[4 * c], vf[4 * c + 1], vf[4 * c + 2], vf[4 * c + 3]}; }
    }
    __syncthreads();
    const int g = wave >> 1, i = (wave & 1) * 64 + lane, h = hk * 4 + g;
    float q[64];
    { const v4u* qp = (const v4u*)(PROJ + (row0 + i) * INW + C_BQ + h * 64); float ss = 0.f;
#pragma unroll
        for (int c = 0; c < 8; ++c) { const v4u a = qp[c];
            q[8 * c + 0] = bflo(a.x); q[8 * c + 1] = bfhi(a.x); q[8 * c + 2] = bflo(a.y); q[8 * c + 3] = bfhi(a.y); q[8 * c + 4] = bflo(a.z); q[8 * c + 5] = bfhi(a.z); q[8 * c + 6] = bflo(a.w); q[8 * c + 7] = bfhi(a.w); }
#pragma unroll
        for (int c = 0; c < 64; ++c) ss += q[c] * q[c];
        const float rs = rsqrtf(ss * (1.0f / 64.0f) + EPS) * 0.125f; const float* qng = PIN(p, I_QNG) + l * 64;
#pragma unroll
        for (int c = 0; c < 64; ++c) q[c] *= rs * qng[c]; }
    float mx = PIN(p, I_SINK)[l * 8 + h], lsum = 1.0f; float o[64];
#pragma unroll
    for (int c = 0; c < 64; ++c) o[c] = 0.f;
    const float* bt = (const float*)(p.ws + WS_TAB) + h * 128;
    for (int dist = 0; dist < 128; ++dist) {
        const int j = i + 128 - dist; const LAS float* kr = Kt + j * KVS; const LAS float* vr = Vt + j * KVS;
        float s0 = 0.f, s1 = 0.f, s2 = 0.f, s3 = 0.f;
#pragma unroll
        for (int c = 0; c < 16; ++c) { const f32x4 kk = *(const LAS f32x4*)(kr + 4 * c); s0 += q[4 * c] * kk.x; s1 += q[4 * c + 1] * kk.y; s2 += q[4 * c + 2] * kk.z; s3 += q[4 * c + 3] * kk.w; }
        float s = (s0 + s1) + (s2 + s3) + bt[dist];
        if (n == 0 && j < 128) s = -1e30f;
        if (s > mx) { const float f = __expf(mx - s); lsum *= f;
#pragma unroll
            for (int c = 0; c < 64; ++c) o[c] *= f;
            mx = s; }
        const float pr = __expf(s - mx); lsum += pr;
#pragma unroll
        for (int c = 0; c < 16; ++c) { const f32x4 vv = *(const LAS f32x4*)(vr + 4 * c); o[4 * c] += pr * vv.x; o[4 * c + 1] += pr * vv.y; o[4 * c + 2] += pr * vv.z; o[4 * c + 3] += pr * vv.w; }
    }
    const float inv = DBG_B / lsum; v4u* op = (v4u*)(MIXED + (row0 + i) * DM + MX_B + h * 64);
#pragma unroll
    for (int c = 0; c < 8; ++c) { v4u w; w.x = pk2(o[8 * c] * inv, o[8 * c + 1] * inv); w.y = pk2(o[8 * c + 2] * inv, o[8 * c + 3] * inv); w.z = pk2(o[8 * c + 4] * inv, o[8 * c + 5] * inv); w.w = pk2(o[8 * c + 6] * inv, o[8 * c + 7] * inv); op[c] = w; }
    __syncthreads();
}

#endif

namespace mb {
typedef short bf16x8 __attribute__((ext_vector_type(8)));
typedef short s16x4 __attribute__((ext_vector_type(4)));
typedef float f32x16 __attribute__((ext_vector_type(16)));
typedef float f32x2_t __attribute__((ext_vector_type(2)));
typedef __bf16 bf16x2_t __attribute__((ext_vector_type(2)));
constexpr int KB_OFF = 0, VB_OFF = 32768, BIAS_OFF = 65536, WS_OFF = 73728, WS_STRIDE = 4608;
__device__ __forceinline__ int crow(int r, int hi) { return (r & 3) + 8 * (r >> 2) + 4 * hi; }
__device__ __forceinline__ unsigned cvtpk(float lo, float hi) { f32x2_t v = {lo, hi}; bf16x2_t b = __builtin_convertvector(v, bf16x2_t); return __builtin_bit_cast(unsigned, b); }
__device__ __forceinline__ s16x4 vtr(LAS const unsigned char* p) { return __builtin_bit_cast(s16x4, __builtin_amdgcn_ds_read_tr16_b64_v4i16((LAS s16x4*)p)); }
}
__device__ __forceinline__ void mixer_b_mfma(const Ctx& p, int l, int unit, LAS unsigned char* lds, int wave, int lane) {
    using namespace mb;
    const int hk = unit & 1, nb = unit >> 1, n = nb & 63; const long row0 = (long)nb * 128, win0 = row0 - 128;
    const bf16* PROJ = (const bf16*)(p.ws + WS_PROJ); bf16* MIXED = (bf16*)(p.ws + WS_MIXED);
    const int tid = wave * 64 + lane, r32 = lane & 31, hi = lane >> 5;
    {
        const int row = tid >> 1, half = tid & 1; const bool valid = (n > 0) || (row >= 128);
        v4u kr[4], vr[4];
        if (valid) { const v4u* kp = (const v4u*)(PROJ + (win0 + row) * INW + C_BK + hk * 64 + half * 32); const v4u* vp = (const v4u*)(PROJ + (win0 + row) * INW + C_BV + hk * 64 + half * 32);
#pragma unroll
            for (int c = 0; c < 4; ++c) { kr[c] = kp[c]; vr[c] = vp[c]; } }
        else {
#pragma unroll
            for (int c = 0; c < 4; ++c) { kr[c] = (v4u){0u, 0u, 0u, 0u}; vr[c] = kr[c]; } }
        float ss = 0.f;
#pragma unroll
        for (int c = 0; c < 4; ++c) { const unsigned w4[4] = {kr[c].x, kr[c].y, kr[c].z, kr[c].w};
#pragma unroll
            for (int e = 0; e < 4; ++e) { const float a = bflo(w4[e]), b = bfhi(w4[e]); ss += a * a + b * b; } }
        ss += __shfl_xor(ss, 1);
        const float rs = rsqrtf(ss * (1.0f / 64.0f) + EPS) * (0.125f * 1.4426950408889634f); const float* kng = PIN(p, I_KNG) + l * 64 + half * 32; const float* qng = PIN(p, I_QNG) + l * 64 + half * 32;
        LAS unsigned char* kdst = lds + KB_OFF + (row >> 6) * 8192 + (half * 4) * 1024 + (row & 63) * 16;
        LAS unsigned char* vdst = lds + VB_OFF + (row >> 6) * 8192 + half * 4096 + ((row & 63) >> 4) * 1024 + (row & 15) * 64;
#pragma unroll
        for (int c = 0; c < 4; ++c) { const unsigned w4[4] = {kr[c].x, kr[c].y, kr[c].z, kr[c].w}; v4u o;
            unsigned ow[4];
#pragma unroll
            for (int e = 0; e < 4; ++e) ow[e] = cvtpk(bflo(w4[e]) * (rs * kng[8 * c + 2 * e] * qng[8 * c + 2 * e]), bfhi(w4[e]) * (rs * kng[8 * c + 2 * e + 1] * qng[8 * c + 2 * e + 1]));
            o.x = ow[0]; o.y = ow[1]; o.z = ow[2]; o.w = ow[3];
            *(LAS v4u*)(kdst + c * 1024) = o;
            *(LAS v4u*)(vdst + c * 16) = vr[c]; }
        const float* bt = (const float*)(p.ws + WS_TAB) + (hk * 4) * 128;
        const float* shp = (const float*)(p.ws + WS_TAB) + 1024 + l * 8 + hk * 4;
        for (int i = tid; i < 4 * 384; i += NWAVES * 64) { const int g = i / 384, x = i % 384 - 128; ((LAS float*)(lds + BIAS_OFF))[i] = (x >= 0 && x < 128) ? bt[g * 128 + 127 - x] * 1.4426950408889634f - shp[g] : -1e30f; }
    }
    __syncthreads();
    const int g = wave >> 1, h = hk * 4 + g;
    LAS float* wsf = (LAS float*)(lds + WS_OFF + wave * WS_STRIDE);
    LAS bf16* stg = (LAS bf16*)(lds + WS_OFF + wave * WS_STRIDE + 256);
    const float sinke = __builtin_amdgcn_exp2f(PIN(p, I_SINK)[l * 8 + h] * 1.4426950408889634f - ((const float*)(p.ws + WS_TAB))[1024 + l * 8 + h]);
    const LAS unsigned char* vp0 = lds + VB_OFF + ((lane >> 4) & 1) * 32 + (lane & 3) * 8 + (4 * hi + ((lane & 15) >> 2)) * 64;
#pragma unroll
    for (int qt = 0; qt < 2; ++qt) {
        const int i0 = (wave & 1) * 64 + qt * 32, qi = i0 + r32, jt0 = (i0 >= 64) ? 1 : 0;
#define MB_LIVE(jt, hh) ((qt == 0) ? !((jt) == 2 && (hh) == 1) : !((jt) == 0 && (hh) == 0))
        bf16x8 qr[4];
        { const bf16* qp = PROJ + (row0 + qi) * INW + C_BQ + h * 64 + hi * 8; v4u raw[4]; float ss = 0.f;
#pragma unroll
            for (int d0 = 0; d0 < 4; ++d0) { raw[d0] = *(const v4u*)(qp + d0 * 16); const unsigned w4[4] = {raw[d0].x, raw[d0].y, raw[d0].z, raw[d0].w};
#pragma unroll
                for (int e = 0; e < 4; ++e) { const float a = bflo(w4[e]), b = bfhi(w4[e]); ss += a * a + b * b; } }
            ss += __shfl_xor(ss, 32);
            const float rs = rsqrtf(ss * (1.0f / 64.0f) + EPS);
#pragma unroll
            for (int d0 = 0; d0 < 4; ++d0) { const unsigned w4[4] = {raw[d0].x, raw[d0].y, raw[d0].z, raw[d0].w}; unsigned ow[4];
#pragma unroll
                for (int e = 0; e < 4; ++e) ow[e] = cvtpk(bflo(w4[e]) * rs, bfhi(w4[e]) * rs);
                v4u o; o.x = ow[0]; o.y = ow[1]; o.z = ow[2]; o.w = ow[3]; qr[d0] = __builtin_bit_cast(bf16x8, o); } }
        f32x16 sc[3][2];
#pragma unroll
        for (int jt = 0; jt < 3; ++jt) { const LAS unsigned char* kb = lds + KB_OFF + (jt0 + jt) * 8192 + hi * 1024 + r32 * 16;
            f32x16 a0 = {}, a1 = {};
#pragma unroll
            for (int d0 = 0; d0 < 4; ++d0) {
                if (MB_LIVE(jt, 0)) { const bf16x8 b0 = *(const LAS bf16x8*)(kb + d0 * 2048); a0 = __builtin_amdgcn_mfma_f32_32x32x16_bf16(b0, qr[d0], a0, 0, 0, 0); }
                if (MB_LIVE(jt, 1)) { const bf16x8 b1 = *(const LAS bf16x8*)(kb + d0 * 2048 + 512); a1 = __builtin_amdgcn_mfma_f32_32x32x16_bf16(b1, qr[d0], a1, 0, 0, 0); } }
            sc[jt][0] = a0; sc[jt][1] = a1; }
        const LAS float* tb = (const LAS float*)(lds + BIAS_OFF) + g * 384 + 128;
        float lsum = 0.f;
#pragma unroll
        for (int jt = 0; jt < 3; ++jt)
#pragma unroll
            for (int hh = 0; hh < 2; ++hh) if (MB_LIVE(jt, hh)) { const int kj0 = 64 * (jt0 + jt) + 32 * hh + 4 * hi;
                const bool first = (n == 0) && (jt0 + jt < 2);
                const LAS float* tx = first ? (tb + 130) : (tb + (127 - (qi + 128 - kj0)));
#pragma unroll
                for (int r = 0; r < 16; ++r) { const int kc = (r & 3) + 8 * (r >> 2);
                    const float e = __builtin_amdgcn_exp2f(sc[jt][hh][r] + tx[kc]); sc[jt][hh][r] = e; lsum += e; } }
        lsum += __shfl_xor(lsum, 32);
        lsum += sinke;
        f32x16 o0 = {}, o1 = {};
#pragma unroll
        for (int jt = 0; jt < 3; ++jt) { const LAS unsigned char* vb = vp0 + (jt0 + jt) * 8192;
#pragma unroll
            for (int ks = 0; ks < 4; ++ks) { const int hh = ks >> 1, rb = (ks & 1) * 8;
                if (MB_LIVE(jt, hh)) {
                v4u pw; pw.x = cvtpk(sc[jt][hh][rb + 0], sc[jt][hh][rb + 1]); pw.y = cvtpk(sc[jt][hh][rb + 2], sc[jt][hh][rb + 3]); pw.z = cvtpk(sc[jt][hh][rb + 4], sc[jt][hh][rb + 5]); pw.w = cvtpk(sc[jt][hh][rb + 6], sc[jt][hh][rb + 7]);
                const bf16x8 pa = __builtin_bit_cast(bf16x8, pw);
                const s16x4 l0 = vtr(vb + ks * 1024), h0 = vtr(vb + ks * 1024 + 512), l1 = vtr(vb + 4096 + ks * 1024), h1 = vtr(vb + 4096 + ks * 1024 + 512);
                const bf16x8 v0 = (bf16x8){l0[0], l0[1], l0[2], l0[3], h0[0], h0[1], h0[2], h0[3]}, v1 = (bf16x8){l1[0], l1[1], l1[2], l1[3], h1[0], h1[1], h1[2], h1[3]};
                o0 = __builtin_amdgcn_mfma_f32_32x32x16_bf16(pa, v0, o0, 0, 0, 0); o1 = __builtin_amdgcn_mfma_f32_32x32x16_bf16(pa, v1, o1, 0, 0, 0); } } }
#undef MB_LIVE
        if (hi == 0) wsf[r32] = lsum;
        LDS_WAIT(); asm volatile("" ::: "memory");
#pragma unroll
        for (int r = 0; r < 16; ++r) { const int orow = crow(r, hi); const float inv = DBG_B * __builtin_amdgcn_rcpf(wsf[orow]);
            const unsigned pk = cvtpk(o0[r] * inv, o1[r] * inv);
            stg[orow * 64 + r32] = (bf16)(pk & 0xffffu); stg[orow * 64 + 32 + r32] = (bf16)(pk >> 16); }
        LDS_WAIT(); asm volatile("" ::: "memory");
        bf16* ow = MIXED + (row0 + i0) * DM + MX_B + h * 64;
#pragma unroll
        for (int i = 0; i < 4; ++i) { const int row = i * 8 + (lane >> 3), ch = lane & 7; const v4u v = *(const LAS v4u*)(stg + row * 64 + ch * 8); *(v4u*)(ow + (long)row * DM + ch * 8) = v; }
        LDS_WAIT(); asm volatile("" ::: "memory");
    }
    __syncthreads();
}

constexpr size_t WS_WTB = WS_TAB + 131072;
constexpr int VNT_STRIDE = 136;
constexpr int A_STG_OFF = 4 * 64 * VNT_STRIDE * 2, A_STG_BYTES = 32 * 36 * 4;
__device__ __forceinline__ float rowsum16_dpp(float v) {
    v += __int_as_float(__builtin_amdgcn_update_dpp(0, __float_as_int(v), 0xB1, 0xf, 0xf, true));
    v += __int_as_float(__builtin_amdgcn_update_dpp(0, __float_as_int(v), 0x4E, 0xf, 0xf, true));
    v += __int_as_float(__builtin_amdgcn_update_dpp(0, __float_as_int(v), 0x141, 0xf, 0xf, true));
    v += __int_as_float(__builtin_amdgcn_update_dpp(0, __float_as_int(v), 0x140, 0xf, 0xf, true));
    return v;
}
__device__ __forceinline__ void mixer_a_mfma(const Ctx& p, int l, int unit, LAS unsigned char* lds, int wave, int lane) {
    using namespace mb;
    LAS bf16* vnT = (LAS bf16*)lds;
    const int ck = unit; const size_t row0 = (size_t)ck * 128;
    const bf16* PROJ = (const bf16*)(p.ws + WS_PROJ); bf16* MIXED = (bf16*)(p.ws + WS_MIXED);
    const int r32 = lane & 31, hi = lane >> 5, g = wave >> 1, dt = wave & 1;
    const bf16* Wg = (const bf16*)(p.ws + WS_WTB) + ((size_t)(l * 4 + g) * 128 + r32) * 128 + 8 * hi;
    v4u wf[20];
#pragma unroll
    for (int ti = 0; ti < 3; ++ti)
#pragma unroll
        for (int ks = 0; ks < 2 * ti + 2; ++ks) wf[ti * (ti + 1) + ks] = *(const v4u*)(Wg + (size_t)(32 * ti) * 128 + 16 * ks);
    const int orow = lane >> 2, od8 = 8 * (lane & 3);
    v4u uv[4][2]; float bsv[4][2];
    { const float* bs = PIN(p, I_BS) + (l * 4 + g) * 128;
#pragma unroll
        for (int ti = 0; ti < 4; ++ti)
#pragma unroll
            for (int j = 0; j < 2; ++j) { const int t = 32 * ti + orow + 16 * j; uv[ti][j] = *(const v4u*)(PROJ + (row0 + t) * INW + C_AU + g * 64 + 32 * dt + od8); bsv[ti][j] = bs[t]; } }
    {
        const int sub = lane >> 4, d4 = (lane & 15) * 4;
        v2u raw[16];
#pragma unroll
        for (int it = 0; it < 16; ++it) raw[it] = *(const v2u*)(PROJ + (row0 + wave * 16 + (it >> 2) * 4 + sub) * INW + C_AV + (it & 3) * 64 + d4);
        const float* vgp = PIN(p, I_VNG) + l * 256 + d4;
#pragma unroll
        for (int it = 0; it < 16; ++it) { const int gg = it & 3, s = wave * 16 + (it >> 2) * 4 + sub;
            const float v0 = bflo(raw[it].x), v1 = bfhi(raw[it].x), v2 = bflo(raw[it].y), v3 = bfhi(raw[it].y);
            const float ss = rowsum16_dpp((v0 * v0 + v1 * v1) + (v2 * v2 + v3 * v3));
            const float rs = rsqrtf(ss * (1.0f / 64.0f) + EPS); const f32x4 vgg = *(const f32x4*)(vgp + gg * 64);
            LAS bf16* dst = vnT + gg * (64 * VNT_STRIDE) + d4 * VNT_STRIDE + s;
            const unsigned p01 = mb_cvtpk(v0 * rs * vgg.x, v1 * rs * vgg.y), p23 = mb_cvtpk(v2 * rs * vgg.z, v3 * rs * vgg.w);
            dst[0] = (bf16)(p01 & 0xffffu); dst[VNT_STRIDE] = (bf16)(p01 >> 16); dst[2 * VNT_STRIDE] = (bf16)(p23 & 0xffffu); dst[3 * VNT_STRIDE] = (bf16)(p23 >> 16); }
    }
    __syncthreads();
#pragma unroll
    for (int ks = 0; ks < 8; ++ks) wf[12 + ks] = *(const v4u*)(Wg + (size_t)96 * 128 + 16 * ks);
    const LAS bf16* vb = vnT + g * (64 * VNT_STRIDE) + (32 * dt + r32) * VNT_STRIDE + 8 * hi;
    LAS float* stf = (LAS float*)(lds + A_STG_OFF + wave * A_STG_BYTES);
#pragma unroll
    for (int ti = 0; ti < 4; ++ti) {
        f32x16 acc = {};
#pragma unroll
        for (int ks = 0; ks < 2 * ti + 2; ++ks) { const bf16x8 b = *(const LAS bf16x8*)(vb + 16 * ks);
            acc = __builtin_amdgcn_mfma_f32_32x32x16_bf16(__builtin_bit_cast(bf16x8, wf[ti * (ti + 1) + ks]), b, acc, 0, 0, 0); }
#pragma unroll
        for (int r = 0; r < 16; ++r) stf[crow(r, hi) * 36 + r32] = acc[r];
        LDS_WAIT(); asm volatile("" ::: "memory");
#pragma unroll
        for (int j = 0; j < 2; ++j) { const int trow = orow + 16 * j; const LAS float* sp = stf + trow * 36 + od8;
            const f32x4 a0 = *(const LAS f32x4*)sp, a1 = *(const LAS f32x4*)(sp + 4); const v4u uu = uv[ti][j]; const float bb = bsv[ti][j];
            v4u o; o.x = mb_cvtpk(bflo(uu.x) * (a0[0] + bb) * DBG_A, bfhi(uu.x) * (a0[1] + bb) * DBG_A); o.y = mb_cvtpk(bflo(uu.y) * (a0[2] + bb) * DBG_A, bfhi(uu.y) * (a0[3] + bb) * DBG_A);
            o.z = mb_cvtpk(bflo(uu.z) * (a1[0] + bb) * DBG_A, bfhi(uu.z) * (a1[1] + bb) * DBG_A); o.w = mb_cvtpk(bflo(uu.w) * (a1[2] + bb) * DBG_A, bfhi(uu.w) * (a1[3] + bb) * DBG_A);
            *(v4u*)(MIXED + (row0 + 32 * ti + trow) * DM + MX_A + g * 64 + 32 * dt + od8) = o; }
        LDS_WAIT(); asm volatile("" ::: "memory");
    }
    __syncthreads();
}
__device__ __forceinline__ float hgrn_lb(const Ctx& p, int l, int kidx) { if (l == 0) return 0.f; const float* lg = PIN(p, I_LBL); return 1.0f / (1.0f + __expf(lg[kidx] - lg[256 + kidx])); }
#ifdef DBG_MIXCMP
__device__ __forceinline__ void hgrn_stage(const bf16* PROJ, size_t rowbase, int hc, const float (&lb8)[8], LAS float* F, LAS float* V, LAS float* Q, int tid) {
    const int tt = tid >> 3, k0 = (tid & 7) * 8; const bf16* rp = PROJ + (rowbase + tt) * INW + hc * 64 + k0;
    const v4u z = *(const v4u*)(rp + C_CF), vi = *(const v4u*)(rp + C_CI);
    float zf[8] = {bflo(z.x), bfhi(z.x), bflo(z.y), bfhi(z.y), bflo(z.z), bfhi(z.z), bflo(z.w), bfhi(z.w)}; float ff[8];
#pragma unroll
    for (int j = 0; j < 8; ++j) ff[j] = lb8[j] + (1.0f - lb8[j]) * __builtin_amdgcn_rcpf(1.0f + __expf(-zf[j]));
    *(LAS f32x4*)(F + tt * 64 + k0) = (f32x4){ff[0], ff[1], ff[2], ff[3]}; *(LAS f32x4*)(F + tt * 64 + k0 + 4) = (f32x4){ff[4], ff[5], ff[6], ff[7]};
    *(LAS f32x4*)(V + tt * 64 + k0) = (f32x4){bflo(vi.x), bfhi(vi.x), bflo(vi.y), bfhi(vi.y)}; *(LAS f32x4*)(V + tt * 64 + k0 + 4) = (f32x4){bflo(vi.z), bfhi(vi.z), bflo(vi.w), bfhi(vi.w)};
    if (Q) { const v4u qq = *(const v4u*)(rp + C_CQ);
        *(LAS f32x4*)(Q + tt * 64 + k0) = (f32x4){bflo(qq.x), bfhi(qq.x), bflo(qq.y), bfhi(qq.y)}; *(LAS f32x4*)(Q + tt * 64 + k0 + 4) = (f32x4){bflo(qq.z), bfhi(qq.z), bflo(qq.w), bfhi(qq.w)}; }
}
__device__ __forceinline__ void mixer_c_pass1_simple(const Ctx& p, int l, int unit, LAS unsigned char* lds, int wave, int lane) {
    LAS float* F = (LAS float*)lds; LAS float* V = F + 4096;
    const int bh = unit >> 4, seg = unit & 15, b = bh >> 2, hc = bh & 3; const size_t row0 = (size_t)b * SEQ + (size_t)seg * 512;
    const bf16* PROJ = (const bf16*)(p.ws + WS_PROJ); const int tid = wave * 64 + lane;
    float lb8[8];
#pragma unroll
    for (int j = 0; j < 8; ++j) lb8[j] = hgrn_lb(p, l, hc * 64 + (tid & 7) * 8 + j);
    float S[8], P[8];
#pragma unroll
    for (int j = 0; j < 8; ++j) { S[j] = 0.f; P[j] = 1.f; }
    for (int cks = 0; cks < 8; ++cks) {
        __syncthreads();
        hgrn_stage(PROJ, row0 + cks * 64, hc, lb8, F, V, nullptr, tid);
        __syncthreads();
        for (int tt = 0; tt < 64; ++tt) {
            const f32x4 fa = *(const LAS f32x4*)(F + tt * 64 + wave * 8), fb = *(const LAS f32x4*)(F + tt * 64 + wave * 8 + 4); const float vv = V[tt * 64 + lane];
            const float f8[8] = {fa.x, fa.y, fa.z, fa.w, fb.x, fb.y, fb.z, fb.w};
#pragma unroll
            for (int j = 0; j < 8; ++j) { S[j] = fmaf(f8[j], S[j] - vv, vv); P[j] *= f8[j]; }
        }
    }
    float* SEGS = (float*)(p.ws + WS_SEGS); float* SEGP = (float*)(p.ws + WS_SEGP);
#pragma unroll
    for (int j = 0; j < 8; ++j) { SEGS[(size_t)unit * 4096 + (wave * 8 + j) * 64 + lane] = S[j]; if (lane == 0) SEGP[unit * 64 + wave * 8 + j] = P[j]; }
    __syncthreads();
}
__device__ __forceinline__ void mixer_c_pass2_simple(const Ctx& p, int l, int unit, LAS unsigned char* lds, int wave, int lane) {
    LAS float* F = (LAS float*)lds; LAS float* V = F + 4096; LAS float* Q = V + 4096; LAS float* PO = Q + 4096;
    const int bh = unit >> 4, seg = unit & 15, b = bh >> 2, hc = bh & 3; const size_t row0 = (size_t)b * SEQ + (size_t)seg * 512;
    const bf16* PROJ = (const bf16*)(p.ws + WS_PROJ); bf16* MIXED = (bf16*)(p.ws + WS_MIXED); const int tid = wave * 64 + lane;
    const float* SEGS = (const float*)(p.ws + WS_SEGS); const float* SEGP = (const float*)(p.ws + WS_SEGP);
    float lb8[8];
#pragma unroll
    for (int j = 0; j < 8; ++j) lb8[j] = hgrn_lb(p, l, hc * 64 + (tid & 7) * 8 + j);
    float S[8];
#pragma unroll
    for (int j = 0; j < 8; ++j) S[j] = 0.f;
    for (int s = 0; s < seg; ++s) { const int u2 = bh * 16 + s;
#pragma unroll
        for (int j = 0; j < 8; ++j) S[j] = SEGP[u2 * 64 + wave * 8 + j] * S[j] + SEGS[(size_t)u2 * 4096 + (wave * 8 + j) * 64 + lane]; }
    const float ong = PIN(p, I_ONG)[l * 64 + lane];
    for (int cks = 0; cks < 8; ++cks) {
        __syncthreads();
        hgrn_stage(PROJ, row0 + cks * 64, hc, lb8, F, V, Q, tid);
        __syncthreads();
        for (int tg = 0; tg < 4; ++tg) {
            for (int t16 = 0; t16 < 16; ++t16) { const int tt = tg * 16 + t16;
                const f32x4 fa = *(const LAS f32x4*)(F + tt * 64 + wave * 8), fb = *(const LAS f32x4*)(F + tt * 64 + wave * 8 + 4);
                const f32x4 qa = *(const LAS f32x4*)(Q + tt * 64 + wave * 8), qb = *(const LAS f32x4*)(Q + tt * 64 + wave * 8 + 4); const float vv = V[tt * 64 + lane];
                const float f8[8] = {fa.x, fa.y, fa.z, fa.w, fb.x, fb.y, fb.z, fb.w}; const float q8[8] = {qa.x, qa.y, qa.z, qa.w, qb.x, qb.y, qb.z, qb.w};
                float po = 0.f;
#pragma unroll
                for (int j = 0; j < 8; ++j) { S[j] = fmaf(f8[j], S[j] - vv, vv); po = fmaf(q8[j], S[j], po); }
                PO[(t16 * 8 + wave) * 64 + lane] = po; }
            __syncthreads();
#pragma unroll
            for (int e = 0; e < 2; ++e) { const int t16 = wave * 2 + e; float o = 0.f;
#pragma unroll
                for (int w = 0; w < 8; ++w) o += PO[(t16 * 8 + w) * 64 + lane];
                const float ss = wave_sum(o * o); const size_t row = row0 + cks * 64 + tg * 16 + t16;
                const float gg = bf2f(PROJ[row * INW + C_CG + hc * 64 + lane]);
                MIXED[row * DM + MX_C + hc * 64 + lane] = (bf16)f2bf(o * rsqrtf(ss * (1.0f / 64.0f) + EPS) * ong * gg * DBG_C); }
            __syncthreads();
        }
    }
}

#endif


__device__ __forceinline__ float wave_sum_dpp(float v) {
    v += __int_as_float(__builtin_amdgcn_update_dpp(0, __float_as_int(v), 0xB1, 0xf, 0xf, true));
    v += __int_as_float(__builtin_amdgcn_update_dpp(0, __float_as_int(v), 0x4E, 0xf, 0xf, true));
    v += __int_as_float(__builtin_amdgcn_update_dpp(0, __float_as_int(v), 0x141, 0xf, 0xf, true));
    v += __int_as_float(__builtin_amdgcn_update_dpp(0, __float_as_int(v), 0x140, 0xf, 0xf, true));
    const int vi = __float_as_int(v);
    return (__int_as_float(__builtin_amdgcn_readlane(vi, 0)) + __int_as_float(__builtin_amdgcn_readlane(vi, 16))) + (__int_as_float(__builtin_amdgcn_readlane(vi, 32)) + __int_as_float(__builtin_amdgcn_readlane(vi, 48)));
}
namespace mc {
constexpr int QT = 0, KT = 4096, QH = 8192, KH = 12288, VV = 16384, DD = 20480, WTO = 20736, OE = 22784, OI = 30976, RB = 39168, LDS_END = 55552, OG = 55552, SF = 57344;
}
#define MC_BAR() do { asm volatile("s_waitcnt lgkmcnt(0)" ::: "memory"); __builtin_amdgcn_s_barrier(); asm volatile("" ::: "memory"); } while (0)
#define MC_PUT_SFRAGS(buf) do { LAS v4u* _sf = (LAS v4u*)(lds + mc::SF + (buf) * 8192 + wave * 4096) + lane; \
    _Pragma("unroll") for (int _f = 0; _f < 4; ++_f) { const int _b = 8 * (_f & 1); v4u _w; \
        if (_f < 2) { _w.x = cvtpk(S0[_b + 0], S0[_b + 1]); _w.y = cvtpk(S0[_b + 2], S0[_b + 3]); _w.z = cvtpk(S0[_b + 4], S0[_b + 5]); _w.w = cvtpk(S0[_b + 6], S0[_b + 7]); } \
        else { _w.x = cvtpk(S1[_b + 0], S1[_b + 1]); _w.y = cvtpk(S1[_b + 2], S1[_b + 3]); _w.z = cvtpk(S1[_b + 4], S1[_b + 5]); _w.w = cvtpk(S1[_b + 6], S1[_b + 7]); } \
        _sf[_f * 64] = _w; } } while (0)
template <bool PASS2>
__device__ __forceinline__ void mixer_c_mfma(const Ctx& p, int l, int unit, LAS unsigned char* lds, int wave, int lane) {
    using namespace mb;
    const int bh = unit >> 4, seg = unit & 15, b = bh >> 2, hc = bh & 3; const size_t row0 = (size_t)b * SEQ + (size_t)seg * 512;
    const bf16* PROJ = (const bf16*)(p.ws + WS_PROJ); bf16* MIXED = (bf16*)(p.ws + WS_MIXED);
    float* SEGS = (float*)(p.ws + WS_SEGS); float* SEGP = (float*)(p.ws + WS_SEGP);
    const int r32 = lane & 31, hi = lane >> 5, kt_lane_off = ((lane >> 4) & 1) * 32 + (lane & 3) * 8 + (4 * hi + ((lane & 15) >> 2)) * 64;
    const int cp = lane & 31, th = lane >> 5;
    const f32x2 lb2 = (f32x2){hgrn_lb(p, l, hc * 64 + 2 * cp), hgrn_lb(p, l, hc * 64 + 2 * cp + 1)}, omlb2 = (f32x2){1.0f - lb2.x, 1.0f - lb2.y};
    const int st = (((wave & 3) * 64 + lane) >> 3), sc8 = (lane & 7) * 8;
    if (PASS2 && wave == 7) ((LAS float*)(lds + mc::OG))[lane] = PIN(p, I_ONG)[l * 64 + lane] * DBG_C;
    f32x16 S0 = {}, S1 = {};
    if (PASS2) {
        LAS float* Ptab = (LAS float*)(lds + mc::OE);
        { const float* ps = SEGP + (size_t)bh * 16 * 64; const int t_ = wave * 64 + lane; const float p0_ = ps[t_], p1_ = ps[t_ + 512]; Ptab[t_] = p0_; Ptab[t_ + 512] = p1_; }
        MC_BAR();
        if (wave < 2) {
            const float* sbase = SEGS + (size_t)bh * 16 * 4096 + wave * 2048 + lane;
            for (int s = 0; s < seg; s += 4) {
                float buf[4][32];
#pragma unroll
                for (int j = 0; j < 4; ++j) { const int sj = (s + j < seg) ? s + j : seg - 1;
#pragma unroll
                    for (int r = 0; r < 32; ++r) buf[j][r] = sbase[(size_t)sj * 4096 + r * 64]; }
#pragma unroll
                for (int j = 0; j < 4; ++j) if (s + j < seg) { const LAS float* pp = Ptab + (s + j) * 64 + 4 * hi;
#pragma unroll
                    for (int gq = 0; gq < 4; ++gq) { const f32x4 d0 = *(const LAS f32x4*)(pp + 8 * gq), d1 = *(const LAS f32x4*)(pp + 32 + 8 * gq);
#pragma unroll
                        for (int e = 0; e < 4; ++e) { const int r = 4 * gq + e; S0[r] = d0[e] * S0[r] + buf[j][r]; S1[r] = d1[e] * S1[r] + buf[j][16 + r]; } } }
            }
        }
    }
    if (PASS2 && wave < 2) MC_PUT_SFRAGS(0);
    f32x2 sumtot = (f32x2){0.f, 0.f};
    const int tid = wave * 64 + lane, ptok = (tid & 255) >> 3, pch = tid & 7, parr = tid >> 8;
    const bf16* gsrc = PROJ + (row0 + ptok) * INW + hc * 64 + pch * 8;
    const int rboff = ptok * 128 + pch * 16;
    v4u pf0, pf1 = (v4u){0u, 0u, 0u, 0u};
    pf0 = *(const v4u*)(gsrc + (parr ? C_CI : C_CF)); if (PASS2) pf1 = *(const v4u*)(gsrc + (parr ? C_CG : C_CQ));
    *(LAS v4u*)(lds + mc::RB + parr * 4096 + rboff) = pf0; if (PASS2) *(LAS v4u*)(lds + mc::RB + (2 + parr) * 4096 + rboff) = pf1;
    MC_BAR();
#ifdef DBG_TIMEC
    long long tacc = 0; const long long tunit0 = clock64();
#endif
#pragma unroll 1
    for (int n = 0; n < 16; ++n) {
#ifdef DBG_TIMEC
        const long long ts1 = clock64();
#endif
        if (n + 1 < 16) { const bf16* gn = gsrc + (size_t)(32 * (n + 1)) * INW;
            pf0 = *(const v4u*)(gn + (parr ? C_CI : C_CF)); if (PASS2) pf1 = *(const v4u*)(gn + (parr ? C_CG : C_CQ)); }
        v4u gvr = (v4u){0u, 0u, 0u, 0u};
        if (PASS2 && wave >= 4) gvr = *(const LAS v4u*)(lds + mc::RB + (6144 + st * 64 + sc8) * 2);
        f32x2 fg[2], cs[2], qv[2], vv[2];
#pragma unroll
        for (int i = 0; i < 2; ++i) { const LAS unsigned* rp = (const LAS unsigned*)(lds + mc::RB) + (4 * wave + 2 * th + i) * 32 + cp;
            const unsigned zw = rp[0], vw = rp[1024];
            const float z0 = fmaxf(bflo(zw), -30.f), z1 = fmaxf(bfhi(zw), -30.f);
            fg[i] = (f32x2){lb2.x + omlb2.x * __builtin_amdgcn_rcpf(1.0f + __builtin_amdgcn_exp2f(z0 * -1.4426950408889634f)), lb2.y + omlb2.y * __builtin_amdgcn_rcpf(1.0f + __builtin_amdgcn_exp2f(z1 * -1.4426950408889634f))};
            vv[i] = (f32x2){bflo(vw), bfhi(vw)};
            if (PASS2) { const unsigned qw = rp[2048]; qv[i] = (f32x2){bflo(qw), bfhi(qw)}; } }
        cs[0] = (f32x2){__builtin_amdgcn_logf(fg[0].x), __builtin_amdgcn_logf(fg[0].y)}; cs[1] = cs[0] + (f32x2){__builtin_amdgcn_logf(fg[1].x), __builtin_amdgcn_logf(fg[1].y)};
        { const f32x2 other = (f32x2){__shfl_xor(cs[1].x, 32), __shfl_xor(cs[1].y, 32)};
            if (th) { cs[0] = cs[0] + other; cs[1] = cs[1] + other; ((LAS f32x2*)(lds + mc::WTO))[wave * 32 + cp] = cs[1]; } }
#ifdef DBG_TIMEC
        const long long tb1a = clock64(); if (DBG_TIMEC == 11) tacc += tb1a - ts1;
#endif
        MC_BAR();
#ifdef DBG_TIMEC
        const long long tb1b = clock64(); if (DBG_TIMEC == 12) tacc += tb1b - tb1a;
#endif
        f32x2 off = (f32x2){0.f, 0.f}, tot = off, mid = off;
#pragma unroll
        for (int w = 0; w < 8; ++w) { const f32x2 tw = ((const LAS f32x2*)(lds + mc::WTO))[w * 32 + cp]; if (w < wave) off = off + tw; if (w < 4) mid = mid + tw; tot = tot + tw; }
        sumtot = sumtot + tot;
#pragma unroll
        for (int i = 0; i < 2; ++i) { const int t = 4 * wave + 2 * th + i; const f32x2 Bt = off + cs[i], kk = (f32x2){1.0f - fg[i].x, 1.0f - fg[i].y};
            const int chb = (cp >> 2) * 512 + t * 16 + (cp & 3) * 4, vlb = (cp >> 4) * 2048 + (t >> 4) * 1024 + (t & 15) * 64 + (cp & 15) * 4;
            *(LAS unsigned*)(lds + mc::KH + vlb) = cvtpk(kk.x * __builtin_amdgcn_exp2f(tot.x - Bt.x), kk.y * __builtin_amdgcn_exp2f(tot.y - Bt.y));
            *(LAS unsigned*)(lds + mc::VV + vlb) = cvtpk(vv[i].x, vv[i].y);
            if (PASS2) { *(LAS unsigned*)(lds + mc::QT + chb) = cvtpk(qv[i].x * __builtin_amdgcn_exp2f(fminf(Bt.x - mid.x, 115.f)), qv[i].y * __builtin_amdgcn_exp2f(fminf(Bt.y - mid.y, 115.f)));
                *(LAS unsigned*)(lds + mc::KT + chb) = cvtpk(kk.x * __builtin_amdgcn_exp2f(fminf(mid.x - Bt.x, 115.f)), kk.y * __builtin_amdgcn_exp2f(fminf(mid.y - Bt.y, 115.f)));
                *(LAS unsigned*)(lds + mc::QH + chb) = cvtpk(qv[i].x * __builtin_amdgcn_exp2f(Bt.x), qv[i].y * __builtin_amdgcn_exp2f(Bt.y)); } }
        if (wave == 0 && th == 0) ((LAS f32x2*)(lds + mc::DD))[cp] = (f32x2){__builtin_amdgcn_exp2f(tot.x), __builtin_amdgcn_exp2f(tot.y)};
#ifdef DBG_TIMEC
        const long long tb2a = clock64(); if (DBG_TIMEC == 13) tacc += tb2a - tb1b;
#endif
        MC_BAR();
#ifdef DBG_TIMEC
        const long long ts2 = clock64(); if (DBG_TIMEC == 14) tacc += ts2 - tb2a; if (DBG_TIMEC == 1) tacc += ts2 - ts1;
#endif
        if (wave < 2) {
            const int vt = wave;
            { const LAS float* dp = (const LAS float*)(lds + mc::DD) + 4 * hi;
#pragma unroll
                for (int gq = 0; gq < 4; ++gq) { const f32x4 d0 = *(const LAS f32x4*)(dp + 8 * gq), d1 = *(const LAS f32x4*)(dp + 32 + 8 * gq);
#pragma unroll
                    for (int e = 0; e < 4; ++e) { S0[4 * gq + e] *= d0[e]; S1[4 * gq + e] *= d1[e]; } } }
#pragma unroll
            for (int ks = 0; ks < 2; ++ks) {
                const LAS unsigned char* vb = lds + mc::VV + vt * 2048 + ks * 1024 + kt_lane_off; const s16x4 vl = vtr(vb), vh = vtr(vb + 512);
                const bf16x8 bv = (bf16x8){vl[0], vl[1], vl[2], vl[3], vh[0], vh[1], vh[2], vh[3]};
                const LAS unsigned char* k0 = lds + mc::KH + ks * 1024 + kt_lane_off; const s16x4 al = vtr(k0), ah = vtr(k0 + 512), bl = vtr(k0 + 2048), bh_ = vtr(k0 + 2048 + 512);
                const bf16x8 a0 = (bf16x8){al[0], al[1], al[2], al[3], ah[0], ah[1], ah[2], ah[3]}, a1 = (bf16x8){bl[0], bl[1], bl[2], bl[3], bh_[0], bh_[1], bh_[2], bh_[3]};
                S0 = __builtin_amdgcn_mfma_f32_32x32x16_bf16(a0, bv, S0, 0, 0, 0); S1 = __builtin_amdgcn_mfma_f32_32x32x16_bf16(a1, bv, S1, 0, 0, 0); }
            if (PASS2 && n + 1 < 16) MC_PUT_SFRAGS((n + 1) & 1);
        } else if (PASS2 && wave >= 4 && wave < 6) {
            const int vt = wave - 4; const LAS v4u* sf = (const LAS v4u*)(lds + mc::SF + (n & 1) * 8192 + vt * 4096) + lane;
            f32x16 o = {};
#pragma unroll
            for (int kt = 0; kt < 2; ++kt)
#pragma unroll
                for (int s2 = 0; s2 < 2; ++s2) { const LAS unsigned char* qa = lds + mc::QH + (4 * kt + 2 * s2) * 512 + r32 * 16 + 8 * hi;
                    const v2u a0 = *(const LAS v2u*)qa, a1 = *(const LAS v2u*)(qa + 512); v4u aw; aw.x = a0.x; aw.y = a0.y; aw.z = a1.x; aw.w = a1.y;
                    const v4u bw = sf[(2 * kt + s2) * 64];
                    o = __builtin_amdgcn_mfma_f32_32x32x16_bf16(__builtin_bit_cast(bf16x8, aw), __builtin_bit_cast(bf16x8, bw), o, 0, 0, 0); }
#pragma unroll
            for (int r = 0; r < 16; ++r) ((LAS float*)(lds + mc::OE))[crow(r, hi) * 64 + 32 * vt + r32] = o[r];
        } else if (PASS2 && wave < 4) {
            const int vt = wave - 2;
            f32x16 at = {};
#pragma unroll
            for (int ks = 0; ks < 4; ++ks) { const bf16x8 a = *(const LAS bf16x8*)(lds + mc::KT + (2 * ks + hi) * 512 + r32 * 16), bq = *(const LAS bf16x8*)(lds + mc::QT + (2 * ks + hi) * 512 + r32 * 16);
                at = __builtin_amdgcn_mfma_f32_32x32x16_bf16(a, bq, at, 0, 0, 0); }
            f32x16 o = {};
#pragma unroll
            for (int ks = 0; ks < 2; ++ks) { float m8[8];
#pragma unroll
                for (int j = 0; j < 8; ++j) { const int r = 8 * ks + j; m8[j] = (crow(r, hi) <= r32) ? at[r] : 0.f; }
                v4u pw; pw.x = cvtpk(m8[0], m8[1]); pw.y = cvtpk(m8[2], m8[3]); pw.z = cvtpk(m8[4], m8[5]); pw.w = cvtpk(m8[6], m8[7]);
                const LAS unsigned char* vb = lds + mc::VV + vt * 2048 + ks * 1024 + kt_lane_off; const s16x4 vl = vtr(vb), vh = vtr(vb + 512);
                const bf16x8 bv = (bf16x8){vl[0], vl[1], vl[2], vl[3], vh[0], vh[1], vh[2], vh[3]};
                o = __builtin_amdgcn_mfma_f32_32x32x16_bf16(__builtin_bit_cast(bf16x8, pw), bv, o, 0, 0, 0); }
#pragma unroll
            for (int r = 0; r < 16; ++r) ((LAS float*)(lds + mc::OI))[crow(r, hi) * 64 + 32 * vt + r32] = o[r];
        }
#ifdef DBG_TIMEC
        const long long ts2b = clock64(); if (DBG_TIMEC == 2) tacc += ts2b - ts2;
#endif
        if (n + 1 < 16) { *(LAS v4u*)(lds + mc::RB + parr * 4096 + rboff) = pf0; if (PASS2) *(LAS v4u*)(lds + mc::RB + (2 + parr) * 4096 + rboff) = pf1; }
        MC_BAR();
#ifdef DBG_TIMEC
        const long long ts3 = clock64(); if (DBG_TIMEC == 6) tacc += ts3 - ts2b;
#endif
        if (PASS2 && wave >= 4) {
            const LAS float* oe = (const LAS float*)(lds + mc::OE) + st * 64 + sc8; const LAS float* oi = (const LAS float*)(lds + mc::OI) + st * 64 + sc8;
            const f32x4 o0 = *(const LAS f32x4*)oe + *(const LAS f32x4*)oi, o1 = *(const LAS f32x4*)(oe + 4) + *(const LAS f32x4*)(oi + 4);
            float ss = ((o0[0] * o0[0] + o0[1] * o0[1]) + (o0[2] * o0[2] + o0[3] * o0[3])) + ((o1[0] * o1[0] + o1[1] * o1[1]) + (o1[2] * o1[2] + o1[3] * o1[3]));
            ss += __int_as_float(__builtin_amdgcn_update_dpp(0, __float_as_int(ss), 0xB1, 0xf, 0xf, true));
            ss += __int_as_float(__builtin_amdgcn_update_dpp(0, __float_as_int(ss), 0x4E, 0xf, 0xf, true));
            ss += __int_as_float(__builtin_amdgcn_update_dpp(0, __float_as_int(ss), 0x141, 0xf, 0xf, true));
            const float rs = rsqrtf(ss * (1.0f / 64.0f) + EPS);
            const f32x4 g0 = (f32x4){bflo(gvr.x), bfhi(gvr.x), bflo(gvr.y), bfhi(gvr.y)}, g1 = (f32x4){bflo(gvr.z), bfhi(gvr.z), bflo(gvr.w), bfhi(gvr.w)};
            const LAS float* ogp = (const LAS float*)(lds + mc::OG) + sc8; const f32x4 ong0 = *(const LAS f32x4*)ogp, ong1 = *(const LAS f32x4*)(ogp + 4);
            const f32x4 y0 = o0 * rs * ong0 * g0, y1 = o1 * rs * ong1 * g1;
            v4u w; w.x = cvtpk(y0[0], y0[1]); w.y = cvtpk(y0[2], y0[3]); w.z = cvtpk(y1[0], y1[1]); w.w = cvtpk(y1[2], y1[3]);
            *(v4u*)(MIXED + (row0 + 32 * n + st) * DM + MX_C + hc * 64 + sc8) = w;
        }
    }
#ifdef DBG_TIMEC
    if (PASS2 && unit == DBG_TIMEC_UNIT && wave == DBG_TIMEC_WAVE && lane == 0) { if (DBG_TIMEC == 4) tacc = clock64() - tunit0; ((float*)(p.ws + WS_TAB + 65536))[4] = (float)tacc; }
#endif
    if (!PASS2) {
        if (wave < 2) { float* sp = SEGS + ((size_t)(unit * 2 + wave) * 2) * 16 * 64 + lane;
#pragma unroll
            for (int r = 0; r < 16; ++r) { sp[(size_t)r * 64] = S0[r]; sp[(size_t)(16 + r) * 64] = S1[r]; } }
        if (wave == 0 && th == 0) { SEGP[unit * 64 + 2 * cp] = __builtin_amdgcn_exp2f(sumtot.x); SEGP[unit * 64 + 2 * cp + 1] = __builtin_amdgcn_exp2f(sumtot.y); }
    }
    __syncthreads();
}
__device__ __forceinline__ void ffn_fixup(const Ctx& p, int l, int tid) {
    const float* HG = (const float*)(p.ws + WS_HG); const float* HU = (const float*)(p.ws + WS_HU); bf16* ACT = (bf16*)(p.ws + WS_ACT);
    const float* cw = PIN(p, I_CONVW) + (size_t)l * 3 * DFF; const float* cb = PIN(p, I_CONVB) + (size_t)l * DFF;
    const int total = 512 * 2 * (DFF / 4);
    for (int idx = blockIdx.x * (NWAVES * 64) + tid; idx < total; idx += gridDim.x * (NWAVES * 64)) {
        const int c4 = idx % (DFF / 4), rr = idx / (DFF / 4), rho = rr & 1, blk = rr >> 1, ch = 4 * c4;
        const bool first = (blk % 128) == 0;
        const f32x4 z = (f32x4){0.f, 0.f, 0.f, 0.f};
        const f32x4 g0 = *(const f32x4*)(HG + ((size_t)blk * 4 + rho) * DFF + ch);
        f32x4 g1, g2;
        if (rho == 1) { g1 = *(const f32x4*)(HG + ((size_t)blk * 4 + 0) * DFF + ch); g2 = first ? z : *(const f32x4*)(HG + ((size_t)(blk - 1) * 4 + 3) * DFF + ch); }
        else { g1 = first ? z : *(const f32x4*)(HG + ((size_t)(blk - 1) * 4 + 3) * DFF + ch); g2 = first ? z : *(const f32x4*)(HG + ((size_t)(blk - 1) * 4 + 2) * DFF + ch); }
        const f32x4 up = *(const f32x4*)(HU + ((size_t)blk * 2 + rho) * DFF + ch);
        const f32x4 w0 = *(const f32x4*)(cw + ch), w1 = *(const f32x4*)(cw + DFF + ch), w2 = *(const f32x4*)(cw + 2 * DFF + ch), bb = *(const f32x4*)(cb + ch);
        f32x4 c = bb + w0 * g2 + w1 * g1 + w2 * g0;
#pragma unroll
        for (int j = 0; j < 4; ++j) c[j] = silu_f(c[j]) * up[j];
        v2u w; w.x = pk2(c[0], c[1]); w.y = pk2(c[2], c[3]);
        *(v2u*)(ACT + ((size_t)blk * 64 + rho) * DFF + ch) = w;
    }
}

#ifndef PREB_ON
#define PREB_ON 0
#endif
constexpr int PH_PER_LAYER = 7, N_PHASES = 1 + DEPTH * PH_PER_LAYER;
__global__ void __launch_bounds__(NWAVES * 64, 2) fwd_kernel(Params args) {
    extern __shared__ __attribute__((aligned(16))) unsigned char lds_raw[];
    LAS unsigned char* lds = (LAS unsigned char*)lds_raw;
    volatile LAS unsigned* MISC = (volatile LAS unsigned*)(lds + MISC_OFF);
    volatile LAS unsigned long long* TAB = (volatile LAS unsigned long long*)(lds + TAB_OFF);
    LAS unsigned char* BKT = lds + TAB_OFF + 256;
    if (threadIdx.x < 64) MISC[threadIdx.x] = 0u;
    if (threadIdx.x == 0) {
#pragma unroll
        for (int i = 0; i < 19; ++i) TAB[i] = (unsigned long long)args.in[i];
        TAB[19] = (unsigned long long)args.out;
    }
    if (threadIdx.x >= 64 && threadIdx.x < 192) BKT[threadIdx.x - 64] = args.bucket[threadIdx.x - 64];
    __syncthreads();
    unsigned* barw = (unsigned*)(args.ws + WS_CTL) + CW_BAR + args.bar_region * XCD_BAR_WORDS;
    const int lo = args.ph_lo, hi = args.ph_hi;
    XcdBarrier bar; bar.bar = barw; bar.x = 0; bar.st = nullptr;
    if (hi - lo > 1) bar = xcd_barrier_post(barw, MISC + 8);
    const int wave_s = 0; bar.wv = 0;
    const int G_raw = gridDim.x;
#pragma nounroll
    for (int ph = lo; ph < hi; ++ph) {
        const int l = (ph - 1) / PH_PER_LAYER, k = (ph == 0) ? -1 : (ph - 1) % PH_PER_LAYER;
#ifdef DBG_DOUBLE
        const int nrep = ((ph == 0 ? 7 : k) == DBG_DOUBLE) ? 2 : 1;
#else
        const int nrep = 1;
#endif
#pragma nounroll
        for (int rep = 0; rep < nrep; ++rep) {
        int bid = (int)blockIdx.x, G = G_raw; asm volatile("" : "+s"(bid), "+s"(G));
        int tid = threadIdx.x; asm volatile("" : "+v"(tid));
        Ctx p; p.tab = TAB; p.bucket = nullptr; { GAS unsigned char* wsg = (GAS unsigned char*)args.ws; asm volatile("" : "+s"(wsg)); p.ws = (unsigned char*)wsg; }
        const int lane = tid & 63, wave = __builtin_amdgcn_readfirstlane(tid >> 6);
        const unsigned char* wl = p.ws + WS_W + (size_t)l * W_LAYER;
        if (ph == 0) {
#ifndef NO_P0
            prologue(p, lds, wave, lane, rep == 0);
#endif
        } else if (k == 0) {
#ifndef NO_P1
            pg8::Gemm g{(const bf16*)(p.ws + WS_XB), (const bf16*)(wl + W_IN), M, INW, DM, (PREB_ON && hi - lo > 1 && ph > 1) ? 1 : 0, wave_s}; InProjOrder S; S.init(M, INW, G, bid);
            if (bid >= 128 && rep == 0) { for (int z = 0; z < SKEW_P1; ++z) __builtin_amdgcn_s_sleep(127); }
            EpiInProj E{(bf16*)(p.ws + WS_PROJ), (const unsigned long long*)(p.ws + WS_SS) + (size_t)(2 * l) * M, DBG_EPI_MODE(rep), lds};
            pg8::gemm_phase<EpiInProj, InProjOrder, true, true>(lds, g, S, E);
#endif
        } else if (k == 1) {
#ifndef NO_P2A
#ifdef DBG_MIXCMP
            if (args.flags & 1) { for (int u = bid; u < 256; u += G) mixer_c_pass1_simple(p, l, u, lds, wave, lane); } else
#endif
            for (int rr = 0; rr < DBG_REP_C1; ++rr)
            for (int u = bid; u < 256; u += G) mixer_c_mfma<false>(p, l, u, lds, wave, lane);
#ifdef DBG_MIXCMP
            if (args.flags & 1) { for (int u = bid; u < 1024; u += G) mixer_a_simple(p, l, u, lds, wave, lane); } else
#endif
            for (int u = bid; u < 256; u += G) mixer_a_mfma(p, l, u, lds, wave, lane);
#endif
        } else if (k == 2) {
#ifndef NO_P2B
#ifdef DBG_MIXCMP
            if (args.flags & 1) { for (int u = bid; u < 256; u += G) mixer_c_pass2_simple(p, l, u, lds, wave, lane); } else
#endif
            for (int rr = 0; rr < DBG_REP_C2; ++rr)
            for (int u = bid; u < 256; u += G) mixer_c_mfma<true>(p, l, u, lds, wave, lane);
#ifdef DBG_MIXCMP
            if (args.flags & 1) { for (int u = bid; u < 512; u += G) mixer_b_simple(p, l, u, lds, wave, lane); } else
#endif
            for (int rr = 0; rr < DBG_REP_B; ++rr)
            for (int u = bid; u < 512; u += G) mixer_b_mfma(p, l, u, lds, wave, lane);
#endif
        } else if (k == 3) {
#ifndef NO_P3
            pg8::Gemm g{(const bf16*)(p.ws + WS_MIXED), (const bf16*)(wl + W_OUT), M, DM, DM, (PREB_ON && hi - lo > 1) ? 1 : 0, wave_s}; pg8::StaticOrder S; S.init(M, DM, G, bid);
            EpiResid E{(bf16*)(p.ws + WS_XB), nullptr, (unsigned long long*)(p.ws + WS_SS) + (size_t)(2 * l + 1) * M, rep == 0 ? 1 : 0};
            pg8::gemm_phase<EpiResid, pg8::StaticOrder, true, true>(lds, g, S, E);
#endif
        } else if (k == 4) {
#ifndef NO_P4
            pg8::Gemm g{(const bf16*)(p.ws + WS_XB), (const bf16*)(wl + W_GU), M, NGU, DM, (PREB_ON && hi - lo > 1) ? 1 : 0, wave_s}; pg8::StaticOrder S; S.init(M, NGU, G, bid);
            if (((bid >> 3) & 1) && rep == 0) { for (int z = 0; z < SKEW_P4; ++z) __builtin_amdgcn_s_sleep(127); }
            EpiFFN E{(bf16*)(p.ws + WS_ACT), (const unsigned long long*)(p.ws + WS_SS) + (size_t)(2 * l + 1) * M, PIN(p, I_CONVW) + (size_t)l * 3 * DFF, PIN(p, I_CONVB) + (size_t)l * DFF, (float*)(p.ws + WS_HG), (float*)(p.ws + WS_HU), DBG_EPI_MODE(rep), lds};
            pg8::gemm_phase<EpiFFN, pg8::StaticOrder, true, true>(lds, g, S, E);
#endif
        } else if (k == 5) {
            ffn_fixup(p, l, tid);
        } else {
#ifndef NO_P5
            pg8::Gemm g{(const bf16*)(p.ws + WS_ACT), (const bf16*)(wl + W_DN), M, DM, DFF, (PREB_ON && hi - lo > 1) ? 1 : 0, wave_s}; pg8::StaticOrder S; S.init(M, DM, G, bid);
            EpiResid E{(bf16*)(p.ws + WS_XB), POUT(p), (unsigned long long*)(p.ws + WS_SS) + (size_t)(2 * l + 2) * M, rep != 0 ? 0 : ((l + 1 < DEPTH) ? 1 : 2)};
            pg8::gemm_phase<EpiResid, pg8::StaticOrder, true, true>(lds, g, S, E);
#endif
        }
        }
        if (ph + 1 < hi) {
            xcd_barrier_head();
            if (PREB_ON && hi - lo > 1 && ph >= 1) {
                const int k2 = ph % PH_PER_LAYER, l2 = ph / PH_PER_LAYER;
                const int N2 = (k2 == 0) ? INW : (k2 == 3 || k2 == 6) ? DM : (k2 == 4) ? NGU : 0, K2 = (k2 == 6) ? DFF : DM;
                const size_t wo2 = (k2 == 0) ? W_IN : (k2 == 3) ? W_OUT : (k2 == 4) ? W_GU : W_DN;
                if (N2 != 0) { pg8::Unit u2; bool ok2; int bid = (int)blockIdx.x, G = G_raw; asm volatile("" : "+s"(bid), "+s"(G));
                    if (k2 == 0) { InProjOrder S; S.init(M, INW, G, bid); ok2 = S.next(0, u2); } else { pg8::StaticOrder S; S.init(M, N2, G, bid); ok2 = S.next(0, u2); }
                    GAS unsigned char* wsg = (GAS unsigned char*)args.ws; asm volatile("" : "+s"(wsg));
                    if (ok2) pg8::gemm_prefetch_b(lds, (const bf16*)((const unsigned char*)wsg + WS_W + (size_t)l2 * W_LAYER + wo2), K2, u2.pn, wave_s); }
            }
            xcd_barrier_tail(bar);
#ifdef DBG_EXTRA_BAR
            for (int z = 0; z < DBG_EXTRA_BAR; ++z) xcd_barrier(bar);
#endif
        }
    }
}


#if defined(DBG_NAIVE_DOWN)
__global__ void __launch_bounds__(256) dbg_down(const bf16* ACT, const float* Wd, const float* X1, float* out) {
    __shared__ float a[4][DFF];
    const int r0 = blockIdx.x * 4, c = threadIdx.x * 4;
    for (int i = threadIdx.x; i < 4 * DFF; i += 256) a[i / DFF][i % DFF] = bf2f(ACT[(size_t)(r0 + i / DFF) * DFF + i % DFF]);
    __syncthreads();
    f32x4 acc[4]; for (int r = 0; r < 4; ++r) acc[r] = (f32x4){0.f, 0.f, 0.f, 0.f};
    for (int k = 0; k < DFF; ++k) { const f32x4 w = *(const f32x4*)(Wd + (size_t)k * DM + c);
        for (int r = 0; r < 4; ++r) acc[r] += w * a[r][k]; }
    for (int r = 0; r < 4; ++r) { const size_t off = (size_t)(r0 + r) * DM + c; *(f32x4*)(out + off) = *(const f32x4*)(X1 + off) + acc[r]; }
}
#endif

#if defined(DBG_FFNCMP)
constexpr int DBG_R = 512;
__global__ void __launch_bounds__(256) dbg_gu(const float* X1, const float* g2, const float* Wg, const float* Wu, float* GU) {
    __shared__ float h[DM];
    const int r = blockIdx.x, c = blockIdx.y * 256 + threadIdx.x;
    float ss = 0.f; for (int k = threadIdx.x; k < DM; k += 256) { const float v = X1[(size_t)r * DM + k]; ss += v * v; }
    __shared__ float red[256]; red[threadIdx.x] = ss; __syncthreads();
    for (int o = 128; o > 0; o >>= 1) { if (threadIdx.x < o) red[threadIdx.x] += red[threadIdx.x + o]; __syncthreads(); }
    const float rstd = rsqrtf(red[0] / DM + EPS);
    for (int k = threadIdx.x; k < DM; k += 256) h[k] = X1[(size_t)r * DM + k] * rstd * g2[k];
    __syncthreads();
    if (c < DFF) { float a = 0.f, b = 0.f; for (int k = 0; k < DM; ++k) { a += h[k] * Wg[(size_t)k * DFF + c]; b += h[k] * Wu[(size_t)k * DFF + c]; }
        GU[((size_t)r * 2 + 0) * DFF + c] = a; GU[((size_t)r * 2 + 1) * DFF + c] = b; }
}
__global__ void __launch_bounds__(256) dbg_cmp(const float* GU, const float* cw, const float* cb, const bf16* ACT, float* acc2) {
    const int r = blockIdx.x, c = blockIdx.y * 256 + threadIdx.x; float num = 0.f, den = 0.f;
    if (c < DFF) { const float g0 = GU[((size_t)r * 2) * DFF + c], g1 = r >= 1 ? GU[((size_t)(r - 1) * 2) * DFF + c] : 0.f, g2 = r >= 2 ? GU[((size_t)(r - 2) * 2) * DFF + c] : 0.f;
#if defined(DBG_TAPS) && DBG_TAPS == 0
        const float cv = cb[c] + cw[2 * DFF + c] * g0;
#elif defined(DBG_TAPS) && DBG_TAPS == 1
        const float cv = cb[c] + cw[DFF + c] * g1 + cw[2 * DFF + c] * g0;
#else
        const float cv = cb[c] + cw[c] * g2 + cw[DFF + c] * g1 + cw[2 * DFF + c] * g0;
#endif
        const float ref = cv / (1.0f + expf(-cv)) * GU[((size_t)r * 2 + 1) * DFF + c];
        const float mine = bf2f(ACT[(size_t)r * DFF + c]);
#if DBG_FFNCMP == 2
        if ((r & 63) < 2) { num = (mine - ref) * (mine - ref); den = ref * ref; }
#elif DBG_FFNCMP == 3
        if ((r & 63) >= 2) { num = (mine - ref) * (mine - ref); den = ref * ref; }
#else
        num = (mine - ref) * (mine - ref); den = ref * ref;
#endif
    }
    __shared__ float rn[256], rd[256]; rn[threadIdx.x] = num; rd[threadIdx.x] = den; __syncthreads();
    for (int o = 128; o > 0; o >>= 1) { if (threadIdx.x < o) { rn[threadIdx.x] += rn[threadIdx.x + o]; rd[threadIdx.x] += rd[threadIdx.x + o]; } __syncthreads(); }
    if (threadIdx.x == 0) { atomicAdd(acc2, rn[0]); atomicAdd(acc2 + 1, rd[0]); }
}
__global__ void dbg_emit(const float* acc2, float* out) { out[0] = 1000.0f * sqrtf(acc2[0] / acc2[1]); }
#endif

#if defined(DBG_MIXCMP)
__global__ void __launch_bounds__(256) dbg_mixcmp(const bf16* A, const bf16* R, int c0, int c1, float* acc2) {
    float num = 0.f, den = 0.f;
    for (size_t r = blockIdx.x; r < (size_t)M; r += gridDim.x)
        for (int c = c0 + threadIdx.x; c < c1; c += 256) { const float a = bf2f(A[r * DM + c]), b = bf2f(R[r * DM + c]); num += (a - b) * (a - b); den += b * b; }
    __shared__ float rn[256], rd[256]; rn[threadIdx.x] = num; rd[threadIdx.x] = den; __syncthreads();
    for (int o = 128; o > 0; o >>= 1) { if (threadIdx.x < o) { rn[threadIdx.x] += rn[threadIdx.x + o]; rd[threadIdx.x] += rd[threadIdx.x + o]; } __syncthreads(); }
    if (threadIdx.x == 0) { atomicAdd(acc2, rn[0]); atomicAdd(acc2 + 1, rd[0]); }
}
__global__ void dbg_emit2(const float* acc2, float* out) { out[0] = 1000.0f * sqrtf(acc2[0] / acc2[1]); }
#endif
#if defined(DBG_TIMEC)
__global__ void dbg_emit3(const float* dv, float* out) { out[0] = 10.0f * (floorf(log2f(dv[4]) * 4.0f) * 0.25f - 8.0f); }
#endif
#ifndef MK_PER_PHASE
#define MK_PER_PHASE 0
#endif
extern "C" void kernel_launch(void* const* d_in, const int* in_sizes, int n_in, void* d_out, int out_size, void* d_ws, size_t ws_size, hipStream_t stream) {
    static int grid = 0;
    if (grid == 0) {
        if (n_in != 19 || in_sizes[0] != M * DM || out_size != M * DM || ws_size < WS_END) { fprintf(stderr, "kernel_launch: unexpected shapes (n_in %d, in0 %d, out %d, ws %zu)\n", n_in, n_in > 0 ? in_sizes[0] : -1, out_size, ws_size); grid = -1; return; }
        int dev = 0, cus = 0;
        if (hipGetDevice(&dev) != hipSuccess || hipDeviceGetAttribute(&cus, hipDeviceAttributeMultiprocessorCount, dev) != hipSuccess) { grid = -1; return; }
        if (hipFuncSetAttribute((const void*)fwd_kernel, hipFuncAttributeMaxDynamicSharedMemorySize, LDS_BYTES) != hipSuccess) { fprintf(stderr, "kernel_launch: hipFuncSetAttribute failed\n"); grid = -1; return; }
        int per_cu = 0;
        if (hipOccupancyMaxActiveBlocksPerMultiprocessor(&per_cu, (const void*)fwd_kernel, NWAVES * 64, LDS_BYTES) != hipSuccess || per_cu < 1) { fprintf(stderr, "kernel_launch: occupancy query reports %d blocks per CU\n", per_cu); }
        (void)hipGetLastError();
        grid = cus < 256 ? cus : 256;
    }
    if (grid < 0) return;
    (void)hipMemsetAsync((char*)d_ws + WS_CTL, 0, CTL_ZERO_BYTES, stream);
    Params a{};
    for (int i = 0; i < 19; ++i) a.in[i] = (const float*)d_in[i];
    a.out = (float*)d_out; a.ws = (unsigned char*)d_ws;
    for (int n = 0; n < 128; ++n) {
        int bkt;
        if (n < 16) bkt = n; else { const float v = logf((float)n / 16.0f) / (float)log(128.0 / 16.0) * 16.0f; bkt = 16 + (int)v; if (bkt > 31) bkt = 31; }
        a.bucket[n] = (unsigned char)bkt;
    }
#if MK_PER_PHASE
    for (int ph = 0; ph < N_PHASES; ++ph) { a.ph_lo = ph; a.ph_hi = ph + 1; hipLaunchKernelGGL(fwd_kernel, dim3(grid), dim3(NWAVES * 64), LDS_BYTES, stream, a); }
#elif defined(DBG_MIXCMP)
    { float* acc2 = (float*)((char*)d_ws + WS_TAB + 65536); (void)hipMemsetAsync(acc2, 0, 8, stream);
      a.ph_lo = 0; a.ph_hi = 4; a.flags = 1; a.bar_region = 0;
      hipLaunchKernelGGL(fwd_kernel, dim3(grid), dim3(NWAVES * 64), LDS_BYTES, stream, a);
      (void)hipMemcpyAsync((char*)d_ws + WS_X1, (char*)d_ws + WS_MIXED, (size_t)M * DM * 2, hipMemcpyDeviceToDevice, stream);
      (void)hipMemsetAsync((char*)d_ws + WS_MIXED, 0, (size_t)M * DM * 2, stream);
      a.ph_lo = 2; a.ph_hi = 4; a.flags = 0; a.bar_region = 1;
      hipLaunchKernelGGL(fwd_kernel, dim3(grid), dim3(NWAVES * 64), LDS_BYTES, stream, a);
      const int c0 = (DBG_MIXCMP == 1) ? 0 : (DBG_MIXCMP == 2) ? 256 : 768, c1 = (DBG_MIXCMP == 1) ? 256 : (DBG_MIXCMP == 2) ? 768 : 1024;
      hipLaunchKernelGGL(dbg_mixcmp, dim3(1024), dim3(256), 0, stream, (const bf16*)((char*)d_ws + WS_MIXED), (const bf16*)((char*)d_ws + WS_X1), c0, c1, acc2);
      (void)hipMemcpyAsync(d_out, d_in[0], (size_t)M * DM * 4, hipMemcpyDeviceToDevice, stream);
      hipLaunchKernelGGL(dbg_emit2, dim3(1), dim3(1), 0, stream, (const float*)acc2, (float*)d_out); }
#elif defined(DBG_TIMEC)
    a.ph_lo = 0; a.ph_hi = N_PHASES;
    hipLaunchKernelGGL(fwd_kernel, dim3(grid), dim3(NWAVES * 64), LDS_BYTES, stream, a);
    (void)hipMemcpyAsync(d_out, d_in[0], (size_t)M * DM * 4, hipMemcpyDeviceToDevice, stream);
    hipLaunchKernelGGL(dbg_emit3, dim3(1), dim3(1), 0, stream, (const float*)((char*)d_ws + WS_TAB + 65536), (float*)d_out);
#elif defined(DBG_NAIVE_DOWN)
    a.ph_lo = 0; a.ph_hi = 7;
    hipLaunchKernelGGL(fwd_kernel, dim3(grid), dim3(NWAVES * 64), LDS_BYTES, stream, a);
    hipLaunchKernelGGL(dbg_down, dim3(M / 4), dim3(256), 0, stream, (const bf16*)((char*)d_ws + WS_ACT), (const float*)d_in[I_WDOWN], (const float*)((char*)d_ws + WS_X1), (float*)d_out);
#elif defined(DBG_FFNCMP)
    a.ph_lo = 0; a.ph_hi = 7;
    hipLaunchKernelGGL(fwd_kernel, dim3(grid), dim3(NWAVES * 64), LDS_BYTES, stream, a);
    { float* GU = (float*)d_out + (size_t)16 * 1024 * 1024; float* acc2 = (float*)((char*)d_ws + WS_TAB + 65536);
      (void)hipMemsetAsync(acc2, 0, 8, stream);
      hipLaunchKernelGGL(dbg_gu, dim3(DBG_R, 11), dim3(256), 0, stream, (const float*)((char*)d_ws + WS_X1), (const float*)d_in[I_N2G], (const float*)d_in[I_WGATE], (const float*)d_in[I_WUP], GU);
      hipLaunchKernelGGL(dbg_cmp, dim3(DBG_R, 11), dim3(256), 0, stream, (const float*)GU, (const float*)d_in[I_CONVW], (const float*)d_in[I_CONVB], (const bf16*)((char*)d_ws + WS_ACT), acc2);
      (void)hipMemcpyAsync(d_out, d_in[0], (size_t)M * DM * 4, hipMemcpyDeviceToDevice, stream);
      hipLaunchKernelGGL(dbg_emit, dim3(1), dim3(1), 0, stream, (const float*)acc2, (float*)d_out); }
#elif defined(DBG_STOP)
    a.ph_lo = 0; a.ph_hi = DBG_STOP + 1;
    hipLaunchKernelGGL(fwd_kernel, dim3(grid), dim3(NWAVES * 64), LDS_BYTES, stream, a);
    { const int k = (DBG_STOP == 0) ? -1 : (DBG_STOP - 1) % PH_PER_LAYER;
      const float* src = (DBG_STOP == 0) ? (const float*)d_in[0] : ((k >= 3 && k <= 5) ? (const float*)((char*)d_ws + WS_X1) : nullptr);
      if (src) (void)hipMemcpyAsync(d_out, src, (size_t)M * DM * 4, hipMemcpyDeviceToDevice, stream); }
#else
    a.ph_lo = 0; a.ph_hi = N_PHASES;
    hipLaunchKernelGGL(fwd_kernel, dim3(grid), dim3(NWAVES * 64), LDS_BYTES, stream, a);
#endif
    const hipError_t le = hipPeekAtLastError();
    if (le != hipSuccess) fprintf(stderr, "kernel_launch: launch failed: %s\n", hipGetErrorName(le));
}
```

```cpp
#include <hip/hip_runtime.h>
#include <cstdio>
#include <cstdint>
#include <cmath>
namespace pg8 {
#define PG8_LAS __attribute__((address_space(3)))
typedef unsigned short bf16_t;
typedef short bf16x8 __attribute__((ext_vector_type(8)));
typedef float f32x4 __attribute__((ext_vector_type(4)));
typedef unsigned u32x4 __attribute__((ext_vector_type(4)));
constexpr int BM = 256, BK = 64, HALF = 128, HTB = HALF * BK * 2  , STAGE_BYTES = 8 * HTB, NXCD = 8, WGM = 8;

__host__ __device__ __forceinline__ int lds_byte(int r, int c) { const int st = (r >> 4) * 2 + (c >> 5), rr = r & 15, cc = c & 31, ob = rr * 64 + cc * 2; return st * 1024 + (ob ^ (((ob >> 9) & 1) << 5)); }
__host__ __device__ __forceinline__ void stage_rc(int b, int& R, int& C) { const int st = b / 1024, sb = b % 1024, swz = sb ^ (((sb >> 9) & 1) << 5); R = (st >> 1) * 16 + swz / 64; C = (st & 1) * 32 + (swz % 64) / 2; }
__host__ __device__ __forceinline__ int perm32(int rho) { const int n = rho >> 4, i = rho & 15; return 8 * (i >> 2) + 4 * n + (i & 3); }

struct Unit { int pm, pn; };
struct Gemm { const bf16_t* A; const bf16_t* Bt; int M, N, K; int preb; int wv; };

struct StaticOrder {
    int nM, nN, nwg, G, c;
    __host__ __device__ void init(int M, int N, int G_, int c_) { nM = M / BM; nN = N / BM; nwg = nM * nN; G = G_; c = c_; }
    __host__ __device__ bool next(int i, Unit& u) const {
        const int L = i * G + c; if (L >= nwg) return false;
        int wgid = L; { const int q = nwg / NXCD, r = nwg % NXCD, xcd = wgid % NXCD, off = wgid / NXCD; wgid = (xcd < r ? xcd * (q + 1) : r * (q + 1) + (xcd - r) * q) + off; }
        const int nig = WGM * nN, gid = wgid / nig, fm = gid * WGM, gsz = (nM - fm) < WGM ? (nM - fm) : WGM;
        u.pm = fm + ((wgid % nig) % gsz); u.pn = (wgid % nig) / gsz; return true;
    }
    __device__ __forceinline__ void a_ready(const Unit&) const {}
    __device__ __forceinline__ void done(const Unit&) const {}
};

__device__ __forceinline__ unsigned cvt_pk_bf16(float lo, float hi) { unsigned r; asm volatile("v_cvt_pk_bf16_f32 %0, %1, %2" : "=v"(r) : "v"(lo), "v"(hi)); return r; }
typedef float f32x2 __attribute__((ext_vector_type(2)));
__device__ __forceinline__ f32x2 gelu_pk(f32x2 v) {
    const f32x2 av = __builtin_elementwise_abs(v), d = av * 0.2316418882f + 1.0f;
    f32x2 t; t.x = __builtin_amdgcn_rcpf(d.x); t.y = __builtin_amdgcn_rcpf(d.y);
    f32x2 q = t * 0.5307027145f + (-0.7265760135f); q = q * t + 0.7107068705f; q = q * t + (-0.142248368f); q = q * t + 0.127414796f; q = q * t;
    const f32x2 s = (v * v) * (-0.72134752044f);
    f32x2 e; e.x = __builtin_amdgcn_exp2f(s.x); e.y = __builtin_amdgcn_exp2f(s.y);
    const f32x2 m = v * (q * e), r = v - m;
    f32x2 o; o.x = v.x < 0.f ? m.x : r.x; o.y = v.y < 0.f ? m.y : r.y; return o;
}

#define PG8_ZERO4(x) do { f32x2 _z0, _z1; asm volatile("v_mov_b64 %0, 0\n\tv_mov_b64 %1, 0" : "=v"(_z0), "=v"(_z1)); (x) = (f32x4){_z0[0], _z0[1], _z1[0], _z1[1]}; } while (0)
template <class Epi, class Sched, bool ALIGN_EPI = false, bool SP2 = false>
__device__ __forceinline__ void gemm_phase(PG8_LAS unsigned char* lds, const Gemm g, const Sched& S, const Epi& E) {
    int tid_l = threadIdx.x; asm volatile("" : "+v"(tid_l));
    const int tid = tid_l, wid = __builtin_amdgcn_readfirstlane(tid >> 6), lane = tid & 63, wr = wid >> 2, wc = wid & 3, fr = lane & 15, fq = lane >> 4;
    const int K = g.K, nt = K / BK;
    unsigned voffA[2], voffB[2];
#pragma unroll
    for (int i = 0; i < 2; ++i) { int R, C; stage_rc(tid * 16 + i * 8192, R, C); const int Rb = Epi::PERM ? ((R & ~31) + perm32(R & 31)) : R;
        const int Ra = Epi::APERM ? ((R & ~63) | (4 * (R & 15) + ((R >> 4) & 3))) : R;
        voffA[i] = (unsigned)(Ra * K + C) * 2u; voffB[i] = (unsigned)(Rb * K + C) * 2u; }
    const size_t kstep = (size_t)(BK * 2);
    const size_t hstep = (size_t)HALF * K * 2;
    const size_t tstep = 2 * hstep;
    const unsigned ldsw = (unsigned)wid * 1024u;
    const int aoff = lds_byte(wr * 64 + fr, fq * 8), boff = lds_byte(wc * 32 + fr, fq * 8);
#define PG8_SA(b, h) (((b) * 2 + (h)) * HTB)
#define PG8_SB(b, h) ((4 + (b) * 2 + (h)) * HTB)
#define PG8_STAGE(bufoff, gbase, voff) do { _Pragma("unroll") for (int _i = 0; _i < 2; ++_i) \
        __builtin_amdgcn_global_load_lds((const unsigned*)((const char*)(gbase) + (voff)[_i]), (PG8_LAS unsigned*)(lds + (bufoff) + ldsw + _i * 8192), 16, 0, 0); } while (0)
#define PG8_LDA(dst, b, h) do { _Pragma("unroll") for (int m = 0; m < 4; ++m) _Pragma("unroll") for (int k = 0; k < 2; ++k) dst[m][k] = *(const PG8_LAS bf16x8*)(lds + PG8_SA(b, h) + aoff + m * 2048 + k * 1024); } while (0)
#define PG8_LDB(dst, b, h) do { _Pragma("unroll") for (int n = 0; n < 2; ++n) _Pragma("unroll") for (int k = 0; k < 2; ++k) dst[n][k] = *(const PG8_LAS bf16x8*)(lds + PG8_SB(b, h) + boff + n * 2048 + k * 1024); } while (0)
#define PG8_MMA(ai, bj, At, Bt) do { __builtin_amdgcn_s_setprio(1); _Pragma("unroll") for (int m = 0; m < 4; ++m) _Pragma("unroll") for (int n = 0; n < 2; ++n) _Pragma("unroll") for (int k = 0; k < 2; ++k) \
        acc[ai][bj][m][n] = __builtin_amdgcn_mfma_f32_16x16x32_bf16(Bt[n][k], At[m][k], acc[ai][bj][m][n], 0, 0, 0); __builtin_amdgcn_s_setprio(0); } while (0)
#define PG8_WAIT_V(n) asm volatile("s_waitcnt vmcnt(" #n ")" ::: "memory")
#define PG8_WAIT_VN(n) asm volatile("s_waitcnt vmcnt(%0)" :: "n"(n) : "memory")
#define PG8_WAIT_L(n) asm volatile("s_waitcnt lgkmcnt(" #n ")" ::: "memory")
#define PG8_BAR __builtin_amdgcn_s_barrier()
#define PG8_SCHED __builtin_amdgcn_sched_barrier(0)
    Unit cur, nxt; int ui = 0;
    if (!S.next(0, cur)) return;
    f32x4 acc[2][2][4][2];
#pragma unroll
    for (int a = 0; a < 2; ++a)
#pragma unroll
        for (int b = 0; b < 2; ++b)
#pragma unroll
            for (int m = 0; m < 4; ++m)
#pragma unroll
                for (int n = 0; n < 2; ++n) PG8_ZERO4(acc[a][b][m][n]);
    bf16x8 At[4][2], B0[2][2], B1[2][2];
    const char* cA = (const char*)g.A + (size_t)cur.pm * tstep; const char* cB = (const char*)g.Bt + (size_t)cur.pn * tstep;
    S.a_ready(cur);
    if constexpr (SP2) {
        if (g.preb) {
            PG8_STAGE(PG8_SA(0, 0), cA, voffA); PG8_STAGE(PG8_SA(0, 1), cA + hstep, voffA);
            if (wr == 1) PG8_BAR;
            PG8_WAIT_V(2); PG8_BAR;
            PG8_STAGE(PG8_SA(1, 0), cA + kstep, voffA);
            PG8_WAIT_V(2); PG8_BAR;
        } else {
        PG8_STAGE(PG8_SB(0, 0), cB, voffB); PG8_STAGE(PG8_SB(0, 1), cB + hstep, voffB); PG8_STAGE(PG8_SA(0, 0), cA, voffA); PG8_STAGE(PG8_SA(0, 1), cA + hstep, voffA);
        if (wr == 1) PG8_BAR;
        PG8_WAIT_V(2); PG8_BAR;
        PG8_STAGE(PG8_SB(1, 0), cB + kstep, voffB); PG8_STAGE(PG8_SA(1, 0), cA + kstep, voffA); PG8_STAGE(PG8_SB(1, 1), cB + hstep + kstep, voffB);
        PG8_WAIT_V(6); PG8_BAR;
        }
    } else {
        PG8_STAGE(PG8_SB(0, 0), cB, voffB); PG8_STAGE(PG8_SA(0, 0), cA, voffA); PG8_STAGE(PG8_SB(0, 1), cB + hstep, voffB); PG8_STAGE(PG8_SA(0, 1), cA + hstep, voffA);
        if (wr == 1) PG8_BAR;
        PG8_WAIT_V(4); PG8_BAR;
        PG8_STAGE(PG8_SB(1, 0), cB + kstep, voffB); PG8_STAGE(PG8_SA(1, 0), cA + kstep, voffA); PG8_STAGE(PG8_SB(1, 1), cB + hstep + kstep, voffB);
        PG8_WAIT_V(6); PG8_BAR;
    }
    for (;;) {
        const bool has_next = S.next(ui + 1, nxt);
        const char* nA = has_next ? (const char*)g.A + (size_t)nxt.pm * tstep : cA; const char* nB = has_next ? (const char*)g.Bt + (size_t)nxt.pn * tstep : cB;
        typename Epi::Pre pre;
        for (int t = 0; t < nt; t += 2) {
            const bool last = (t == nt - 2);
            const char* a1 = cA + (size_t)(t + 1) * kstep;
            const char* a2 = last ? nA : cA + (size_t)(t + 2) * kstep; const char* b2 = last ? nB : cB + (size_t)(t + 2) * kstep;
            const char* a3 = a2 + kstep; const char* b3 = b2 + kstep;
            if (last && has_next) S.a_ready(nxt);
            if constexpr (SP2) {
            PG8_LDB(B0, 0, 0); PG8_LDB(B1, 0, 1); PG8_SCHED; PG8_LDA(At, 0, 0); PG8_STAGE(PG8_SA(1, 1), a1 + hstep, voffA);
            if (Epi::NPRE > 0 && last) { pre = E.preload(cur, wr, wc, fr, fq); PG8_WAIT_VN(8 + Epi::NPRE); } else PG8_WAIT_V(8);
            PG8_WAIT_L(0); PG8_BAR; PG8_MMA(0, 0, At, B0); PG8_MMA(0, 1, At, B1); PG8_BAR; PG8_SCHED;
            PG8_LDA(At, 0, 1); PG8_STAGE(PG8_SB(0, 0), b2, voffB); PG8_STAGE(PG8_SB(0, 1), b2 + hstep, voffB); PG8_STAGE(PG8_SA(0, 0), a2, voffA);
            if (Epi::NPRE > 0 && last) PG8_WAIT_VN(8 + Epi::NPRE); else PG8_WAIT_V(8);
            PG8_WAIT_L(0); PG8_BAR; PG8_MMA(1, 0, At, B0); PG8_MMA(1, 1, At, B1); PG8_BAR; PG8_SCHED;
            PG8_LDB(B0, 1, 0); PG8_LDB(B1, 1, 1); PG8_SCHED; PG8_LDA(At, 1, 0); PG8_STAGE(PG8_SA(0, 1), a2 + hstep, voffA);
            if (Epi::NPRE > 0 && last) PG8_WAIT_VN(8 + Epi::NPRE); else PG8_WAIT_V(8);
            PG8_WAIT_L(0); PG8_BAR; PG8_MMA(0, 0, At, B0); PG8_MMA(0, 1, At, B1); PG8_BAR; PG8_SCHED;
            PG8_LDA(At, 1, 1); PG8_STAGE(PG8_SB(1, 0), b3, voffB); PG8_STAGE(PG8_SB(1, 1), b3 + hstep, voffB); PG8_STAGE(PG8_SA(1, 0), a3, voffA);
            PG8_WAIT_V(8); PG8_WAIT_L(0); PG8_BAR; PG8_MMA(1, 0, At, B0); PG8_MMA(1, 1, At, B1); PG8_BAR; PG8_SCHED;
            } else {
            PG8_LDB(B0, 0, 0); PG8_SCHED; PG8_LDA(At, 0, 0); PG8_STAGE(PG8_SA(1, 1), a1 + hstep, voffA);
            PG8_WAIT_L(8); PG8_BAR; PG8_WAIT_L(0); PG8_MMA(0, 0, At, B0); PG8_BAR; PG8_SCHED;
            PG8_LDB(B1, 0, 1); PG8_STAGE(PG8_SB(0, 0), b2, voffB);
            PG8_BAR; PG8_WAIT_L(0); PG8_MMA(0, 1, At, B1); PG8_BAR;
            PG8_LDA(At, 0, 1); PG8_STAGE(PG8_SA(0, 0), a2, voffA);
            PG8_BAR; PG8_WAIT_L(0); PG8_MMA(1, 0, At, B0); PG8_BAR; PG8_SCHED;
            PG8_STAGE(PG8_SB(0, 1), b2 + hstep, voffB);
            PG8_WAIT_V(6); PG8_BAR; PG8_MMA(1, 1, At, B1); PG8_BAR;
            PG8_LDB(B0, 1, 0); PG8_SCHED; PG8_LDA(At, 1, 0); PG8_STAGE(PG8_SA(0, 1), a2 + hstep, voffA);
            PG8_WAIT_L(8); PG8_BAR; PG8_WAIT_L(0); PG8_MMA(0, 0, At, B0); PG8_BAR; PG8_SCHED;
            PG8_LDB(B1, 1, 1); PG8_STAGE(PG8_SB(1, 0), b3, voffB);
            PG8_BAR; PG8_WAIT_L(0); PG8_MMA(0, 1, At, B1); PG8_BAR;
            PG8_LDA(At, 1, 1); PG8_STAGE(PG8_SA(1, 0), a3, voffA);
            PG8_BAR; PG8_WAIT_L(0); PG8_MMA(1, 0, At, B0); PG8_BAR; PG8_SCHED;
            PG8_STAGE(PG8_SB(1, 1), b3 + hstep, voffB);
            PG8_WAIT_V(6); PG8_BAR; PG8_MMA(1, 1, At, B1); PG8_BAR;
            }
        }
        if constexpr (ALIGN_EPI) { if (wr == 0) PG8_BAR; }
        if constexpr (!Epi::AFTER_DRAIN) { E(acc, cur, wr, wc, fr, fq, pre); S.done(cur); }
        if (!has_next) break;
#pragma unroll
        for (int a = 0; a < 2; ++a)
#pragma unroll
            for (int b = 0; b < 2; ++b)
#pragma unroll
                for (int m = 0; m < 4; ++m)
#pragma unroll
                    for (int n = 0; n < 2; ++n) PG8_ZERO4(acc[a][b][m][n]);
        cur = nxt; cA = nA; cB = nB; ++ui;
        if constexpr (ALIGN_EPI) { if (wr == 1) PG8_BAR; }
    }
    PG8_WAIT_V(0);
    if constexpr (!ALIGN_EPI) { if (wr == 0) PG8_BAR; }
    PG8_BAR;
    if constexpr (Epi::AFTER_DRAIN) { E.fused(acc, cur, wr, wc, fr, fq, lds, wid, lane); S.done(cur); }
#undef PG8_SA
#undef PG8_SB
#undef PG8_STAGE
#undef PG8_LDA
#undef PG8_LDB
#undef PG8_MMA
#undef PG8_WAIT_V
#undef PG8_WAIT_VN
#undef PG8_WAIT_L
#undef PG8_BAR
#undef PG8_SCHED
}
__device__ __forceinline__ void gemm_prefetch_b(PG8_LAS unsigned char* lds, const bf16_t* Bt, int K, int pn, int wv) {
    int tid_l = threadIdx.x; asm volatile("" : "+v"(tid_l));
    const int tid = tid_l, wid = __builtin_amdgcn_readfirstlane(tid >> 6);
    const size_t hstep = (size_t)HALF * K * 2, kstep = (size_t)(BK * 2);
    const char* cB = (const char*)Bt + (size_t)pn * 2 * hstep;
    const unsigned ldsw = (unsigned)wid * 1024u;
#pragma unroll
    for (int i = 0; i < 2; ++i) { int R, C; stage_rc(tid * 16 + i * 8192, R, C); const int Rb = (R & ~31) + perm32(R & 31); const unsigned voff = (unsigned)(Rb * K + C) * 2u;
#pragma unroll
        for (int b = 0; b < 2; ++b)
#pragma unroll
            for (int h = 0; h < 2; ++h)
                __builtin_amdgcn_global_load_lds((const unsigned*)(cB + (size_t)b * kstep + (size_t)h * hstep + voff), (PG8_LAS unsigned*)(lds + (4 + b * 2 + h) * HTB + ldsw + i * 8192), 16, 0, 0); }
}
}

constexpr int NWAVES = 8;
constexpr int BATCH = 4, SEQ = 8192, DM = 1024, DEPTH = 2;
constexpr int M = BATCH * SEQ;
constexpr int INW = 2304, DFF = 2816, NGU = 2 * DFF;
constexpr float EPS = 1e-6f;
constexpr int C_AU = 0, C_AV = 256, C_BQ = 512, C_BK = 1024, C_BV = 1152, C_CQ = 1280, C_CF = 1536, C_CI = 1792, C_CG = 2048;
constexpr int MX_A = 0, MX_B = 256, MX_C = 768;

constexpr size_t MiB = 1u << 20;
constexpr size_t WS_CTL = 0, CTL_ZERO_BYTES = 2 * MiB;
constexpr size_t WS_TAB = 2 * MiB;
constexpr size_t WS_SS = 1 * MiB;
constexpr size_t WS_SEGS = 4 * MiB;
constexpr size_t WS_SEGP = 8 * MiB;
constexpr size_t WS_HG = 10 * MiB;
constexpr size_t WS_HU = 32 * MiB;
constexpr size_t WS_W = 44 * MiB, W_LAYER = 24 * MiB;
constexpr size_t W_IN = 0, W_OUT = 5 * MiB, W_GU = 7 * MiB, W_DN = 18 * MiB;
constexpr size_t WS_XB = 92 * MiB;
constexpr size_t WS_X1 = 156 * MiB;
constexpr size_t WS_PROJ = 284 * MiB;
constexpr size_t WS_MIXED = 428 * MiB;
constexpr size_t WS_ACT = 284 * MiB;
constexpr size_t WS_END = 492 * MiB;
static_assert((size_t)INW * DM * 2 <= W_OUT - W_IN && (size_t)DM * DM * 2 <= W_GU - W_OUT && (size_t)NGU * DM * 2 <= W_DN - W_GU && W_DN + (size_t)DM * DFF * 2 <= W_LAYER, "weight map");
static_assert(WS_ACT + (size_t)M * DFF * 2 <= WS_END && WS_MIXED + (size_t)M * DM * 2 <= WS_END && WS_PROJ + (size_t)M * INW * 2 <= WS_MIXED, "activation map");
static_assert(WS_HG + (size_t)512 * 4 * DFF * 4 <= WS_HU && WS_HU + (size_t)512 * 2 * DFF * 4 <= WS_W, "halo map");
constexpr int CW_BAR = 4096;

constexpr int LDS_BYTES = 147456;
constexpr int MISC_OFF = LDS_BYTES - 256;

#define GAS __attribute__((address_space(1)))
#define LAS __attribute__((address_space(3)))
typedef unsigned short bf16;
typedef unsigned v4u __attribute__((ext_vector_type(4)));
typedef unsigned v2u __attribute__((ext_vector_type(2)));
typedef float f32x4 __attribute__((ext_vector_type(4)));
typedef float f32x2 __attribute__((ext_vector_type(2)));
#define RLX_AGENT __ATOMIC_RELAXED, __HIP_MEMORY_SCOPE_AGENT
#define LDS_WAIT() asm volatile("s_waitcnt lgkmcnt(0)" ::: "memory")
__device__ __forceinline__ unsigned f2bf(float f) { unsigned u = __builtin_bit_cast(unsigned, f); return (u + 0x7fffu + ((u >> 16) & 1u)) >> 16; }
__device__ __forceinline__ unsigned pk2(float lo, float hi) { return f2bf(lo) | (f2bf(hi) << 16); }
__device__ __forceinline__ float bf2f(unsigned short h) { return __builtin_bit_cast(float, (unsigned)h << 16); }
__device__ __forceinline__ float bflo(unsigned w) { return __builtin_bit_cast(float, w << 16); }
__device__ __forceinline__ float bfhi(unsigned w) { return __builtin_bit_cast(float, w & 0xffff0000u); }
__device__ __forceinline__ float silu_f(float v) { return v * __builtin_amdgcn_rcpf(1.0f + __builtin_amdgcn_exp2f(v * -1.4426950408889634f)); }
__device__ __forceinline__ float wave_sum(float v) {
#pragma unroll
    for (int o = 1; o < 64; o <<= 1) v += __shfl_xor(v, o);
    return v;
}
#define XB_TMO      128
#define XB_XCNT(j)  (256  + 64 * (j))
#define XB_XSUB(j)  (1280 + 64 * (j))
#define XB_XGEN(j)  (2304 + 64 * (j))
#define XB_TOP      3328
#define XB_TOPGEN   3392
#define XCD_BAR_WORDS 3456
#define XB_SPIN_CAP (1u << 18)

__device__ __forceinline__ unsigned xb_ld(unsigned* p)              { return __hip_atomic_load(p, __ATOMIC_RELAXED, __HIP_MEMORY_SCOPE_AGENT); }
__device__ __forceinline__ unsigned xb_add(unsigned* p, unsigned v) { return __hip_atomic_fetch_add(p, v, __ATOMIC_RELAXED, __HIP_MEMORY_SCOPE_AGENT); }
__device__ __forceinline__ unsigned xb_xcc_id() { return (unsigned)__builtin_amdgcn_s_getreg((3 << 11) | 20) & 0xFu; }
#define XB_SPIN(cond, bar) do { unsigned _sp = 0; while (cond) { __builtin_amdgcn_s_sleep(1); \
    if ((++_sp & 255u) == 0u) { if (xb_ld(&(bar)[XB_TMO])) break; if (_sp > XB_SPIN_CAP) { atomicAdd(&(bar)[XB_TMO], 1u); break; } } } } while (0)

struct XcdBarrier {
    unsigned* bar; unsigned x;
    int wv;
    volatile LAS unsigned* st;
};

__device__ __forceinline__ XcdBarrier xcd_barrier_post(unsigned* bar, volatile LAS unsigned* st) {
    XcdBarrier b; b.bar = bar; b.x = xb_xcc_id(); b.st = st; b.wv = 0;
    if (threadIdx.x == 0) (void)xb_add(&bar[XB_XCNT(b.x)], 1u);
    return b;
}
__device__ __forceinline__ void xcd_barrier_complete(unsigned* bar, unsigned x, unsigned& nloc, unsigned& nx) {
    const unsigned G = gridDim.x * gridDim.y * gridDim.z;
    unsigned sum, cnt, mine, sp = 0u;
    for (;;) {
        sum = 0u; cnt = 0u; mine = 0u;
#pragma nounroll
        for (unsigned j = 0; j < 16; ++j) { const unsigned c = xb_ld(&bar[XB_XCNT(j)]); sum += c; cnt += (c > 0u) ? 1u : 0u; mine = (j == x) ? c : mine; }
        if (sum == G) break;
        __builtin_amdgcn_s_sleep(1);
        if ((++sp & 255u) == 0u) { if (xb_ld(&bar[XB_TMO])) break; if (sp > XB_SPIN_CAP) { atomicAdd(&bar[XB_TMO], 1u); break; } }
    }
    nloc = mine > 0u ? mine : 1u; nx = cnt > 0u ? cnt : 1u;
}

__device__ __forceinline__ void xcd_barrier_head() {
    asm volatile("s_waitcnt vmcnt(0)" ::: "memory");
    __syncthreads();
}
__device__ __forceinline__ void xcd_barrier_tail(const XcdBarrier& b) {
    if (threadIdx.x == 0) {
        unsigned* bar = b.bar;
        __builtin_amdgcn_s_waitcnt(0);
        unsigned nloc = b.st[0], nx = b.st[1];
        if (nloc == 0u) { xcd_barrier_complete(bar, b.x, nloc, nx); b.st[0] = nloc; b.st[1] = nx; }
        const unsigned old = xb_add(&bar[XB_XSUB(b.x)], 1u);
        const unsigned gen = old / nloc;
        if (old + 1u == (gen + 1u) * nloc) {
            __builtin_amdgcn_fence(__ATOMIC_RELEASE, "agent");
            asm volatile("s_waitcnt vmcnt(0)" ::: "memory");
            const unsigned og = xb_add(&bar[XB_TOP], 1u);
            const unsigned tg = og / nx;
            if (og + 1u == (tg + 1u) * nx) xb_add(&bar[XB_TOPGEN], 1u);
            else XB_SPIN(xb_ld(&bar[XB_TOPGEN]) == tg, bar);
            __builtin_amdgcn_fence(__ATOMIC_ACQUIRE, "agent");
            xb_add(&bar[XB_XGEN(b.x)], 1u);
            asm volatile("s_waitcnt vmcnt(0)" ::: "memory");
        } else {
            XB_SPIN(xb_ld(&bar[XB_XGEN(b.x)]) == gen, bar);
            __builtin_amdgcn_fence(__ATOMIC_ACQUIRE, "agent");
            asm volatile("s_waitcnt vmcnt(0)" ::: "memory");
        }
    }
    asm volatile("s_waitcnt vmcnt(0)" ::: "memory");
    __syncthreads();
}
__device__ __forceinline__ void xcd_barrier(const XcdBarrier& b) { xcd_barrier_head(); xcd_barrier_tail(b); }


#ifndef DBG_MIX
#define DBG_MIX 7
#endif
#ifdef DBG_NULL_EPI
#define DBG_EPI_MODE(rep) ((rep) == 0 ? 1 : DBG_NULL_EPI == 2 ? 2 : 0)
#else
#define DBG_EPI_MODE(rep) 1
#endif
#ifndef SKEW_P4
#define SKEW_P4 0
#endif
#ifndef SKEW_P1
#define SKEW_P1 0
#endif
#ifndef DBG_REP_C1
#define DBG_REP_C1 1
#endif
#ifndef DBG_REP_C2
#define DBG_REP_C2 1
#endif
#ifndef DBG_REP_B
#define DBG_REP_B 1
#endif
#define DBG_A ((DBG_MIX & 1) ? 1.0f : 0.0f)
#define DBG_B ((DBG_MIX & 2) ? 1.0f : 0.0f)
#define DBG_C ((DBG_MIX & 4) ? 1.0f : 0.0f)
typedef float mb_f32x2_t __attribute__((ext_vector_type(2))); typedef __bf16 mb_bf16x2_t __attribute__((ext_vector_type(2)));
__device__ __forceinline__ unsigned mb_cvtpk(float lo, float hi) { mb_f32x2_t v = {lo, hi}; mb_bf16x2_t b = __builtin_convertvector(v, mb_bf16x2_t); return __builtin_bit_cast(unsigned, b); }
struct Params { const float* in[19]; float* out; unsigned char* ws; int ph_lo, ph_hi; int flags, bar_region; unsigned char bucket[128]; };

struct Ctx { volatile LAS unsigned long long* tab; unsigned char* ws; const unsigned char* bucket; };
constexpr int TAB_OFF = LDS_BYTES - 1024;
__device__ __forceinline__ const float* tab_ptr(const Ctx& c, int i) {
    const unsigned long long v = c.tab[i];
    const unsigned lo = (unsigned)__builtin_amdgcn_readfirstlane((int)(unsigned)v), hi = (unsigned)__builtin_amdgcn_readfirstlane((int)(unsigned)(v >> 32));
    return (const float*)(const GAS float*)(((unsigned long long)hi << 32) | lo);
}
#define PIN(c, i) tab_ptr(c, (i))
#define POUT(c) ((float*)tab_ptr(c, 19))
enum { I_X = 0, I_N1G, I_WIN, I_VNG, I_WS, I_BS, I_QNG, I_KNG, I_SINK, I_RELB, I_LBL, I_ONG, I_WOUT, I_N2G, I_WGATE, I_WUP, I_CONVW, I_CONVB, I_WDOWN };

__device__ __forceinline__ float u64f(unsigned long long v) { return fmaf((float)(unsigned)(v >> 32), 4294967296.0f, (float)(unsigned)v); }
__device__ __forceinline__ float row_rstd(const unsigned long long* SS, int r) {
    return rsqrtf(u64f(SS[r]) * (1.0f / 16777216.0f / DM) + EPS);
}

constexpr int CW_LDS = 131072, SS_LDS = 133120;
struct EpiInProj {
    static constexpr bool PERM = true, APERM = false, AFTER_DRAIN = false;
    bf16* O; const unsigned long long* SS; int mode; LAS unsigned char* lds;
    static constexpr int NPRE = 1;
    struct Pre {};
    __device__ __forceinline__ Pre preload(const pg8::Unit& u, int wr, int wc, int fr_in, int fq_in) const {
        int fr = fr_in, fq = fq_in; asm volatile("" : "+v"(fr), "+v"(fq));
        const int wid = wr * 4 + wc, lane = fq * 16 + fr;
        __builtin_amdgcn_global_load_lds((const unsigned*)(SS + (size_t)u.pm * 256) + wid * 64 + lane, (LAS unsigned*)(lds + SS_LDS + wid * 256), 4, 0, 0);
        return Pre{};
    }
    __device__ __forceinline__ void operator()(pg8::f32x4 (&acc)[2][2][4][2], const pg8::Unit& u, int wr, int wc, int fr_in, int fq_in, const Pre& pre) const {
        int fr = fr_in, fq = fq_in; asm volatile("" : "+v"(fr), "+v"(fq));
        if (mode == 0) return;
        const int row0 = u.pm * 256 + wr * 64 + fr, col0 = u.pn * 256 + wc * 32 + 8 * fq;
        const int act = (u.pn <= 1) ? 1 : ((u.pn == 5 || u.pn == 8) ? 2 : 0);
        float rs8[8];
#pragma unroll
        for (int i = 0; i < 8; ++i) rs8[i] = rsqrtf(u64f(*(const LAS unsigned long long*)(lds + SS_LDS + (wr * 64 + fr + (i >> 2) * 128 + (i & 3) * 16) * 8)) * (1.0f / 16777216.0f / DM) + EPS);
        if (act == 1) body<1>(acc, rs8, row0, col0); else if (act == 2) body<2>(acc, rs8, row0, col0); else body<0>(acc, rs8, row0, col0);
    }
    template <int ACT> __device__ __forceinline__ void body(pg8::f32x4 (&acc)[2][2][4][2], const float (&rs8)[8], int row0, int col0) const {
#pragma unroll
        for (int ai = 0; ai < 2; ++ai)
#pragma unroll
            for (int m = 0; m < 4; ++m) {
                const int r = row0 + ai * 128 + m * 16; const float rs = rs8[ai * 4 + m]; bf16* rowp = O + (size_t)r * INW + col0;
#pragma unroll
                for (int bj = 0; bj < 2; ++bj) {
                    f32x4 v0 = acc[ai][bj][m][0] * rs, v1 = acc[ai][bj][m][1] * rs;
                    if (ACT == 1) { pg8::f32x2 a = pg8::gelu_pk((pg8::f32x2){v0[0], v0[1]}), b = pg8::gelu_pk((pg8::f32x2){v0[2], v0[3]}), c = pg8::gelu_pk((pg8::f32x2){v1[0], v1[1]}), d = pg8::gelu_pk((pg8::f32x2){v1[2], v1[3]});
                        v0 = (f32x4){a.x, a.y, b.x, b.y}; v1 = (f32x4){c.x, c.y, d.x, d.y}; }
                    else if (ACT == 2) {
#pragma unroll
                        for (int j = 0; j < 4; ++j) { v0[j] = silu_f(v0[j]); v1[j] = silu_f(v1[j]); } }
                    v4u w; w.x = pg8::cvt_pk_bf16(v0[0], v0[1]); w.y = pg8::cvt_pk_bf16(v0[2], v0[3]); w.z = pg8::cvt_pk_bf16(v1[0], v1[1]); w.w = pg8::cvt_pk_bf16(v1[2], v1[3]);
                    *(v4u*)(rowp + bj * 128) = w; }
            }
    }
};
struct EpiResid {
    static constexpr bool PERM = true, APERM = false, AFTER_DRAIN = false;
    bf16* xb; float* out; unsigned long long* SS; int mode;
    static constexpr int NPRE = 0;
    struct Pre {};
    __device__ __forceinline__ Pre preload(const pg8::Unit&, int, int, int, int) const { return Pre{}; }
    __device__ __forceinline__ void operator()(pg8::f32x4 (&acc)[2][2][4][2], const pg8::Unit& u, int wr, int wc, int fr_in, int fq_in, const Pre&) const {
        int fr = fr_in, fq = fq_in; asm volatile("" : "+v"(fr), "+v"(fq));
        if (mode == 0) return;
        const unsigned row0 = (unsigned)(u.pm * 256 + wr * 64 + fr), col0 = (unsigned)(u.pn * 256 + wc * 32 + 8 * fq);
        v4u rawall[2][4][2];
#pragma unroll
        for (int ai = 0; ai < 2; ++ai)
#pragma unroll
            for (int m = 0; m < 4; ++m)
#pragma unroll
                for (int bj = 0; bj < 2; ++bj) rawall[ai][m][bj] = *(const v4u*)((const char*)xb + ((row0 + ai * 128 + m * 16) * (unsigned)DM + col0 + bj * 128) * 2u);
#pragma unroll
        for (int ai = 0; ai < 2; ++ai) {
            v4u raw8[4][2];
#pragma unroll
            for (int m = 0; m < 4; ++m)
#pragma unroll
                for (int bj = 0; bj < 2; ++bj) raw8[m][bj] = rawall[ai][m][bj];
#pragma unroll
            for (int m = 0; m < 4; ++m) {
                const unsigned r = row0 + ai * 128 + m * 16, off = r * (unsigned)DM + col0; float ss = 0.f;
#pragma unroll
                for (int bj = 0; bj < 2; ++bj) {
                    const v4u raw = raw8[m][bj];
                    const f32x4 o0 = (f32x4){bflo(raw.x), bfhi(raw.x), bflo(raw.y), bfhi(raw.y)} + acc[ai][bj][m][0], o1 = (f32x4){bflo(raw.z), bfhi(raw.z), bflo(raw.w), bfhi(raw.w)} + acc[ai][bj][m][1];
                    if (mode == 1) { ss += ((o0[0] * o0[0] + o0[1] * o0[1]) + (o0[2] * o0[2] + o0[3] * o0[3])) + ((o1[0] * o1[0] + o1[1] * o1[1]) + (o1[2] * o1[2] + o1[3] * o1[3]));
                        v4u w; w.x = pg8::cvt_pk_bf16(o0[0], o0[1]); w.y = pg8::cvt_pk_bf16(o0[2], o0[3]); w.z = pg8::cvt_pk_bf16(o1[0], o1[1]); w.w = pg8::cvt_pk_bf16(o1[2], o1[3]);
                        *(v4u*)((char*)xb + (off + bj * 128) * 2u) = w; }
                    else { *(f32x4*)((char*)out + (size_t)(off + bj * 128) * 4u) = o0; *(f32x4*)((char*)out + (size_t)(off + bj * 128 + 4) * 4u) = o1; }
                }
                if (mode == 1) { ss += __shfl_xor(ss, 16); ss += __shfl_xor(ss, 32); if (fq == 0) __hip_atomic_fetch_add(SS + r, (unsigned long long)(ss * 16777216.0f), __ATOMIC_RELAXED, __HIP_MEMORY_SCOPE_AGENT); }
            }
            asm volatile("" ::: "memory");
        }
    }
};
struct EpiFFN {
    static constexpr bool PERM = true, APERM = true, AFTER_DRAIN = false;
    bf16* ACT; const unsigned long long* SS; const float* cw; const float* cb; float* HG; float* HU; int mode; LAS unsigned char* lds;
    template <class T> static __device__ __forceinline__ T ldg(const void* base, unsigned boff) { return *(const T*)((const char*)base + boff); }
    template <class T> static __device__ __forceinline__ void stg(void* base, unsigned boff, T v) { *(T*)((char*)base + boff) = v; }
    static __device__ __forceinline__ f32x4 shr1(const f32x4& g) {
        f32x4 r;
#pragma unroll
        for (int j = 0; j < 4; ++j) { const float gj = g[j]; r[j] = __int_as_float(__builtin_amdgcn_update_dpp(0, __float_as_int(gj), 0x111, 0xf, 0xf, true)); }
        return r; }
    static constexpr int NPRE = 2;
    struct Pre {};
    __device__ __forceinline__ Pre preload(const pg8::Unit& u, int wr, int wc, int fr_in, int fq_in) const {
        int fr = fr_in, fq = fq_in; asm volatile("" : "+v"(fr), "+v"(fq));
        const int wid = wr * 4 + wc, lane = fq * 16 + fr, trow = wid >> 1;
        __builtin_amdgcn_global_load_lds((const unsigned*)(SS + (size_t)u.pm * 256) + wid * 64 + lane, (LAS unsigned*)(lds + SS_LDS + wid * 256), 4, 0, 0);
        const unsigned ch = (unsigned)(u.pn * 128 + (wid & 1) * 64 + lane);
        const float* src = (trow < 3) ? cw + (size_t)trow * DFF + ch : cb + ch;
        __builtin_amdgcn_global_load_lds((const unsigned*)src, (LAS unsigned*)(lds + CW_LDS + wid * 256), 4, 0, 0);
        return Pre{};
    }
    __device__ __forceinline__ void operator()(pg8::f32x4 (&acc)[2][2][4][2], const pg8::Unit& u, int wr, int wc, int fr_in, int fq_in, const Pre& pre) const {
        int fr = fr_in, fq = fq_in; asm volatile("" : "+v"(fr), "+v"(fq));
        if (mode == 0) return;
        const unsigned rowb = (unsigned)(u.pm * 256 + wr * 64 + 4 * fr), ch0 = (unsigned)(u.pn * 128 + wc * 32 + 8 * fq);
        float rs8[8];
#pragma unroll
        for (int i = 0; i < 8; ++i) rs8[i] = rsqrtf(u64f(*(const LAS unsigned long long*)(lds + SS_LDS + (wr * 64 + 4 * fr + (i >> 2) * 128 + (i & 3)) * 8)) * (1.0f / 16777216.0f / DM) + EPS);
        if (fr == 0 || fr == 15) {
#pragma unroll
            for (int ai = 0; ai < 2; ++ai) {
                const unsigned blk = (unsigned)(u.pm * 4 + ai * 2 + wr);
#pragma unroll
                for (int n = 0; n < 2; ++n) { const unsigned ch = ch0 + 4u * n;
                    if (fr == 0) {
#pragma unroll
                        for (int m = 0; m < 2; ++m) { stg<f32x4>(HG, ((blk * 4u + m) * (unsigned)DFF + ch) * 4u, acc[ai][0][m][n] * rs8[ai * 4 + m]); stg<f32x4>(HU, ((blk * 2u + m) * (unsigned)DFF + ch) * 4u, acc[ai][1][m][n] * rs8[ai * 4 + m]); } }
                    else {
#pragma unroll
                        for (int m = 2; m < 4; ++m) stg<f32x4>(HG, ((blk * 4u + m) * (unsigned)DFF + ch) * 4u, acc[ai][0][m][n] * rs8[ai * 4 + m]); } }
            }
        }
        asm volatile("" ::: "memory");
#pragma unroll
        for (int n = 0; n < 2; ++n) {
            const unsigned ch = ch0 + 4u * n; const float nl2e = -1.4426950408889634f;
            const LAS float* wt = (const LAS float*)(lds + CW_LDS) + (wc * 32 + 8 * fq + 4 * n);
            f32x4 w0 = *(const LAS f32x4*)wt * nl2e, w1 = *(const LAS f32x4*)(wt + 128) * nl2e, w2 = *(const LAS f32x4*)(wt + 256) * nl2e, bb = *(const LAS f32x4*)(wt + 384) * nl2e;
            asm volatile("" : "+v"(w0), "+v"(w1), "+v"(w2), "+v"(bb));
            f32x4 g[2][4];
#pragma unroll
            for (int ai = 0; ai < 2; ++ai)
#pragma unroll
                for (int m = 0; m < 4; ++m) g[ai][m] = acc[ai][0][m][n] * rs8[ai * 4 + m];
            f32x4 h3[2], h2[2];
#pragma unroll
            for (int ai = 0; ai < 2; ++ai) { h3[ai] = shr1(g[ai][3]); h2[ai] = shr1(g[ai][2]); }
#pragma unroll
            for (int ai = 0; ai < 2; ++ai)
#pragma unroll
                for (int m = 0; m < 4; ++m) {
                    const f32x4 p1 = (m == 0) ? h3[ai] : g[ai][m - 1], p2 = (m == 0) ? h2[ai] : (m == 1) ? h3[ai] : g[ai][m - 2];
                    f32x4 c2 = w0 * p2 + bb; c2 = w1 * p1 + c2; c2 = w2 * g[ai][m] + c2;
                    const f32x4 ups = acc[ai][1][m][n] * (rs8[ai * 4 + m] * -0.6931471805599453f);
                    f32x4 e;
#pragma unroll
                    for (int j = 0; j < 4; ++j) e[j] = __builtin_amdgcn_rcpf(1.0f + __builtin_amdgcn_exp2f(c2[j]));
                    acc[ai][0][m][n] = (c2 * e) * ups;
                }
            asm volatile("" ::: "memory");
        }
#pragma unroll
        for (int ai = 0; ai < 2; ++ai) {
#pragma unroll
            for (int m = 0; m < 4; ++m) {
                const unsigned r = rowb + ai * 128 + m;
                const f32x4 v0 = acc[ai][0][m][0], v1 = acc[ai][0][m][1];
                v4u w; w.x = pg8::cvt_pk_bf16(v0[0], v0[1]); w.y = pg8::cvt_pk_bf16(v0[2], v0[3]); w.z = pg8::cvt_pk_bf16(v1[0], v1[1]); w.w = pg8::cvt_pk_bf16(v1[2], v1[3]);
                unsigned bo = (r * (unsigned)DFF + ch0) * 2u;
                if (m < 2) bo = (fr == 0) ? (unsigned)((size_t)M * DFF * 2) + ((unsigned)(((wr * 4 + wc) * 64 + fq * 16 + fr) * 32) + m * 16u) : bo;
                stg<v4u>(ACT, bo, w);
            }
            asm volatile("" ::: "memory");
        }
    }
};


struct InProjOrder {
    int G, c; pg8::StaticOrder fb;
    __device__ void init(int M_, int N_, int G_, int c_) { G = G_; c = c_; fb.init(M_, N_, G_, c_); }
    __device__ bool next(int i, pg8::Unit& u) const {
        if (G != 256) return fb.next(i, u);
        const int x = c & 7, j = c >> 3;
        if (j < 16) { if (i >= 5) return false; const int idx = i * 16 + j, grp = idx / 40, r = idx % 40, t = r >> 3;
            u.pm = 16 * x + 8 * grp + (r & 7); u.pn = (t == 0) ? 2 : (t == 1) ? 3 : (t == 2) ? 4 : (t == 3) ? 6 : 7; }
        else { if (i >= 4) return false; const int idx = i * 16 + (j - 16), grp = idx >> 5, r = idx & 31, t = r >> 3;
            u.pm = 16 * x + 8 * grp + (r & 7); u.pn = (t == 0) ? 0 : (t == 1) ? 1 : (t == 2) ? 5 : 8; }
        return true;
    }
    __device__ __forceinline__ void a_ready(const pg8::Unit&) const {}
    __device__ __forceinline__ void done(const pg8::Unit&) const {}
};
__device__ __forceinline__ void p0_transpose_item(const float* W, int K, int N, const float* gk, bf16* WT, int dest_row0, int k0, int n0, LAS float* scr, int lane) {
    const int rr = lane >> 4, c4 = (lane & 15) * 4;
#pragma unroll
    for (int i = 0; i < 16; ++i) { const int kk = 4 * i + rr; f32x4 v = __builtin_nontemporal_load((const f32x4*)(W + (size_t)(k0 + kk) * N + n0 + c4)); if (gk) v = v * gk[k0 + kk];
        LAS float* d = scr + kk * 65 + c4; d[0] = v.x; d[1] = v.y; d[2] = v.z; d[3] = v.w; }
    LDS_WAIT(); asm volatile("" ::: "memory");
    const int c = lane & 7;
#pragma unroll
    for (int j = 0; j < 8; ++j) { const int n = (lane >> 3) + 8 * j; const LAS float* s = scr + (8 * c) * 65 + n;
        v4u o; o.x = mb_cvtpk(s[0 * 65], s[1 * 65]); o.y = mb_cvtpk(s[2 * 65], s[3 * 65]); o.z = mb_cvtpk(s[4 * 65], s[5 * 65]); o.w = mb_cvtpk(s[6 * 65], s[7 * 65]);
        *(GAS v4u*)(WT + (size_t)(dest_row0 + n) * K + k0 + 8 * c) = o; }
    LDS_WAIT(); asm volatile("" ::: "memory");
}

__device__ __forceinline__ void prologue(const Ctx& p, LAS unsigned char* lds, int wave, int lane, bool first) {
    LAS float* scr = (LAS float*)(lds + wave * 16640);
    const int gw = blockIdx.x * NWAVES + wave, NGW = gridDim.x * NWAVES;
    constexpr int I_IN = (DM / 64) * (INW / 64), I_OUT = (DM / 64) * (DM / 64), I_G = (DM / 64) * (DFF / 64), I_D = (DFF / 64) * (DM / 64);
    constexpr int PER_L = I_IN + I_OUT + 2 * I_G + I_D;
    for (int it = gw; it < DEPTH * PER_L; it += NGW) {
        const int l = it / PER_L; int r = it % PER_L;
        unsigned char* wl = p.ws + WS_W + (size_t)l * W_LAYER;
        if (r < I_IN) { const int nblk = INW / 64, kb = r / nblk, nb = r % nblk;
            p0_transpose_item(PIN(p, I_WIN) + (size_t)l * DM * INW, DM, INW, PIN(p, I_N1G) + l * DM, (bf16*)(wl + W_IN), 64 * nb, 64 * kb, 64 * nb, scr, lane); continue; } r -= I_IN;
        if (r < I_OUT) { const int nblk = DM / 64, kb = r / nblk, nb = r % nblk;
            p0_transpose_item(PIN(p, I_WOUT) + (size_t)l * DM * DM, DM, DM, nullptr, (bf16*)(wl + W_OUT), 64 * nb, 64 * kb, 64 * nb, scr, lane); continue; } r -= I_OUT;
        if (r < 2 * I_G) { const int up = r >= I_G; if (up) r -= I_G; const int nblk = DFF / 64, kb = r / nblk, nb = r % nblk, n0 = 64 * nb;
            const int dest = 256 * (n0 / 128) + (n0 % 128) + (up ? 128 : 0);
            p0_transpose_item(PIN(p, up ? I_WUP : I_WGATE) + (size_t)l * DM * DFF, DM, DFF, PIN(p, I_N2G) + l * DM, (bf16*)(wl + W_GU), dest, 64 * kb, n0, scr, lane); continue; } r -= 2 * I_G;
        { const int nblk = DM / 64, kb = r / nblk, nb = r % nblk;
            p0_transpose_item(PIN(p, I_WDOWN) + (size_t)l * DFF * DM, DFF, DM, nullptr, (bf16*)(wl + W_DN), 64 * nb, 64 * kb, 64 * nb, scr, lane); }
    }
    const float* x = PIN(p, I_X); bf16* XB = (bf16*)(p.ws + WS_XB); unsigned long long* SS = (unsigned long long*)(p.ws + WS_SS);
    for (int m0 = gw; m0 < M; m0 += 4 * NGW) {
        f32x4 v[4][4]; float s[4];
#pragma unroll
        for (int q = 0; q < 4; ++q) { const int m = (m0 + q * NGW < M) ? m0 + q * NGW : m0; const f32x4* xr = (const f32x4*)(x + (size_t)m * DM) + lane;
#pragma unroll
            for (int j = 0; j < 4; ++j) v[q][j] = __builtin_nontemporal_load(xr + 64 * j); }
#pragma unroll
        for (int q = 0; q < 4; ++q) { s[q] = 0.f;
#pragma unroll
            for (int j = 0; j < 4; ++j) s[q] += (v[q][j].x * v[q][j].x + v[q][j].y * v[q][j].y) + (v[q][j].z * v[q][j].z + v[q][j].w * v[q][j].w); }
#pragma unroll
        for (int o = 1; o < 64; o <<= 1) {
#pragma unroll
            for (int q = 0; q < 4; ++q) s[q] += __shfl_xor(s[q], o); }
#pragma unroll
        for (int q = 0; q < 4; ++q) { const int m = m0 + q * NGW; if (m < M) {
            unsigned long long* o8 = (unsigned long long*)(XB + (size_t)m * DM) + lane;
#pragma unroll
            for (int j = 0; j < 4; ++j) o8[64 * j] = (unsigned long long)pk2(v[q][j].x, v[q][j].y) | ((unsigned long long)pk2(v[q][j].z, v[q][j].w) << 32);
            if (lane == 0 && first) __hip_atomic_fetch_add(SS + m, (unsigned long long)(s[q] * 16777216.0f), __ATOMIC_RELAXED, __HIP_MEMORY_SCOPE_AGENT); } }
    }
    { bf16* wtb = (bf16*)(p.ws + WS_TAB + 131072); const float* wsrc = PIN(p, I_WS);
        for (int i = gw * 64 + lane; i < DEPTH * 4 * 128 * 128; i += NGW * 64) { const int s_ = i & 127, t_ = (i >> 7) & 127; wtb[i] = (bf16)f2bf(s_ <= t_ ? wsrc[i] : 0.f); } }
    if (blockIdx.x == 0) { float* bt = (float*)(p.ws + WS_TAB);
        for (int i = wave * 64 + lane; i < 1024; i += NWAVES * 64) { const int h = i >> 7, d = i & 127; bt[i] = PIN(p, I_RELB)[(int)((LAS unsigned char*)(lds + TAB_OFF + 256))[d] * 8 + h]; } }
    if (blockIdx.x == 1) {
        for (int idx = wave; idx < DEPTH * 8; idx += NWAVES) { const int l_ = idx >> 3, h = idx & 7;
            float gm = fabsf(PIN(p, I_QNG)[l_ * 64 + lane] * PIN(p, I_KNG)[l_ * 64 + lane]);
            const LAS unsigned char* bk = (const LAS unsigned char*)(lds + TAB_OFF + 256);
            float bm = fmaxf(PIN(p, I_RELB)[(int)bk[lane] * 8 + h], PIN(p, I_RELB)[(int)bk[lane + 64] * 8 + h]);
#pragma unroll
            for (int o = 1; o < 64; o <<= 1) { gm = fmaxf(gm, __shfl_xor(gm, o)); bm = fmaxf(bm, __shfl_xor(bm, o)); }
            if (lane == 0) ((float*)(p.ws + WS_TAB))[1024 + idx] = (8.0f * gm + fmaxf(bm, PIN(p, I_SINK)[idx])) * 1.4426950408889634f; } }
}

#ifdef DBG_MIXCMP
__device__ __forceinline__ void mixer_a_simple(const Ctx& p, int l, int unit, LAS unsigned char* lds, int wave, int lane) {
    LAS float* vn = (LAS float*)lds;
    const int g = unit & 3, ck = unit >> 2; const size_t row0 = (size_t)ck * 128;
    const bf16* PROJ = (const bf16*)(p.ws + WS_PROJ); bf16* MIXED = (bf16*)(p.ws + WS_MIXED);
    const float vg = PIN(p, I_VNG)[(l * 4 + g) * 64 + lane];
#pragma unroll 4
    for (int i = 0; i < 16; ++i) { const int s = wave * 16 + i;
        const float v = bf2f(PROJ[(row0 + s) * INW + C_AV + g * 64 + lane]);
        const float ss = wave_sum(v * v);
        vn[s * 64 + lane] = v * rsqrtf(ss * (1.0f / 64.0f) + EPS) * vg; }
    __syncthreads();
    const float* Wg = PIN(p, I_WS) + (size_t)(l * 4 + g) * 128 * 128; const float* bs = PIN(p, I_BS) + (l * 4 + g) * 128;
    for (int i = 0; i < 16; ++i) { const int t = __builtin_amdgcn_readfirstlane(wave + 8 * i);
        const float* wrow = Wg + t * 128; float a = 0.f;
        for (int s0 = 0; s0 <= t; s0 += 4) { const f32x4 w = *(const f32x4*)(wrow + s0);
#pragma unroll
            for (int j = 0; j < 4; ++j) { const float wj = (s0 + j <= t) ? w[j] : 0.f; a += wj * vn[(s0 + j) * 64 + lane]; } }
        a += bs[t];
        const float uval = bf2f(PROJ[(row0 + t) * INW + C_AU + g * 64 + lane]);
        MIXED[(row0 + t) * DM + MX_A + g * 64 + lane] = (bf16)f2bf(uval * a * DBG_A); }
    __syncthreads();
}

#endif
#ifdef DBG_MIXCMP
constexpr int KVS = 68;
__device__ __forceinline__ void mixer_b_simple(const Ctx& p, int l, int unit, LAS unsigned char* lds, int wave, int lane) {
    LAS float* Kt = (LAS float*)lds; LAS float* Vt = Kt + 256 * KVS;
    const int hk = unit & 1, nb = unit >> 1, n = nb & 63; const long row0 = (long)nb * 128, win0 = row0 - 128;
    const bf16* PROJ = (const bf16*)(p.ws + WS_PROJ); bf16* MIXED = (bf16*)(p.ws + WS_MIXED);
    const int tid = wave * 64 + lane;
    {
        const int row = tid >> 1, half = tid & 1; const bool valid = (n > 0) || (row >= 128);
        float kf[32], vf[32];
        if (valid) { const v4u* kp = (const v4u*)(PROJ + (win0 + row) * INW + C_BK + hk * 64 + half * 32); const v4u* vp = (const v4u*)(PROJ + (win0 + row) * INW + C_BV + hk * 64 + half * 32);
#pragma unroll
            for (int c = 0; c < 4; ++c) { const v4u a = kp[c], b = vp[c];
                kf[8 * c + 0] = bflo(a.x); kf[8 * c + 1] = bfhi(a.x); kf[8 * c + 2] = bflo(a.y); kf[8 * c + 3] = bfhi(a.y); kf[8 * c + 4] = bflo(a.z); kf[8 * c + 5] = bfhi(a.z); kf[8 * c + 6] = bflo(a.w); kf[8 * c + 7] = bfhi(a.w);
                vf[8 * c + 0] = bflo(b.x); vf[8 * c + 1] = bfhi(b.x); vf[8 * c + 2] = bflo(b.y); vf[8 * c + 3] = bfhi(b.y); vf[8 * c + 4] = bflo(b.z); vf[8 * c + 5] = bfhi(b.z); vf[8 * c + 6] = bflo(b.w); vf[8 * c + 7] = bfhi(b.w); } }
        else {
#pragma unroll
            for (int c = 0; c < 32; ++c) { kf[c] = 0.f; vf[c] = 0.f; } }
        float ss = 0.f;
#pragma unroll
        for (int c = 0; c < 32; ++c) ss += kf[c] * kf[c];
        ss += __shfl_xor(ss, 1);
        const float rs = rsqrtf(ss * (1.0f / 64.0f) + EPS); const float* kng = PIN(p, I_KNG) + l * 64 + half * 32;
#pragma unroll
        for (int c = 0; c < 8; ++c) {
            *(LAS f32x4*)(Kt + row * KVS + half * 32 + 4 * c) = (f32x4){kf[4 * c] * rs * kng[4 * c], kf[4 * c + 1] * rs * kng[4 * c + 1], kf[4 * c + 2] * rs * kng[4 * c + 2], kf[4 * c + 3] * rs * kng[4 * c + 3]};
            *(LAS f32x4*)(Vt + row * KVS + half * 32 + 4 * c) = (f32x4){vf[4 * c], vf[4 * c + 1], vf[4 * c + 2], vf[4 * c + 3]}; }
    }
    __syncthreads();
    const int g = wave >> 1, i = (wave & 1) * 64 + lane, h = hk * 4 + g;
    float q[64];
    { const v4u* qp = (const v4u*)(PROJ + (row0 + i) * INW + C_BQ + h * 64); float ss = 0.f;
#pragma unroll
        for (int c = 0; c < 8; ++c) { const v4u a = qp[c];
            q[8 * c + 0] = bflo(a.x); q[8 * c + 1] = bfhi(a.x); q[8 * c + 2] = bflo(a.y); q[8 * c + 3] = bfhi(a.y); q[8 * c + 4] = bflo(a.z); q[8 * c + 5] = bfhi(a.z); q[8 * c + 6] = bflo(a.w); q[8 * c + 7] = bfhi(a.w); }
#pragma unroll
        for (int c = 0; c < 64; ++c) ss += q[c] * q[c];
        const float rs = rsqrtf(ss * (1.0f / 64.0f) + EPS) * 0.125f; const float* qng = PIN(p, I_QNG) + l * 64;
#pragma unroll
        for (int c = 0; c < 64; ++c) q[c] *= rs * qng[c]; }
    float mx = PIN(p, I_SINK)[l * 8 + h], lsum = 1.0f; float o[64];
#pragma unroll
    for (int c = 0; c < 64; ++c) o[c] = 0.f;
    const float* bt = (const float*)(p.ws + WS_TAB) + h * 128;
    for (int dist = 0; dist < 128; ++dist) {
        const int j = i + 128 - dist; const LAS float* kr = Kt + j * KVS; const LAS float* vr = Vt + j * KVS;
        float s0 = 0.f, s1 = 0.f, s2 = 0.f, s3 = 0.f;
#pragma unroll
        for (int c = 0; c < 16; ++c) { const f32x4 kk = *(const LAS f32x4*)(kr + 4 * c); s0 += q[4 * c] * kk.x; s1 += q[4 * c + 1] * kk.y; s2 += q[4 * c + 2] * kk.z; s3 += q[4 * c + 3] * kk.w; }
        float s = (s0 + s1) + (s2 + s3) + bt[dist];
        if (n == 0 && j < 128) s = -1e30f;
        if (s > mx) { const float f = __expf(mx - s); lsum *= f;
#pragma unroll
            for (int c = 0; c < 64; ++c) o[c] *= f;
            mx = s; }
        const float pr = __expf(s - mx); lsum += pr;
#pragma unroll
        for (int c = 0; c < 16; ++c) { const f32x4 vv = *(const LAS f32x4*)(vr + 4 * c); o[4 * c] += pr * vv.x; o[4 * c + 1] += pr * vv.y; o[4 * c + 2] += pr * vv.z; o[4 * c + 3] += pr * vv.w; }
    }
    const float inv = DBG_B / lsum; v4u* op = (v4u*)(MIXED + (row0 + i) * DM + MX_B + h * 64);
#pragma unroll
    for (int c = 0; c < 8; ++c) { v4u w; w.x = pk2(o[8 * c] * inv, o[8 * c + 1] * inv); w.y = pk2(o[8 * c + 2] * inv, o[8 * c + 3] * inv); w.z = pk2(o[8 * c + 4] * inv, o[8 * c + 5] * inv); w.w = pk2(o[8 * c + 6] * inv, o[8 * c + 7] * inv); op[c] = w; }
    __syncthreads();
}

#endif

namespace mb {
typedef short bf16x8 __attribute__((ext_vector_type(8)));
typedef short s16x4 __attribute__((ext_vector_type(4)));
typedef float f32x16 __attribute__((ext_vector_type(16)));
typedef float f32x2_t __attribute__((ext_vector_type(2)));
typedef __bf16 bf16x2_t __attribute__((ext_vector_type(2)));
constexpr int KB_OFF = 0, VB_OFF = 32768, BIAS_OFF = 65536, WS_OFF = 73728, WS_STRIDE = 4608;
__device__ __forceinline__ int crow(int r, int hi) { return (r & 3) + 8 * (r >> 2) + 4 * hi; }
__device__ __forceinline__ unsigned cvtpk(float lo, float hi) { f32x2_t v = {lo, hi}; bf16x2_t b = __builtin_convertvector(v, bf16x2_t); return __builtin_bit_cast(unsigned, b); }
__device__ __forceinline__ s16x4 vtr(LAS const unsigned char* p) { return __builtin_bit_cast(s16x4, __builtin_amdgcn_ds_read_tr16_b64_v4i16((LAS s16x4*)p)); }
}
__device__ __forceinline__ void mixer_b_mfma(const Ctx& p, int l, int unit, LAS unsigned char* lds, int wave, int lane) {
    using namespace mb;
    const int hk = unit & 1, nb = unit >> 1, n = nb & 63; const long row0 = (long)nb * 128, win0 = row0 - 128;
    const bf16* PROJ = (const bf16*)(p.ws + WS_PROJ); bf16* MIXED = (bf16*)(p.ws + WS_MIXED);
    const int tid = wave * 64 + lane, r32 = lane & 31, hi = lane >> 5;
    {
        const int row = tid >> 1, half = tid & 1; const bool valid = (n > 0) || (row >= 128);
        v4u kr[4], vr[4];
        if (valid) { const v4u* kp = (const v4u*)(PROJ + (win0 + row) * INW + C_BK + hk * 64 + half * 32); const v4u* vp = (const v4u*)(PROJ + (win0 + row) * INW + C_BV + hk * 64 + half * 32);
#pragma unroll
            for (int c = 0; c < 4; ++c) { kr[c] = kp[c]; vr[c] = vp[c]; } }
        else {
#pragma unroll
            for (int c = 0; c < 4; ++c) { kr[c] = (v4u){0u, 0u, 0u, 0u}; vr[c] = kr[c]; } }
        float ss = 0.f;
#pragma unroll
        for (int c = 0; c < 4; ++c) { const unsigned w4[4] = {kr[c].x, kr[c].y, kr[c].z, kr[c].w};
#pragma unroll
            for (int e = 0; e < 4; ++e) { const float a = bflo(w4[e]), b = bfhi(w4[e]); ss += a * a + b * b; } }
        ss += __shfl_xor(ss, 1);
        const float rs = rsqrtf(ss * (1.0f / 64.0f) + EPS) * (0.125f * 1.4426950408889634f); const float* kng = PIN(p, I_KNG) + l * 64 + half * 32; const float* qng = PIN(p, I_QNG) + l * 64 + half * 32;
        LAS unsigned char* kdst = lds + KB_OFF + (row >> 6) * 8192 + (half * 4) * 1024 + (row & 63) * 16;
        LAS unsigned char* vdst = lds + VB_OFF + (row >> 6) * 8192 + half * 4096 + ((row & 63) >> 4) * 1024 + (row & 15) * 64;
#pragma unroll
        for (int c = 0; c < 4; ++c) { const unsigned w4[4] = {kr[c].x, kr[c].y, kr[c].z, kr[c].w}; v4u o;
            unsigned ow[4];
#pragma unroll
            for (int e = 0; e < 4; ++e) ow[e] = cvtpk(bflo(w4[e]) * (rs * kng[8 * c + 2 * e] * qng[8 * c + 2 * e]), bfhi(w4[e]) * (rs * kng[8 * c + 2 * e + 1] * qng[8 * c + 2 * e + 1]));
            o.x = ow[0]; o.y = ow[1]; o.z = ow[2]; o.w = ow[3];
            *(LAS v4u*)(kdst + c * 1024) = o;
            *(LAS v4u*)(vdst + c * 16) = vr[c]; }
        const float* bt = (const float*)(p.ws + WS_TAB) + (hk * 4) * 128;
        const float* shp = (const float*)(p.ws + WS_TAB) + 1024 + l * 8 + hk * 4;
        for (int i = tid; i < 4 * 384; i += NWAVES * 64) { const int g = i / 384, x = i % 384 - 128; ((LAS float*)(lds + BIAS_OFF))[i] = (x >= 0 && x < 128) ? bt[g * 128 + 127 - x] * 1.4426950408889634f - shp[g] : -1e30f; }
    }
    __syncthreads();
    const int g = wave >> 1, h = hk * 4 + g;
    LAS float* wsf = (LAS float*)(lds + WS_OFF + wave * WS_STRIDE);
    LAS bf16* stg = (LAS bf16*)(lds + WS_OFF + wave * WS_STRIDE + 256);
    const float sinke = __builtin_amdgcn_exp2f(PIN(p, I_SINK)[l * 8 + h] * 1.4426950408889634f - ((const float*)(p.ws + WS_TAB))[1024 + l * 8 + h]);
    const LAS unsigned char* vp0 = lds + VB_OFF + ((lane >> 4) & 1) * 32 + (lane & 3) * 8 + (4 * hi + ((lane & 15) >> 2)) * 64;
#pragma unroll
    for (int qt = 0; qt < 2; ++qt) {
        const int i0 = (wave & 1) * 64 + qt * 32, qi = i0 + r32, jt0 = (i0 >= 64) ? 1 : 0;
#define MB_LIVE(jt, hh) ((qt == 0) ? !((jt) == 2 && (hh) == 1) : !((jt) == 0 && (hh) == 0))
        bf16x8 qr[4];
        { const bf16* qp = PROJ + (row0 + qi) * INW + C_BQ + h * 64 + hi * 8; v4u raw[4]; float ss = 0.f;
#pragma unroll
            for (int d0 = 0; d0 < 4; ++d0) { raw[d0] = *(const v4u*)(qp + d0 * 16); const unsigned w4[4] = {raw[d0].x, raw[d0].y, raw[d0].z, raw[d0].w};
#pragma unroll
                for (int e = 0; e < 4; ++e) { const float a = bflo(w4[e]), b = bfhi(w4[e]); ss += a * a + b * b; } }
            ss += __shfl_xor(ss, 32);
            const float rs = rsqrtf(ss * (1.0f / 64.0f) + EPS);
#pragma unroll
            for (int d0 = 0; d0 < 4; ++d0) { const unsigned w4[4] = {raw[d0].x, raw[d0].y, raw[d0].z, raw[d0].w}; unsigned ow[4];
#pragma unroll
                for (int e = 0; e < 4; ++e) ow[e] = cvtpk(bflo(w4[e]) * rs, bfhi(w4[e]) * rs);
                v4u o; o.x = ow[0]; o.y = ow[1]; o.z = ow[2]; o.w = ow[3]; qr[d0] = __builtin_bit_cast(bf16x8, o); } }
        f32x16 sc[3][2];
#pragma unroll
        for (int jt = 0; jt < 3; ++jt) { const LAS unsigned char* kb = lds + KB_OFF + (jt0 + jt) * 8192 + hi * 1024 + r32 * 16;
            f32x16 a0 = {}, a1 = {};
#pragma unroll
            for (int d0 = 0; d0 < 4; ++d0) {
                if (MB_LIVE(jt, 0)) { const bf16x8 b0 = *(const LAS bf16x8*)(kb + d0 * 2048); a0 = __builtin_amdgcn_mfma_f32_32x32x16_bf16(b0, qr[d0], a0, 0, 0, 0); }
                if (MB_LIVE(jt, 1)) { const bf16x8 b1 = *(const LAS bf16x8*)(kb + d0 * 2048 + 512); a1 = __builtin_amdgcn_mfma_f32_32x32x16_bf16(b1, qr[d0], a1, 0, 0, 0); } }
            sc[jt][0] = a0; sc[jt][1] = a1; }
        const LAS float* tb = (const LAS float*)(lds + BIAS_OFF) + g * 384 + 128;
        float lsum = 0.f;
#pragma unroll
        for (int jt = 0; jt < 3; ++jt)
#pragma unroll
            for (int hh = 0; hh < 2; ++hh) if (MB_LIVE(jt, hh)) { const int kj0 = 64 * (jt0 + jt) + 32 * hh + 4 * hi;
                const bool first = (n == 0) && (jt0 + jt < 2);
                const LAS float* tx = first ? (tb + 130) : (tb + (127 - (qi + 128 - kj0)));
#pragma unroll
                for (int r = 0; r < 16; ++r) { const int kc = (r & 3) + 8 * (r >> 2);
                    const float e = __builtin_amdgcn_exp2f(sc[jt][hh][r] + tx[kc]); sc[jt][hh][r] = e; lsum += e; } }
        lsum += __shfl_xor(lsum, 32);
        lsum += sinke;
        f32x16 o0 = {}, o1 = {};
#pragma unroll
        for (int jt = 0; jt < 3; ++jt) { const LAS unsigned char* vb = vp0 + (jt0 + jt) * 8192;
#pragma unroll
            for (int ks = 0; ks < 4; ++ks) { const int hh = ks >> 1, rb = (ks & 1) * 8;
                if (MB_LIVE(jt, hh)) {
                v4u pw; pw.x = cvtpk(sc[jt][hh][rb + 0], sc[jt][hh][rb + 1]); pw.y = cvtpk(sc[jt][hh][rb + 2], sc[jt][hh][rb + 3]); pw.z = cvtpk(sc[jt][hh][rb + 4], sc[jt][hh][rb + 5]); pw.w = cvtpk(sc[jt][hh][rb + 6], sc[jt][hh][rb + 7]);
                const bf16x8 pa = __builtin_bit_cast(bf16x8, pw);
                const s16x4 l0 = vtr(vb + ks * 1024), h0 = vtr(vb + ks * 1024 + 512), l1 = vtr(vb + 4096 + ks * 1024), h1 = vtr(vb + 4096 + ks * 1024 + 512);
                const bf16x8 v0 = (bf16x8){l0[0], l0[1], l0[2], l0[3], h0[0], h0[1], h0[2], h0[3]}, v1 = (bf16x8){l1[0], l1[1], l1[2], l1[3], h1[0], h1[1], h1[2], h1[3]};
                o0 = __builtin_amdgcn_mfma_f32_32x32x16_bf16(pa, v0, o0, 0, 0, 0); o1 = __builtin_amdgcn_mfma_f32_32x32x16_bf16(pa, v1, o1, 0, 0, 0); } } }
#undef MB_LIVE
        if (hi == 0) wsf[r32] = lsum;
        LDS_WAIT(); asm volatile("" ::: "memory");
#pragma unroll
        for (int r = 0; r < 16; ++r) { const int orow = crow(r, hi); const float inv = DBG_B * __builtin_amdgcn_rcpf(wsf[orow]);
            const unsigned pk = cvtpk(o0[r] * inv, o1[r] * inv);
            stg[orow * 64 + r32] = (bf16)(pk & 0xffffu); stg[orow * 64 + 32 + r32] = (bf16)(pk >> 16); }
        LDS_WAIT(); asm volatile("" ::: "memory");
        bf16* ow = MIXED + (row0 + i0) * DM + MX_B + h * 64;
#pragma unroll
        for (int i = 0; i < 4; ++i) { const int row = i * 8 + (lane >> 3), ch = lane & 7; const v4u v = *(const LAS v4u*)(stg + row * 64 + ch * 8); *(v4u*)(ow + (long)row * DM + ch * 8) = v; }
        LDS_WAIT(); asm volatile("" ::: "memory");
    }
    __syncthreads();
}

constexpr size_t WS_WTB = WS_TAB + 131072;
constexpr int VNT_STRIDE = 136;
constexpr int A_STG_OFF = 4 * 64 * VNT_STRIDE * 2, A_STG_BYTES = 32 * 36 * 4;
__device__ __forceinline__ float rowsum16_dpp(float v) {
    v += __int_as_float(__builtin_amdgcn_update_dpp(0, __float_as_int(v), 0xB1, 0xf, 0xf, true));
    v += __int_as_float(__builtin_amdgcn_update_dpp(0, __float_as_int(v), 0x4E, 0xf, 0xf, true));
    v += __int_as_float(__builtin_amdgcn_update_dpp(0, __float_as_int(v), 0x141, 0xf, 0xf, true));
    v += __int_as_float(__builtin_amdgcn_update_dpp(0, __float_as_int(v), 0x140, 0xf, 0xf, true));
    return v;
}
__device__ __forceinline__ void mixer_a_mfma(const Ctx& p, int l, int unit, LAS unsigned char* lds, int wave, int lane) {
    using namespace mb;
    LAS bf16* vnT = (LAS bf16*)lds;
    const int ck = unit; const size_t row0 = (size_t)ck * 128;
    const bf16* PROJ = (const bf16*)(p.ws + WS_PROJ); bf16* MIXED = (bf16*)(p.ws + WS_MIXED);
    const int r32 = lane & 31, hi = lane >> 5, g = wave >> 1, dt = wave & 1;
    const bf16* Wg = (const bf16*)(p.ws + WS_WTB) + ((size_t)(l * 4 + g) * 128 + r32) * 128 + 8 * hi;
    v4u wf[20];
#pragma unroll
    for (int ti = 0; ti < 3; ++ti)
#pragma unroll
        for (int ks = 0; ks < 2 * ti + 2; ++ks) wf[ti * (ti + 1) + ks] = *(const v4u*)(Wg + (size_t)(32 * ti) * 128 + 16 * ks);
    const int orow = lane >> 2, od8 = 8 * (lane & 3);
    v4u uv[4][2]; float bsv[4][2];
    { const float* bs = PIN(p, I_BS) + (l * 4 + g) * 128;
#pragma unroll
        for (int ti = 0; ti < 4; ++ti)
#pragma unroll
            for (int j = 0; j < 2; ++j) { const int t = 32 * ti + orow + 16 * j; uv[ti][j] = *(const v4u*)(PROJ + (row0 + t) * INW + C_AU + g * 64 + 32 * dt + od8); bsv[ti][j] = bs[t]; } }
    {
        const int sub = lane >> 4, d4 = (lane & 15) * 4;
        v2u raw[16];
#pragma unroll
        for (int it = 0; it < 16; ++it) raw[it] = *(const v2u*)(PROJ + (row0 + wave * 16 + (it >> 2) * 4 + sub) * INW + C_AV + (it & 3) * 64 + d4);
        const float* vgp = PIN(p, I_VNG) + l * 256 + d4;
#pragma unroll
        for (int it = 0; it < 16; ++it) { const int gg = it & 3, s = wave * 16 + (it >> 2) * 4 + sub;
            const float v0 = bflo(raw[it].x), v1 = bfhi(raw[it].x), v2 = bflo(raw[it].y), v3 = bfhi(raw[it].y);
            const float ss = rowsum16_dpp((v0 * v0 + v1 * v1) + (v2 * v2 + v3 * v3));
            const float rs = rsqrtf(ss * (1.0f / 64.0f) + EPS); const f32x4 vgg = *(const f32x4*)(vgp + gg * 64);
            LAS bf16* dst = vnT + gg * (64 * VNT_STRIDE) + d4 * VNT_STRIDE + s;
            const unsigned p01 = mb_cvtpk(v0 * rs * vgg.x, v1 * rs * vgg.y), p23 = mb_cvtpk(v2 * rs * vgg.z, v3 * rs * vgg.w);
            dst[0] = (bf16)(p01 & 0xffffu); dst[VNT_STRIDE] = (bf16)(p01 >> 16); dst[2 * VNT_STRIDE] = (bf16)(p23 & 0xffffu); dst[3 * VNT_STRIDE] = (bf16)(p23 >> 16); }
    }
    __syncthreads();
#pragma unroll
    for (int ks = 0; ks < 8; ++ks) wf[12 + ks] = *(const v4u*)(Wg + (size_t)96 * 128 + 16 * ks);
    const LAS bf16* vb = vnT + g * (64 * VNT_STRIDE) + (32 * dt + r32) * VNT_STRIDE + 8 * hi;
    LAS float* stf = (LAS float*)(lds + A_STG_OFF + wave * A_STG_BYTES);
#pragma unroll
    for (int ti = 0; ti < 4; ++ti) {
        f32x16 acc = {};
#pragma unroll
        for (int ks = 0; ks < 2 * ti + 2; ++ks) { const bf16x8 b = *(const LAS bf16x8*)(vb + 16 * ks);
            acc = __builtin_amdgcn_mfma_f32_32x32x16_bf16(__builtin_bit_cast(bf16x8, wf[ti * (ti + 1) + ks]), b, acc, 0, 0, 0); }
#pragma unroll
        for (int r = 0; r < 16; ++r) stf[crow(r, hi) * 36 + r32] = acc[r];
        LDS_WAIT(); asm volatile("" ::: "memory");
#pragma unroll
        for (int j = 0; j < 2; ++j) { const int trow = orow + 16 * j; const LAS float* sp = stf + trow * 36 + od8;
            const f32x4 a0 = *(const LAS f32x4*)sp, a1 = *(const LAS f32x4*)(sp + 4); const v4u uu = uv[ti][j]; const float bb = bsv[ti][j];
            v4u o; o.x = mb_cvtpk(bflo(uu.x) * (a0[0] + bb) * DBG_A, bfhi(uu.x) * (a0[1] + bb) * DBG_A); o.y = mb_cvtpk(bflo(uu.y) * (a0[2] + bb) * DBG_A, bfhi(uu.y) * (a0[3] + bb) * DBG_A);
            o.z = mb_cvtpk(bflo(uu.z) * (a1[0] + bb) * DBG_A, bfhi(uu.z) * (a1[1] + bb) * DBG_A); o.w = mb_cvtpk(bflo(uu.w) * (a1[2] + bb) * DBG_A, bfhi(uu.w) * (a1[3] + bb) * DBG_A);
            *(v4u*)(MIXED + (row0 + 32 * ti + trow) * DM + MX_A + g * 64 + 32 * dt + od8) = o; }
        LDS_WAIT(); asm volatile("" ::: "memory");
    }
    __syncthreads();
}
__device__ __forceinline__ float hgrn_lb(const Ctx& p, int l, int kidx) { if (l == 0) return 0.f; const float* lg = PIN(p, I_LBL); return 1.0f / (1.0f + __expf(lg[kidx] - lg[256 + kidx])); }
#ifdef DBG_MIXCMP
__device__ __forceinline__ void hgrn_stage(const bf16* PROJ, size_t rowbase, int hc, const float (&lb8)[8], LAS float* F, LAS float* V, LAS float* Q, int tid) {
    const int tt = tid >> 3, k0 = (tid & 7) * 8; const bf16* rp = PROJ + (rowbase + tt) * INW + hc * 64 + k0;
    const v4u z = *(const v4u*)(rp + C_CF), vi = *(const v4u*)(rp + C_CI);
    float zf[8] = {bflo(z.x), bfhi(z.x), bflo(z.y), bfhi(z.y), bflo(z.z), bfhi(z.z), bflo(z.w), bfhi(z.w)}; float ff[8];
#pragma unroll
    for (int j = 0; j < 8; ++j) ff[j] = lb8[j] + (1.0f - lb8[j]) * __builtin_amdgcn_rcpf(1.0f + __expf(-zf[j]));
    *(LAS f32x4*)(F + tt * 64 + k0) = (f32x4){ff[0], ff[1], ff[2], ff[3]}; *(LAS f32x4*)(F + tt * 64 + k0 + 4) = (f32x4){ff[4], ff[5], ff[6], ff[7]};
    *(LAS f32x4*)(V + tt * 64 + k0) = (f32x4){bflo(vi.x), bfhi(vi.x), bflo(vi.y), bfhi(vi.y)}; *(LAS f32x4*)(V + tt * 64 + k0 + 4) = (f32x4){bflo(vi.z), bfhi(vi.z), bflo(vi.w), bfhi(vi.w)};
    if (Q) { const v4u qq = *(const v4u*)(rp + C_CQ);
        *(LAS f32x4*)(Q + tt * 64 + k0) = (f32x4){bflo(qq.x), bfhi(qq.x), bflo(qq.y), bfhi(qq.y)}; *(LAS f32x4*)(Q + tt * 64 + k0 + 4) = (f32x4){bflo(qq.z), bfhi(qq.z), bflo(qq.w), bfhi(qq.w)}; }
}
__device__ __forceinline__ void mixer_c_pass1_simple(const Ctx& p, int l, int unit, LAS unsigned char* lds, int wave, int lane) {
    LAS float* F = (LAS float*)lds; LAS float* V = F + 4096;
    const int bh = unit >> 4, seg = unit & 15, b = bh >> 2, hc = bh & 3; const size_t row0 = (size_t)b * SEQ + (size_t)seg * 512;
    const bf16* PROJ = (const bf16*)(p.ws + WS_PROJ); const int tid = wave * 64 + lane;
    float lb8[8];
#pragma unroll
    for (int j = 0; j < 8; ++j) lb8[j] = hgrn_lb(p, l, hc * 64 + (tid & 7) * 8 + j);
    float S[8], P[8];
#pragma unroll
    for (int j = 0; j < 8; ++j) { S[j] = 0.f; P[j] = 1.f; }
    for (int cks = 0; cks < 8; ++cks) {
        __syncthreads();
        hgrn_stage(PROJ, row0 + cks * 64, hc, lb8, F, V, nullptr, tid);
        __syncthreads();
        for (int tt = 0; tt < 64; ++tt) {
            const f32x4 fa = *(const LAS f32x4*)(F + tt * 64 + wave * 8), fb = *(const LAS f32x4*)(F + tt * 64 + wave * 8 + 4); const float vv = V[tt * 64 + lane];
            const float f8[8] = {fa.x, fa.y, fa.z, fa.w, fb.x, fb.y, fb.z, fb.w};
#pragma unroll
            for (int j = 0; j < 8; ++j) { S[j] = fmaf(f8[j], S[j] - vv, vv); P[j] *= f8[j]; }
        }
    }
    float* SEGS = (float*)(p.ws + WS_SEGS); float* SEGP = (float*)(p.ws + WS_SEGP);
#pragma unroll
    for (int j = 0; j < 8; ++j) { SEGS[(size_t)unit * 4096 + (wave * 8 + j) * 64 + lane] = S[j]; if (lane == 0) SEGP[unit * 64 + wave * 8 + j] = P[j]; }
    __syncthreads();
}
__device__ __forceinline__ void mixer_c_pass2_simple(const Ctx& p, int l, int unit, LAS unsigned char* lds, int wave, int lane) {
    LAS float* F = (LAS float*)lds; LAS float* V = F + 4096; LAS float* Q = V + 4096; LAS float* PO = Q + 4096;
    const int bh = unit >> 4, seg = unit & 15, b = bh >> 2, hc = bh & 3; const size_t row0 = (size_t)b * SEQ + (size_t)seg * 512;
    const bf16* PROJ = (const bf16*)(p.ws + WS_PROJ); bf16* MIXED = (bf16*)(p.ws + WS_MIXED); const int tid = wave * 64 + lane;
    const float* SEGS = (const float*)(p.ws + WS_SEGS); const float* SEGP = (const float*)(p.ws + WS_SEGP);
    float lb8[8];
#pragma unroll
    for (int j = 0; j < 8; ++j) lb8[j] = hgrn_lb(p, l, hc * 64 + (tid & 7) * 8 + j);
    float S[8];
#pragma unroll
    for (int j = 0; j < 8; ++j) S[j] = 0.f;
    for (int s = 0; s < seg; ++s) { const int u2 = bh * 16 + s;
#pragma unroll
        for (int j = 0; j < 8; ++j) S[j] = SEGP[u2 * 64 + wave * 8 + j] * S[j] + SEGS[(size_t)u2 * 4096 + (wave * 8 + j) * 64 + lane]; }
    const float ong = PIN(p, I_ONG)[l * 64 + lane];
    for (int cks = 0; cks < 8; ++cks) {
        __syncthreads();
        hgrn_stage(PROJ, row0 + cks * 64, hc, lb8, F, V, Q, tid);
        __syncthreads();
        for (int tg = 0; tg < 4; ++tg) {
            for (int t16 = 0; t16 < 16; ++t16) { const int tt = tg * 16 + t16;
                const f32x4 fa = *(const LAS f32x4*)(F + tt * 64 + wave * 8), fb = *(const LAS f32x4*)(F + tt * 64 + wave * 8 + 4);
                const f32x4 qa = *(const LAS f32x4*)(Q + tt * 64 + wave * 8), qb = *(const LAS f32x4*)(Q + tt * 64 + wave * 8 + 4); const float vv = V[tt * 64 + lane];
                const float f8[8] = {fa.x, fa.y, fa.z, fa.w, fb.x, fb.y, fb.z, fb.w}; const float q8[8] = {qa.x, qa.y, qa.z, qa.w, qb.x, qb.y, qb.z, qb.w};
                float po = 0.f;
#pragma unroll
                for (int j = 0; j < 8; ++j) { S[j] = fmaf(f8[j], S[j] - vv, vv); po = fmaf(q8[j], S[j], po); }
                PO[(t16 * 8 + wave) * 64 + lane] = po; }
            __syncthreads();
#pragma unroll
            for (int e = 0; e < 2; ++e) { const int t16 = wave * 2 + e; float o = 0.f;
#pragma unroll
                for (int w = 0; w < 8; ++w) o += PO[(t16 * 8 + w) * 64 + lane];
                const float ss = wave_sum(o * o); const size_t row = row0 + cks * 64 + tg * 16 + t16;
                const float gg = bf2f(PROJ[row * INW + C_CG + hc * 64 + lane]);
                MIXED[row * DM + MX_C + hc * 64 + lane] = (bf16)f2bf(o * rsqrtf(ss * (1.0f / 64.0f) + EPS) * ong * gg * DBG_C); }
            __syncthreads();
        }
    }
}

#endif


__device__ __forceinline__ float wave_sum_dpp(float v) {
    v += __int_as_float(__builtin_amdgcn_update_dpp(0, __float_as_int(v), 0xB1, 0xf, 0xf, true));
    v += __int_as_float(__builtin_amdgcn_update_dpp(0, __float_as_int(v), 0x4E, 0xf, 0xf, true));
    v += __int_as_float(__builtin_amdgcn_update_dpp(0, __float_as_int(v), 0x141, 0xf, 0xf, true));
    v += __int_as_float(__builtin_amdgcn_update_dpp(0, __float_as_int(v), 0x140, 0xf, 0xf, true));
    const int vi = __float_as_int(v);
    return (__int_as_float(__builtin_amdgcn_readlane(vi, 0)) + __int_as_float(__builtin_amdgcn_readlane(vi, 16))) + (__int_as_float(__builtin_amdgcn_readlane(vi, 32)) + __int_as_float(__builtin_amdgcn_readlane(vi, 48)));
}
namespace mc {
constexpr int QT = 0, KT = 4096, QH = 8192, KH = 12288, VV = 16384, DD = 20480, WTO = 20736, OE = 22784, OI = 30976, RB = 39168, LDS_END = 55552, OG = 55552;
}
#define MC_BAR() do { asm volatile("s_waitcnt lgkmcnt(0)" ::: "memory"); __builtin_amdgcn_s_barrier(); asm volatile("" ::: "memory"); } while (0)
template <bool PASS2>
__device__ __forceinline__ void mixer_c_mfma(const Ctx& p, int l, int unit, LAS unsigned char* lds, int wave, int lane) {
    using namespace mb;
    const int bh = unit >> 4, seg = unit & 15, b = bh >> 2, hc = bh & 3; const size_t row0 = (size_t)b * SEQ + (size_t)seg * 512;
    const bf16* PROJ = (const bf16*)(p.ws + WS_PROJ); bf16* MIXED = (bf16*)(p.ws + WS_MIXED);
    float* SEGS = (float*)(p.ws + WS_SEGS); float* SEGP = (float*)(p.ws + WS_SEGP);
    const int r32 = lane & 31, hi = lane >> 5, kt_lane_off = ((lane >> 4) & 1) * 32 + (lane & 3) * 8 + (4 * hi + ((lane & 15) >> 2)) * 64;
    const int cp = lane & 31, th = lane >> 5;
    const f32x2 lb2 = (f32x2){hgrn_lb(p, l, hc * 64 + 2 * cp), hgrn_lb(p, l, hc * 64 + 2 * cp + 1)}, omlb2 = (f32x2){1.0f - lb2.x, 1.0f - lb2.y};
    const int st = (((wave & 3) * 64 + lane) >> 3), sc8 = (lane & 7) * 8;
    if (PASS2 && wave == 7) ((LAS float*)(lds + mc::OG))[lane] = PIN(p, I_ONG)[l * 64 + lane] * DBG_C;
    f32x16 S0 = {}, S1 = {};
    if (PASS2) {
        LAS float* Ptab = (LAS float*)(lds + mc::OE);
        { const float* ps = SEGP + (size_t)bh * 16 * 64; const int t_ = wave * 64 + lane; const float p0_ = ps[t_], p1_ = ps[t_ + 512]; Ptab[t_] = p0_; Ptab[t_ + 512] = p1_; }
        MC_BAR();
        if (wave < 2) {
            const float* sbase = SEGS + (size_t)bh * 16 * 4096 + wave * 2048 + lane;
            for (int s = 0; s < seg; s += 4) {
                float buf[4][32];
#pragma unroll
                for (int j = 0; j < 4; ++j) { const int sj = (s + j < seg) ? s + j : seg - 1;
#pragma unroll
                    for (int r = 0; r < 32; ++r) buf[j][r] = sbase[(size_t)sj * 4096 + r * 64]; }
#pragma unroll
                for (int j = 0; j < 4; ++j) if (s + j < seg) { const LAS float* pp = Ptab + (s + j) * 64 + 4 * hi;
#pragma unroll
                    for (int gq = 0; gq < 4; ++gq) { const f32x4 d0 = *(const LAS f32x4*)(pp + 8 * gq), d1 = *(const LAS f32x4*)(pp + 32 + 8 * gq);
#pragma unroll
                        for (int e = 0; e < 4; ++e) { const int r = 4 * gq + e; S0[r] = d0[e] * S0[r] + buf[j][r]; S1[r] = d1[e] * S1[r] + buf[j][16 + r]; } } }
            }
        }
    }
    f32x2 sumtot = (f32x2){0.f, 0.f};
    const int tid = wave * 64 + lane, ptok = (tid & 255) >> 3, pch = tid & 7, parr = tid >> 8;
    const bf16* gsrc = PROJ + (row0 + ptok) * INW + hc * 64 + pch * 8;
    const int rboff = ptok * 128 + pch * 16;
    v4u pf0, pf1 = (v4u){0u, 0u, 0u, 0u};
    pf0 = *(const v4u*)(gsrc + (parr ? C_CI : C_CF)); if (PASS2) pf1 = *(const v4u*)(gsrc + (parr ? C_CG : C_CQ));
    *(LAS v4u*)(lds + mc::RB + parr * 4096 + rboff) = pf0; if (PASS2) *(LAS v4u*)(lds + mc::RB + (2 + parr) * 4096 + rboff) = pf1;
    MC_BAR();
#ifdef DBG_TIMEC
    long long tacc = 0; const long long tunit0 = clock64();
#endif
#pragma unroll 1
    for (int n = 0; n < 16; ++n) {
#ifdef DBG_TIMEC
        const long long ts1 = clock64();
#endif
        if (n + 1 < 16) { const bf16* gn = gsrc + (size_t)(32 * (n + 1)) * INW;
            pf0 = *(const v4u*)(gn + (parr ? C_CI : C_CF)); if (PASS2) pf1 = *(const v4u*)(gn + (parr ? C_CG : C_CQ)); }
        v4u gvr = (v4u){0u, 0u, 0u, 0u};
        if (PASS2 && wave >= 4) gvr = *(const LAS v4u*)(lds + mc::RB + (6144 + st * 64 + sc8) * 2);
        f32x2 fg[2], cs[2], qv[2], vv[2];
#pragma unroll
        for (int i = 0; i < 2; ++i) { const LAS unsigned* rp = (const LAS unsigned*)(lds + mc::RB) + (4 * wave + 2 * th + i) * 32 + cp;
            const unsigned zw = rp[0], vw = rp[1024];
            const float z0 = fmaxf(bflo(zw), -30.f), z1 = fmaxf(bfhi(zw), -30.f);
            fg[i] = (f32x2){lb2.x + omlb2.x * __builtin_amdgcn_rcpf(1.0f + __builtin_amdgcn_exp2f(z0 * -1.4426950408889634f)), lb2.y + omlb2.y * __builtin_amdgcn_rcpf(1.0f + __builtin_amdgcn_exp2f(z1 * -1.4426950408889634f))};
            vv[i] = (f32x2){bflo(vw), bfhi(vw)};
            if (PASS2) { const unsigned qw = rp[2048]; qv[i] = (f32x2){bflo(qw), bfhi(qw)}; } }
        cs[0] = (f32x2){__builtin_amdgcn_logf(fg[0].x), __builtin_amdgcn_logf(fg[0].y)}; cs[1] = cs[0] + (f32x2){__builtin_amdgcn_logf(fg[1].x), __builtin_amdgcn_logf(fg[1].y)};
        { const f32x2 other = (f32x2){__shfl_xor(cs[1].x, 32), __shfl_xor(cs[1].y, 32)};
            if (th) { cs[0] = cs[0] + other; cs[1] = cs[1] + other; ((LAS f32x2*)(lds + mc::WTO))[wave * 32 + cp] = cs[1]; } }
#ifdef DBG_TIMEC
        const long long tb1a = clock64(); if (DBG_TIMEC == 11) tacc += tb1a - ts1;
#endif
        MC_BAR();
#ifdef DBG_TIMEC
        const long long tb1b = clock64(); if (DBG_TIMEC == 12) tacc += tb1b - tb1a;
#endif
        f32x2 off = (f32x2){0.f, 0.f}, tot = off, mid = off;
#pragma unroll
        for (int w = 0; w < 8; ++w) { const f32x2 tw = ((const LAS f32x2*)(lds + mc::WTO))[w * 32 + cp]; if (w < wave) off = off + tw; if (w < 4) mid = mid + tw; tot = tot + tw; }
        sumtot = sumtot + tot;
#pragma unroll
        for (int i = 0; i < 2; ++i) { const int t = 4 * wave + 2 * th + i; const f32x2 Bt = off + cs[i], kk = (f32x2){1.0f - fg[i].x, 1.0f - fg[i].y};
            const int chb = (cp >> 2) * 512 + t * 16 + (cp & 3) * 4, vlb = (cp >> 4) * 2048 + (t >> 4) * 1024 + (t & 15) * 64 + (cp & 15) * 4;
            *(LAS unsigned*)(lds + mc::KH + vlb) = cvtpk(kk.x * __builtin_amdgcn_exp2f(tot.x - Bt.x), kk.y * __builtin_amdgcn_exp2f(tot.y - Bt.y));
            *(LAS unsigned*)(lds + mc::VV + vlb) = cvtpk(vv[i].x, vv[i].y);
            if (PASS2) { *(LAS unsigned*)(lds + mc::QT + chb) = cvtpk(qv[i].x * __builtin_amdgcn_exp2f(fminf(Bt.x - mid.x, 115.f)), qv[i].y * __builtin_amdgcn_exp2f(fminf(Bt.y - mid.y, 115.f)));
                *(LAS unsigned*)(lds + mc::KT + chb) = cvtpk(kk.x * __builtin_amdgcn_exp2f(fminf(mid.x - Bt.x, 115.f)), kk.y * __builtin_amdgcn_exp2f(fminf(mid.y - Bt.y, 115.f)));
                *(LAS unsigned*)(lds + mc::QH + chb) = cvtpk(qv[i].x * __builtin_amdgcn_exp2f(Bt.x), qv[i].y * __builtin_amdgcn_exp2f(Bt.y)); } }
        if (wave == 0 && th == 0) ((LAS f32x2*)(lds + mc::DD))[cp] = (f32x2){__builtin_amdgcn_exp2f(tot.x), __builtin_amdgcn_exp2f(tot.y)};
#ifdef DBG_TIMEC
        const long long tb2a = clock64(); if (DBG_TIMEC == 13) tacc += tb2a - tb1b;
#endif
        MC_BAR();
#ifdef DBG_TIMEC
        const long long ts2 = clock64(); if (DBG_TIMEC == 14) tacc += ts2 - tb2a; if (DBG_TIMEC == 1) tacc += ts2 - ts1;
#endif
        if (wave < 2) {
            const int vt = wave;
            if (PASS2) {
                f32x16 o = {};
#pragma unroll
                for (int kt = 0; kt < 2; ++kt)
#pragma unroll
                    for (int s2 = 0; s2 < 2; ++s2) { const LAS unsigned char* qa = lds + mc::QH + (4 * kt + 2 * s2) * 512 + r32 * 16 + 8 * hi;
                        const v2u a0 = *(const LAS v2u*)qa, a1 = *(const LAS v2u*)(qa + 512); v4u aw; aw.x = a0.x; aw.y = a0.y; aw.z = a1.x; aw.w = a1.y;
                        v4u bw;
                        if (kt == 0) { bw.x = cvtpk(S0[8 * s2 + 0], S0[8 * s2 + 1]); bw.y = cvtpk(S0[8 * s2 + 2], S0[8 * s2 + 3]); bw.z = cvtpk(S0[8 * s2 + 4], S0[8 * s2 + 5]); bw.w = cvtpk(S0[8 * s2 + 6], S0[8 * s2 + 7]); }
                        else { bw.x = cvtpk(S1[8 * s2 + 0], S1[8 * s2 + 1]); bw.y = cvtpk(S1[8 * s2 + 2], S1[8 * s2 + 3]); bw.z = cvtpk(S1[8 * s2 + 4], S1[8 * s2 + 5]); bw.w = cvtpk(S1[8 * s2 + 6], S1[8 * s2 + 7]); }
                        o = __builtin_amdgcn_mfma_f32_32x32x16_bf16(__builtin_bit_cast(bf16x8, aw), __builtin_bit_cast(bf16x8, bw), o, 0, 0, 0); }
#pragma unroll
                for (int r = 0; r < 16; ++r) ((LAS float*)(lds + mc::OE))[crow(r, hi) * 64 + 32 * vt + r32] = o[r];
            }
            { const LAS float* dp = (const LAS float*)(lds + mc::DD) + 4 * hi;
#pragma unroll
                for (int gq = 0; gq < 4; ++gq) { const f32x4 d0 = *(const LAS f32x4*)(dp + 8 * gq), d1 = *(const LAS f32x4*)(dp + 32 + 8 * gq);
#pragma unroll
                    for (int e = 0; e < 4; ++e) { S0[4 * gq + e] *= d0[e]; S1[4 * gq + e] *= d1[e]; } } }
#pragma unroll
            for (int ks = 0; ks < 2; ++ks) {
                const LAS unsigned char* vb = lds + mc::VV + vt * 2048 + ks * 1024 + kt_lane_off; const s16x4 vl = vtr(vb), vh = vtr(vb + 512);
                const bf16x8 bv = (bf16x8){vl[0], vl[1], vl[2], vl[3], vh[0], vh[1], vh[2], vh[3]};
                const LAS unsigned char* k0 = lds + mc::KH + ks * 1024 + kt_lane_off; const s16x4 al = vtr(k0), ah = vtr(k0 + 512), bl = vtr(k0 + 2048), bh_ = vtr(k0 + 2048 + 512);
                const bf16x8 a0 = (bf16x8){al[0], al[1], al[2], al[3], ah[0], ah[1], ah[2], ah[3]}, a1 = (bf16x8){bl[0], bl[1], bl[2], bl[3], bh_[0], bh_[1], bh_[2], bh_[3]};
                S0 = __builtin_amdgcn_mfma_f32_32x32x16_bf16(a0, bv, S0, 0, 0, 0); S1 = __builtin_amdgcn_mfma_f32_32x32x16_bf16(a1, bv, S1, 0, 0, 0); }
        } else if (PASS2 && wave < 4) {
            const int vt = wave - 2;
            f32x16 at = {};
#pragma unroll
            for (int ks = 0; ks < 4; ++ks) { const bf16x8 a = *(const LAS bf16x8*)(lds + mc::KT + (2 * ks + hi) * 512 + r32 * 16), bq = *(const LAS bf16x8*)(lds + mc::QT + (2 * ks + hi) * 512 + r32 * 16);
                at = __builtin_amdgcn_mfma_f32_32x32x16_bf16(a, bq, at, 0, 0, 0); }
            f32x16 o = {};
#pragma unroll
            for (int ks = 0; ks < 2; ++ks) { float m8[8];
#pragma unroll
                for (int j = 0; j < 8; ++j) { const int r = 8 * ks + j; m8[j] = (crow(r, hi) <= r32) ? at[r] : 0.f; }
                v4u pw; pw.x = cvtpk(m8[0], m8[1]); pw.y = cvtpk(m8[2], m8[3]); pw.z = cvtpk(m8[4], m8[5]); pw.w = cvtpk(m8[6], m8[7]);
                const LAS unsigned char* vb = lds + mc::VV + vt * 2048 + ks * 1024 + kt_lane_off; const s16x4 vl = vtr(vb), vh = vtr(vb + 512);
                const bf16x8 bv = (bf16x8){vl[0], vl[1], vl[2], vl[3], vh[0], vh[1], vh[2], vh[3]};
                o = __builtin_amdgcn_mfma_f32_32x32x16_bf16(__builtin_bit_cast(bf16x8, pw), bv, o, 0, 0, 0); }
#pragma unroll
            for (int r = 0; r < 16; ++r) ((LAS float*)(lds + mc::OI))[crow(r, hi) * 64 + 32 * vt + r32] = o[r];
        }
#ifdef DBG_TIMEC
        const long long ts2b = clock64(); if (DBG_TIMEC == 2) tacc += ts2b - ts2;
#endif
        if (n + 1 < 16) { *(LAS v4u*)(lds + mc::RB + parr * 4096 + rboff) = pf0; if (PASS2) *(LAS v4u*)(lds + mc::RB + (2 + parr) * 4096 + rboff) = pf1; }
        MC_BAR();
#ifdef DBG_TIMEC
        const long long ts3 = clock64(); if (DBG_TIMEC == 6) tacc += ts3 - ts2b;
#endif
        if (PASS2 && wave >= 4) {
            const LAS float* oe = (const LAS float*)(lds + mc::OE) + st * 64 + sc8; const LAS float* oi = (const LAS float*)(lds + mc::OI) + st * 64 + sc8;
            const f32x4 o0 = *(const LAS f32x4*)oe + *(const LAS f32x4*)oi, o1 = *(const LAS f32x4*)(oe + 4) + *(const LAS f32x4*)(oi + 4);
            float ss = ((o0[0] * o0[0] + o0[1] * o0[1]) + (o0[2] * o0[2] + o0[3] * o0[3])) + ((o1[0] * o1[0] + o1[1] * o1[1]) + (o1[2] * o1[2] + o1[3] * o1[3]));
            ss += __int_as_float(__builtin_amdgcn_update_dpp(0, __float_as_int(ss), 0xB1, 0xf, 0xf, true));
            ss += __int_as_float(__builtin_amdgcn_update_dpp(0, __float_as_int(ss), 0x4E, 0xf, 0xf, true));
            ss += __int_as_float(__builtin_amdgcn_update_dpp(0, __float_as_int(ss), 0x141, 0xf, 0xf, true));
            const float rs = rsqrtf(ss * (1.0f / 64.0f) + EPS);
            const f32x4 g0 = (f32x4){bflo(gvr.x), bfhi(gvr.x), bflo(gvr.y), bfhi(gvr.y)}, g1 = (f32x4){bflo(gvr.z), bfhi(gvr.z), bflo(gvr.w), bfhi(gvr.w)};
            const LAS float* ogp = (const LAS float*)(lds + mc::OG) + sc8; const f32x4 ong0 = *(const LAS f32x4*)ogp, ong1 = *(const LAS f32x4*)(ogp + 4);
            const f32x4 y0 = o0 * rs * ong0 * g0, y1 = o1 * rs * ong1 * g1;
            v4u w; w.x = cvtpk(y0[0], y0[1]); w.y = cvtpk(y0[2], y0[3]); w.z = cvtpk(y1[0], y1[1]); w.w = cvtpk(y1[2], y1[3]);
            *(v4u*)(MIXED + (row0 + 32 * n + st) * DM + MX_C + hc * 64 + sc8) = w;
        }
    }
#ifdef DBG_TIMEC
    if (PASS2 && unit == DBG_TIMEC_UNIT && wave == DBG_TIMEC_WAVE && lane == 0) { if (DBG_TIMEC == 4) tacc = clock64() - tunit0; ((float*)(p.ws + WS_TAB + 65536))[4] = (float)tacc; }
#endif
    if (!PASS2) {
        if (wave < 2) { float* sp = SEGS + ((size_t)(unit * 2 + wave) * 2) * 16 * 64 + lane;
#pragma unroll
            for (int r = 0; r < 16; ++r) { sp[(size_t)r * 64] = S0[r]; sp[(size_t)(16 + r) * 64] = S1[r]; } }
        if (wave == 0 && th == 0) { SEGP[unit * 64 + 2 * cp] = __builtin_amdgcn_exp2f(sumtot.x); SEGP[unit * 64 + 2 * cp + 1] = __builtin_amdgcn_exp2f(sumtot.y); }
    }
    __syncthreads();
}
__device__ __forceinline__ void ffn_fixup(const Ctx& p, int l, int tid) {
    const float* HG = (const float*)(p.ws + WS_HG); const float* HU = (const float*)(p.ws + WS_HU); bf16* ACT = (bf16*)(p.ws + WS_ACT);
    const float* cw = PIN(p, I_CONVW) + (size_t)l * 3 * DFF; const float* cb = PIN(p, I_CONVB) + (size_t)l * DFF;
    const int total = 512 * 2 * (DFF / 4);
    for (int idx = blockIdx.x * (NWAVES * 64) + tid; idx < total; idx += gridDim.x * (NWAVES * 64)) {
        const int c4 = idx % (DFF / 4), rr = idx / (DFF / 4), rho = rr & 1, blk = rr >> 1, ch = 4 * c4;
        const bool first = (blk % 128) == 0;
        const f32x4 z = (f32x4){0.f, 0.f, 0.f, 0.f};
        const f32x4 g0 = *(const f32x4*)(HG + ((size_t)blk * 4 + rho) * DFF + ch);
        f32x4 g1, g2;
        if (rho == 1) { g1 = *(const f32x4*)(HG + ((size_t)blk * 4 + 0) * DFF + ch); g2 = first ? z : *(const f32x4*)(HG + ((size_t)(blk - 1) * 4 + 3) * DFF + ch); }
        else { g1 = first ? z : *(const f32x4*)(HG + ((size_t)(blk - 1) * 4 + 3) * DFF + ch); g2 = first ? z : *(const f32x4*)(HG + ((size_t)(blk - 1) * 4 + 2) * DFF + ch); }
        const f32x4 up = *(const f32x4*)(HU + ((size_t)blk * 2 + rho) * DFF + ch);
        const f32x4 w0 = *(const f32x4*)(cw + ch), w1 = *(const f32x4*)(cw + DFF + ch), w2 = *(const f32x4*)(cw + 2 * DFF + ch), bb = *(const f32x4*)(cb + ch);
        f32x4 c = bb + w0 * g2 + w1 * g1 + w2 * g0;
#pragma unroll
        for (int j = 0; j < 4; ++j) c[j] = silu_f(c[j]) * up[j];
        v2u w; w.x = pk2(c[0], c[1]); w.y = pk2(c[2], c[3]);
        *(v2u*)(ACT + ((size_t)blk * 64 + rho) * DFF + ch) = w;
    }
}

#ifndef PREB_ON
#define PREB_ON 0
#endif
constexpr int PH_PER_LAYER = 7, N_PHASES = 1 + DEPTH * PH_PER_LAYER;
__global__ void __launch_bounds__(NWAVES * 64, 2) fwd_kernel(Params args) {
    extern __shared__ __attribute__((aligned(16))) unsigned char lds_raw[];
    LAS unsigned char* lds = (LAS unsigned char*)lds_raw;
    volatile LAS unsigned* MISC = (volatile LAS unsigned*)(lds + MISC_OFF);
    volatile LAS unsigned long long* TAB = (volatile LAS unsigned long long*)(lds + TAB_OFF);
    LAS unsigned char* BKT = lds + TAB_OFF + 256;
    if (threadIdx.x < 64) MISC[threadIdx.x] = 0u;
    if (threadIdx.x == 0) {
#pragma unroll
        for (int i = 0; i < 19; ++i) TAB[i] = (unsigned long long)args.in[i];
        TAB[19] = (unsigned long long)args.out;
    }
    if (threadIdx.x >= 64 && threadIdx.x < 192) BKT[threadIdx.x - 64] = args.bucket[threadIdx.x - 64];
    __syncthreads();
    unsigned* barw = (unsigned*)(args.ws + WS_CTL) + CW_BAR + args.bar_region * XCD_BAR_WORDS;
    const int lo = args.ph_lo, hi = args.ph_hi;
    XcdBarrier bar; bar.bar = barw; bar.x = 0; bar.st = nullptr;
    if (hi - lo > 1) bar = xcd_barrier_post(barw, MISC + 8);
    const int wave_s = 0; bar.wv = 0;
    const int G_raw = gridDim.x;
#pragma nounroll
    for (int ph = lo; ph < hi; ++ph) {
        const int l = (ph - 1) / PH_PER_LAYER, k = (ph == 0) ? -1 : (ph - 1) % PH_PER_LAYER;
#ifdef DBG_DOUBLE
        const int nrep = ((ph == 0 ? 7 : k) == DBG_DOUBLE) ? 2 : 1;
#else
        const int nrep = 1;
#endif
#pragma nounroll
        for (int rep = 0; rep < nrep; ++rep) {
        int bid = (int)blockIdx.x, G = G_raw; asm volatile("" : "+s"(bid), "+s"(G));
        int tid = threadIdx.x; asm volatile("" : "+v"(tid));
        Ctx p; p.tab = TAB; p.bucket = nullptr; { GAS unsigned char* wsg = (GAS unsigned char*)args.ws; asm volatile("" : "+s"(wsg)); p.ws = (unsigned char*)wsg; }
        const int lane = tid & 63, wave = __builtin_amdgcn_readfirstlane(tid >> 6);
        const unsigned char* wl = p.ws + WS_W + (size_t)l * W_LAYER;
        if (ph == 0) {
#ifndef NO_P0
            prologue(p, lds, wave, lane, rep == 0);
#endif
        } else if (k == 0) {
#ifndef NO_P1
            pg8::Gemm g{(const bf16*)(p.ws + WS_XB), (const bf16*)(wl + W_IN), M, INW, DM, (PREB_ON && hi - lo > 1 && ph > 1) ? 1 : 0, wave_s}; InProjOrder S; S.init(M, INW, G, bid);
            if (bid >= 128 && rep == 0) { for (int z = 0; z < SKEW_P1; ++z) __builtin_amdgcn_s_sleep(127); }
            EpiInProj E{(bf16*)(p.ws + WS_PROJ), (const unsigned long long*)(p.ws + WS_SS) + (size_t)(2 * l) * M, DBG_EPI_MODE(rep), lds};
            pg8::gemm_phase<EpiInProj, InProjOrder, true, true>(lds, g, S, E);
#endif
        } else if (k == 1) {
#ifndef NO_P2A
#ifdef DBG_MIXCMP
            if (args.flags & 1) { for (int u = bid; u < 256; u += G) mixer_c_pass1_simple(p, l, u, lds, wave, lane); } else
#endif
            for (int rr = 0; rr < DBG_REP_C1; ++rr)
            for (int u = bid; u < 256; u += G) mixer_c_mfma<false>(p, l, u, lds, wave, lane);
#ifdef DBG_MIXCMP
            if (args.flags & 1) { for (int u = bid; u < 1024; u += G) mixer_a_simple(p, l, u, lds, wave, lane); } else
#endif
            for (int u = bid; u < 256; u += G) mixer_a_mfma(p, l, u, lds, wave, lane);
#endif
        } else if (k == 2) {
#ifndef NO_P2B
#ifdef DBG_MIXCMP
            if (args.flags & 1) { for (int u = bid; u < 256; u += G) mixer_c_pass2_simple(p, l, u, lds, wave, lane); } else
#endif
            for (int rr = 0; rr < DBG_REP_C2; ++rr)
            for (int u = bid; u < 256; u += G) mixer_c_mfma<true>(p, l, u, lds, wave, lane);
#ifdef DBG_MIXCMP
            if (args.flags & 1) { for (int u = bid; u < 512; u += G) mixer_b_simple(p, l, u, lds, wave, lane); } else
#endif
            for (int rr = 0; rr < DBG_REP_B; ++rr)
            for (int u = bid; u < 512; u += G) mixer_b_mfma(p, l, u, lds, wave, lane);
#endif
        } else if (k == 3) {
#ifndef NO_P3
            pg8::Gemm g{(const bf16*)(p.ws + WS_MIXED), (const bf16*)(wl + W_OUT), M, DM, DM, (PREB_ON && hi - lo > 1) ? 1 : 0, wave_s}; pg8::StaticOrder S; S.init(M, DM, G, bid);
            EpiResid E{(bf16*)(p.ws + WS_XB), nullptr, (unsigned long long*)(p.ws + WS_SS) + (size_t)(2 * l + 1) * M, rep == 0 ? 1 : 0};
            pg8::gemm_phase<EpiResid, pg8::StaticOrder, true, true>(lds, g, S, E);
#endif
        } else if (k == 4) {
#ifndef NO_P4
            pg8::Gemm g{(const bf16*)(p.ws + WS_XB), (const bf16*)(wl + W_GU), M, NGU, DM, (PREB_ON && hi - lo > 1) ? 1 : 0, wave_s}; pg8::StaticOrder S; S.init(M, NGU, G, bid);
            if (((bid >> 3) & 1) && rep == 0) { for (int z = 0; z < SKEW_P4; ++z) __builtin_amdgcn_s_sleep(127); }
            EpiFFN E{(bf16*)(p.ws + WS_ACT), (const unsigned long long*)(p.ws + WS_SS) + (size_t)(2 * l + 1) * M, PIN(p, I_CONVW) + (size_t)l * 3 * DFF, PIN(p, I_CONVB) + (size_t)l * DFF, (float*)(p.ws + WS_HG), (float*)(p.ws + WS_HU), DBG_EPI_MODE(rep), lds};
            pg8::gemm_phase<EpiFFN, pg8::StaticOrder, true, true>(lds, g, S, E);
#endif
        } else if (k == 5) {
            ffn_fixup(p, l, tid);
        } else {
#ifndef NO_P5
            pg8::Gemm g{(const bf16*)(p.ws + WS_ACT), (const bf16*)(wl + W_DN), M, DM, DFF, (PREB_ON && hi - lo > 1) ? 1 : 0, wave_s}; pg8::StaticOrder S; S.init(M, DM, G, bid);
            EpiResid E{(bf16*)(p.ws + WS_XB), POUT(p), (unsigned long long*)(p.ws + WS_SS) + (size_t)(2 * l + 2) * M, rep != 0 ? 0 : ((l + 1 < DEPTH) ? 1 : 2)};
            pg8::gemm_phase<EpiResid, pg8::StaticOrder, true, true>(lds, g, S, E);
#endif
        }
        }
        if (ph + 1 < hi) {
            xcd_barrier_head();
            if (PREB_ON && hi - lo > 1 && ph >= 1) {
                const int k2 = ph % PH_PER_LAYER, l2 = ph / PH_PER_LAYER;
                const int N2 = (k2 == 0) ? INW : (k2 == 3 || k2 == 6) ? DM : (k2 == 4) ? NGU : 0, K2 = (k2 == 6) ? DFF : DM;
                const size_t wo2 = (k2 == 0) ? W_IN : (k2 == 3) ? W_OUT : (k2 == 4) ? W_GU : W_DN;
                if (N2 != 0) { pg8::Unit u2; bool ok2; int bid = (int)blockIdx.x, G = G_raw; asm volatile("" : "+s"(bid), "+s"(G));
                    if (k2 == 0) { InProjOrder S; S.init(M, INW, G, bid); ok2 = S.next(0, u2); } else { pg8::StaticOrder S; S.init(M, N2, G, bid); ok2 = S.next(0, u2); }
                    GAS unsigned char* wsg = (GAS unsigned char*)args.ws; asm volatile("" : "+s"(wsg));
                    if (ok2) pg8::gemm_prefetch_b(lds, (const bf16*)((const unsigned char*)wsg + WS_W + (size_t)l2 * W_LAYER + wo2), K2, u2.pn, wave_s); }
            }
            xcd_barrier_tail(bar);
#ifdef DBG_EXTRA_BAR
            for (int z = 0; z < DBG_EXTRA_BAR; ++z) xcd_barrier(bar);
#endif
        }
    }
}


#if defined(DBG_NAIVE_DOWN)
__global__ void __launch_bounds__(256) dbg_down(const bf16* ACT, const float* Wd, const float* X1, float* out) {
    __shared__ float a[4][DFF];
    const int r0 = blockIdx.x * 4, c = threadIdx.x * 4;
    for (int i = threadIdx.x; i < 4 * DFF; i += 256) a[i / DFF][i % DFF] = bf2f(ACT[(size_t)(r0 + i / DFF) * DFF + i % DFF]);
    __syncthreads();
    f32x4 acc[4]; for (int r = 0; r < 4; ++r) acc[r] = (f32x4){0.f, 0.f, 0.f, 0.f};
    for (int k = 0; k < DFF; ++k) { const f32x4 w = *(const f32x4*)(Wd + (size_t)k * DM + c);
        for (int r = 0; r < 4; ++r) acc[r] += w * a[r][k]; }
    for (int r = 0; r < 4; ++r) { const size_t off = (size_t)(r0 + r) * DM + c; *(f32x4*)(out + off) = *(const f32x4*)(X1 + off) + acc[r]; }
}
#endif

#if defined(DBG_FFNCMP)
constexpr int DBG_R = 512;
__global__ void __launch_bounds__(256) dbg_gu(const float* X1, const float* g2, const float* Wg, const float* Wu, float* GU) {
    __shared__ float h[DM];
    const int r = blockIdx.x, c = blockIdx.y * 256 + threadIdx.x;
    float ss = 0.f; for (int k = threadIdx.x; k < DM; k += 256) { const float v = X1[(size_t)r * DM + k]; ss += v * v; }
    __shared__ float red[256]; red[threadIdx.x] = ss; __syncthreads();
    for (int o = 128; o > 0; o >>= 1) { if (threadIdx.x < o) red[threadIdx.x] += red[threadIdx.x + o]; __syncthreads(); }
    const float rstd = rsqrtf(red[0] / DM + EPS);
    for (int k = threadIdx.x; k < DM; k += 256) h[k] = X1[(size_t)r * DM + k] * rstd * g2[k];
    __syncthreads();
    if (c < DFF) { float a = 0.f, b = 0.f; for (int k = 0; k < DM; ++k) { a += h[k] * Wg[(size_t)k * DFF + c]; b += h[k] * Wu[(size_t)k * DFF + c]; }
        GU[((size_t)r * 2 + 0) * DFF + c] = a; GU[((size_t)r * 2 + 1) * DFF + c] = b; }
}
__global__ void __launch_bounds__(256) dbg_cmp(const float* GU, const float* cw, const float* cb, const bf16* ACT, float* acc2) {
    const int r = blockIdx.x, c = blockIdx.y * 256 + threadIdx.x; float num = 0.f, den = 0.f;
    if (c < DFF) { const float g0 = GU[((size_t)r * 2) * DFF + c], g1 = r >= 1 ? GU[((size_t)(r - 1) * 2) * DFF + c] : 0.f, g2 = r >= 2 ? GU[((size_t)(r - 2) * 2) * DFF + c] : 0.f;
#if defined(DBG_TAPS) && DBG_TAPS == 0
        const float cv = cb[c] + cw[2 * DFF + c] * g0;
#elif defined(DBG_TAPS) && DBG_TAPS == 1
        const float cv = cb[c] + cw[DFF + c] * g1 + cw[2 * DFF + c] * g0;
#else
        const float cv = cb[c] + cw[c] * g2 + cw[DFF + c] * g1 + cw[2 * DFF + c] * g0;
#endif
        const float ref = cv / (1.0f + expf(-cv)) * GU[((size_t)r * 2 + 1) * DFF + c];
        const float mine = bf2f(ACT[(size_t)r * DFF + c]);
#if DBG_FFNCMP == 2
        if ((r & 63) < 2) { num = (mine - ref) * (mine - ref); den = ref * ref; }
#elif DBG_FFNCMP == 3
        if ((r & 63) >= 2) { num = (mine - ref) * (mine - ref); den = ref * ref; }
#else
        num = (mine - ref) * (mine - ref); den = ref * ref;
#endif
    }
    __shared__ float rn[256], rd[256]; rn[threadIdx.x] = num; rd[threadIdx.x] = den; __syncthreads();
    for (int o = 128; o > 0; o >>= 1) { if (threadIdx.x < o) { rn[threadIdx.x] += rn[threadIdx.x + o]; rd[threadIdx.x] += rd[threadIdx.x + o]; } __syncthreads(); }
    if (threadIdx.x == 0) { atomicAdd(acc2, rn[0]); atomicAdd(acc2 + 1, rd[0]); }
}
__global__ void dbg_emit(const float* acc2, float* out) { out[0] = 1000.0f * sqrtf(acc2[0] / acc2[1]); }
#endif

#if defined(DBG_MIXCMP)
__global__ void __launch_bounds__(256) dbg_mixcmp(const bf16* A, const bf16* R, int c0, int c1, float* acc2) {
    float num = 0.f, den = 0.f;
    for (size_t r = blockIdx.x; r < (size_t)M; r += gridDim.x)
        for (int c = c0 + threadIdx.x; c < c1; c += 256) { const float a = bf2f(A[r * DM + c]), b = bf2f(R[r * DM + c]); num += (a - b) * (a - b); den += b * b; }
    __shared__ float rn[256], rd[256]; rn[threadIdx.x] = num; rd[threadIdx.x] = den; __syncthreads();
    for (int o = 128; o > 0; o >>= 1) { if (threadIdx.x < o) { rn[threadIdx.x] += rn[threadIdx.x + o]; rd[threadIdx.x] += rd[threadIdx.x + o]; } __syncthreads(); }
    if (threadIdx.x == 0) { atomicAdd(acc2, rn[0]); atomicAdd(acc2 + 1, rd[0]); }
}
__global__ void dbg_emit2(const float* acc2, float* out) { out[0] = 1000.0f * sqrtf(acc2[0] / acc2[1]); }
#endif
#if defined(DBG_TIMEC)
__global__ void dbg_emit3(const float* dv, float* out) { out[0] = 10.0f * (floorf(log2f(dv[4]) * 4.0f) * 0.25f - 8.0f); }
#endif
#ifndef MK_PER_PHASE
#define MK_PER_PHASE 0
#endif
extern "C" void kernel_launch(void* const* d_in, const int* in_sizes, int n_in, void* d_out, int out_size, void* d_ws, size_t ws_size, hipStream_t stream) {
    static int grid = 0;
    if (grid == 0) {
        if (n_in != 19 || in_sizes[0] != M * DM || out_size != M * DM || ws_size < WS_END) { fprintf(stderr, "kernel_launch: unexpected shapes (n_in %d, in0 %d, out %d, ws %zu)\n", n_in, n_in > 0 ? in_sizes[0] : -1, out_size, ws_size); grid = -1; return; }
        int dev = 0, cus = 0;
        if (hipGetDevice(&dev) != hipSuccess || hipDeviceGetAttribute(&cus, hipDeviceAttributeMultiprocessorCount, dev) != hipSuccess) { grid = -1; return; }
        if (hipFuncSetAttribute((const void*)fwd_kernel, hipFuncAttributeMaxDynamicSharedMemorySize, LDS_BYTES) != hipSuccess) { fprintf(stderr, "kernel_launch: hipFuncSetAttribute failed\n"); grid = -1; return; }
        int per_cu = 0;
        if (hipOccupancyMaxActiveBlocksPerMultiprocessor(&per_cu, (const void*)fwd_kernel, NWAVES * 64, LDS_BYTES) != hipSuccess || per_cu < 1) { fprintf(stderr, "kernel_launch: occupancy query reports %d blocks per CU\n", per_cu); }
        (void)hipGetLastError();
        grid = cus < 256 ? cus : 256;
    }
    if (grid < 0) return;
    (void)hipMemsetAsync((char*)d_ws + WS_CTL, 0, CTL_ZERO_BYTES, stream);
    Params a{};
    for (int i = 0; i < 19; ++i) a.in[i] = (const float*)d_in[i];
    a.out = (float*)d_out; a.ws = (unsigned char*)d_ws;
    for (int n = 0; n < 128; ++n) {
        int bkt;
        if (n < 16) bkt = n; else { const float v = logf((float)n / 16.0f) / (float)log(128.0 / 16.0) * 16.0f; bkt = 16 + (int)v; if (bkt > 31) bkt = 31; }
        a.bucket[n] = (unsigned char)bkt;
    }
#if MK_PER_PHASE
    for (int ph = 0; ph < N_PHASES; ++ph) { a.ph_lo = ph; a.ph_hi = ph + 1; hipLaunchKernelGGL(fwd_kernel, dim3(grid), dim3(NWAVES * 64), LDS_BYTES, stream, a); }
#elif defined(DBG_MIXCMP)
    { float* acc2 = (float*)((char*)d_ws + WS_TAB + 65536); (void)hipMemsetAsync(acc2, 0, 8, stream);
      a.ph_lo = 0; a.ph_hi = 4; a.flags = 1; a.bar_region = 0;
      hipLaunchKernelGGL(fwd_kernel, dim3(grid), dim3(NWAVES * 64), LDS_BYTES, stream, a);
      (void)hipMemcpyAsync((char*)d_ws + WS_X1, (char*)d_ws + WS_MIXED, (size_t)M * DM * 2, hipMemcpyDeviceToDevice, stream);
      (void)hipMemsetAsync((char*)d_ws + WS_MIXED, 0, (size_t)M * DM * 2, stream);
      a.ph_lo = 2; a.ph_hi = 4; a.flags = 0; a.bar_region = 1;
      hipLaunchKernelGGL(fwd_kernel, dim3(grid), dim3(NWAVES * 64), LDS_BYTES, stream, a);
      const int c0 = (DBG_MIXCMP == 1) ? 0 : (DBG_MIXCMP == 2) ? 256 : 768, c1 = (DBG_MIXCMP == 1) ? 256 : (DBG_MIXCMP == 2) ? 768 : 1024;
      hipLaunchKernelGGL(dbg_mixcmp, dim3(1024), dim3(256), 0, stream, (const bf16*)((char*)d_ws + WS_MIXED), (const bf16*)((char*)d_ws + WS_X1), c0, c1, acc2);
      (void)hipMemcpyAsync(d_out, d_in[0], (size_t)M * DM * 4, hipMemcpyDeviceToDevice, stream);
      hipLaunchKernelGGL(dbg_emit2, dim3(1), dim3(1), 0, stream, (const float*)acc2, (float*)d_out); }
#elif defined(DBG_TIMEC)
    a.ph_lo = 0; a.ph_hi = N_PHASES;
    hipLaunchKernelGGL(fwd_kernel, dim3(grid), dim3(NWAVES * 64), LDS_BYTES, stream, a);
    (void)hipMemcpyAsync(d_out, d_in[0], (size_t)M * DM * 4, hipMemcpyDeviceToDevice, stream);
    hipLaunchKernelGGL(dbg_emit3, dim3(1), dim3(1), 0, stream, (const float*)((char*)d_ws + WS_TAB + 65536), (float*)d_out);
#elif defined(DBG_NAIVE_DOWN)
    a.ph_lo = 0; a.ph_hi = 7;
    hipLaunchKernelGGL(fwd_kernel, dim3(grid), dim3(NWAVES * 64), LDS_BYTES, stream, a);
    hipLaunchKernelGGL(dbg_down, dim3(M / 4), dim3(256), 0, stream, (const bf16*)((char*)d_ws + WS_ACT), (const float*)d_in[I_WDOWN], (const float*)((char*)d_ws + WS_X1), (float*)d_out);
#elif defined(DBG_FFNCMP)
    a.ph_lo = 0; a.ph_hi = 7;
    hipLaunchKernelGGL(fwd_kernel, dim3(grid), dim3(NWAVES * 64), LDS_BYTES, stream, a);
    { float* GU = (float*)d_out + (size_t)16 * 1024 * 1024; float* acc2 = (float*)((char*)d_ws + WS_TAB + 65536);
      (void)hipMemsetAsync(acc2, 0, 8, stream);
      hipLaunchKernelGGL(dbg_gu, dim3(DBG_R, 11), dim3(256), 0, stream, (const float*)((char*)d_ws + WS_X1), (const float*)d_in[I_N2G], (const float*)d_in[I_WGATE], (const float*)d_in[I_WUP], GU);
      hipLaunchKernelGGL(dbg_cmp, dim3(DBG_R, 11), dim3(256), 0, stream, (const float*)GU, (const float*)d_in[I_CONVW], (const float*)d_in[I_CONVB], (const bf16*)((char*)d_ws + WS_ACT), acc2);
      (void)hipMemcpyAsync(d_out, d_in[0], (size_t)M * DM * 4, hipMemcpyDeviceToDevice, stream);
      hipLaunchKernelGGL(dbg_emit, dim3(1), dim3(1), 0, stream, (const float*)acc2, (float*)d_out); }
#elif defined(DBG_STOP)
    a.ph_lo = 0; a.ph_hi = DBG_STOP + 1;
    hipLaunchKernelGGL(fwd_kernel, dim3(grid), dim3(NWAVES * 64), LDS_BYTES, stream, a);
    { const int k = (DBG_STOP == 0) ? -1 : (DBG_STOP - 1) % PH_PER_LAYER;
      const float* src = (DBG_STOP == 0) ? (const float*)d_in[0] : ((k >= 3 && k <= 5) ? (const float*)((char*)d_ws + WS_X1) : nullptr);
      if (src) (void)hipMemcpyAsync(d_out, src, (size_t)M * DM * 4, hipMemcpyDeviceToDevice, stream); }
#else
    a.ph_lo = 0; a.ph_hi = N_PHASES;
    hipLaunchKernelGGL(fwd_kernel, dim3(grid), dim3(NWAVES * 64), LDS_BYTES, stream, a);
#endif
    const hipError_t le = hipPeekAtLastError();
    if (le != hipSuccess) fprintf(stderr, "kernel_launch: launch failed: %s\n", hipGetErrorName(le));
}
```
